# Optimizing an MI355X kernel written in HIP

```python
import jax, jax.numpy as jnp
from jax import lax
import numpy as np

D_MODEL = 1024
BATCH = 8
SEQ = 4096
DEPTH = 4
DEC_BATCH = 8
DEC_SEQ = 8192
PAST_LEN = 128

GRID_W = 64
HEAD_DIM = 64
NA_HEADS = 8
NA_WIN_H = 8
NA_WIN_W = 16
GQA_Q_HEADS = 8
GQA_KV_HEADS = 2
GQA_GROUP = GQA_Q_HEADS // GQA_KV_HEADS
Q_BLOCK = 128
ROPE_THETA = 10000.0
N_EXPERTS = 16
EC_CAPACITY = 2
D_EXPERT = 2048
NA_WIDTH = NA_HEADS * HEAD_DIM
GQA_WIDTH = GQA_Q_HEADS * HEAD_DIM
KV_WIDTH = GQA_KV_HEADS * HEAD_DIM
S_NA = 3 * NA_WIDTH
S_GQ = S_NA + GQA_WIDTH
S_GK = S_GQ + KV_WIDTH
S_GV = S_GK + KV_WIDTH
D_IN = S_GV + 2 * D_MODEL
DN_ALPHA = (2 * DEPTH) ** 0.25
DN_BETA = (8 * DEPTH) ** -0.25
LN_EPS = 1e-5
RMS_EPS = 1e-6

kernel_name = "hybrid_natten_gqa_ec_moe_encoder"

f32 = jnp.float32


def layer_norm(x, g, b):
    xf = x.astype(f32)
    mu = jnp.mean(xf, axis=-1, keepdims=True)
    xc = xf - mu
    var = jnp.mean(xc * xc, axis=-1, keepdims=True)
    return (xc * lax.rsqrt(var + LN_EPS) * g.astype(f32) + b.astype(f32)).astype(x.dtype)


def rms_norm_heads(x, g):
    xf = x.astype(f32)
    return (xf * lax.rsqrt(jnp.mean(xf * xf, axis=-1, keepdims=True) + RMS_EPS) * g.astype(f32)).astype(x.dtype)


def axial_rope_tables(S):
    t = jnp.arange(S)
    row = (t // GRID_W).astype(f32)
    col = (t % GRID_W).astype(f32)
    half = HEAD_DIM // 2
    inv_freq = ROPE_THETA ** (-jnp.arange(0, half, 2, dtype=f32) / half)
    ang_r = row[:, None] * inv_freq[None, :]
    ang_c = col[:, None] * inv_freq[None, :]
    ang = jnp.concatenate([ang_r, ang_r, ang_c, ang_c], axis=-1)
    return jnp.cos(ang), jnp.sin(ang)


def rotate_half(p):
    h = p.shape[-1] // 2
    return jnp.concatenate([-p[..., h:], p[..., :h]], axis=-1)


def apply_axial_rope(x, cos, sin):
    half = HEAD_DIM // 2
    xf = x.astype(f32)
    rot = jnp.concatenate([rotate_half(xf[..., :half]), rotate_half(xf[..., half:])], axis=-1)
    return (xf * cos[None, :, None, :] + rot * sin[None, :, None, :]).astype(x.dtype)


def neighbourhood_attention(q, k, v, rpb):
    B, S, H, dh = q.shape
    rows = S // GRID_W
    kh = min(NA_WIN_H, rows)
    grid = (B, rows, GRID_W, H, dh)
    qg = (q * dh ** -0.5).reshape(grid)
    kg = k.reshape(grid)
    vg = v.reshape(grid)
    r_all = jnp.arange(rows)
    row_start = jnp.clip(r_all - kh // 2, 0, rows - kh)
    c = jnp.arange(GRID_W)
    col_start = jnp.clip(c - NA_WIN_W // 2, 0, GRID_W - NA_WIN_W)
    col_idx = col_start[:, None] + jnp.arange(NA_WIN_W)[None, :]
    dc_idx = col_idx - c[:, None] + (NA_WIN_W - 1)
    rpb_col = rpb[:, :, dc_idx]

    def one_row(r):
        rs = row_start[r]
        q_r = lax.dynamic_index_in_dim(qg, r, axis=1, keepdims=False)
        k_rows = lax.dynamic_slice_in_dim(kg, rs, kh, axis=1)
        v_rows = lax.dynamic_slice_in_dim(vg, rs, kh, axis=1)
        k_win = k_rows[:, :, col_idx]
        v_win = v_rows[:, :, col_idx]
        dr_idx = rs + jnp.arange(kh) - r + (NA_WIN_H - 1)
        bias = jnp.take(rpb_col, dr_idx, axis=1).transpose(0, 2, 1, 3)
        s = jnp.einsum('bchd,bicjhd->bhcij', q_r, k_win).astype(f32) + bias.astype(f32)[None]
        p = jax.nn.softmax(s.reshape(B, H, GRID_W, kh * NA_WIN_W), axis=-1).reshape(s.shape).astype(v.dtype)
        return jnp.einsum('bhcij,bicjhd->bchd', p, v_win)

    out = lax.map(one_row, r_all)
    return out.transpose(1, 0, 2, 3, 4).reshape(B, S, H * dh)


def gqa_block_attention(q, k, v):
    B, S, Hq, dh = q.shape
    nb = S // Q_BLOCK
    qb = (q * dh ** -0.5).reshape(B, nb, Q_BLOCK, GQA_KV_HEADS, GQA_GROUP, dh).transpose(1, 0, 2, 3, 4, 5)

    def one_block(q_blk):
        s = jnp.einsum('bqkgd,bskd->bkgqs', q_blk, k).astype(f32)
        p = jax.nn.softmax(s, axis=-1).astype(v.dtype)
        return jnp.einsum('bkgqs,bskd->bqkgd', p, v)

    out = lax.map(one_block, qb)
    return out.transpose(1, 0, 2, 3, 4, 5).reshape(B, S, Hq * dh)


def expert_choice_ffn(x, w_router, w_e_gate, w_e_up, w_e_down):
    B, S, D = x.shape
    n = B * S
    cap = EC_CAPACITY * n // N_EXPERTS
    xt = x.reshape(n, D)
    affinity = jax.nn.softmax((xt @ w_router).astype(f32), axis=-1)
    gate_val, tok_idx = lax.top_k(affinity.T, cap)
    xe = jnp.take(xt, tok_idx, axis=0)
    h = jax.nn.silu(jnp.einsum('ecd,edf->ecf', xe, w_e_gate)) * jnp.einsum('ecd,edf->ecf', xe, w_e_up)
    ye = jnp.einsum('ecf,efd->ecd', h, w_e_down) * gate_val[..., None].astype(x.dtype)
    y = jnp.zeros_like(xt).at[tok_idx.reshape(-1)].add(ye.reshape(-1, D))
    return y.reshape(B, S, D)


def trunk_layer(x, w_in, na_rpb, q_norm, k_norm, w_br_na, w_br_gqa, w_out, ln1_g, ln1_b,
                w_router, w_e_gate, w_e_up, w_e_down, ln2_g, ln2_b):
    B, S, _ = x.shape
    proj = x @ w_in
    na_qkv, gq, gk, gv, gate_logits = jnp.split(proj, [S_NA, S_GQ, S_GK, S_GV], axis=-1)
    na_qkv = na_qkv.reshape(B, S, 3, NA_HEADS, HEAD_DIM)
    y_na = neighbourhood_attention(na_qkv[:, :, 0], na_qkv[:, :, 1], na_qkv[:, :, 2], na_rpb) @ w_br_na
    cos, sin = axial_rope_tables(S)
    q = apply_axial_rope(rms_norm_heads(gq.reshape(B, S, GQA_Q_HEADS, HEAD_DIM), q_norm), cos, sin)
    k = apply_axial_rope(rms_norm_heads(gk.reshape(B, S, GQA_KV_HEADS, HEAD_DIM), k_norm), cos, sin)
    v = gv.reshape(B, S, GQA_KV_HEADS, HEAD_DIM)
    y_gqa = gqa_block_attention(q, k, v) @ w_br_gqa
    gates = jax.nn.sigmoid(gate_logits)
    mix = (gates[..., :D_MODEL] * y_na + gates[..., D_MODEL:] * y_gqa) @ w_out
    x = layer_norm(DN_ALPHA * x + mix, ln1_g, ln1_b)
    x = layer_norm(DN_ALPHA * x + expert_choice_ffn(x, w_router, w_e_gate, w_e_up, w_e_down), ln2_g, ln2_b)
    return x


def setup_inputs(seed: int = 0) -> dict:
    key = jax.random.key(seed)
    ks = jax.random.split(key, 16)
    D, L, E, F = D_MODEL, DEPTH, N_EXPERTS, D_EXPERT
    nrm = lambda k, shape: jax.random.normal(k, shape, dtype=f32)
    col_scale = np.ones((D_IN,), np.float32)
    col_scale[2 * NA_WIDTH:3 * NA_WIDTH] = DN_BETA
    col_scale[S_GK:S_GV] = DN_BETA
    return {
        "x_prompt": nrm(ks[0], (BATCH, SEQ, D)),
        "x_sample": nrm(ks[1], (DEC_BATCH, DEC_SEQ, D)),
        "w_in": nrm(ks[2], (L, D, D_IN)) * D ** -0.5 * jnp.asarray(col_scale),
        "na_rpb": nrm(ks[3], (L, NA_HEADS, 2 * NA_WIN_H - 1, 2 * NA_WIN_W - 1)) * 0.1,
        "q_norm": 1.0 + 0.1 * nrm(ks[4], (L, HEAD_DIM)),
        "k_norm": 1.0 + 0.1 * nrm(ks[5], (L, HEAD_DIM)),
        "w_br_na": nrm(ks[6], (L, NA_WIDTH, D)) * NA_WIDTH ** -0.5,
        "w_br_gqa": nrm(ks[7], (L, GQA_WIDTH, D)) * GQA_WIDTH ** -0.5,
        "w_out": nrm(ks[8], (L, D, D)) * D ** -0.5 * DN_BETA,
        "ln1_g": 1.0 + 0.1 * nrm(ks[9], (L, D)),
        "ln1_b": 0.02 * nrm(ks[10], (L, D)),
        "w_router": nrm(ks[11], (L, D, E)) * D ** -0.5,
        "w_e_gate": nrm(ks[12], (L, E, D, F)) * D ** -0.5,
        "w_e_up": nrm(ks[13], (L, E, D, F)) * D ** -0.5,
        "w_e_down": nrm(ks[14], (L, E, F, D)) * F ** -0.5 * DN_BETA,
        "ln2_g": 1.0 + 0.1 * nrm(ks[15], (L, D)),
        "ln2_b": 0.02 * nrm(jax.random.fold_in(ks[15], 1), (L, D)),
    }


def reference(x_prompt, x_sample, w_in, na_rpb, q_norm, k_norm, w_br_na, w_br_gqa, w_out, ln1_g, ln1_b,
              w_router, w_e_gate, w_e_up, w_e_down, ln2_g, ln2_b):
    y_prompt = x_prompt
    y_sample = x_sample
    for l in range(DEPTH):
        p = (w_in[l], na_rpb[l], q_norm[l], k_norm[l], w_br_na[l], w_br_gqa[l], w_out[l], ln1_g[l], ln1_b[l],
             w_router[l], w_e_gate[l], w_e_up[l], w_e_down[l], ln2_g[l], ln2_b[l])
        y_prompt = trunk_layer(y_prompt, *p)
        y_sample = trunk_layer(y_sample, *p)
    return (y_prompt, y_sample)
```

```cpp
#include <hip/hip_runtime.h>
#include <hip/hip_bf16.h>
#include <cstdio>
#include <cstdint>
#include <cmath>
#include <type_traits>

#ifndef MK_N_LAUNCHES
#define MK_N_LAUNCHES 1
#endif

namespace pg8 {
#define PG8_LAS __attribute__((address_space(3)))
typedef unsigned short bf16_t;
typedef short bf16x8 __attribute__((ext_vector_type(8)));
typedef float f32x4 __attribute__((ext_vector_type(4)));
typedef unsigned u32x4 __attribute__((ext_vector_type(4)));
constexpr int BM = 256, BK = 64, HALF = 128, HTB = HALF * BK * 2  , STAGE_BYTES = 8 * HTB, NXCD = 8, WGM = 8;

__host__ __device__ __forceinline__ int lds_byte(int r, int c) { const int st = (r >> 4) * 2 + (c >> 5), rr = r & 15, cc = c & 31, ob = rr * 64 + cc * 2; return st * 1024 + (ob ^ (((ob >> 9) & 1) << 5)); }
__host__ __device__ __forceinline__ void stage_rc(int b, int& R, int& C) { const int st = b / 1024, sb = b % 1024, swz = sb ^ (((sb >> 9) & 1) << 5); R = (st >> 1) * 16 + swz / 64; C = (st & 1) * 32 + (swz % 64) / 2; }
__host__ __device__ __forceinline__ int perm32(int rho) { const int n = rho >> 4, i = rho & 15; return 8 * (i >> 2) + 4 * n + (i & 3); }

struct Unit { int pm, pn; };
struct Gemm { const bf16_t* A; const bf16_t* Bt; int M, N, K; };

template <int MODE> struct TileOrder {
    int nM, nN, nwg, G, c;
    __host__ __device__ void init(int nM_, int nN_, int G_, int c_) { nM = nM_; nN = nN_; nwg = nM * nN; G = G_; c = c_; }
    __host__ __device__ bool next(int i, Unit& u) const {
        const long L = (MODE == 3) ? (long)(i >> 1) * G + c : (long)i * G + c; if (L >= nwg) return false;
        int wgid = (int)L; { const int q = nwg / NXCD, r = nwg % NXCD, xcd = wgid % NXCD, off = wgid / NXCD; wgid = (xcd < r ? xcd * (q + 1) : r * (q + 1) + (xcd - r) * q) + off; }
        const int nig = WGM * nN, gid = wgid / nig, fm = gid * WGM, gsz = (nM - fm) < WGM ? (nM - fm) : WGM;
        const int pm = fm + ((wgid % nig) % gsz), pn = (wgid % nig) / gsz;
        int grp = 0;
        if (MODE == 1) grp = pm / 384;
        if (MODE == 2) grp = pm < 256 ? (pm >> 4) : ((pm - 256) >> 5);
        if (MODE == 3) { grp = i & 1; u.pm = grp * nM + pm; u.pn = grp * nN + pn; return true; }
        u.pm = pm; u.pn = grp * nN + pn; return true;
    }
    static constexpr bool GATHER = false; const int* gidx;
    __device__ __forceinline__ void a_ready(const Unit&) const {}
    __device__ __forceinline__ void done(const Unit&) const {}
};
struct TileOrderGather : TileOrder<2> { static constexpr bool GATHER = true; };

typedef float f32x2_c __attribute__((ext_vector_type(2))); typedef __bf16 bf16x2_c __attribute__((ext_vector_type(2)));
__device__ __forceinline__ unsigned cvt_pk_bf16(float lo, float hi) { const f32x2_c v = {lo, hi}; const bf16x2_c b = __builtin_convertvector(v, bf16x2_c); return __builtin_bit_cast(unsigned, b); }
__device__ __forceinline__ u32x4 pack8(const f32x4 a, const f32x4 b) { u32x4 w; w.x = cvt_pk_bf16(a[0], a[1]); w.y = cvt_pk_bf16(a[2], a[3]); w.z = cvt_pk_bf16(b[0], b[1]); w.w = cvt_pk_bf16(b[2], b[3]); return w; }
__device__ __forceinline__ float bfbits2f(unsigned v16) { return __uint_as_float(v16 << 16); }
__device__ __forceinline__ float sigmoid_f(float v) { return __builtin_amdgcn_rcpf(1.0f + __builtin_amdgcn_exp2f(-1.4426950408889634f * v)); }
__device__ __forceinline__ f32x4 exp2_4(const f32x4 v) { return (f32x4){__builtin_amdgcn_exp2f(v[0]), __builtin_amdgcn_exp2f(v[1]), __builtin_amdgcn_exp2f(v[2]), __builtin_amdgcn_exp2f(v[3])}; }
__device__ __forceinline__ f32x4 rcp_4(const f32x4 v) { return (f32x4){__builtin_amdgcn_rcpf(v[0]), __builtin_amdgcn_rcpf(v[1]), __builtin_amdgcn_rcpf(v[2]), __builtin_amdgcn_rcpf(v[3])}; }
__device__ __forceinline__ f32x4 sigmoid_scaled4(const f32x4 a, const float cneg) { return rcp_4(exp2_4(a * cneg) + 1.0f); }

typedef unsigned u32x2 __attribute__((ext_vector_type(2)));
__device__ __forceinline__ unsigned pack4_fp8(float a, float b, float c, float d) { int w = 0; w = __builtin_amdgcn_cvt_pk_fp8_f32(a, b, w, false); w = __builtin_amdgcn_cvt_pk_fp8_f32(c, d, w, true); return (unsigned)w; }

struct EpiProj {
    static constexpr bool PERM = true, AFTER_DRAIN = false;
    bf16_t* NAQKV;
    bf16_t* RAW;
    unsigned char* GATES;
    float qscale, ascale;
    __device__ __forceinline__ void operator()(const f32x4 (&acc)[2][2][4][2], const Unit& u, int wr, int wc, int fr, int fq) const {
        const int pn = u.pn;
        const size_t row0 = (size_t)u.pm * BM + wr * 64 + fr; const int colw = wc * 32 + 8 * fq;
        if (pn < 6) {
            const float sc = (pn < 2 ? qscale : 1.0f) * ascale;
#pragma unroll
            for (int ai = 0; ai < 2; ++ai)
#pragma unroll
                for (int m = 0; m < 4; ++m)
#pragma unroll
                    for (int bj = 0; bj < 2; ++bj)
                        *(u32x4*)(NAQKV + (row0 + ai * HALF + m * 16) * 1536 + pn * BM + bj * HALF + colw) = pack8(acc[ai][bj][m][0] * sc, acc[ai][bj][m][1] * sc);
        } else if (pn < 9) {
#pragma unroll
            for (int ai = 0; ai < 2; ++ai)
#pragma unroll
                for (int m = 0; m < 4; ++m)
#pragma unroll
                    for (int bj = 0; bj < 2; ++bj) *(u32x4*)(RAW + (row0 + ai * HALF + m * 16) * 768 + (pn - 6) * BM + bj * HALF + colw) = pack8(acc[ai][bj][m][0] * ascale, acc[ai][bj][m][1] * ascale);
        } else {
#pragma unroll
            for (int ai = 0; ai < 2; ++ai)
#pragma unroll
                for (int m = 0; m < 4; ++m)
#pragma unroll
                    for (int bj = 0; bj < 2; ++bj) { f32x4 v0 = acc[ai][bj][m][0] * ascale, v1 = acc[ai][bj][m][1] * ascale;
#pragma unroll
                        for (int k = 0; k < 4; ++k) { v0[k] = sigmoid_f(v0[k]); v1[k] = sigmoid_f(v1[k]); }
                        u32x2 w8; w8.x = pack4_fp8(v0[0], v0[1], v0[2], v0[3]); w8.y = pack4_fp8(v1[0], v1[1], v1[2], v1[3]);
                        *(u32x2*)(GATES + (row0 + ai * HALF + m * 16) * 2048 + (pn - 9) * BM + bj * HALF + colw) = w8; }
        }
    }
};
struct EpiBranch {
    static constexpr bool PERM = true, AFTER_DRAIN = false;
    const unsigned char* GATES; bf16_t* Z; unsigned char* Z8; float ascale;
    template <bool G1> __device__ __forceinline__ void body8(const f32x4 (&acc)[2][2][4][2], const size_t row0, const int col0) const {
        typedef float f32x2g __attribute__((ext_vector_type(2)));
#pragma unroll
        for (int ai = 0; ai < 2; ++ai) {
            u32x2 g[4][2], z[4][2];
#pragma unroll
            for (int m = 0; m < 4; ++m)
#pragma unroll
                for (int bj = 0; bj < 2; ++bj) {
                    g[m][bj] = *(const u32x2*)(GATES + (row0 + ai * HALF + m * 16) * 2048 + (G1 ? 1024 : 0) + col0 + bj * HALF);
                    if (G1) z[m][bj] = *(const u32x2*)(Z8 + (row0 + ai * HALF + m * 16) * 1024 + col0 + bj * HALF); }
#pragma unroll
            for (int m = 0; m < 4; ++m)
#pragma unroll
                for (int bj = 0; bj < 2; ++bj) {
                    const u32x2 gw = g[m][bj];
                    const f32x2g a0 = __builtin_amdgcn_cvt_pk_f32_fp8((int)gw.x, false), a1 = __builtin_amdgcn_cvt_pk_f32_fp8((int)gw.x, true), a2 = __builtin_amdgcn_cvt_pk_f32_fp8((int)gw.y, false), a3 = __builtin_amdgcn_cvt_pk_f32_fp8((int)gw.y, true);
                    f32x4 v0 = acc[ai][bj][m][0] * ((f32x4){a0.x, a0.y, a1.x, a1.y} * ascale), v1 = acc[ai][bj][m][1] * ((f32x4){a2.x, a2.y, a3.x, a3.y} * ascale);
                    if (G1) { const u32x2 zw = z[m][bj];
                        const f32x2g b0 = __builtin_amdgcn_cvt_pk_f32_fp8((int)zw.x, false), b1 = __builtin_amdgcn_cvt_pk_f32_fp8((int)zw.x, true), b2 = __builtin_amdgcn_cvt_pk_f32_fp8((int)zw.y, false), b3 = __builtin_amdgcn_cvt_pk_f32_fp8((int)zw.y, true);
                        v0 = v0 + (f32x4){b0.x, b0.y, b1.x, b1.y}; v1 = v1 + (f32x4){b2.x, b2.y, b3.x, b3.y}; }
                    u32x2 w8; w8.x = pack4_fp8(v0[0], v0[1], v0[2], v0[3]); w8.y = pack4_fp8(v1[0], v1[1], v1[2], v1[3]);
                    *(u32x2*)(Z8 + (row0 + ai * HALF + m * 16) * 1024 + col0 + bj * HALF) = w8; }
            __builtin_amdgcn_sched_barrier(0);
        }
    }
    __device__ __forceinline__ void operator()(const f32x4 (&acc)[2][2][4][2], const Unit& u, int wr, int wc, int fr, int fq) const {
        const int grp = u.pm >= 384 ? 1 : 0, pm = u.pm - grp * 384, pn = u.pn & 3;
        if (Z8) { const size_t row0 = (size_t)pm * BM + wr * 64 + fr; const int col0 = pn * BM + wc * 32 + 8 * fq;
            if (grp) body8<true>(acc, row0, col0); else body8<false>(acc, row0, col0);
            return; }
#pragma unroll
        for (int ai = 0; ai < 2; ++ai)
#pragma unroll
            for (int m = 0; m < 4; ++m) {
                const size_t row = (size_t)pm * BM + ai * HALF + wr * 64 + m * 16 + fr;
#pragma unroll
                for (int bj = 0; bj < 2; ++bj) {
                    const int col = pn * BM + bj * HALF + wc * 32 + 8 * fq;
                    const u32x2 g = *(const u32x2*)(GATES + row * 2048 + grp * 1024 + col);
                    f32x4 v0 = acc[ai][bj][m][0], v1 = acc[ai][bj][m][1];
                    { typedef float f32x2g __attribute__((ext_vector_type(2)));
                      const f32x2g a0 = __builtin_amdgcn_cvt_pk_f32_fp8((int)g.x, false), a1 = __builtin_amdgcn_cvt_pk_f32_fp8((int)g.x, true), a2 = __builtin_amdgcn_cvt_pk_f32_fp8((int)g.y, false), a3 = __builtin_amdgcn_cvt_pk_f32_fp8((int)g.y, true);
                      v0[0] *= a0.x; v0[1] *= a0.y; v0[2] *= a1.x; v0[3] *= a1.y; v1[0] *= a2.x; v1[1] *= a2.y; v1[2] *= a3.x; v1[3] *= a3.y; }
                    bf16_t* zp = Z + row * 1024 + col;
                    if (grp) { const u32x4 z = *(const u32x4*)zp;
                        v0[0] += bfbits2f(z.x & 0xffffu); v0[1] += bfbits2f(z.x >> 16); v0[2] += bfbits2f(z.y & 0xffffu); v0[3] += bfbits2f(z.y >> 16);
                        v1[0] += bfbits2f(z.z & 0xffffu); v1[1] += bfbits2f(z.z >> 16); v1[2] += bfbits2f(z.w & 0xffffu); v1[3] += bfbits2f(z.w >> 16); }
                    *(u32x4*)zp = pack8(v0, v1);
                }
            }
    }
};
template <bool MIX8> struct EpiResid {
    static constexpr bool PERM = true, AFTER_DRAIN = false;
    float* X; float alpha, ascale; unsigned char* M8;
    __device__ __forceinline__ void operator()(const f32x4 (&acc)[2][2][4][2], const Unit& u, int wr, int wc, int fr, int fq) const {
#pragma unroll
        for (int ai = 0; ai < 2; ++ai)
#pragma unroll
            for (int m = 0; m < 4; ++m) {
                const size_t row = (size_t)u.pm * BM + ai * HALF + wr * 64 + m * 16 + fr;
#pragma unroll
                for (int bj = 0; bj < 2; ++bj) {
                    const size_t off = row * 1024 + u.pn * BM + bj * HALF + wc * 32 + 8 * fq;
                    if constexpr (MIX8) { const f32x4 m0 = acc[ai][bj][m][0] * ascale, m1 = acc[ai][bj][m][1] * ascale; u32x2 w8; w8.x = pack4_fp8(m0[0], m0[1], m0[2], m0[3]); w8.y = pack4_fp8(m1[0], m1[1], m1[2], m1[3]);
                        *(u32x2*)(M8 + off) = w8; }
                    else { float* p = X + off; const f32x4 x0 = *(const f32x4*)p, x1 = *(const f32x4*)(p + 4);
                        *(f32x4*)p = x0 * alpha + acc[ai][bj][m][0] * ascale; *(f32x4*)(p + 4) = x1 * alpha + acc[ai][bj][m][1] * ascale; }
                }
            }
    }
};
template <bool FP8OUT> struct EpiSwiGLU {
    static constexpr bool PERM = true, AFTER_DRAIN = false;
    void* H; float ascale;
    __device__ __forceinline__ void operator()(const f32x4 (&acc)[2][2][4][2], const Unit& u, int wr, int wc, int fr, int fq) const {
        const int pn = u.pn & 15;
#pragma unroll
        for (int ai = 0; ai < 2; ++ai)
#pragma unroll
            for (int m = 0; m < 4; ++m) {
                const size_t row = (size_t)u.pm * BM + ai * HALF + wr * 64 + m * 16 + fr;
                const float cneg = -1.4426950408889634f * ascale, s2 = ascale * ascale;
                const f32x4 h0 = (acc[ai][0][m][0] * acc[ai][1][m][0]) * (sigmoid_scaled4(acc[ai][0][m][0], cneg) * s2);
                const f32x4 h1 = (acc[ai][0][m][1] * acc[ai][1][m][1]) * (sigmoid_scaled4(acc[ai][0][m][1], cneg) * s2);
                const size_t off = row * 2048 + pn * HALF + wc * 32 + 8 * fq;
                if (FP8OUT) { u32x2 w; w.x = pack4_fp8(h0[0], h0[1], h0[2], h0[3]); w.y = pack4_fp8(h1[0], h1[1], h1[2], h1[3]); *(u32x2*)((unsigned char*)H + off) = w; }
                else *(u32x4*)((bf16_t*)H + off) = pack8(h0, h1);
            }
    }
};
template <bool FP8OUT> struct EpiDown {
    static constexpr bool PERM = true, AFTER_DRAIN = false;
    void* YE; float ascale;
    __device__ __forceinline__ void operator()(const f32x4 (&acc)[2][2][4][2], const Unit& u, int wr, int wc, int fr, int fq) const {
        const int pn = u.pn & 3;
#pragma unroll
        for (int ai = 0; ai < 2; ++ai)
#pragma unroll
            for (int m = 0; m < 4; ++m) {
                const size_t row = (size_t)u.pm * BM + ai * HALF + wr * 64 + m * 16 + fr;
#pragma unroll
                for (int bj = 0; bj < 2; ++bj)
                { const f32x4 v0 = acc[ai][bj][m][0] * ascale, v1 = acc[ai][bj][m][1] * ascale; const size_t off = row * 1024 + pn * BM + bj * HALF + wc * 32 + 8 * fq;
                  if (FP8OUT) { u32x2 w8; w8.x = pack4_fp8(v0[0], v0[1], v0[2], v0[3]); w8.y = pack4_fp8(v1[0], v1[1], v1[2], v1[3]); *(u32x2*)((unsigned char*)YE + off) = w8; }
                  else *(u32x4*)((bf16_t*)YE + off) = pack8(v0, v1); }
            }
    }
};

template <class Epi, class Sched, bool ALIGN_EPI = false, bool SP2 = false, bool FP8 = false>
__device__ __forceinline__ void gemm_phase(PG8_LAS unsigned char* lds, const Gemm g, const Sched& S, const Epi& E) {
    int tid_ = threadIdx.x; asm volatile("" : "+v"(tid_));
    const int tid = tid_, wid = __builtin_amdgcn_readfirstlane(tid >> 6), lane = tid & 63, wr = wid >> 2, wc = wid & 3, fr = lane & 15, fq = lane >> 4;
    const int K = g.K, nt = K / BK;
    unsigned voffA[2], voffB[2]; int gR[2]; unsigned gC[2];
#pragma unroll
    for (int i = 0; i < 2; ++i) { int R, C; stage_rc(tid * 16 + i * 8192, R, C); const int Rb = Epi::PERM ? ((R & ~31) + perm32(R & 31)) : R;
        voffA[i] = (unsigned)(R * K + C) * 2u; voffB[i] = (unsigned)(Rb * K + C) * 2u; gR[i] = R; gC[i] = (unsigned)C * 2u; }
    constexpr bool GATH = Sched::GATHER; static_assert(!GATH || SP2, "the gather variant is written for the SP2 loop");
    unsigned oc[2][2] = {{0u, 0u}, {0u, 0u}}, on[2][2] = {{0u, 0u}, {0u, 0u}};
#define PG8_GOFF(o, unit) do { _Pragma("unroll") for (int _h = 0; _h < 2; ++_h) _Pragma("unroll") for (int _i = 0; _i < 2; ++_i) \
        (o)[_h][_i] = (unsigned)S.gidx[(unit).pm * BM + _h * HALF + gR[_i]] * (unsigned)(K * 2) + gC[_i]; } while (0)
    const size_t kstep = (size_t)(BK * 2);
    const size_t hstep = (size_t)HALF * K * 2;
    const size_t tstep = 2 * hstep;
    const unsigned ldsw = (unsigned)wid * 1024u;
    const int aoff = lds_byte(wr * 64 + fr, fq * 8), boff = lds_byte(wc * 32 + fr, fq * 8);
    typedef int i32x4_t __attribute__((ext_vector_type(4))); typedef int i32x8_t __attribute__((ext_vector_type(8)));
    int sc8 = 0x7F7F7F7F; asm volatile("" : "+v"(sc8));
#define PG8_SA(b, h) (((b) * 2 + (h)) * HTB)
#define PG8_SB(b, h) ((4 + (b) * 2 + (h)) * HTB)
#define PG8_STAGE(bufoff, gbase, voff) do { _Pragma("unroll") for (int _i = 0; _i < 2; ++_i) \
        __builtin_amdgcn_global_load_lds((const unsigned*)((const char*)(gbase) + (voff)[_i]), (PG8_LAS unsigned*)(lds + (bufoff) + ldsw + _i * 8192), 16, 0, 0); } while (0)
#define PG8_LD32(p) __builtin_shufflevector(*(const PG8_LAS i32x4_t*)(p), *(const PG8_LAS i32x4_t*)((p) + 1024), 0, 1, 2, 3, 4, 5, 6, 7)
#define PG8_LDA(dst, b, h) do { if constexpr (FP8) { _Pragma("unroll") for (int m = 0; m < 4; ++m) dst##8[m] = PG8_LD32(lds + PG8_SA(b, h) + aoff + m * 2048); } else { \
        _Pragma("unroll") for (int m = 0; m < 4; ++m) _Pragma("unroll") for (int k = 0; k < 2; ++k) dst[m][k] = *(const PG8_LAS bf16x8*)(lds + PG8_SA(b, h) + aoff + m * 2048 + k * 1024); } } while (0)
#define PG8_LDB(dst, b, h) do { if constexpr (FP8) { _Pragma("unroll") for (int n = 0; n < 2; ++n) dst##8[n] = PG8_LD32(lds + PG8_SB(b, h) + boff + n * 2048); } else { \
        _Pragma("unroll") for (int n = 0; n < 2; ++n) _Pragma("unroll") for (int k = 0; k < 2; ++k) dst[n][k] = *(const PG8_LAS bf16x8*)(lds + PG8_SB(b, h) + boff + n * 2048 + k * 1024); } } while (0)
#define PG8_MMA(ai, bj, At, Bt) do { __builtin_amdgcn_s_setprio(1); if constexpr (FP8) { _Pragma("unroll") for (int m = 0; m < 4; ++m) _Pragma("unroll") for (int n = 0; n < 2; ++n) \
        asm volatile("v_mfma_scale_f32_16x16x128_f8f6f4 %0, %1, %2, %0, %3, %3 op_sel_hi:[0,0,0]" : "+v"(acc[ai][bj][m][n]) : "v"(Bt##8[n]), "v"(At##8[m]), "v"(sc8)); } else { \
        _Pragma("unroll") for (int m = 0; m < 4; ++m) _Pragma("unroll") for (int n = 0; n < 2; ++n) _Pragma("unroll") for (int k = 0; k < 2; ++k) \
        acc[ai][bj][m][n] = __builtin_amdgcn_mfma_f32_16x16x32_bf16(Bt[n][k], At[m][k], acc[ai][bj][m][n], 0, 0, 0); } __builtin_amdgcn_s_setprio(0); } while (0)
#define PG8_WAIT_V(n) asm volatile("s_waitcnt vmcnt(" #n ")" ::: "memory")
#define PG8_WAIT_L(n) asm volatile("s_waitcnt lgkmcnt(" #n ")" ::: "memory")
#define PG8_BAR __builtin_amdgcn_s_barrier()
#define PG8_SCHED __builtin_amdgcn_sched_barrier(0)
    Unit cur, nxt; int ui = 0;
    if (!S.next(0, cur)) return;
    f32x4 acc[2][2][4][2];
#pragma unroll
    for (int a = 0; a < 2; ++a)
#pragma unroll
        for (int b = 0; b < 2; ++b)
#pragma unroll
            for (int m = 0; m < 4; ++m)
#pragma unroll
                for (int n = 0; n < 2; ++n) acc[a][b][m][n] = (f32x4){0.f, 0.f, 0.f, 0.f};
    bf16x8 At[4][2], B0[2][2], B1[2][2]; i32x8_t At8[4], B08[2], B18[2];
    const char* const gA = (const char*)g.A;
    const char* cA = (const char*)g.A + (size_t)cur.pm * tstep; const char* cB = (const char*)g.Bt + (size_t)cur.pn * tstep;
    S.a_ready(cur);
    if constexpr (SP2) {
        if constexpr (GATH) { PG8_GOFF(oc, cur); }
        PG8_STAGE(PG8_SB(0, 0), cB, voffB); PG8_STAGE(PG8_SB(0, 1), cB + hstep, voffB);
        if constexpr (GATH) { PG8_STAGE(PG8_SA(0, 0), gA, oc[0]); PG8_STAGE(PG8_SA(0, 1), gA, oc[1]); } else { PG8_STAGE(PG8_SA(0, 0), cA, voffA); PG8_STAGE(PG8_SA(0, 1), cA + hstep, voffA); }
        if (wr == 1) PG8_BAR;
        PG8_WAIT_V(2); PG8_BAR;
        PG8_STAGE(PG8_SB(1, 0), cB + kstep, voffB); if constexpr (GATH) { PG8_STAGE(PG8_SA(1, 0), gA + kstep, oc[0]); } else { PG8_STAGE(PG8_SA(1, 0), cA + kstep, voffA); } PG8_STAGE(PG8_SB(1, 1), cB + hstep + kstep, voffB);
        PG8_WAIT_V(6); PG8_BAR;
    } else {
        PG8_STAGE(PG8_SB(0, 0), cB, voffB); PG8_STAGE(PG8_SA(0, 0), cA, voffA); PG8_STAGE(PG8_SB(0, 1), cB + hstep, voffB); PG8_STAGE(PG8_SA(0, 1), cA + hstep, voffA);
        if (wr == 1) PG8_BAR;
        PG8_WAIT_V(4); PG8_BAR;
        PG8_STAGE(PG8_SB(1, 0), cB + kstep, voffB); PG8_STAGE(PG8_SA(1, 0), cA + kstep, voffA); PG8_STAGE(PG8_SB(1, 1), cB + hstep + kstep, voffB);
        PG8_WAIT_V(6); PG8_BAR;
    }
    for (;;) {
        const bool has_next = S.next(ui + 1, nxt);
        if constexpr (GATH) { if (has_next) { PG8_GOFF(on, nxt); } else { _Pragma("unroll") for (int _h = 0; _h < 2; ++_h) _Pragma("unroll") for (int _i = 0; _i < 2; ++_i) on[_h][_i] = oc[_h][_i]; } }
        const char* nA = has_next ? (const char*)g.A + (size_t)nxt.pm * tstep : cA; const char* nB = has_next ? (const char*)g.Bt + (size_t)nxt.pn * tstep : cB;
        for (int t = 0; t < nt; t += 2) {
            const bool last = (t == nt - 2);
            const char* a1 = cA + (size_t)(t + 1) * kstep;
            const char* a2 = last ? nA : cA + (size_t)(t + 2) * kstep; const char* b2 = last ? nB : cB + (size_t)(t + 2) * kstep;
            const char* a3 = a2 + kstep; const char* b3 = b2 + kstep;
            if (last && has_next) S.a_ready(nxt);
            const char* ga1 = gA + (size_t)(t + 1) * kstep; const char* ga2 = last ? gA : gA + (size_t)(t + 2) * kstep;
            unsigned os0[2], os1[2];
            if constexpr (GATH) { os0[0] = last ? on[0][0] : oc[0][0]; os0[1] = last ? on[0][1] : oc[0][1]; os1[0] = last ? on[1][0] : oc[1][0]; os1[1] = last ? on[1][1] : oc[1][1]; }
            if constexpr (SP2) {
            PG8_LDB(B0, 0, 0); PG8_LDB(B1, 0, 1); PG8_SCHED; PG8_LDA(At, 0, 0); if constexpr (GATH) { PG8_STAGE(PG8_SA(1, 1), ga1, oc[1]); } else { PG8_STAGE(PG8_SA(1, 1), a1 + hstep, voffA); }
            PG8_WAIT_V(8); PG8_WAIT_L(0); PG8_BAR; PG8_MMA(0, 0, At, B0); PG8_MMA(0, 1, At, B1); PG8_BAR; PG8_SCHED;
            PG8_LDA(At, 0, 1); PG8_STAGE(PG8_SB(0, 0), b2, voffB); PG8_STAGE(PG8_SB(0, 1), b2 + hstep, voffB); if constexpr (GATH) { PG8_STAGE(PG8_SA(0, 0), ga2, os0); } else { PG8_STAGE(PG8_SA(0, 0), a2, voffA); }
            PG8_WAIT_V(8); PG8_WAIT_L(0); PG8_BAR; PG8_MMA(1, 0, At, B0); PG8_MMA(1, 1, At, B1); PG8_BAR; PG8_SCHED;
            PG8_LDB(B0, 1, 0); PG8_LDB(B1, 1, 1); PG8_SCHED; PG8_LDA(At, 1, 0); if constexpr (GATH) { PG8_STAGE(PG8_SA(0, 1), ga2, os1); } else { PG8_STAGE(PG8_SA(0, 1), a2 + hstep, voffA); }
            PG8_WAIT_V(8); PG8_WAIT_L(0); PG8_BAR; PG8_MMA(0, 0, At, B0); PG8_MMA(0, 1, At, B1); PG8_BAR; PG8_SCHED;
            PG8_LDA(At, 1, 1); PG8_STAGE(PG8_SB(1, 0), b3, voffB); PG8_STAGE(PG8_SB(1, 1), b3 + hstep, voffB); if constexpr (GATH) { PG8_STAGE(PG8_SA(1, 0), ga2 + kstep, os0); } else { PG8_STAGE(PG8_SA(1, 0), a3, voffA); }
            PG8_WAIT_V(8); PG8_WAIT_L(0); PG8_BAR; PG8_MMA(1, 0, At, B0); PG8_MMA(1, 1, At, B1); PG8_BAR; PG8_SCHED;
            } else {
            PG8_LDB(B0, 0, 0); PG8_SCHED; PG8_LDA(At, 0, 0); PG8_STAGE(PG8_SA(1, 1), a1 + hstep, voffA);
            PG8_WAIT_L(8); PG8_BAR; PG8_WAIT_L(0); PG8_MMA(0, 0, At, B0); PG8_BAR; PG8_SCHED;
            PG8_LDB(B1, 0, 1); PG8_STAGE(PG8_SB(0, 0), b2, voffB);
            PG8_BAR; PG8_WAIT_L(0); PG8_MMA(0, 1, At, B1); PG8_BAR;
            PG8_LDA(At, 0, 1); PG8_STAGE(PG8_SA(0, 0), a2, voffA);
            PG8_BAR; PG8_WAIT_L(0); PG8_MMA(1, 0, At, B0); PG8_BAR; PG8_SCHED;
            PG8_STAGE(PG8_SB(0, 1), b2 + hstep, voffB);
            PG8_WAIT_V(6); PG8_BAR; PG8_MMA(1, 1, At, B1); PG8_BAR;
            PG8_LDB(B0, 1, 0); PG8_SCHED; PG8_LDA(At, 1, 0); PG8_STAGE(PG8_SA(0, 1), a2 + hstep, voffA);
            PG8_WAIT_L(8); PG8_BAR; PG8_WAIT_L(0); PG8_MMA(0, 0, At, B0); PG8_BAR; PG8_SCHED;
            PG8_LDB(B1, 1, 1); PG8_STAGE(PG8_SB(1, 0), b3, voffB);
            PG8_BAR; PG8_WAIT_L(0); PG8_MMA(0, 1, At, B1); PG8_BAR;
            PG8_LDA(At, 1, 1); PG8_STAGE(PG8_SA(1, 0), a3, voffA);
            PG8_BAR; PG8_WAIT_L(0); PG8_MMA(1, 0, At, B0); PG8_BAR; PG8_SCHED;
            PG8_STAGE(PG8_SB(1, 1), b3 + hstep, voffB);
            PG8_WAIT_V(6); PG8_BAR; PG8_MMA(1, 1, At, B1); PG8_BAR;
            }
        }
        if constexpr (ALIGN_EPI) { if (wr == 0) PG8_BAR; }
        if constexpr (FP8) asm volatile("s_nop 15\n\ts_nop 15" ::: "memory");
        if constexpr (!Epi::AFTER_DRAIN) { E(acc, cur, wr, wc, fr, fq); S.done(cur); }
        if (!has_next) break;
#pragma unroll
        for (int a = 0; a < 2; ++a)
#pragma unroll
            for (int b = 0; b < 2; ++b)
#pragma unroll
                for (int m = 0; m < 4; ++m)
#pragma unroll
                    for (int n = 0; n < 2; ++n) acc[a][b][m][n] = (f32x4){0.f, 0.f, 0.f, 0.f};
        cur = nxt; cA = nA; cB = nB; ++ui;
        if constexpr (GATH) { _Pragma("unroll") for (int _h = 0; _h < 2; ++_h) _Pragma("unroll") for (int _i = 0; _i < 2; ++_i) oc[_h][_i] = on[_h][_i]; }
        if constexpr (ALIGN_EPI) { if (wr == 1) PG8_BAR; }
    }
    PG8_WAIT_V(0);
    if constexpr (!ALIGN_EPI) { if (wr == 0) PG8_BAR; }
    PG8_BAR;
    if constexpr (Epi::AFTER_DRAIN) { E.fused(acc, cur, wr, wc, fr, fq, lds, wid, lane); S.done(cur); }
#undef PG8_SA
#undef PG8_SB
#undef PG8_STAGE
#undef PG8_LDA
#undef PG8_LDB
#undef PG8_MMA
#undef PG8_WAIT_V
#undef PG8_WAIT_L
#undef PG8_BAR
#undef PG8_SCHED
#undef PG8_LD32
#undef PG8_GOFF
}

}

namespace attn_body {

using bf16=__hip_bfloat16;
using bf16x8=__attribute__((ext_vector_type(8)))short;
using s16x4=__attribute__((ext_vector_type(4)))short;
using f32x16=__attribute__((ext_vector_type(16)))float;
using u32x4=__attribute__((ext_vector_type(4)))unsigned;
constexpr int D=64,QP=768,KP=768,VP=768,OP=512;
constexpr int NW=8,QBLK=32,QB=QBLK*NW,KVBLK=64;
constexpr int ATTN_UNIT_ROWS=QB;
__device__ __forceinline__ int crow(int r,int hi){return (r&3)+8*(r>>2)+4*hi;}
#define SBAR() __builtin_amdgcn_sched_barrier(0)
constexpr int NSLOT=3, SLOTB=8192;
constexpr int LDS_K=0, LDS_V=NSLOT*SLOTB, LDS_WS=2*NSLOT*SLOTB, LDS_OST=LDS_WS+NW*64*4, LDS_BYTES=LDS_OST+NW*4096;
constexpr float C2=0.125f*1.4426950408889634f;
__device__ __forceinline__ void glds16(const void*gsrc,unsigned lds_dst){unsigned keep;
  asm volatile("s_mov_b32 %0, m0\n\ts_mov_b32 m0, %2\n\ts_nop 0\n\tglobal_load_lds_dwordx4 %1, off\n\ts_mov_b32 m0, %0":"=&s"(keep):"v"(gsrc),"s"(lds_dst):"memory");}
__device__ __forceinline__ float max3f(float a,float b,float c){float r;asm("v_max3_f32 %0, %1, %2, %3":"=v"(r):"v"(a),"v"(b),"v"(c));return r;}
__device__ __forceinline__ float max2f(float a,float b){float r;asm("v_max_f32_e32 %0, %1, %2":"=v"(r):"v"(a),"v"(b));return r;}
__device__ __forceinline__ float fadd_s(float a,float b){float r;asm("v_add_f32_e32 %0, %1, %2":"=v"(r):"v"(a),"v"(b));return r;}
__device__ __forceinline__ float fsub_s(float a,float b){float r;asm("v_sub_f32_e32 %0, %1, %2":"=v"(r):"v"(a),"v"(b));return r;}
typedef float f32x2_t __attribute__((ext_vector_type(2))); typedef __bf16 bf16x2_t __attribute__((ext_vector_type(2)));
__device__ __forceinline__ unsigned cvtpk_s(float lo,float hi){f32x2_t v={lo,hi};bf16x2_t b=__builtin_convertvector(v,bf16x2_t);return __builtin_bit_cast(unsigned,b);}
#define WAIT_BAR(N) asm volatile("s_waitcnt vmcnt(" #N ") lgkmcnt(0)\n\ts_barrier":::"memory")

__device__ __forceinline__ void qkt(f32x16&p0,f32x16&p1,const char*Kslot,const bf16x8*qr,const f32x16&negm,int r32,int hi){
  const char*kb=Kslot+hi*1024+r32*16;
  #pragma unroll
  for(int d0=0;d0<4;++d0){
    const bf16x8 b0=*reinterpret_cast<const bf16x8*>(kb+d0*2048);
    const bf16x8 b1=*reinterpret_cast<const bf16x8*>(kb+d0*2048+512);
    if(d0==0){p0=__builtin_amdgcn_mfma_f32_32x32x16_bf16(b0,qr[0],negm,0,0,0);p1=__builtin_amdgcn_mfma_f32_32x32x16_bf16(b1,qr[0],negm,0,0,0);}
    else{p0=__builtin_amdgcn_mfma_f32_32x32x16_bf16(b0,qr[d0],p0,0,0,0);p1=__builtin_amdgcn_mfma_f32_32x32x16_bf16(b1,qr[d0],p1,0,0,0);}}
}
typedef __attribute__((address_space(3))) const char* lds_cptr;
typedef short v4i16_t __attribute__((ext_vector_type(4)));
__device__ __forceinline__ void kload8(bf16x8*kf,lds_cptr kp){
  kf[0]=*(const __attribute__((address_space(3))) bf16x8*)(kp);      kf[1]=*(const __attribute__((address_space(3))) bf16x8*)(kp+512);
  kf[2]=*(const __attribute__((address_space(3))) bf16x8*)(kp+2048); kf[3]=*(const __attribute__((address_space(3))) bf16x8*)(kp+2560);
  kf[4]=*(const __attribute__((address_space(3))) bf16x8*)(kp+4096); kf[5]=*(const __attribute__((address_space(3))) bf16x8*)(kp+4608);
  kf[6]=*(const __attribute__((address_space(3))) bf16x8*)(kp+6144); kf[7]=*(const __attribute__((address_space(3))) bf16x8*)(kp+6656);
}
__device__ __forceinline__ void kload2(bf16x8*kf,lds_cptr kp,int j){ kf[2*j]=*(const __attribute__((address_space(3))) bf16x8*)(kp+j*2048); kf[2*j+1]=*(const __attribute__((address_space(3))) bf16x8*)(kp+j*2048+512); }
__device__ __forceinline__ s16x4 vtr(lds_cptr p){ return __builtin_bit_cast(s16x4,__builtin_amdgcn_ds_read_tr16_b64_v4i16((__attribute__((address_space(3))) v4i16_t*)p)); }
__device__ __forceinline__ float rowmax(const f32x16&p0,const f32x16&p1){
  float a=max3f(p0[0],p0[1],p1[0]),b=max3f(p0[2],p0[3],p1[1]);a=max3f(a,p1[2],p1[3]);
  #pragma unroll
  for(int r=4;r<16;r+=4){a=max3f(a,p0[r],p0[r+1]);b=max3f(b,p0[r+2],p0[r+3]);a=max3f(a,p1[r],p1[r+1]);b=max3f(b,p1[r+2],p1[r+3]);}
  const float m=max2f(a,b);
  auto rr=__builtin_amdgcn_permlane32_swap(__float_as_uint(m),__float_as_uint(m),false,false);
  return max2f(__uint_as_float(rr[0]),__uint_as_float(rr[1]));
}
__device__ __forceinline__ void pv(f32x16*o,int vb,bf16x8 pa0,bf16x8 pa1,bf16x8 pa2,bf16x8 pa3){
  #pragma unroll
  for(int d0=0;d0<2;++d0){s16x4 lo[4],hi[4];
    #pragma unroll
    for(int ks=0;ks<4;++ks){
      asm volatile("ds_read_b64_tr_b16 %0,%1 offset:%c2":"=&v"(lo[ks]):"v"(vb),"i"(d0*4096+ks*1024):"memory");
      asm volatile("ds_read_b64_tr_b16 %0,%1 offset:%c2":"=&v"(hi[ks]):"v"(vb),"i"(d0*4096+ks*1024+512):"memory");}
    asm volatile("s_waitcnt lgkmcnt(0)":::"memory");SBAR();
    #define PK(k) (bf16x8){lo[k][0],lo[k][1],lo[k][2],lo[k][3],hi[k][0],hi[k][1],hi[k][2],hi[k][3]}
    o[d0]=__builtin_amdgcn_mfma_f32_32x32x16_bf16(pa0,PK(0),o[d0],0,0,0);
    o[d0]=__builtin_amdgcn_mfma_f32_32x32x16_bf16(pa1,PK(1),o[d0],0,0,0);
    o[d0]=__builtin_amdgcn_mfma_f32_32x32x16_bf16(pa2,PK(2),o[d0],0,0,0);
    o[d0]=__builtin_amdgcn_mfma_f32_32x32x16_bf16(pa3,PK(3),o[d0],0,0,0);
    #undef PK
  }
}

#ifndef ATTN_STORE16
#define ATTN_STORE16(p,v) (*(u32x4*)(p)=(v))
#endif
constexpr float O8SCALE=32.f;
typedef int i32x8q __attribute__((ext_vector_type(8))); typedef int i32x4q __attribute__((ext_vector_type(4)));
#define MFMA8(a,b,c) __builtin_amdgcn_mfma_scale_f32_32x32x64_f8f6f4((a),(b),(c),0,0,0,0x7F7F7F7F,0,0x7F7F7F7F)
template<int THRL,bool NOMAX=false,bool O8=false,bool QK8=false> __device__ __forceinline__ void attn_unit(long qrow0,long kvrow0,int NT,const bf16*Qh,const bf16*__restrict__ Kh,const bf16*__restrict__ Vh,bf16*Oh,char*shm){
  int tid_=threadIdx.x; asm volatile("":"+v"(tid_)); const int tid=tid_,lane=tid&63,r32=lane&31,hi=lane>>5; const int wid=__builtin_amdgcn_readfirstlane(tid>>6);
  const bf16*Qw=Qh+(qrow0+wid*QBLK)*QP; constexpr int RB8=896, VPe=QK8?448:VP;
  const unsigned lds0=(unsigned)(uintptr_t)shm;
  float*wsf=(float*)(shm+LDS_WS)+wid*64;
  const char*ksrc=QK8?(const char*)Kh+(kvrow0+lane)*RB8+(wid&3)*16:(const char*)(Kh+(kvrow0+lane)*KP+wid*8);
  const long kstep=QK8?(long)KVBLK*RB8:(long)KVBLK*KP*2;
  const bf16*vsrc=Vh+(kvrow0+16*(wid&3)+(lane>>2))*VPe+(wid>>2)*32+(lane&3)*8;
  const unsigned kdst=lds0+LDS_K+(QK8?(wid&3):wid)*1024, vdst=lds0+LDS_V+wid*1024;
  #define DMA_K(t,slot) glds16(ksrc+(long)(t)*kstep,(unsigned)__builtin_amdgcn_readfirstlane(kdst+(slot)))
  #define DMA_V(t,slot) glds16(vsrc+(long)(t)*KVBLK*VPe,(unsigned)__builtin_amdgcn_readfirstlane(vdst+(slot)))
  const int vb0=(int)(lds0+LDS_V)+((lane>>4)&1)*32+(lane&3)*8+(4*hi+((lane&15)>>2))*64;
  const char*Kbase=shm+LDS_K; bf16x8 kf[8]; i32x8q kf8[2]; i32x8q qr8;
  const lds_cptr shm3=(lds_cptr)shm; const lds_cptr kp0=shm3+LDS_K+hi*(QK8?2048:1024)+r32*16;     const lds_cptr vp0=shm3+LDS_V+((lane>>4)&1)*32+(lane&3)*8+(4*hi+((lane&15)>>2))*64;
  DMA_K(0,0);DMA_V(0,0);DMA_K(1,SLOTB);
  bf16x8 qr[4];
  #pragma unroll
  for(int d0=0;d0<4;++d0)if constexpr(!QK8)qr[d0]=*reinterpret_cast<const bf16x8*>(&Qw[(long)r32*QP+d0*16+hi*8]);
  if constexpr(QK8){ const char*q8=(const char*)Qh+(qrow0+wid*QBLK+r32)*RB8+32*hi; const i32x4q a_=*reinterpret_cast<const i32x4q*>(q8), b_=*reinterpret_cast<const i32x4q*>(q8+16); qr8=__builtin_shufflevector(a_,b_,0,1,2,3,4,5,6,7); }
  float mhat=0.f,l_reg=0.f;f32x16 o[2];o[0]=f32x16{};o[1]=f32x16{};
  typedef float f32x4_t __attribute__((ext_vector_type(4)));
  f32x4_t lsum={0.f,0.f,0.f,0.f}; bf16x8 bones; { const short one_=((((lane>>4)&1)!=0)==((lane&15)>=8))?(short)0x3F80:(short)0; bones=(bf16x8){one_,one_,one_,one_,one_,one_,one_,one_}; }
  #define LSUM(k) do{ lsum=__builtin_amdgcn_mfma_f32_16x16x32_bf16(PAF(k),bones,lsum,0,0,0); }while(0)
f32x16 negm=f32x16{};if constexpr(!NOMAX)asm volatile("":"+v"(negm));
  #define CMASK(P0,P1,t) do{}while(0)
  bool resc=false;
  #define KLD8(blk,kp_) do{ const i32x4q a_=*(const __attribute__((address_space(3))) i32x4q*)((kp_)+(blk)*512), b_=*(const __attribute__((address_space(3))) i32x4q*)((kp_)+(blk)*512+1024); kf8[blk]=__builtin_shufflevector(a_,b_,0,1,2,3,4,5,6,7); }while(0)
  #define START(P0,P1) do{ if constexpr(!NOMAX){ const float rm=rowmax(P0,P1); resc=false; \
    { const float dl=rm; mhat=fadd_s(mhat,dl); \
      _Pragma("unroll") for(int r=0;r<16;++r){P0[r]=fsub_s(P0[r],dl);P1[r]=fsub_s(P1[r],dl);} \
      _Pragma("unroll") for(int r=0;r<16;++r)negm[r]=-mhat; asm volatile("":"+v"(negm)); } } \
    _Pragma("unroll") for(int r=0;r<16;++r)P0[r]=__builtin_amdgcn_exp2f(P0[r]); }while(0)
  #define RESC() do{ if constexpr(!NOMAX) if(resc){ asm volatile("s_waitcnt lgkmcnt(0)":::"memory"); \
      _Pragma("unroll") for(int d_=0;d_<2;++d_) _Pragma("unroll") for(int r=0;r<16;++r)o[d_][r]*=wsf[crow(r,hi)]; } }while(0)
  f32x16 pA0,pA1,pB0,pB1;
  int sl_prev=0,sl_cur=0,sl_next=SLOTB;
  #define ROT() do{sl_prev=sl_cur;sl_cur=sl_next;sl_next=(sl_next==(NSLOT-1)*SLOTB)?0:sl_next+SLOTB;}while(0)
  DMA_K(2,2*SLOTB);
  WAIT_BAR(3);
  if constexpr(QK8){ KLD8(0,kp0); KLD8(1,kp0); pA0=MFMA8(kf8[0],qr8,negm); pA1=MFMA8(kf8[1],qr8,negm); } else qkt(pA0,pA1,Kbase,qr,negm,r32,hi);
  asm volatile("s_nop 15\n\ts_nop 7":"+v"(pA0),"+v"(pA1));CMASK(pA0,pA1,0);
  START(pA0,pA1);
  if constexpr(!NOMAX){ _Pragma("unroll") for(int r=0;r<16;++r)pA1[r]=__builtin_amdgcn_exp2f(pA1[r]); }
  WAIT_BAR(0);
  DMA_K(3,0);DMA_V(1,SLOTB);
  ROT();
  if constexpr(QK8){ KLD8(0,kp0+sl_cur); KLD8(1,kp0+sl_cur); } else kload8(kf,kp0+sl_cur);
  WAIT_BAR(2);
  s16x4 vlo[8],vhi[8]; u32x4 pw0,pw1,pw2,pw3;
  #define PKW(P,B) cvtpk_s(P[B],P[B+1])
  #define PAF(k) __builtin_bit_cast(bf16x8,pw##k)
  #define VFR(i) (bf16x8){vlo[i][0],vlo[i][1],vlo[i][2],vlo[i][3],vhi[i][0],vhi[i][1],vhi[i][2],vhi[i][3]}
  #define PIN(x) asm volatile("":"+v"(x))
  #define MX3(a,b,c) __builtin_fmaxf(__builtin_fmaxf((a),(b)),(c))
  #define GAPA(MF,A0,A1,A2,A3,W0,W1,PW) do{ MF; sacc+=A0; sacc+=A1; sacc+=A2; sacc+=A3; PIN(sacc); W0; W1; PIN(PW); SBAR(); }while(0)
  #define EX(v) __builtin_amdgcn_exp2f(v)
  #define QKM(E8,E16) do{ if constexpr(QK8){ E8; } else { E16; } }while(0)
  #define GAPB(MF,X,B) do{ MF; X[B]=EX(X[B]); X[B+1]=EX(X[B+1]); X[B+2]=EX(X[B+2]); X[B+3]=EX(X[B+3]); PIN(X); SBAR(); }while(0)
  #define VRD(i) do{ vlo[i]=vtr(vp_+(((i)>>2)*4096+((i)&3)*1024)); vhi[i]=vtr(vp_+(((i)>>2)*4096+((i)&3)*1024+512)); }while(0)
  #define KRD(G,j) do{ if(G){ if constexpr(QK8){ if((j)<2){ KLD8((j),kp0+sl_next); SBAR(); } } else { kload2(kf,kp0+sl_next,j); SBAR(); } } }while(0)
  #define STEP(C0,C1,P0,P1,t,GK,GV,GL) do{ SBAR(); \
    const lds_cptr vp_=vp0+sl_prev; \
    VRD(0); SBAR(); float sacc=(P0[0]+P0[1]); \
    GAPA(QKM(C0=MFMA8(kf8[0],qr8,negm), C0=__builtin_amdgcn_mfma_f32_32x32x16_bf16(kf[0],qr[0],negm,0,0,0)), P0[2],P0[3],P0[4],P0[5],     pw0[0]=PKW(P0,0), pw0[1]=PKW(P0,2), pw0); \
    VRD(4); SBAR(); GAPA(QKM((void)0, C1=__builtin_amdgcn_mfma_f32_32x32x16_bf16(kf[1],qr[0],negm,0,0,0)), P0[6],P0[7],P0[8],P0[9],     pw0[2]=PKW(P0,4), pw0[3]=PKW(P0,6), pw0); \
    VRD(1); SBAR(); GAPA(QKM((void)0, C0=__builtin_amdgcn_mfma_f32_32x32x16_bf16(kf[2],qr[1],C0,0,0,0)),   P0[10],P0[11],P0[12],P0[13], pw1[0]=PKW(P0,8), pw1[1]=PKW(P0,10), pw1); \
    VRD(5); SBAR(); GAPA(QKM((void)0, C1=__builtin_amdgcn_mfma_f32_32x32x16_bf16(kf[3],qr[1],C1,0,0,0)),   P0[14],P0[15],P1[0],P1[1],   pw1[2]=PKW(P0,12),pw1[3]=PKW(P0,14), pw1); \
    VRD(2); SBAR(); GAPA(QKM(C1=MFMA8(kf8[1],qr8,negm), C0=__builtin_amdgcn_mfma_f32_32x32x16_bf16(kf[4],qr[2],C0,0,0,0)),   P1[2],P1[3],P1[4],P1[5],     pw2[0]=PKW(P1,0), pw2[1]=PKW(P1,2), pw2); \
    VRD(6); SBAR(); GAPA(QKM((void)0, C1=__builtin_amdgcn_mfma_f32_32x32x16_bf16(kf[5],qr[2],C1,0,0,0)),   P1[6],P1[7],P1[8],P1[9],     pw2[2]=PKW(P1,4), pw2[3]=PKW(P1,6), pw2); \
    VRD(3); SBAR(); GAPA(QKM((void)0, C0=__builtin_amdgcn_mfma_f32_32x32x16_bf16(kf[6],qr[3],C0,0,0,0)),   P1[10],P1[11],P1[12],P1[13], pw3[0]=PKW(P1,8), pw3[1]=PKW(P1,10), pw3); \
    VRD(7); SBAR(); GAPA(QKM((void)0, C1=__builtin_amdgcn_mfma_f32_32x32x16_bf16(kf[7],qr[3],C1,0,0,0)),   P1[14],P1[15],0.f,0.f,       pw3[2]=PKW(P1,12),pw3[3]=PKW(P1,14), pw3); \
    l_reg+=sacc; \
    if(GK){DMA_K((t)+3,sl_cur);} if(GV){DMA_V((t)+1,sl_next);} \
    CMASK(C0,C1,t); \
    if constexpr(!NOMAX){ float a=MX3(C0[0],C0[1],C1[0]),b=MX3(C0[2],C0[3],C1[1]); a=MX3(a,C1[2],C1[3]); \
      _Pragma("unroll") for(int r=4;r<16;r+=4){a=MX3(a,C0[r],C0[r+1]);b=MX3(b,C0[r+2],C0[r+3]);a=MX3(a,C1[r],C1[r+1]);b=MX3(b,C1[r+2],C1[r+3]);} \
      float rm=__builtin_fmaxf(a,b); { auto rr=__builtin_amdgcn_permlane32_swap(__float_as_uint(rm),__float_as_uint(rm),false,false); rm=__builtin_fmaxf(__uint_as_float(rr[0]),__uint_as_float(rr[1])); } \
      resc=false; \
      if(__builtin_expect(__any(rm>(float)THRL),0)){ const float dl=__builtin_fmaxf(rm,0.f); mhat+=dl; \
        _Pragma("unroll") for(int r=0;r<16;++r){C0[r]-=dl;C1[r]-=dl;} \
        _Pragma("unroll") for(int r=0;r<16;++r)negm[r]=-mhat; asm volatile("":"+v"(negm)); \
        const float f=__builtin_amdgcn_exp2f(-dl); l_reg*=f; if(hi==0)wsf[r32]=f; resc=true; } } \
    SBAR(); \
    GAPB(o[0]=__builtin_amdgcn_mfma_f32_32x32x16_bf16(PAF(0),VFR(0),o[0],0,0,0), C0,0); \
    GAPB(o[1]=__builtin_amdgcn_mfma_f32_32x32x16_bf16(PAF(0),VFR(4),o[1],0,0,0), C0,4); \
    KRD(GL,0); GAPB(o[0]=__builtin_amdgcn_mfma_f32_32x32x16_bf16(PAF(1),VFR(1),o[0],0,0,0), C0,8); \
    KRD(GL,1); GAPB(o[1]=__builtin_amdgcn_mfma_f32_32x32x16_bf16(PAF(1),VFR(5),o[1],0,0,0), C0,12); \
    KRD(GL,2); GAPB(o[0]=__builtin_amdgcn_mfma_f32_32x32x16_bf16(PAF(2),VFR(2),o[0],0,0,0), C1,0); \
    KRD(GL,3); GAPB(o[1]=__builtin_amdgcn_mfma_f32_32x32x16_bf16(PAF(2),VFR(6),o[1],0,0,0), C1,4); \
    GAPB(o[0]=__builtin_amdgcn_mfma_f32_32x32x16_bf16(PAF(3),VFR(3),o[0],0,0,0), C1,8); \
    GAPB(o[1]=__builtin_amdgcn_mfma_f32_32x32x16_bf16(PAF(3),VFR(7),o[1],0,0,0), C1,12); \
    }while(0)
  #define EX2(P,B) P[B]=EX(P[B]); P[(B)+1]=EX(P[(B)+1]);
  #define GAPX(MF,EXS,W0,W1,PW,PP) do{ MF; EXS PIN(PP); W0; W1; PIN(PW); SBAR(); }while(0)
  #define GAPY(MF,X,B) do{ MF; X[B]=EX(X[B]); X[(B)+1]=EX(X[(B)+1]); PIN(X); SBAR(); }while(0)
  #define STEPX(C0,C1,P0,P1,t,GK,GV,GL) do{ SBAR(); \
    const lds_cptr vp_=vp0+sl_prev; \
    VRD(0); SBAR(); \
    GAPX(QKM(C0=MFMA8(kf8[0],qr8,negm), C0=__builtin_amdgcn_mfma_f32_32x32x16_bf16(kf[0],qr[0],negm,0,0,0)), EX2(P1,0),             pw0[0]=PKW(P0,0), pw0[1]=PKW(P0,2), pw0, P1); \
    VRD(4); SBAR(); GAPX(QKM((void)0, C1=__builtin_amdgcn_mfma_f32_32x32x16_bf16(kf[1],qr[0],negm,0,0,0)), EX2(P1,2),  pw0[2]=PKW(P0,4), pw0[3]=PKW(P0,6), pw0, P1); \
    VRD(1); SBAR(); GAPX(QKM((void)0, C0=__builtin_amdgcn_mfma_f32_32x32x16_bf16(kf[2],qr[1],C0,0,0,0)),   EX2(P1,4),  pw1[0]=PKW(P0,8), pw1[1]=PKW(P0,10), pw1, P1); \
    VRD(5); SBAR(); GAPX(QKM((void)0, C1=__builtin_amdgcn_mfma_f32_32x32x16_bf16(kf[3],qr[1],C1,0,0,0)),   EX2(P1,6),  pw1[2]=PKW(P0,12),pw1[3]=PKW(P0,14), pw1, P1); \
    VRD(2); SBAR(); GAPX(QKM(C1=MFMA8(kf8[1],qr8,negm), C0=__builtin_amdgcn_mfma_f32_32x32x16_bf16(kf[4],qr[2],C0,0,0,0)),   EX2(P1,8) EX2(P1,10),  pw2[0]=PKW(P1,0), pw2[1]=PKW(P1,2), pw2, P1); \
    VRD(6); SBAR(); GAPX(QKM((void)0, C1=__builtin_amdgcn_mfma_f32_32x32x16_bf16(kf[5],qr[2],C1,0,0,0)),   EX2(P1,12) EX2(P1,14), pw2[2]=PKW(P1,4), pw2[3]=PKW(P1,6), pw2, P1); \
    VRD(3); SBAR(); GAPX(QKM((void)0, C0=__builtin_amdgcn_mfma_f32_32x32x16_bf16(kf[6],qr[3],C0,0,0,0)),   ,           pw3[0]=PKW(P1,8), pw3[1]=PKW(P1,10), pw3, P1); \
    VRD(7); SBAR(); GAPX(QKM((void)0, C1=__builtin_amdgcn_mfma_f32_32x32x16_bf16(kf[7],qr[3],C1,0,0,0)),   ,           pw3[2]=PKW(P1,12),pw3[3]=PKW(P1,14), pw3, P1); \
    if(GK){DMA_K((t)+3,sl_cur);} if(GV){DMA_V((t)+1,sl_next);} \
    SBAR(); \
    LSUM(0); GAPY(o[0]=__builtin_amdgcn_mfma_f32_32x32x16_bf16(PAF(0),VFR(0),o[0],0,0,0), C0,0); \
    GAPY(o[1]=__builtin_amdgcn_mfma_f32_32x32x16_bf16(PAF(0),VFR(4),o[1],0,0,0), C0,2); \
    KRD(GL,0); LSUM(1); GAPY(o[0]=__builtin_amdgcn_mfma_f32_32x32x16_bf16(PAF(1),VFR(1),o[0],0,0,0), C0,4); \
    KRD(GL,1); GAPY(o[1]=__builtin_amdgcn_mfma_f32_32x32x16_bf16(PAF(1),VFR(5),o[1],0,0,0), C0,6); \
    KRD(GL,2); LSUM(2); GAPY(o[0]=__builtin_amdgcn_mfma_f32_32x32x16_bf16(PAF(2),VFR(2),o[0],0,0,0), C0,8); \
    KRD(GL,3); GAPY(o[1]=__builtin_amdgcn_mfma_f32_32x32x16_bf16(PAF(2),VFR(6),o[1],0,0,0), C0,10); \
    LSUM(3); GAPY(o[0]=__builtin_amdgcn_mfma_f32_32x32x16_bf16(PAF(3),VFR(3),o[0],0,0,0), C0,12); \
    GAPY(o[1]=__builtin_amdgcn_mfma_f32_32x32x16_bf16(PAF(3),VFR(7),o[1],0,0,0), C0,14); \
    }while(0)
  #define STEPS(C0,C1,P0,P1,t,GK,GV,GL) do{ if constexpr(NOMAX) STEPX(C0,C1,P0,P1,t,GK,GV,GL); else STEP(C0,C1,P0,P1,t,GK,GV,GL); }while(0)
  int t=1;
  #undef CMASK
  #define CMASK(P0,P1,t) do{}while(0)
  for(;t+5<NT;t+=2){
    STEPS(pB0,pB1,pA0,pA1,t,true,true,true);     WAIT_BAR(2); RESC(); ROT();
    STEPS(pA0,pA1,pB0,pB1,t+1,true,true,true);   WAIT_BAR(2); RESC(); ROT();
  }
  #undef CMASK
  #define CMASK(P0,P1,t) do{}while(0)
  #define ENDW(tt) do{ if((tt)+3<NT){WAIT_BAR(2);} else if((tt)+2<NT){WAIT_BAR(1);} else {WAIT_BAR(0);} }while(0)
  for(;t+1<NT;t+=2){
    STEPS(pB0,pB1,pA0,pA1,t,(t+3<NT),(t+1<NT),(t+1<NT));       ENDW(t);   RESC(); ROT();
    STEPS(pA0,pA1,pB0,pB1,t+1,(t+4<NT),(t+2<NT),(t+2<NT));     ENDW(t+1); RESC(); ROT();
  }
  STEPS(pB0,pB1,pA0,pA1,NT-1,false,false,false); RESC();
  { if constexpr(NOMAX){ _Pragma("unroll") for(int r=0;r<16;++r)pB1[r]=__builtin_amdgcn_exp2f(pB1[r]); }
    else { float sacc=pB0[0]+pB0[1]; _Pragma("unroll") for(int r=2;r<16;++r)sacc+=pB0[r]; _Pragma("unroll") for(int r=0;r<16;++r)sacc+=pB1[r]; l_reg+=sacc; }
    pw0=(u32x4){PKW(pB0,0),PKW(pB0,2),PKW(pB0,4),PKW(pB0,6)};pw1=(u32x4){PKW(pB0,8),PKW(pB0,10),PKW(pB0,12),PKW(pB0,14)};pw2=(u32x4){PKW(pB1,0),PKW(pB1,2),PKW(pB1,4),PKW(pB1,6)};pw3=(u32x4){PKW(pB1,8),PKW(pB1,10),PKW(pB1,12),PKW(pB1,14)};
    SBAR(); if constexpr(NOMAX){ LSUM(0); LSUM(1); LSUM(2); LSUM(3); } pv(o,vb0+sl_cur,PAF(0),PAF(1),PAF(2),PAF(3)); }
  #undef LSUM
  #undef QKM
  #undef KLD8
  #undef EX2
  #undef GAPX
  #undef GAPY
  #undef STEPX
  #undef STEPS
  #undef PKW
  #undef PAF
  #undef VFR
  #undef PIN
  #undef MX3
  #undef GAPA
  #undef GAPB
  #undef EX
  #undef VRD
  #undef KRD
  #undef STEP
  #undef ENDW
  if constexpr(NOMAX){ asm volatile("s_nop 7":"+v"(lsum));
    if((lane&7)==0){ const int qb_=4*(lane>>4)+16*((lane>>3)&1); wsf[32+qb_]=lsum[0]; wsf[33+qb_]=lsum[1]; wsf[34+qb_]=lsum[2]; wsf[35+qb_]=lsum[3]; }
  } else {
  {auto rr=__builtin_amdgcn_permlane32_swap(__float_as_uint(l_reg),__float_as_uint(l_reg),false,false);l_reg=__uint_as_float(rr[0])+__uint_as_float(rr[1]);}
  if(hi==0)wsf[32+r32]=l_reg; }
  asm volatile("s_waitcnt lgkmcnt(0)":::"memory");
  float rli[16];
  #pragma unroll
  for(int r=0;r<16;++r)rli[r]=__builtin_amdgcn_rcpf(wsf[32+crow(r,hi)]);
  if constexpr(O8){ unsigned char*Ow8=(unsigned char*)Oh+(qrow0+wid*QBLK)*OP; unsigned char*stg8=(unsigned char*)(shm+LDS_OST)+wid*2048;
    #pragma unroll
    for(int r=0;r<16;++r){const int orow=crow(r,hi); const float sc=rli[r]*O8SCALE;
      #pragma unroll
      for(int d0=0;d0<2;++d0)stg8[orow*64+d0*32+r32]=(unsigned char)(__builtin_amdgcn_cvt_pk_fp8_f32(o[d0][r]*sc,o[d0][r]*sc,0,false)&0xff);}
    asm volatile("s_waitcnt lgkmcnt(0)":::"memory");
    #pragma unroll
    for(int i=0;i<2;++i){const int row=i*16+(lane>>2),ch=lane&3; const u32x4 v=*(const u32x4*)(stg8+row*64+ch*16); ATTN_STORE16(Ow8+(long)row*OP+ch*16,v);}
  } else {
  bf16*Ow=Oh+(qrow0+wid*QBLK)*OP;
  { bf16*stg=(bf16*)(shm+LDS_OST)+wid*2048;
    #pragma unroll
    for(int r=0;r<16;++r){const int orow=crow(r,hi);
      #pragma unroll
      for(int d0=0;d0<2;++d0)stg[orow*64+d0*32+r32]=__float2bfloat16(o[d0][r]*rli[r]);}
    asm volatile("s_waitcnt lgkmcnt(0)":::"memory");
    #pragma unroll
    for(int i=0;i<4;++i){const int row=i*8+(lane>>3),ch=lane&7; const u32x4 v=*(const u32x4*)(stg+row*64+ch*8); ATTN_STORE16(Ow+(long)row*OP+ch*8,v);} }
  }
  asm volatile("s_waitcnt lgkmcnt(0)\n\ts_barrier":::"memory");
  #undef DMA_K
  #undef DMA_V
  #undef CMASK
  #undef START
  #undef RESC
  #undef ROT
}
constexpr int ATTN_LDS_BYTES=LDS_BYTES;
#undef SBAR
#undef WAIT_BAR
}

#ifndef DUP_MASK
#define DUP_MASK 0
#endif
#ifndef ROPE_DRY_FIRST
#define ROPE_DRY_FIRST 0
#endif
#define NREP(p) (1 + (((DUP_MASK) >> (p)) & 1))
#ifndef FP8_E1
#define FP8_E1 1
#endif
#ifndef FP8_E2
#define FP8_E2 1
#endif
#ifndef FP8_G1
#define FP8_G1 1
#endif
#ifndef FP8_OUT
#define FP8_OUT 1
#endif
#ifndef FP8_MIX
#define FP8_MIX 1
#endif
#ifndef FP8_YE
#define FP8_YE 1
#endif
#ifndef FP8_NAQK
#define FP8_NAQK 1
#endif
#ifndef FP8_QK
#define FP8_QK 1
#endif
#ifndef FP8_BR
#define FP8_BR 1
#endif
constexpr float WIN_SCALE = 64.f, WOUT_SCALE = 64.f, ATT_SCALE = 32.f, WBR_SCALE = 16.f;
static_assert(!FP8_G1 || FP8_E1, "the e4m3 activation buffer sits in the upper half of the bf16 XB region: with FP8_G1 the bf16 x1 must not be written (needs FP8_E1)");
constexpr float W1_SCALE = 64.f, W2_SCALE = 128.f;
constexpr int NWAVES = 8;
constexpr int N_LAUNCHES = MK_N_LAUNCHES;
constexpr int DM = 1024, DEPTH = 4, NP = 32768, NS = 65536, NTOK = NP + NS;
constexpr int SEQ_P = 4096, SEQ_S = 8192;
constexpr int D_IN = 4352, NE = 16, DF = 2048;
constexpr int NSLOTROWS = 2 * NTOK;
constexpr int PH_PER_LAYER = 12, N_PHASES = DEPTH * PH_PER_LAYER;
constexpr float LN_EPS = 1e-5f, RMS_EPS = 1e-6f, LOG2E = 1.4426950408889634f;
constexpr float DN_ALPHA = 1.681792830507429f;
constexpr float QSCALE = 0.125f * LOG2E;
static_assert(N_LAUNCHES == 1 || N_LAUNCHES == N_PHASES, "MK_N_LAUNCHES is 1 or 48");

constexpr size_t MiB = 1u << 20;
constexpr size_t WS_CTL = 0, CTL_ZERO_BYTES = 1 * MiB;
constexpr size_t WS_WIN = 2 * MiB;
constexpr size_t WS_WBR = WS_WIN + (size_t)D_IN * DM * 2;
constexpr size_t WS_WOUT = WS_WBR + (size_t)2 * 1024 * 512 * 2;
constexpr size_t WS_W1 = WS_WOUT + (size_t)1024 * 2048 * 2;
constexpr size_t WS_W2 = WS_W1 + (size_t)NE * 4096 * 1024 * 2;
constexpr size_t WS_XB = WS_W2 + (size_t)NE * 1024 * 2048 * 2;
constexpr size_t WS_R1 = WS_XB + (size_t)NTOK * DM * 2;
constexpr size_t WS_NAQKV = WS_R1;
constexpr size_t WS_RAWQK = WS_NAQKV + (size_t)NTOK * 1536 * 2;
constexpr size_t WS_GATES = WS_RAWQK + (size_t)NTOK * 768 * 4;
constexpr size_t WS_R1_END = WS_GATES + (size_t)NTOK * 2048 * 2;
constexpr size_t WS_H = WS_R1;
constexpr size_t WS_XB8_OLD = WS_XB + (size_t)NTOK * DM;
static_assert(WS_H + (size_t)NSLOTROWS * DF * 2 <= WS_R1_END && (!(FP8_G1 || FP8_E1) || true), "H overlay fits R1");
constexpr size_t WS_R2 = WS_R1_END;
constexpr size_t WS_ATT = WS_R2;
constexpr size_t WS_Z = WS_ATT + (size_t)2 * NTOK * 512 * 2;
constexpr size_t WS_QKVB = WS_Z + (size_t)NTOK * 1024 * 2;
constexpr size_t WS_MIX8 = WS_QKVB + (size_t)NTOK * DM;
constexpr size_t WS_R2_END = WS_Z + (size_t)NTOK * 2048 * 2;
constexpr size_t WS_XG = WS_R2;
constexpr size_t WS_YE = WS_R2;
static_assert(WS_XG + (size_t)NSLOTROWS * DM * 2 <= WS_R2_END, "XG/YE overlay fits R2");
constexpr size_t WS_AFFT = WS_R2_END;
constexpr size_t WS_SLOT = WS_AFFT + (size_t)NTOK * NE * 4;
constexpr size_t WS_IDX = WS_SLOT + (size_t)NTOK * NE * 4;
constexpr size_t WS_GVAL = WS_IDX + (size_t)NSLOTROWS * 4;
constexpr size_t WS_XB8 = WS_GVAL + (size_t)NSLOTROWS * 4;
constexpr size_t WS_END = WS_XB8 + (size_t)NTOK * DM;
static_assert(WS_END <= (size_t)2047 * MiB, "d_ws map fits under 2 GiB");
constexpr size_t WS_STATS = 1 * MiB;
constexpr int CW_BAR = 4096;

constexpr int RING_OFF = 0, RING_BYTES = 131072;
constexpr int LDSCTL_OFF = RING_BYTES, MISC_OFF = LDSCTL_OFF + 320;
constexpr int LDS_BYTES = 147456;
static_assert(MISC_OFF + 128 <= LDS_BYTES, "LDS map");

#define GAS __attribute__((address_space(1)))
#define LAS __attribute__((address_space(3)))
typedef unsigned short bf16;
typedef unsigned v4u __attribute__((ext_vector_type(4)));
typedef unsigned v2u __attribute__((ext_vector_type(2)));
typedef float f32x4 __attribute__((ext_vector_type(4)));
typedef float f32x16 __attribute__((ext_vector_type(16)));
typedef short bf16x8 __attribute__((ext_vector_type(8)));
typedef GAS unsigned gu32;
#define RLX_AGENT __ATOMIC_RELAXED, __HIP_MEMORY_SCOPE_AGENT
#define LDS_WAIT() asm volatile("s_waitcnt lgkmcnt(0)" ::: "memory")
#define VM_WAIT() asm volatile("s_waitcnt vmcnt(0)" ::: "memory")
__device__ __forceinline__ unsigned f2bf(float f) { unsigned u = __builtin_bit_cast(unsigned, f); return (u + 0x7fffu + ((u >> 16) & 1u)) >> 16; }
__device__ __forceinline__ unsigned pk2(float lo, float hi) { typedef float f32x2p __attribute__((ext_vector_type(2))); typedef __bf16 bf16x2p __attribute__((ext_vector_type(2)));
    const f32x2p v = {lo, hi}; return __builtin_bit_cast(unsigned, __builtin_convertvector(v, bf16x2p)); }
__device__ __forceinline__ float bf_lo(unsigned w) { return __uint_as_float(w << 16); }
__device__ __forceinline__ float bf_hi(unsigned w) { return __uint_as_float(w & 0xffff0000u); }


#ifndef ROPE_FUSED
#define ROPE_FUSED 1
#endif
namespace pg8 {
struct EpiProjRope {
    static constexpr bool PERM = true, AFTER_DRAIN = false;
    bf16_t* NAQKV; bf16_t* QKVB; unsigned char* GATES; const float* qn; const float* kn; PG8_LAS float* xch; float qscale, ascale;
    __device__ __forceinline__ void operator()(const f32x4 (&acc)[2][2][4][2], const Unit& u, int wr, int wc, int fr, int fq) const {
        const int pn = u.pn;
        const size_t row0 = (size_t)u.pm * BM + wr * 64 + fr; const int colw = wc * 32 + 8 * fq;
        if (pn < 6) {
            const float sc = (pn < 2 ? qscale : 1.0f) * ascale;
#pragma unroll
            for (int ai = 0; ai < 2; ++ai)
#pragma unroll
                for (int m = 0; m < 4; ++m)
#pragma unroll
                    for (int bj = 0; bj < 2; ++bj) {
                        if (FP8_NAQK) { unsigned char* const rp = (unsigned char*)NAQKV + (row0 + ai * HALF + m * 16) * 2048; const f32x4 v0 = acc[ai][bj][m][0] * sc, v1 = acc[ai][bj][m][1] * sc;
                            if (pn < 4) { u32x2 w; w.x = pack4_fp8(v0[0], v0[1], v0[2], v0[3]); w.y = pack4_fp8(v1[0], v1[1], v1[2], v1[3]); *(u32x2*)(rp + pn * BM + bj * HALF + colw) = w; }
                            else *(u32x4*)(rp + 1024 + 2 * ((pn - 4) * BM + bj * HALF + colw)) = pack8(v0, v1); }
                        else *(u32x4*)(NAQKV + (row0 + ai * HALF + m * 16) * 1536 + pn * BM + bj * HALF + colw) = pack8(acc[ai][bj][m][0] * sc, acc[ai][bj][m][1] * sc); }
        } else if (pn < 9) {
            unsigned xo_mine = (unsigned)(size_t)xch + (unsigned)(((wr * 64 + fr) * 8 + wc) * 4), xo_part = (unsigned)(size_t)xch + (unsigned)(((wr * 64 + fr) * 8 + (wc ^ 1)) * 4);
            asm volatile("" : "+v"(xo_mine), "+v"(xo_part));
            PG8_LAS float* const xm = (PG8_LAS float*)(size_t)xo_mine; PG8_LAS float* const xp = (PG8_LAS float*)(size_t)xo_part;
#pragma unroll
            for (int ai = 0; ai < 2; ++ai)
#pragma unroll
                for (int m = 0; m < 4; ++m)
#pragma unroll
                    for (int bj = 0; bj < 2; ++bj) { const f32x4 a = acc[ai][bj][m][0], b = acc[ai][bj][m][1];
                        float s = ((a[0] * a[0] + a[1] * a[1]) + (a[2] * a[2] + a[3] * a[3])) + ((b[0] * b[0] + b[1] * b[1]) + (b[2] * b[2] + b[3] * b[3]));
                        s *= ascale * ascale; s += __shfl_xor(s, 16); s += __shfl_xor(s, 32);
                        if (fq == 0) xm[(ai * HALF + m * 16) * 8 + bj * 4] = s; }
            asm volatile("s_waitcnt lgkmcnt(0)\n\ts_barrier" ::: "memory");
            const int dq = 32 * (wc & 1) + 8 * fq;
            const int off0 = (pn - 6) * BM + colw, offv = 640 + 2 * colw;
            const float* gsrc = (pn == 8 ? kn : qn) + dq; const f32x4 g0 = *(const f32x4*)gsrc, g1 = *(const f32x4*)(gsrc + 4);
            const float invf0 = (fq & 1) ? 0.01f : 1.0f;
            constexpr float RJ[8] = {1.0f, 0.5623413251903491f, 0.31622776601683794f, 0.1778279410038923f, 0.1f, 0.05623413251903491f, 0.031622776601683794f, 0.01778279410038923f};
            const float sgn = (fq & 2) ? 1.f : -1.f;
            auto rows = [&](auto kv_) __attribute__((always_inline)) { constexpr bool KV = decltype(kv_)::value;
#pragma unroll
            for (int ai = 0; ai < 2; ++ai)
#pragma unroll
                for (int m = 0; m < 4; ++m) {
                    const int rl = ai * HALF + wr * 64 + m * 16 + fr; const int R = u.pm * BM + rl;
                    const int t = R < 32768 ? (R & 4095) : ((R - 32768) & 8191);
                    const float pos = (float)((wc & 1) ? (t & 63) : (t >> 6));
                    const float pf = pos * invf0;
                    const float tot0 = xm[(ai * HALF + m * 16) * 8] + xp[(ai * HALF + m * 16) * 8], tot1 = xm[(ai * HALF + m * 16) * 8 + 4] + xp[(ai * HALF + m * 16) * 8 + 4];
                    const float rn0 = 1.0f / sqrtf(tot0 * (1.0f / 64.0f) + 1e-6f), rn1 = 1.0f / sqrtf(tot1 * (1.0f / 64.0f) + 1e-6f), osc = pn < 8 ? qscale : 1.0f;
#pragma unroll
                    for (int hk = 0; hk < 2; ++hk) {
                        float cs[4], sn[4];
#pragma unroll
                        for (int k = 0; k < 4; ++k) { const float ang = pf * RJ[4 * hk + k]; cs[k] = __cosf(ang); sn[k] = __sinf(ang); }
#pragma unroll
                        for (int bj = 0; bj < 2; ++bj) {
                            constexpr bool plain_ct = KV; const bool plain = plain_ct && bj == 1;
                            const f32x4 a = acc[ai][bj][m][hk] * ascale, y = a * (bj ? rn1 : rn0) * (hk ? g1 : g0);
                            f32x4 r;
#pragma unroll
                            for (int k = 0; k < 4; ++k) { const float p = __shfl_xor(y[k], 32); r[k] = (y[k] * cs[k] + sgn * p * sn[k]) * osc; }
                            const f32x4 o = plain ? a : r;
                            if (FP8_QK) { unsigned char* const rowp = (unsigned char*)QKVB + (size_t)R * 896 + (bj ? (KV ? offv : off0 + HALF) : off0);
                                if (plain) { u32x2 w; w.x = cvt_pk_bf16(o[0], o[1]); w.y = cvt_pk_bf16(o[2], o[3]); *(u32x2*)(rowp + 8 * hk) = w; }
                                else *(unsigned*)(rowp + 4 * hk) = pack4_fp8(o[0], o[1], o[2], o[3]); }
                            else { u32x2 w; w.x = cvt_pk_bf16(o[0], o[1]); w.y = cvt_pk_bf16(o[2], o[3]);
                            *(u32x2*)(QKVB + (size_t)R * 768 + (pn - 6) * BM + bj * HALF + colw + 4 * hk) = w; }
                        }
                    }
                    __builtin_amdgcn_sched_barrier(0);
                }
            };
            if (pn == 8) rows(std::true_type{}); else rows(std::false_type{});
        } else {
#pragma unroll
            for (int ai = 0; ai < 2; ++ai)
#pragma unroll
                for (int m = 0; m < 4; ++m)
#pragma unroll
                    for (int bj = 0; bj < 2; ++bj) { const float cneg = -1.4426950408889634f * ascale; const f32x4 v0 = sigmoid_scaled4(acc[ai][bj][m][0], cneg), v1 = sigmoid_scaled4(acc[ai][bj][m][1], cneg);
                        u32x2 w8; w8.x = pack4_fp8(v0[0], v0[1], v0[2], v0[3]); w8.y = pack4_fp8(v1[0], v1[1], v1[2], v1[3]);
                        *(u32x2*)(GATES + (row0 + ai * HALF + m * 16) * 2048 + (pn - 9) * BM + bj * HALF + colw) = w8; }
        }
    }
};
}

#define XB_TMO      128
#define XB_XCNT(j)  (256  + 64 * (j))
#define XB_XSUB(j)  (1280 + 64 * (j))
#define XB_XGEN(j)  (2304 + 64 * (j))
#define XB_TOP      3328
#define XB_TOPGEN   3392
#define XCD_BAR_WORDS 3456
#define XB_SPIN_CAP (1u << 18)

__device__ __forceinline__ unsigned xb_ld(unsigned* p)              { return __hip_atomic_load(p, __ATOMIC_RELAXED, __HIP_MEMORY_SCOPE_AGENT); }
__device__ __forceinline__ unsigned xb_add(unsigned* p, unsigned v) { return __hip_atomic_fetch_add(p, v, __ATOMIC_RELAXED, __HIP_MEMORY_SCOPE_AGENT); }
__device__ __forceinline__ unsigned xb_xcc_id() { return (unsigned)__builtin_amdgcn_s_getreg((3 << 11) | 20) & 0xFu; }
#define XB_SPIN(cond, bar) do { unsigned _sp = 0; while (cond) { __builtin_amdgcn_s_sleep(1); \
    if ((++_sp & 255u) == 0u) { if (xb_ld(&(bar)[XB_TMO])) break; if (_sp > XB_SPIN_CAP) { atomicAdd(&(bar)[XB_TMO], 1u); break; } } } } while (0)

struct XcdBarrier {
    unsigned* bar; unsigned x;
    volatile LAS unsigned* st;
};

__device__ __forceinline__ XcdBarrier xcd_barrier_post(unsigned* bar, volatile LAS unsigned* st) {
    XcdBarrier b; b.bar = bar; b.x = xb_xcc_id(); b.st = st;
    if (threadIdx.x == 0) (void)xb_add(&bar[XB_XCNT(b.x)], 1u);
    return b;
}
__device__ __forceinline__ void xcd_barrier_complete(unsigned* bar, unsigned x, unsigned& nloc, unsigned& nx) {
    const unsigned G = gridDim.x * gridDim.y * gridDim.z;
    unsigned sum, cnt, mine, sp = 0u;
    for (;;) {
        sum = 0u; cnt = 0u; mine = 0u;
#pragma unroll
        for (unsigned j = 0; j < 16; ++j) { const unsigned c = xb_ld(&bar[XB_XCNT(j)]); sum += c; cnt += (c > 0u) ? 1u : 0u; mine = (j == x) ? c : mine; }
        if (sum == G) break;
        __builtin_amdgcn_s_sleep(1);
        if ((++sp & 255u) == 0u) { if (xb_ld(&bar[XB_TMO])) break; if (sp > XB_SPIN_CAP) { atomicAdd(&bar[XB_TMO], 1u); break; } }
    }
    nloc = mine > 0u ? mine : 1u; nx = cnt > 0u ? cnt : 1u;
}

__device__ __forceinline__ void xcd_barrier(const XcdBarrier& b) {
    asm volatile("s_waitcnt vmcnt(0)" ::: "memory");
    __syncthreads();
    if (threadIdx.x == 0) {
        unsigned* bar = b.bar;
        __builtin_amdgcn_s_waitcnt(0);
        unsigned nloc = b.st[0], nx = b.st[1];
        if (nloc == 0u) { xcd_barrier_complete(bar, b.x, nloc, nx); b.st[0] = nloc; b.st[1] = nx; }
        const unsigned old = xb_add(&bar[XB_XSUB(b.x)], 1u);
        const unsigned gen = old / nloc;
        if (old + 1u == (gen + 1u) * nloc) {
            __builtin_amdgcn_fence(__ATOMIC_RELEASE, "agent");
            asm volatile("s_waitcnt vmcnt(0)" ::: "memory");
            const unsigned og = xb_add(&bar[XB_TOP], 1u);
            const unsigned tg = og / nx;
            if (og + 1u == (tg + 1u) * nx) xb_add(&bar[XB_TOPGEN], 1u);
            else XB_SPIN(xb_ld(&bar[XB_TOPGEN]) == tg, bar);
            __builtin_amdgcn_fence(__ATOMIC_ACQUIRE, "agent");
            xb_add(&bar[XB_XGEN(b.x)], 1u);
            asm volatile("s_waitcnt vmcnt(0)" ::: "memory");
        } else {
            XB_SPIN(xb_ld(&bar[XB_XGEN(b.x)]) == gen, bar);
            __builtin_amdgcn_fence(__ATOMIC_ACQUIRE, "agent");
            asm volatile("s_waitcnt vmcnt(0)" ::: "memory");
        }
    }
    __syncthreads();
}


struct Args { const float* in[17]; float* out; unsigned char* ws; int ph_lo, ph_hi; };
enum { I_XP = 0, I_XS, I_WIN, I_RPB, I_QN, I_KN, I_WNA, I_WGQ, I_WOUT, I_L1G, I_L1B, I_WR, I_WG, I_WU, I_WD, I_L2G, I_L2B };
struct Frame {
    LAS unsigned char* lds;
    int tid, lane, wave;
    int vcu, G;
};
__device__ __forceinline__ GAS unsigned char* ws_here(unsigned char* p0) { GAS unsigned char* p = (GAS unsigned char*)p0; asm volatile("" : "+s"(p)); return p; }
#define WSP(T, off) ((T*)(ws_here(A.ws) + (off)))
__device__ __forceinline__ Frame fresh_frame(const Frame& F0) {
    Frame F = F0; int t = threadIdx.x; asm volatile("" : "+v"(t)); F.tid = t; F.lane = t & 63; F.wave = __builtin_amdgcn_readfirstlane(t >> 6); return F; }

__device__ __forceinline__ float wave_sum(float v) {
#pragma unroll
    for (int o = 1; o < 64; o <<= 1) v += __shfl_xor(v, o);
    return v;
}
__device__ __forceinline__ float wave_max(float v) {
#pragma unroll
    for (int o = 1; o < 64; o <<= 1) v = fmaxf(v, __shfl_xor(v, o));
    return v;
}

__device__ __forceinline__ void conv_item(const float* W, int N, int k0, int n0, bf16* dst, int dpitch, LAS float* scr, int lane) {
#pragma unroll 8
    for (int i = 0; i < 32; ++i) { const int kk = 2 * i + (lane >> 5); scr[kk * 33 + (lane & 31)] = W[(size_t)(k0 + kk) * N + n0 + (lane & 31)]; }
    LDS_WAIT(); asm volatile("" ::: "memory");
    const int c = lane & 7;
#pragma unroll
    for (int j = 0; j < 4; ++j) { const int n = (lane >> 3) + 8 * j; const LAS float* s = scr + (8 * c) * 33 + n;
        v4u o; o.x = pk2(s[0 * 33], s[1 * 33]); o.y = pk2(s[2 * 33], s[3 * 33]); o.z = pk2(s[4 * 33], s[5 * 33]); o.w = pk2(s[6 * 33], s[7 * 33]);
        *(GAS v4u*)(dst + (size_t)n * dpitch + 8 * c) = o; }
    LDS_WAIT(); asm volatile("" ::: "memory");
}
__device__ __forceinline__ void conv8_item(const float* W, int N, int k0, int n0, unsigned char* dst, int dpitch, float scale, LAS float* scr, int lane) {
#pragma unroll 8
    for (int i = 0; i < 32; ++i) { const int kk = 2 * i + (lane >> 5); scr[kk * 33 + (lane & 31)] = W[(size_t)(k0 + kk) * N + n0 + (lane & 31)] * scale; }
    LDS_WAIT(); asm volatile("" ::: "memory");
    const int n = lane >> 1, c2 = lane & 1; const LAS float* s = scr + (32 * c2) * 33 + n;
    v4u o0, o1;
    o0.x = pg8::pack4_fp8(s[0 * 33], s[1 * 33], s[2 * 33], s[3 * 33]);     o0.y = pg8::pack4_fp8(s[4 * 33], s[5 * 33], s[6 * 33], s[7 * 33]);
    o0.z = pg8::pack4_fp8(s[8 * 33], s[9 * 33], s[10 * 33], s[11 * 33]);   o0.w = pg8::pack4_fp8(s[12 * 33], s[13 * 33], s[14 * 33], s[15 * 33]);
    o1.x = pg8::pack4_fp8(s[16 * 33], s[17 * 33], s[18 * 33], s[19 * 33]); o1.y = pg8::pack4_fp8(s[20 * 33], s[21 * 33], s[22 * 33], s[23 * 33]);
    o1.z = pg8::pack4_fp8(s[24 * 33], s[25 * 33], s[26 * 33], s[27 * 33]); o1.w = pg8::pack4_fp8(s[28 * 33], s[29 * 33], s[30 * 33], s[31 * 33]);
    GAS v4u* d = (GAS v4u*)(dst + (size_t)n * dpitch + 32 * c2);
    d[0] = o0; d[1] = o1;
    LDS_WAIT(); asm volatile("" ::: "memory");
}
struct CItem { const float* src; unsigned char* dst; int N, dpitch; float scale; int f8; };
__device__ __forceinline__ CItem conv_expert_item(const Args& A, int layer, int r) {
    constexpr int I_E = 16 * 64, I_D = 32 * 32, per_e = 2 * I_E + I_D;
    CItem c; const int e = r / per_e; r -= e * per_e;
    if (r < 2 * I_E) { const int up = r / I_E, q = r % I_E, kb = q / 64, nb = q % 64, n0 = 32 * nb;
        c.src = (up ? A.in[I_WU] : A.in[I_WG]) + ((size_t)layer * NE + e) * DM * DF + (size_t)(64 * kb) * DF + n0; c.N = DF;
        const int drow = e * 4096 + (n0 >> 7) * 256 + up * 128 + (n0 & 127);
        c.f8 = FP8_E1; c.scale = FP8_E1 ? W1_SCALE : 1.f; c.dpitch = FP8_E1 ? DM : 2 * DM;
        c.dst = WSP(unsigned char, WS_W1) + (size_t)drow * c.dpitch + (size_t)(64 * kb) * (FP8_E1 ? 1 : 2);
    } else { r -= 2 * I_E; const int kb = r / 32, nb = r % 32;
        c.src = A.in[I_WD] + ((size_t)layer * NE + e) * DF * DM + (size_t)(64 * kb) * DM + 32 * nb; c.N = DM;
        c.f8 = FP8_E2; c.scale = FP8_E2 ? W2_SCALE : 1.f; c.dpitch = FP8_E2 ? DF : 2 * DF;
        c.dst = WSP(unsigned char, WS_W2) + (size_t)(e * 1024 + 32 * nb) * c.dpitch + (size_t)(64 * kb) * (FP8_E2 ? 1 : 2);
    }
    return c;
}
__device__ __forceinline__ void conv_experts(const Args& A, const Frame& F0, int layer, int gw, int NGW) {
    const Frame F = fresh_frame(F0);
    LAS float* scr = (LAS float*)(F.lds + RING_OFF + F.wave * 16384);
    const int lane = F.lane;
    constexpr int NIT = NE * (2 * 16 * 64 + 32 * 32);
    float ra[32], rb[32]; CItem cur, nxt;
    int it = gw;
    if (it < NIT) { cur = conv_expert_item(A, layer, it);
#pragma unroll
        for (int i = 0; i < 32; ++i) ra[i] = cur.src[(size_t)(2 * i + (lane >> 5)) * cur.N + (lane & 31)]; }
#pragma unroll 1
    while (it < NIT) {
        const int it2 = it + NGW;
        if (it2 < NIT) { nxt = conv_expert_item(A, layer, it2);
#pragma unroll
            for (int i = 0; i < 32; ++i) rb[i] = nxt.src[(size_t)(2 * i + (lane >> 5)) * nxt.N + (lane & 31)]; }
#pragma unroll
        for (int i = 0; i < 32; ++i) scr[(2 * i + (lane >> 5)) * 33 + (lane & 31)] = ra[i] * cur.scale;
        LDS_WAIT(); asm volatile("" ::: "memory");
        if (cur.f8) {
            const int n = lane >> 1, c2 = lane & 1; const LAS float* s = scr + (32 * c2) * 33 + n;
            v4u o0, o1;
            o0.x = pg8::pack4_fp8(s[0 * 33], s[1 * 33], s[2 * 33], s[3 * 33]);     o0.y = pg8::pack4_fp8(s[4 * 33], s[5 * 33], s[6 * 33], s[7 * 33]);
            o0.z = pg8::pack4_fp8(s[8 * 33], s[9 * 33], s[10 * 33], s[11 * 33]);   o0.w = pg8::pack4_fp8(s[12 * 33], s[13 * 33], s[14 * 33], s[15 * 33]);
            o1.x = pg8::pack4_fp8(s[16 * 33], s[17 * 33], s[18 * 33], s[19 * 33]); o1.y = pg8::pack4_fp8(s[20 * 33], s[21 * 33], s[22 * 33], s[23 * 33]);
            o1.z = pg8::pack4_fp8(s[24 * 33], s[25 * 33], s[26 * 33], s[27 * 33]); o1.w = pg8::pack4_fp8(s[28 * 33], s[29 * 33], s[30 * 33], s[31 * 33]);
            GAS v4u* d = (GAS v4u*)(cur.dst + (size_t)n * cur.dpitch + 32 * c2);
            d[0] = o0; d[1] = o1;
        } else {
            const int c = lane & 7;
#pragma unroll
            for (int j = 0; j < 4; ++j) { const int n = (lane >> 3) + 8 * j; const LAS float* s = scr + (8 * c) * 33 + n;
                v4u o; o.x = pk2(s[0 * 33], s[1 * 33]); o.y = pk2(s[2 * 33], s[3 * 33]); o.z = pk2(s[4 * 33], s[5 * 33]); o.w = pk2(s[6 * 33], s[7 * 33]);
                *(GAS v4u*)(cur.dst + (size_t)n * cur.dpitch + 16 * c) = o; }
        }
        LDS_WAIT(); asm volatile("" ::: "memory");
#pragma unroll
        for (int i = 0; i < 32; ++i) ra[i] = rb[i];
        cur = nxt; it = it2;
    }
}
template <int PART> __device__ __forceinline__ void phase_conv(const Args& A, const Frame& F0, int layer, int gw, int NGW) {
    const Frame F = fresh_frame(F0);
    LAS float* scr = (LAS float*)(F.lds + RING_OFF + F.wave * 16384);
    constexpr int I_IN = 16 * 136, I_BR = 8 * 32, I_OUT = 16 * 32, I_E = 16 * 64  , I_D = 32 * 32  ;
    constexpr int NSMALL = I_IN + 2 * I_BR + I_OUT, NITEMS = NSMALL + NE * (2 * I_E + I_D);
    for (int it = (PART == 0 ? 0 : NSMALL) + gw; it < (PART == 0 ? NSMALL : NITEMS); it += NGW) {
        int r = it;
        if (r < I_IN) { const int kb = r / 136, nb = r % 136;
            if (FP8_G1) conv8_item(A.in[I_WIN] + (size_t)layer * DM * D_IN, D_IN, 64 * kb, 32 * nb, WSP(unsigned char, WS_WIN) + (size_t)(32 * nb) * DM + 64 * kb, DM, WIN_SCALE, scr, F.lane);
            else conv_item(A.in[I_WIN] + (size_t)layer * DM * D_IN, D_IN, 64 * kb, 32 * nb, WSP(bf16, WS_WIN) + (size_t)(32 * nb) * DM + 64 * kb, DM, scr, F.lane);
            continue; } r -= I_IN;
        if (r < I_BR) { const int kb = r / 32, nb = r % 32;
            if (FP8_BR) conv8_item(A.in[I_WNA] + (size_t)layer * 512 * DM, DM, 64 * kb, 32 * nb, WSP(unsigned char, WS_WBR) + (size_t)(32 * nb) * 512 + 64 * kb, 512, WBR_SCALE, scr, F.lane);
            else conv_item(A.in[I_WNA] + (size_t)layer * 512 * DM, DM, 64 * kb, 32 * nb, WSP(bf16, WS_WBR) + (size_t)(32 * nb) * 512 + 64 * kb, 512, scr, F.lane); continue; } r -= I_BR;
        if (r < I_BR) { const int kb = r / 32, nb = r % 32;
            if (FP8_BR) conv8_item(A.in[I_WGQ] + (size_t)layer * 512 * DM, DM, 64 * kb, 32 * nb, WSP(unsigned char, WS_WBR) + (size_t)(1024 + 32 * nb) * 512 + 64 * kb, 512, WBR_SCALE, scr, F.lane);
            else conv_item(A.in[I_WGQ] + (size_t)layer * 512 * DM, DM, 64 * kb, 32 * nb, WSP(bf16, WS_WBR) + (size_t)(1024 + 32 * nb) * 512 + 64 * kb, 512, scr, F.lane); continue; } r -= I_BR;
        if (r < I_OUT) { const int kb = r / 32, nb = r % 32;
            if (FP8_OUT) conv8_item(A.in[I_WOUT] + (size_t)layer * DM * DM, DM, 64 * kb, 32 * nb, WSP(unsigned char, WS_WOUT) + (size_t)(32 * nb) * DM + 64 * kb, DM, WOUT_SCALE, scr, F.lane);
            else conv_item(A.in[I_WOUT] + (size_t)layer * DM * DM, DM, 64 * kb, 32 * nb, WSP(bf16, WS_WOUT) + (size_t)(32 * nb) * DM + 64 * kb, DM, scr, F.lane);
            continue; } r -= I_OUT;
        const int per_e = 2 * I_E + I_D, e = r / per_e; r -= e * per_e;
        if (r < 2 * I_E) { const int up = r / I_E, q = r % I_E, kb = q / 64, nb = q % 64, n0 = 32 * nb;
            const float* src = (up ? A.in[I_WU] : A.in[I_WG]) + ((size_t)layer * NE + e) * DM * DF;
            const int drow = e * 4096 + (n0 >> 7) * 256 + up * 128 + (n0 & 127);
            if (FP8_E1) conv8_item(src, DF, 64 * kb, n0, WSP(unsigned char, WS_W1) + (size_t)drow * DM + 64 * kb, DM, W1_SCALE, scr, F.lane);
            else conv_item(src, DF, 64 * kb, n0, WSP(bf16, WS_W1) + (size_t)drow * DM + 64 * kb, DM, scr, F.lane);
            continue; }
        r -= 2 * I_E;
        { const int kb = r / 32, nb = r % 32; const float* src = A.in[I_WD] + ((size_t)layer * NE + e) * DF * DM;
          if (FP8_E2) conv8_item(src, DM, 64 * kb, 32 * nb, WSP(unsigned char, WS_W2) + (size_t)(e * 1024 + 32 * nb) * DF + 64 * kb, DF, W2_SCALE, scr, F.lane);
          else conv_item(src, DM, 64 * kb, 32 * nb, WSP(bf16, WS_W2) + (size_t)(e * 1024 + 32 * nb) * DF + 64 * kb, DF, scr, F.lane); }
    }
    if (PART == 0 && layer == 0) {
        for (int m = gw; m < NTOK; m += NGW) {
            const float* src = m < NP ? A.in[I_XP] + (size_t)m * DM : A.in[I_XS] + (size_t)(m - NP) * DM;
            const GAS f32x4* xr = (const GAS f32x4*)src + F.lane;
            GAS f32x4* xo = (GAS f32x4*)(A.out + (size_t)m * DM) + F.lane;
            GAS v2u* bo = (GAS v2u*)(WSP(bf16, WS_XB) + (size_t)m * DM) + F.lane;
#pragma unroll
            for (int j = 0; j < 4; ++j) { const f32x4 v = xr[64 * j]; if (!FP8_MIX) xo[64 * j] = v;
                if (FP8_G1) ((GAS unsigned*)(WSP(unsigned char, WS_XB8) + (size_t)m * DM))[F.lane + 64 * j] = pg8::pack4_fp8(v.x, v.y, v.z, v.w);
                else { v2u w; w.x = pk2(v.x, v.y); w.y = pk2(v.z, v.w); bo[64 * j] = w; } }
        }
    }
}

__device__ __forceinline__ int crow16(int rr, int hi) { return (rr & 3) + 8 * (rr >> 2) + 4 * hi; }
#define NA_COMPUTE1(CUR_, KR_) { \
            const LAS unsigned char* trow = (const LAS unsigned char*)(tab + ((KR_) - rA + 7) * 32) + blane; \
            f32x16 c0; \
            if (FP8_NAQK) { const attn_body::i32x4q a_ = *(const LAS attn_body::i32x4q*)((CUR_) + kroff), b_ = *(const LAS attn_body::i32x4q*)((CUR_) + kroff + 1040); c0 = MFMA8(__builtin_shufflevector(a_, b_, 0, 1, 2, 3, 4, 5, 6, 7), qf8, am0v); } else \
    _Pragma("unroll") \
            for (int ds = 0; ds < 4; ++ds) { \
                const bf16x8 k0 = *(const LAS bf16x8*)((CUR_) + kroff + ds * 2080); \
                c0 = __builtin_amdgcn_mfma_f32_32x32x16_bf16(k0, qf[ds], ds == 0 ? am0v : c0, 0, 0, 0);     \
            } \
            float mx = -INFINITY; \
    _Pragma("unroll") \
            for (int rr = 0; rr < 16; rr += 2) { \
                const float b0 = *(const LAS float*)(trow + 4 * ((rr & 3) + 8 * (rr >> 2))), b1 = *(const LAS float*)(trow + 4 * (((rr + 1) & 3) + 8 * ((rr + 1) >> 2))); \
                c0[rr] += b0; c0[rr + 1] += b1; \
                mx = fmaxf(mx, fmaxf(c0[rr], c0[rr + 1])); \
            } \
            { const auto rr_ = __builtin_amdgcn_permlane32_swap(__float_as_uint(mx), __float_as_uint(mx), false, false); mx = fmaxf(__uint_as_float(rr_[0]), __uint_as_float(rr_[1])); }     \
            const bool rowlive = ((KR_) >= rsq) && ((KR_) < rsq + 8);      \
            { const bool need = rowlive && (mx > mrun + 8.0f);     \
              if (__any(need)) { const float mnew = need ? mx : mrun, alpha = need ? __builtin_amdgcn_exp2f(mrun - mnew) : 1.0f; mrun = mnew; lrun *= alpha; \
    _Pragma("unroll") \
                for (int db = 0; db < 2; ++db) \
    _Pragma("unroll") \
                    for (int k = 0; k < 16; ++k) o[db][k] *= alpha; } } \
            const float msub = rowlive ? mrun : INFINITY;                   \
            float ps = 0.f; \
    _Pragma("unroll") \
            for (int rr = 0; rr < 16; ++rr) { c0[rr] = __builtin_amdgcn_exp2f(c0[rr] - msub); ps += c0[rr]; } \
            lrun += ps; \
            bf16x8 pb[2]; \
    _Pragma("unroll") \
            for (int s = 0; s < 2; ++s) { \
                v4u w0; \
                w0.x = pk2(c0[8 * s + 0], c0[8 * s + 1]); w0.y = pk2(c0[8 * s + 2], c0[8 * s + 3]); w0.z = pk2(c0[8 * s + 4], c0[8 * s + 5]); w0.w = pk2(c0[8 * s + 6], c0[8 * s + 7]); \
                pb[s] = __builtin_bit_cast(bf16x8, w0); \
            } \
    _Pragma("unroll") \
            for (int s = 0; s < 2; ++s) \
    _Pragma("unroll") \
                for (int db = 0; db < 2; ++db) { \
                    const LAS unsigned char* vp = (CUR_) + vroff + db * 4160 + s * 1024; \
                    const attn_body::s16x4 lo = attn_body::vtr((attn_body::lds_cptr)vp), hi2 = attn_body::vtr((attn_body::lds_cptr)(vp + 512)); \
                    const bf16x8 vfr = (bf16x8){lo[0], lo[1], lo[2], lo[3], hi2[0], hi2[1], hi2[2], hi2[3]}; \
                    o[db] = __builtin_amdgcn_mfma_f32_32x32x16_bf16(vfr, pb[s], o[db], 0, 0, 0); } }
#define NA_COMPUTE2(CUR0_, CUR1_, KR_) { \
            const LAS unsigned char* trow = (const LAS unsigned char*)(tab + ((KR_) - rA + 7) * 32) + blane; \
            f32x16 c0, c1; \
            if (FP8_NAQK) { const attn_body::i32x4q a0_ = *(const LAS attn_body::i32x4q*)((CUR0_) + kroff), b0_ = *(const LAS attn_body::i32x4q*)((CUR0_) + kroff + 1040), a1_ = *(const LAS attn_body::i32x4q*)((CUR1_) + kroff), b1_ = *(const LAS attn_body::i32x4q*)((CUR1_) + kroff + 1040); \
                c0 = MFMA8(__builtin_shufflevector(a0_, b0_, 0, 1, 2, 3, 4, 5, 6, 7), qf8, am0v); c1 = MFMA8(__builtin_shufflevector(a1_, b1_, 0, 1, 2, 3, 4, 5, 6, 7), qf8, am0v); } else \
    _Pragma("unroll") \
            for (int ds = 0; ds < 4; ++ds) { \
                const bf16x8 k0 = *(const LAS bf16x8*)((CUR0_) + kroff + ds * 2080), k1 = *(const LAS bf16x8*)((CUR1_) + kroff + ds * 2080); \
                c0 = __builtin_amdgcn_mfma_f32_32x32x16_bf16(k0, qf[ds], ds == 0 ? am0v : c0, 0, 0, 0); \
                c1 = __builtin_amdgcn_mfma_f32_32x32x16_bf16(k1, qf[ds], ds == 0 ? am0v : c1, 0, 0, 0); \
            } \
            float mx0 = -INFINITY, mx1 = -INFINITY; \
    _Pragma("unroll") \
            for (int rr = 0; rr < 16; rr += 2) { \
                const float b0 = *(const LAS float*)(trow + 4 * ((rr & 3) + 8 * (rr >> 2))), b1 = *(const LAS float*)(trow + 4 * (((rr + 1) & 3) + 8 * ((rr + 1) >> 2))); \
                const float d0 = *(const LAS float*)(trow + 128 + 4 * ((rr & 3) + 8 * (rr >> 2))), d1 = *(const LAS float*)(trow + 128 + 4 * (((rr + 1) & 3) + 8 * ((rr + 1) >> 2))); \
                c0[rr] += b0; c0[rr + 1] += b1; c1[rr] += d0; c1[rr + 1] += d1; \
                mx0 = fmaxf(mx0, fmaxf(c0[rr], c0[rr + 1])); mx1 = fmaxf(mx1, fmaxf(c1[rr], c1[rr + 1])); \
            } \
            const bool rowlive0 = ((KR_) >= rsq) && ((KR_) < rsq + 8), rowlive1 = ((KR_) + 1 >= rsq) && ((KR_) + 1 < rsq + 8); \
            float mx = fmaxf(rowlive0 ? mx0 : -INFINITY, rowlive1 ? mx1 : -INFINITY); \
            { const auto rr_ = __builtin_amdgcn_permlane32_swap(__float_as_uint(mx), __float_as_uint(mx), false, false); mx = fmaxf(__uint_as_float(rr_[0]), __uint_as_float(rr_[1])); } \
            { const bool need = mx > mrun + 8.0f;                           \
              if (__any(need)) { const float mnew = need ? mx : mrun, alpha = need ? __builtin_amdgcn_exp2f(mrun - mnew) : 1.0f; mrun = mnew; lrun *= alpha; \
    _Pragma("unroll") \
                for (int db = 0; db < 2; ++db) \
    _Pragma("unroll") \
                    for (int k = 0; k < 16; ++k) o[db][k] *= alpha; } } \
            const float msub0 = rowlive0 ? mrun : INFINITY, msub1 = rowlive1 ? mrun : INFINITY; \
            float ps = 0.f; \
    _Pragma("unroll") \
            for (int rr = 0; rr < 16; ++rr) { c0[rr] = __builtin_amdgcn_exp2f(c0[rr] - msub0); c1[rr] = __builtin_amdgcn_exp2f(c1[rr] - msub1); ps += c0[rr] + c1[rr]; } \
            lrun += ps; \
            bf16x8 pb[2][2]; \
    _Pragma("unroll") \
            for (int s = 0; s < 2; ++s) { \
                v4u w0, w1; \
                w0.x = pk2(c0[8 * s + 0], c0[8 * s + 1]); w0.y = pk2(c0[8 * s + 2], c0[8 * s + 3]); w0.z = pk2(c0[8 * s + 4], c0[8 * s + 5]); w0.w = pk2(c0[8 * s + 6], c0[8 * s + 7]); \
                w1.x = pk2(c1[8 * s + 0], c1[8 * s + 1]); w1.y = pk2(c1[8 * s + 2], c1[8 * s + 3]); w1.z = pk2(c1[8 * s + 4], c1[8 * s + 5]); w1.w = pk2(c1[8 * s + 6], c1[8 * s + 7]); \
                pb[0][s] = __builtin_bit_cast(bf16x8, w0); pb[1][s] = __builtin_bit_cast(bf16x8, w1); \
            } \
    _Pragma("unroll") \
            for (int kb2 = 0; kb2 < 2; ++kb2) \
    _Pragma("unroll") \
                for (int s = 0; s < 2; ++s) \
    _Pragma("unroll") \
                    for (int db = 0; db < 2; ++db) { \
                        const LAS unsigned char* vp = (kb2 ? (CUR1_) : (CUR0_)) + vroff + db * 4160 + s * 1024; \
                        const attn_body::s16x4 lo = attn_body::vtr((attn_body::lds_cptr)vp), hi2 = attn_body::vtr((attn_body::lds_cptr)(vp + 512)); \
                        const bf16x8 vfr = (bf16x8){lo[0], lo[1], lo[2], lo[3], hi2[0], hi2[1], hi2[2], hi2[3]}; \
                        o[db] = __builtin_amdgcn_mfma_f32_32x32x16_bf16(vfr, pb[kb2][s], o[db], 0, 0, 0); } }
constexpr int NA_KBUF = 8 * 1040, NA_VBUF = 2 * 4160, NA_BUF = NA_KBUF + NA_VBUF;
__device__ __forceinline__ void na_unitset(const bf16* __restrict__ QKV, bf16* __restrict__ OUT, const LAS float* tab, LAS unsigned char* stg  , size_t tok0, int rows, int h, int r0, int tid, int lane, int wave) {
    const int r32 = lane & 31, hi = lane >> 5;
    const int rA = r0 + 2 * (wave >> 2), ag = wave & 3, rq = rA + (r32 >> 4);
    int rsA = rA - 4; rsA = rsA < 0 ? 0 : rsA; rsA = rsA > rows - 8 ? rows - 8 : rsA;
    int rsB = rA - 3; rsB = rsB < 0 ? 0 : rsB; rsB = rsB > rows - 8 ? rows - 8 : rsB;
    const int rsq = (r32 >> 4) ? rsB : rsA;
    int kr_lo = r0 - 4; kr_lo = kr_lo < 0 ? 0 : kr_lo; kr_lo = kr_lo > rows - 8 ? rows - 8 : kr_lo;
    int kr_hi = r0 - 1; kr_hi = kr_hi < 0 ? 0 : kr_hi; kr_hi = kr_hi > rows - 8 ? rows - 8 : kr_hi; kr_hi += 7;
    const int nk = kr_hi - kr_lo + 1;
    const int c = 16 * ag + (r32 & 15);
    int cs = c - 8; cs = cs < 0 ? 0 : cs; cs = cs > 48 ? 48 : cs;
    int kb = 16 * ag - 8; kb = kb < 0 ? 0 : kb; kb = kb > 32 ? 32 : kb;
    bf16x8 qf[4];
#pragma unroll
    for (int ds = 0; ds < 4; ++ds) qf[ds] = FP8_NAQK ? (bf16x8){} : *(const bf16x8*)(QKV + (tok0 + (size_t)rq * 64 + c) * 1536 + h * 64 + 16 * ds + 8 * hi);
    const unsigned char* const N8 = (const unsigned char*)QKV; attn_body::i32x8q qf8 = {};
    if (FP8_NAQK) { const unsigned char* qp = N8 + (tok0 + (size_t)rq * 64 + c) * 2048 + h * 64 + 32 * hi; const attn_body::i32x4q a_ = *(const attn_body::i32x4q*)qp, b_ = *(const attn_body::i32x4q*)(qp + 16); qf8 = __builtin_shufflevector(a_, b_, 0, 1, 2, 3, 4, 5, 6, 7); }
    f32x16 o[2];
#pragma unroll
    for (int b = 0; b < 2; ++b)
#pragma unroll
        for (int k = 0; k < 16; ++k) o[b][k] = 0.f;
    float mrun = -INFINITY, lrun = 0.f;
    f32x16 am0v;
#pragma unroll
    for (int rr = 0; rr < 16; ++rr) { const int kc0 = kb + crow16(rr, hi); am0v[rr] = (kc0 >= cs && kc0 < cs + 16) ? 0.f : -INFINITY; }
    const int blane = 4 * (15 - c + kb + 4 * hi) - 128 * (r32 >> 4);
    const int skey = tid >> 3, sch = tid & 7;
    const bf16* gk = QKV + (tok0 + (size_t)kr_lo * 64 + skey) * 1536 + 512 + h * 64 + 8 * sch;
    const unsigned char* const gkk = N8 + (tok0 + (size_t)kr_lo * 64 + skey) * 2048 + 512 + h * 64 + (sch & 3) * 16;
    const unsigned char* const gkv = N8 + (tok0 + (size_t)kr_lo * 64 + skey) * 2048 + 1024 + h * 128 + sch * 16;
#define NA_LDK(j_) (FP8_NAQK ? *(const GAS v4u*)(gkk + (size_t)(j_) * 131072) : *(const GAS v4u*)(gk + (size_t)(j_) * 64 * 1536))
#define NA_LDV(j_) (FP8_NAQK ? *(const GAS v4u*)(gkv + (size_t)(j_) * 131072) : *(const GAS v4u*)(gk + (size_t)(j_) * 64 * 1536 + 512))
    const int kwoff = (FP8_NAQK ? (sch & 3) : sch) * 1040 + skey * 16, vwoff = NA_KBUF + (sch >> 2) * 4160 + skey * 64 + (sch & 3) * 16;
    const int kroff = FP8_NAQK ? hi * 2080 + (kb + r32) * 16 : hi * 1040 + (kb + r32) * 16;
    const int vroff = NA_KBUF + kb * 64 + ((lane >> 4) & 1) * 32 + (lane & 3) * 8 + (4 * hi + ((lane & 15) >> 2)) * 64;
    v4u kq0 = NA_LDK(0), vq0 = NA_LDV(0), kq1 = kq0, vq1 = vq0, kq2 = kq0, vq2 = vq0, kq3 = kq0, vq3 = vq0;
    if (1 < nk) { kq1 = NA_LDK(1); vq1 = NA_LDV(1); }
    if (2 < nk) { kq2 = NA_LDK(2); vq2 = NA_LDV(2); }
    if (3 < nk) { kq3 = NA_LDK(3); vq3 = NA_LDV(3); }
    *(LAS v4u*)(stg + kwoff) = kq0; *(LAS v4u*)(stg + vwoff) = vq0;
    if (1 < nk) { *(LAS v4u*)(stg + NA_BUF + kwoff) = kq1; *(LAS v4u*)(stg + NA_BUF + vwoff) = vq1; }
    __syncthreads();
    if (4 < nk) { kq0 = NA_LDK(4); vq0 = NA_LDV(4); }
    if (5 < nk) { kq1 = NA_LDK(5); vq1 = NA_LDV(5); }
#define NA_STEP(t, KA, VA, KB, VB) do { \
        LAS unsigned char* cur0 = stg + ((t) & 3) * NA_BUF; LAS unsigned char* cur1 = stg + (((t) + 1) & 3) * NA_BUF; \
        const int kr = kr_lo + (t); \
        const bool live0 = kr >= rsA && kr < rsB + 8, live1 = ((t) + 1 < nk) && kr + 1 >= rsA && kr + 1 < rsB + 8; \
        if (live0 && live1) NA_COMPUTE2(cur0, cur1, kr) else if (live0) NA_COMPUTE1(cur0, kr) else if (live1) NA_COMPUTE1(cur1, kr + 1) \
        if ((t) + 2 < nk) { LAS unsigned char* nxt = stg + (((t) + 2) & 3) * NA_BUF; *(LAS v4u*)(nxt + kwoff) = KA; *(LAS v4u*)(nxt + vwoff) = VA; } \
        if ((t) + 3 < nk) { LAS unsigned char* nxt = stg + (((t) + 3) & 3) * NA_BUF; *(LAS v4u*)(nxt + kwoff) = KB; *(LAS v4u*)(nxt + vwoff) = VB; } \
        if ((t) + 6 < nk) { KA = NA_LDK((t) + 6); VA = NA_LDV((t) + 6); } \
        if ((t) + 7 < nk) { KB = NA_LDK((t) + 7); VB = NA_LDV((t) + 7); } \
        __syncthreads(); } while (0)
#pragma unroll 1
    for (int t0 = 0; t0 < nk; t0 += 4) {
        NA_STEP(t0, kq2, vq2, kq3, vq3);
        if (t0 + 2 < nk) NA_STEP(t0 + 2, kq0, vq0, kq1, vq1);
    }
#undef NA_STEP
    float l; { const auto rr_ = __builtin_amdgcn_permlane32_swap(__float_as_uint(lrun), __float_as_uint(lrun), false, false); l = __uint_as_float(rr_[0]) + __uint_as_float(rr_[1]); } const float inv = 1.0f / l;
    if (FP8_BR) { unsigned char* orow8 = (unsigned char*)OUT + (tok0 + (size_t)rq * 64 + c) * 512 + h * 64; const float sc = inv * ATT_SCALE;
#pragma unroll
        for (int db = 0; db < 2; ++db)
#pragma unroll
            for (int g = 0; g < 4; ++g) *(GAS unsigned*)(orow8 + 32 * db + 8 * g + 4 * hi) = pg8::pack4_fp8(o[db][4 * g + 0] * sc, o[db][4 * g + 1] * sc, o[db][4 * g + 2] * sc, o[db][4 * g + 3] * sc);
        return; }
    bf16* orow = OUT + (tok0 + (size_t)rq * 64 + c) * 512 + h * 64;
#pragma unroll
    for (int db = 0; db < 2; ++db)
#pragma unroll
        for (int g = 0; g < 4; ++g) { v2u w; w.x = pk2(o[db][4 * g + 0] * inv, o[db][4 * g + 1] * inv); w.y = pk2(o[db][4 * g + 2] * inv, o[db][4 * g + 3] * inv);
            *(GAS v2u*)(orow + 32 * db + 8 * g + 4 * hi) = w; }
}
struct RopeLane { f32x4 gq, gk; float invf[4]; };
template <bool DRY> __device__ __forceinline__ void rope_compute(const Args& A, const RopeLane& L, const f32x4 (&v)[3], int m, int lane) {
    bf16* outrow = (DRY ? WSP(bf16, WS_Z) : WSP(bf16, WS_QKVB)) + (size_t)m * 768;
    const int t = m < NP ? (m & (SEQ_P - 1)) : ((m - NP) & (SEQ_S - 1));
    const int pos = (lane & 8) ? (t & 63) : (t >> 6);
    float cs[4], sn[4];
#pragma unroll
    for (int k = 0; k < 4; ++k) { const float ang = (float)pos * L.invf[k]; cs[k] = __cosf(ang); sn[k] = __sinf(ang); }
    const float sgn = (lane & 4) ? 1.f : -1.f;
    v2u ob[3];
#pragma unroll
    for (int j = 0; j < 3; ++j) {
        f32x4 x = v[j];
        const bool is_v = (j == 2) && (lane >= 32);
        float ss = (x.x * x.x + x.y * x.y) + (x.z * x.z + x.w * x.w);
        ss += __shfl_xor(ss, 1); ss += __shfl_xor(ss, 2); ss += __shfl_xor(ss, 4); ss += __shfl_xor(ss, 8);
        const float rn = 1.0f / sqrtf(ss * (1.0f / 64.0f) + RMS_EPS);
        const f32x4 gn = (j < 2) ? L.gq : L.gk;
        f32x4 y = x * rn * gn;
        f32x4 pr; pr.x = __shfl_xor(y.x, 4); pr.y = __shfl_xor(y.y, 4); pr.z = __shfl_xor(y.z, 4); pr.w = __shfl_xor(y.w, 4);
        f32x4 o;
        o.x = y.x * cs[0] + sgn * pr.x * sn[0]; o.y = y.y * cs[1] + sgn * pr.y * sn[1]; o.z = y.z * cs[2] + sgn * pr.z * sn[2]; o.w = y.w * cs[3] + sgn * pr.w * sn[3];
        if (j < 2) o = o * QSCALE;
        if (is_v) o = x;
        ob[j].x = pk2(o.x, o.y); ob[j].y = pk2(o.z, o.w);
    }
    GAS v2u* dst = (GAS v2u*)outrow + lane;
#ifdef ROPE_DRY_NOSTORE
    if (DRY) { asm volatile("" :: "v"(ob[0].x), "v"(ob[0].y), "v"(ob[1].x), "v"(ob[1].y), "v"(ob[2].x), "v"(ob[2].y)); return; }
#endif
#pragma unroll
    for (int j = 0; j < 3; ++j) dst[64 * j] = ob[j];
}
__device__ __forceinline__ void phase_na(const Args& A, const Frame& F0, int layer) {
    const Frame F = fresh_frame(F0);
    LAS float* tab = (LAS float*)(F.lds + RING_OFF) + 64;
    const float* rpb = A.in[I_RPB] + (size_t)layer * 8 * 15 * 31;
    for (int idx = F.tid; idx < 128; idx += NWAVES * 64) { (idx < 64 ? tab - 64 : tab + 8 * 15 * 32 - 64)[idx] = 0.f; }
    for (int idx = F.tid; idx < 8 * 15 * 32; idx += NWAVES * 64) { const int h = idx / 480, rem = idx % 480, dr = rem >> 5, dc = rem & 31;
        tab[idx] = dc < 31 ? rpb[(h * 15 + dr) * 31 + dc] * LOG2E : 0.f; }
    __syncthreads();
    const int gw = F.vcu * NWAVES + F.wave, NGW = F.G * NWAVES;
    constexpr int NUS_P = 8 * 8 * 16, NUS = NUS_P + 8 * 8 * 32;
#pragma unroll 1
    for (int rep_ = 0; rep_ < NREP(2); ++rep_)
#pragma unroll 1
    for (int us = F.vcu; us < NUS; us += F.G) {
        size_t tok0; int rows, h, r0;
        if (us < NUS_P) { const int b = us >> 7; h = (us >> 4) & 7; r0 = (us & 15) * 4; tok0 = (size_t)b * SEQ_P; rows = 64; }
        else { const int q = us - NUS_P, b = q >> 8; h = (q >> 5) & 7; r0 = (q & 31) * 4; tok0 = (size_t)NP + (size_t)b * SEQ_S; rows = 128; }
        na_unitset(WSP(bf16, WS_NAQKV), rep_ ? WSP(bf16, WS_Z) : WSP(bf16, WS_ATT), tab + h * 480, F.lds + RING_OFF + 16384, tok0, rows, h, r0, F.tid, F.lane, F.wave);
    }
#pragma unroll 1
    for (int rq_ = 0; rq_ < (ROPE_FUSED ? 0 : NREP(12)); ++rq_) { const int rp_ = ROPE_DRY_FIRST ? (NREP(12) - 1 - rq_) : rq_;
        RopeLane L; const int lane = F.lane, d0 = 4 * (lane & 15);
        L.gq = *(const GAS f32x4*)(A.in[I_QN] + layer * 64 + d0); L.gk = *(const GAS f32x4*)(A.in[I_KN] + layer * 64 + d0);
#pragma unroll
        for (int k = 0; k < 4; ++k) L.invf[k] = __builtin_amdgcn_exp2f(-(float)((d0 + k) & 15) * (13.287712379549449f / 16.0f));
        v2u nxb[3];
        if (gw < NTOK) { const GAS v2u* src = (const GAS v2u*)(WSP(bf16, WS_RAWQK) + (size_t)gw * 768) + lane;
#pragma unroll
            for (int j = 0; j < 3; ++j) nxb[j] = src[64 * j]; }
#pragma unroll 1
        for (int m = gw; m < NTOK; m += NGW) {
            f32x4 v[3];
#pragma unroll
            for (int j = 0; j < 3; ++j) { v[j].x = bf_lo(nxb[j].x); v[j].y = bf_hi(nxb[j].x); v[j].z = bf_lo(nxb[j].y); v[j].w = bf_hi(nxb[j].y); }
            const int m2 = m + NGW;
            if (m2 < NTOK) { const GAS v2u* src = (const GAS v2u*)(WSP(bf16, WS_RAWQK) + (size_t)m2 * 768) + lane;
#pragma unroll
                for (int j = 0; j < 3; ++j) nxb[j] = src[64 * j]; }
            if (rp_) rope_compute<true>(A, L, v, m, lane); else rope_compute<false>(A, L, v, m, lane);
        }
    }
    __syncthreads();
}

#define XIN_BASES() const float* const XLO = (FP8_MIX && layer == 0) ? A.in[I_XP] : A.out; const float* const XHI = (FP8_MIX && layer == 0) ? A.in[I_XS] - (size_t)NP * DM : A.out
#define XIN_ROW(m_) (((m_) < NP ? XLO : XHI) + (size_t)(m_) * DM)
template <int CTRL> __device__ __forceinline__ float dpp_mov(float v) { return __int_as_float(__builtin_amdgcn_update_dpp(0, __float_as_int(v), CTRL, 0xF, 0xF, true)); }
__device__ __forceinline__ float row16_sum(float v) { v += dpp_mov<0x128>(v); v += dpp_mov<0x124>(v); v += dpp_mov<0x122>(v); v += dpp_mov<0x121>(v); return v; }
__device__ __forceinline__ float swap16_sum(float a, float b) { const auto rr = __builtin_amdgcn_permlane16_swap(__float_as_uint(a), __float_as_uint(b), false, false); return __uint_as_float(rr[0]) + __uint_as_float(rr[1]); }
__device__ __forceinline__ float swap32_sum(float a, float b) { const auto rr = __builtin_amdgcn_permlane32_swap(__float_as_uint(a), __float_as_uint(b), false, false); return __uint_as_float(rr[0]) + __uint_as_float(rr[1]); }
__device__ __forceinline__ float swap16_max(float a) { const auto rr = __builtin_amdgcn_permlane16_swap(__float_as_uint(a), __float_as_uint(a), false, false); return fmaxf(__uint_as_float(rr[0]), __uint_as_float(rr[1])); }
__device__ __forceinline__ float swap32_max(float a) { const auto rr = __builtin_amdgcn_permlane32_swap(__float_as_uint(a), __float_as_uint(a), false, false); return fmaxf(__uint_as_float(rr[0]), __uint_as_float(rr[1])); }
__device__ __forceinline__ float wave_sum_x(float v) { v = row16_sum(v); v = swap16_sum(v, v); return swap32_sum(v, v); }
template <bool DRY> __device__ __forceinline__ void phase_ln1(const Args& A, const Frame& F0, int layer) {
    const Frame F = fresh_frame(F0);
    constexpr int NR = 2;
    typedef float f32x2v __attribute__((ext_vector_type(2)));
    const int gw = F.vcu * NWAVES + F.wave, NGW = F.G * NWAVES, lane = F.lane;
    const GAS f32x4* gp = (const GAS f32x4*)(A.in[I_L1G] + (size_t)layer * DM) + lane;
    const GAS f32x4* bp = (const GAS f32x4*)(A.in[I_L1B] + (size_t)layer * DM) + lane;
    XIN_BASES();
    float* AFFT = DRY ? WSP(float, WS_R1 + 420 * MiB) : WSP(float, WS_AFFT);
    float* XO = DRY ? WSP(float, WS_R1) : A.out; bf16* XBO = DRY ? WSP(bf16, WS_Z + 201326592) : WSP(bf16, WS_XB);
    { const GAS f32x4* wsrc = (const GAS f32x4*)(A.in[I_WR] + (size_t)layer * DM * NE);
      for (int idx = F.tid; idx < DM * 4; idx += NWAVES * 64) { const int d = idx >> 2, q = idx & 3; *(LAS f32x4*)(F.lds + RING_OFF + d * 64 + (d >> 2) * 16 + q * 16) = wsrc[idx]; }
      __syncthreads(); }
    f32x4 nx[NR][4]; unsigned nmx[NR][4];
#define LN1_LOADSET(mb_) do { const GAS f32x4* src = (const GAS f32x4*)XIN_ROW(mb_) + lane; const GAS unsigned* ms = (const GAS unsigned*)(WSP(unsigned char, WS_MIX8) + (size_t)(mb_) * DM) + lane; \
        _Pragma("unroll") for (int r = 0; r < NR; ++r) { \
            _Pragma("unroll") for (int j = 0; j < 4; ++j) nx[r][j] = __builtin_nontemporal_load(&src[r * (DM / 4) + 64 * j]); \
            _Pragma("unroll") for (int j = 0; j < 4; ++j) nmx[r][j] = FP8_MIX ? ms[r * (DM / 4) + 64 * j] : 0u; } } while (0)
    if (NR * gw < NTOK) LN1_LOADSET(NR * gw);
#pragma unroll 1
    for (int m0 = NR * gw; m0 < NTOK; m0 += NR * NGW) {
        int wlo = lane * 272; asm volatile("" : "+v"(wlo));
        const LAS unsigned char* wl = F.lds + RING_OFF + wlo;
        f32x4 v[NR][4]; float mean[NR], rstd[NR];
#pragma unroll
        for (int r = 0; r < NR; ++r) {
            float s = 0.f;
#pragma unroll
            for (int j = 0; j < 4; ++j) { v[r][j] = nx[r][j];
                if (FP8_MIX) { const f32x2v lo = __builtin_amdgcn_cvt_pk_f32_fp8((int)nmx[r][j], false), hi = __builtin_amdgcn_cvt_pk_f32_fp8((int)nmx[r][j], true);
                    v[r][j].x = __builtin_fmaf(v[r][j].x, DN_ALPHA, lo.x); v[r][j].y = __builtin_fmaf(v[r][j].y, DN_ALPHA, lo.y); v[r][j].z = __builtin_fmaf(v[r][j].z, DN_ALPHA, hi.x); v[r][j].w = __builtin_fmaf(v[r][j].w, DN_ALPHA, hi.y); }
                s += (v[r][j].x + v[r][j].y) + (v[r][j].z + v[r][j].w); }
            mean[r] = wave_sum_x(s) * (1.f / DM);
        }
        __builtin_amdgcn_sched_barrier(0);
        { const int m2 = m0 + NR * NGW; if (m2 < NTOK) LN1_LOADSET(m2); }
        __builtin_amdgcn_sched_barrier(0);
#pragma unroll
        for (int r = 0; r < NR; ++r) { float s2 = 0.f;
#pragma unroll
            for (int j = 0; j < 4; ++j) { v[r][j] = v[r][j] - mean[r]; s2 += (v[r][j].x * v[r][j].x + v[r][j].y * v[r][j].y) + (v[r][j].z * v[r][j].z + v[r][j].w * v[r][j].w); }
            rstd[r] = 1.f / sqrtf(wave_sum_x(s2) * (1.f / DM) + LN_EPS);
            if (!DRY && lane == 0) { *(GAS f32x2v*)(WSP(float, WS_STATS) + (size_t)(m0 + r) * 2) = (f32x2v){mean[r], rstd[r]}; } }
        { int go = lane; asm volatile("" : "+v"(go));
#pragma unroll
          for (int j = 0; j < 4; ++j) { const f32x4 g4 = gp[go - lane + 64 * j], b4 = bp[go - lane + 64 * j];
#pragma unroll
            for (int r = 0; r < NR; ++r) { v[r][j] = v[r][j] * rstd[r] * g4 + b4;
                if (DRY) ((GAS f32x4*)(XO + (size_t)(m0 + r) * DM) + lane)[64 * j] = v[r][j];
                if (FP8_E1 && !DRY) ((GAS unsigned*)(WSP(unsigned char, WS_XB8) + (size_t)(m0 + r) * DM))[lane + 64 * j] = pg8::pack4_fp8(v[r][j].x, v[r][j].y, v[r][j].z, v[r][j].w);
                if (!FP8_E1) { v2u w; w.x = pk2(v[r][j].x, v[r][j].y); w.y = pk2(v[r][j].z, v[r][j].w); ((GAS v2u*)(XBO + (size_t)(m0 + r) * DM) + lane)[64 * j] = w; } } } }
        f32x2v lg[NR][8];
#pragma unroll
        for (int r = 0; r < NR; ++r)
#pragma unroll
            for (int e = 0; e < 8; ++e) lg[r][e] = (f32x2v){0.f, 0.f};
        {
            f32x4 wc[4], wn[4];
#pragma unroll
            for (int q = 0; q < 4; ++q) wc[q] = *(const LAS f32x4*)(wl + 16 * q);
#pragma unroll
            for (int g = 0; g < 16; ++g) {
                if (g + 1 < 16) {
#pragma unroll
                    for (int q = 0; q < 4; ++q) wn[q] = *(const LAS f32x4*)(wl + 17408 * ((g + 1) >> 2) + 64 * ((g + 1) & 3) + 16 * q); }
                __builtin_amdgcn_sched_barrier(0);
#pragma unroll
                for (int q = 0; q < 4; ++q) { const f32x2v wa = {wc[q].x, wc[q].y}, wb = {wc[q].z, wc[q].w};
#pragma unroll
                    for (int r = 0; r < NR; ++r) { const float xv = v[r][g >> 2][g & 3]; const f32x2v x2 = {xv, xv};
                        lg[r][2 * q] = __builtin_elementwise_fma(x2, wa, lg[r][2 * q]); lg[r][2 * q + 1] = __builtin_elementwise_fma(x2, wb, lg[r][2 * q + 1]); } }
                static_assert(NR == 2, "the pin below names both rows' accumulators");
                asm volatile("" : "+v"(lg[0][0]), "+v"(lg[0][1]), "+v"(lg[0][2]), "+v"(lg[0][3]), "+v"(lg[0][4]), "+v"(lg[0][5]), "+v"(lg[0][6]), "+v"(lg[0][7]),
                                  "+v"(lg[1][0]), "+v"(lg[1][1]), "+v"(lg[1][2]), "+v"(lg[1][3]), "+v"(lg[1][4]), "+v"(lg[1][5]), "+v"(lg[1][6]), "+v"(lg[1][7]));
                __builtin_amdgcn_sched_barrier(0);
#pragma unroll
                for (int q = 0; q < 4; ++q) wc[q] = wn[q];
            }
        }
#pragma unroll
        for (int r = 0; r < NR; ++r) {
            float t[8], u[4];
#pragma unroll
            for (int i = 0; i < 8; ++i) t[i] = swap32_sum(lg[r][i >> 1][i & 1], lg[r][4 + (i >> 1)][i & 1]);
#pragma unroll
            for (int i = 0; i < 4; ++i) u[i] = row16_sum(swap16_sum(t[i], t[i + 4]));
            float mx = fmaxf(fmaxf(u[0], u[1]), fmaxf(u[2], u[3])); mx = swap32_max(swap16_max(mx));
            float den = 0.f;
#pragma unroll
            for (int i = 0; i < 4; ++i) { u[i] = __expf(u[i] - mx); den += u[i]; }
            den = swap16_sum(den, den); den = swap32_sum(den, den);
            const float inv = 1.0f / den;
            const int i4 = lane & 3, e = 4 * (lane >> 4) + i4;
            const float mine = (i4 == 0 ? u[0] : i4 == 1 ? u[1] : i4 == 2 ? u[2] : u[3]) * inv;
            const int m = m0 + r;
            if ((lane & 15) < 4) { float* dst = m < NP ? AFFT + (size_t)e * NP + m : AFFT + (size_t)NE * NP + (size_t)e * NS + (m - NP); *dst = mine; }
        }
    }
}

constexpr size_t SEL_ALT = WS_R1 + 900 * MiB - WS_SLOT;
__device__ __forceinline__ void select_slow(const Args& A, const Frame& F, int task, size_t alt = 0) {
    const int grp = task >> 4, e = task & 15, n = grp ? NS : NP, cap = n >> 3;
    const unsigned* keys = (const unsigned*)(grp ? WSP(float, WS_AFFT) + (size_t)NE * NP + (size_t)e * NS : WSP(float, WS_AFFT) + (size_t)e * NP);
    const int tokbase = grp ? NP : 0, slotbase = grp ? NE * (NP >> 3) + e * cap : e * cap;
    int* SLOT = WSP(int, WS_SLOT + alt); int* IDX = WSP(int, WS_IDX + alt); float* GVAL = WSP(float, WS_GVAL + alt);
    LAS unsigned* hist = (LAS unsigned*)(F.lds + RING_OFF);
    LAS unsigned* wsum = hist + 2048;
    LAS unsigned* bc = hist + 2048 + 64;
    const int tid = F.tid, lane = F.lane, wid = F.wave;
    unsigned prefix = 0u, pmask = 0u, k = (unsigned)cap;
#pragma unroll 1
    for (int pass = 0; pass < 3; ++pass) {
        const int shift = pass == 0 ? 21 : (pass == 1 ? 10 : 0);
        const unsigned dmask = pass == 2 ? 1023u : 2047u;
        for (int i = tid; i < 2048; i += NWAVES * 64) hist[i] = 0u;
        __syncthreads();
        for (int i = tid; i < n; i += NWAVES * 64) { const unsigned key = keys[i]; if ((key & pmask) == prefix) __hip_atomic_fetch_add(&hist[(key >> shift) & dmask], 1u, __ATOMIC_RELAXED, __HIP_MEMORY_SCOPE_WORKGROUP); }
        __syncthreads();
        const unsigned c0 = hist[4 * tid], c1 = hist[4 * tid + 1], c2 = hist[4 * tid + 2], c3 = hist[4 * tid + 3];
        const unsigned tsum = c0 + c1 + c2 + c3;
        unsigned inc = tsum;
#pragma unroll
        for (int o = 1; o < 64; o <<= 1) { const unsigned t2 = __shfl_down(inc, o); if (lane + o < 64) inc += t2; }
        if (lane == 0) wsum[wid] = inc;
        __syncthreads();
        unsigned above = inc - tsum;
        for (int w = wid + 1; w < NWAVES; ++w) above += wsum[w];
        unsigned a = above;
        if (a < k && a + c3 >= k) { bc[0] = 4 * tid + 3; bc[1] = k - a; } a += c3;
        if (a < k && a + c2 >= k) { bc[0] = 4 * tid + 2; bc[1] = k - a; } a += c2;
        if (a < k && a + c1 >= k) { bc[0] = 4 * tid + 1; bc[1] = k - a; } a += c1;
        if (a < k && a + c0 >= k) { bc[0] = 4 * tid + 0; bc[1] = k - a; }
        __syncthreads();
        const unsigned bin = bc[0]; k = bc[1];
        prefix |= bin << shift; pmask |= dmask << shift;
        __syncthreads();
    }
    const unsigned thr = prefix, need = k;
    const unsigned cnt_gt = (unsigned)cap - need;
    unsigned base_gt = 0u, base_eq = 0u;
    const unsigned long long lt_mask = (1ull << lane) - 1ull;
#pragma unroll 1
    for (int base = 0, it = 0; base < n; base += NWAVES * 64, ++it) {
        const unsigned key = keys[base + tid];
        const bool gt = key > thr, eq = key == thr;
        const unsigned long long bg = __ballot(gt), be = __ballot(eq);
        LAS unsigned* ws = wsum + 16 + (it & 1) * 16;
        if (lane == 0) { ws[wid] = (unsigned)__popcll(bg); ws[8 + wid] = (unsigned)__popcll(be); }
        __syncthreads();
        unsigned og = 0u, oe = 0u, tg = 0u, te = 0u;
#pragma unroll
        for (int w = 0; w < NWAVES; ++w) { const unsigned a = ws[w], b = ws[8 + w]; if (w < wid) { og += a; oe += b; } tg += a; te += b; }
        const unsigned rg = base_gt + og + (unsigned)__popcll(bg & lt_mask), re = base_eq + oe + (unsigned)__popcll(be & lt_mask);
        int srow = -1;
        if (gt) srow = slotbase + (int)rg;
        else if (eq && re < need) srow = slotbase + (int)(cnt_gt + re);
        const int tok = tokbase + base + tid;
        SLOT[(size_t)tok * NE + e] = srow;
        if (srow >= 0) { IDX[srow] = tok; GVAL[srow] = __uint_as_float(key); }
        base_gt += tg; base_eq += te;
    }
    __syncthreads();
}

constexpr int SEL_LISTCAP = 2048;
#define SEL_BIN(kk) ({ int b_ = (int)(__uint_as_float(kk) * 2048.0f); b_ = b_ > 2047 ? 2047 : b_; b_; })
#define SEL_LOAD64(hb) _Pragma("unroll") for (int i = 0; i < 64; ++i) key[i] = (unsigned)__builtin_amdgcn_raw_buffer_load_b32(krs, tid * 4, ((hb) * 64 + i) * 2048, 0)
template <int NH  > __device__ __forceinline__ bool select_fast(const Args& A, const Frame& F, int task, size_t alt = 0) {
    const int grp = task >> 4, e = task & 15, cap = NH * 64 * 64;
    const unsigned* keys = (const unsigned*)(grp ? WSP(float, WS_AFFT) + (size_t)NE * NP + (size_t)e * NS : WSP(float, WS_AFFT) + (size_t)e * NP);
    const int tokbase = grp ? NP : 0, slotbase = grp ? NE * (NP >> 3) + e * cap : e * cap;
    GAS int* SLOT = (GAS int*)WSP(int, WS_SLOT + alt); GAS int* IDX = (GAS int*)WSP(int, WS_IDX + alt); GAS float* GVAL = (GAS float*)WSP(float, WS_GVAL + alt);
    LAS unsigned* hist = (LAS unsigned*)(F.lds + RING_OFF);
    LAS unsigned* wsum = hist + 2048;
    LAS unsigned* bc = hist + 2048 + 64;
    LAS unsigned* lkey = hist + 4096;
    LAS unsigned* lidx = lkey + SEL_LISTCAP;
    LAS unsigned* tabc = lidx + SEL_LISTCAP;
    const int tid = F.tid, lane = F.lane, wid = F.wave;
    const __amdgpu_buffer_rsrc_t krs = __builtin_amdgcn_make_buffer_rsrc((void*)keys, 0, NH * 64 * 512 * 4, 0x00020000);
    unsigned key[64];
    for (int i = tid; i < 2048; i += NWAVES * 64) hist[i] = 0u;
    if (tid == 0) bc[2] = 0u;
    __syncthreads();
#pragma unroll 1
    for (int hb = 0; hb < NH; ++hb) {
        SEL_LOAD64(hb);
#pragma unroll
        for (int i = 0; i < 64; ++i) __hip_atomic_fetch_add(&hist[SEL_BIN(key[i])], 1u, __ATOMIC_RELAXED, __HIP_MEMORY_SCOPE_WORKGROUP);
    }
    __syncthreads();
    {
        const unsigned c0 = hist[4 * tid], c1 = hist[4 * tid + 1], c2 = hist[4 * tid + 2], c3 = hist[4 * tid + 3];
        const unsigned tsum = c0 + c1 + c2 + c3, k = (unsigned)cap;
        unsigned inc = tsum;
#pragma unroll
        for (int o = 1; o < 64; o <<= 1) { const unsigned t2 = __shfl_down(inc, o); if (lane + o < 64) inc += t2; }
        if (lane == 0) wsum[wid] = inc;
        __syncthreads();
        unsigned a = inc - tsum;
        for (int w = wid + 1; w < NWAVES; ++w) a += wsum[w];
        if (a < k && a + c3 >= k) { bc[0] = 4 * tid + 3; bc[1] = k - a; bc[3] = c3; } a += c3;
        if (a < k && a + c2 >= k) { bc[0] = 4 * tid + 2; bc[1] = k - a; bc[3] = c2; } a += c2;
        if (a < k && a + c1 >= k) { bc[0] = 4 * tid + 1; bc[1] = k - a; bc[3] = c1; } a += c1;
        if (a < k && a + c0 >= k) { bc[0] = 4 * tid + 0; bc[1] = k - a; bc[3] = c0; }
        __syncthreads();
    }
    const int tbin = (int)bc[0]; const unsigned kin = bc[1], m = bc[3];
    if (m > (unsigned)SEL_LISTCAP) return false;
#pragma unroll 1
    for (int hb = 0; hb < NH; ++hb) {
        SEL_LOAD64(hb);
#pragma unroll
        for (int i = 0; i < 64; ++i) if (SEL_BIN(key[i]) == tbin) { const unsigned p = __hip_atomic_fetch_add(&bc[2], 1u, __ATOMIC_RELAXED, __HIP_MEMORY_SCOPE_WORKGROUP); lkey[p] = key[i]; lidx[p] = (unsigned)((hb * 64 + i) * 512 + tid); }
    }
    __syncthreads();
    for (unsigned p = tid; p < m; p += NWAVES * 64) {
        const unsigned kp = lkey[p], ip = lidx[p]; unsigned rank = 0u;
        for (unsigned q = 0; q < m; ++q) { const unsigned kq = lkey[q], iq = lidx[q]; rank += (kq > kp || (kq == kp && iq < ip)) ? 1u : 0u; }
        if (rank == kin - 1u) { bc[4] = kp; bc[5] = ip; }
    }
    __syncthreads();
    const unsigned tkey = bc[4], tidx = bc[5];
    const unsigned long long lt_mask = (1ull << lane) - 1ull;
#pragma unroll 1
    for (int hb = 0; hb < NH; ++hb) {
        SEL_LOAD64(hb);
#pragma unroll
        for (int i = 0; i < 64; ++i) {
            const int b = SEL_BIN(key[i]); const unsigned ti = (unsigned)((hb * 64 + i) * 512 + tid);
            const bool sel = b > tbin || (b == tbin && (key[i] > tkey || (key[i] == tkey && ti <= tidx)));
            const unsigned long long bal = __ballot(sel);
            if (lane == 0) tabc[(hb * 64 + i) * 8 + wid] = (unsigned)__popcll(bal);
            if ((i & 7) == 7) __builtin_amdgcn_sched_barrier(0);
        }
    }
    __syncthreads();
    {
        unsigned v[NH], s = 0u;
#pragma unroll
        for (int q = 0; q < NH; ++q) { v[q] = tabc[NH * tid + q]; s += v[q]; }
        unsigned inc = s;
#pragma unroll
        for (int o = 1; o < 64; o <<= 1) { const unsigned t2 = __shfl_up(inc, o); if (lane >= o) inc += t2; }
        if (lane == 63) wsum[wid] = inc;
        __syncthreads();
        unsigned base = inc - s;
        for (int w = 0; w < wid; ++w) base += wsum[w];
#pragma unroll
        for (int q = 0; q < NH; ++q) { tabc[NH * tid + q] = base; base += v[q]; }
        __syncthreads();
    }
#pragma unroll 1
    for (int hb = 0; hb < NH; ++hb) {
        SEL_LOAD64(hb);
#pragma unroll
        for (int i = 0; i < 64; ++i) {
            const int b = SEL_BIN(key[i]); const unsigned ti = (unsigned)((hb * 64 + i) * 512 + tid);
            const bool sel = b > tbin || (b == tbin && (key[i] > tkey || (key[i] == tkey && ti <= tidx)));
            const unsigned long long bal = __ballot(sel);
            const int tok = tokbase + (hb * 64 + i) * 512 + tid;
            int srow = -1;
            if (sel) srow = slotbase + (int)(tabc[(hb * 64 + i) * 8 + wid] + (unsigned)__popcll(bal & lt_mask));
            SLOT[(size_t)tok * NE + e] = srow;
            if (sel) { IDX[srow] = tok; GVAL[srow] = __uint_as_float(key[i]); }
            if ((i & 7) == 7) __builtin_amdgcn_sched_barrier(0);
        }
    }
    __syncthreads();
    return true;
}
#undef SEL_BIN
#undef SEL_LOAD64
__device__ __forceinline__ void phase_select(const Args& A, const Frame& F0, size_t alt = 0) {
    const Frame F = fresh_frame(F0);
    const int task = blockIdx.x;
    if (task >= 2 * NE) return;
    const bool ok = (task >> 4) ? select_fast<NS / 32768>(A, F, task, alt) : select_fast<NP / 32768>(A, F, task, alt);
    if (!ok) { __syncthreads(); select_slow(A, F, task, alt); }
}

__device__ __forceinline__ void phase_gather(const Args& A, const Frame& F0) {
    const Frame F = fresh_frame(F0);
    const int gw = F.vcu * NWAVES + F.wave, NGW = F.G * NWAVES, lane = F.lane;
    const int* IDX = WSP(int, WS_IDX);
#pragma unroll 1
    for (int s = gw; s < NSLOTROWS; s += NGW) {
        const int tok = IDX[s];
        const GAS v4u* src = (const GAS v4u*)(WSP(bf16, WS_XB) + (size_t)tok * DM);
        GAS v4u* dst = (GAS v4u*)(WSP(bf16, WS_XG) + (size_t)s * DM);
        const v4u a = src[lane], b = src[lane + 64];
        dst[lane] = a; dst[lane + 64] = b;
    }
}

template <bool DRY> __device__ __forceinline__ void phase_ln2(const Args& A, const Frame& F0, int layer) {
    static_assert(FP8_YE, "the pipelined combine reads e4m3 expert rows");
    const Frame F = fresh_frame(F0);
    const int gw = F.vcu * NWAVES + F.wave, NGW = F.G * NWAVES, lane = F.lane;
    const GAS f32x4* gp = (const GAS f32x4*)(A.in[I_L2G] + (size_t)layer * DM) + lane;
    const GAS f32x4* bp = (const GAS f32x4*)(A.in[I_L2B] + (size_t)layer * DM) + lane;
    XIN_BASES();
    const int* SLOT = WSP(int, WS_SLOT); const float* GVAL = WSP(float, WS_GVAL);
    const unsigned char* YE = WSP(unsigned char, WS_YE);
    float* XO = DRY ? WSP(float, WS_R1) : A.out; bf16* XBO = DRY ? WSP(bf16, WS_Z + 201326592) : WSP(bf16, WS_XB);
    const GAS f32x4* g1p = (const GAS f32x4*)(A.in[I_L1G] + (size_t)layer * DM) + lane;
    const GAS f32x4* b1p = (const GAS f32x4*)(A.in[I_L1B] + (size_t)layer * DM) + lane;
    f32x4 g1[4], b1[4];
#pragma unroll
    for (int j = 0; j < 4; ++j) { g1[j] = g1p[64 * j]; b1[j] = b1p[64 * j]; }
    typedef float f32x2s __attribute__((ext_vector_type(2)));
    const GAS f32x2s* STATS = (const GAS f32x2s*)WSP(float, WS_STATS);
#define LN2_DECODE(sv_, gvl_, srow_, gv_, rest_) do { unsigned long long mk_ = __ballot((sv_) >= 0); \
        _Pragma("unroll") for (int b = 0; b < 4; ++b) { if (mk_) { const int e_ = __builtin_ctzll(mk_); mk_ &= mk_ - 1ull; srow_[b] = __builtin_amdgcn_readlane((sv_), e_); \
            gv_[b] = __builtin_bit_cast(float, __builtin_amdgcn_readlane(__builtin_bit_cast(int, (gvl_)), e_)); } else { srow_[b] = -1; gv_[b] = 0.f; } } rest_ = mk_; } while (0)
#define LN2_LOADROW(m_, y_, wb_, srow_) do { const GAS f32x4* xr_ = (const GAS f32x4*)XIN_ROW(m_) + lane; \
        _Pragma("unroll") for (int j = 0; j < 4; ++j) y_[j] = __builtin_nontemporal_load(&xr_[64 * j]);     \
        if (FP8_MIX) { const GAS unsigned* ms_ = (const GAS unsigned*)(WSP(unsigned char, WS_MIX8) + (size_t)(m_) * DM) + lane; _Pragma("unroll") for (int j = 0; j < 4; ++j) y_##mx[j] = ms_[64 * j]; } \
        _Pragma("unroll") for (int b = 0; b < 4; ++b) { if (srow_[b] >= 0) { const GAS unsigned* yr_ = (const GAS unsigned*)(YE + (size_t)srow_[b] * DM) + lane; \
            _Pragma("unroll") for (int j = 0; j < 4; ++j) wb_[b][j] = yr_[64 * j]; } else { _Pragma("unroll") for (int j = 0; j < 4; ++j) wb_[b][j] = 0u; } } } while (0)
    int svC = -1; float gvlC = 0.f; f32x2s stC = (f32x2s){0.f, 1.f};
    if (gw < NTOK) { svC = lane < NE ? SLOT[(size_t)gw * NE + lane] : -1; gvlC = svC >= 0 ? GVAL[svC] : 0.f; stC = STATS[gw]; }
    int svB = -1; float gvlB = 0.f; f32x2s stB = (f32x2s){0.f, 1.f};
    if (gw + NGW < NTOK) { svB = lane < NE ? SLOT[(size_t)(gw + NGW) * NE + lane] : -1; gvlB = svB >= 0 ? GVAL[svB] : 0.f; stB = STATS[gw + NGW]; }
    int srowC[4]; float gvC[4]; unsigned long long restC; f32x4 yC[4]; unsigned wbC[4][4]; unsigned yCmx[4] = {0u, 0u, 0u, 0u};
    LN2_DECODE(svC, gvlC, srowC, gvC, restC);
    if (gw < NTOK) LN2_LOADROW(gw, yC, wbC, srowC);
#pragma unroll 1
    for (int m = gw; m < NTOK; m += NGW) {
        const int m2 = m + NGW, m3 = m + 2 * NGW;
        int srowN[4]; float gvN[4]; unsigned long long restN; f32x4 yN[4]; unsigned wbN[4][4]; unsigned yNmx[4] = {0u, 0u, 0u, 0u};
        LN2_DECODE(svB, gvlB, srowN, gvN, restN);
        if (m2 < NTOK) LN2_LOADROW(m2, yN, wbN, srowN);
        int svNN = -1; f32x2s stNN = (f32x2s){0.f, 1.f};
        if (m3 < NTOK) { svNN = lane < NE ? SLOT[(size_t)m3 * NE + lane] : -1; stNN = STATS[m3]; }
        f32x4 v[4];
#pragma unroll
        for (int j = 0; j < 4; ++j) { f32x4 y = yC[j];
            if (FP8_MIX) { const f32x2s lo = __builtin_amdgcn_cvt_pk_f32_fp8((int)yCmx[j], false), hi = __builtin_amdgcn_cvt_pk_f32_fp8((int)yCmx[j], true);
                y.x = __builtin_fmaf(y.x, DN_ALPHA, lo.x); y.y = __builtin_fmaf(y.y, DN_ALPHA, lo.y); y.z = __builtin_fmaf(y.z, DN_ALPHA, hi.x); y.w = __builtin_fmaf(y.w, DN_ALPHA, hi.y); }
            v[j] = (((y - stC.x) * stC.y) * g1[j] + b1[j]) * DN_ALPHA; }
#pragma unroll
        for (int b = 0; b < 4; ++b)
#pragma unroll
            for (int j = 0; j < 4; ++j) { const f32x2s lo = __builtin_amdgcn_cvt_pk_f32_fp8((int)wbC[b][j], false), hi = __builtin_amdgcn_cvt_pk_f32_fp8((int)wbC[b][j], true);
                v[j].x += gvC[b] * lo.x; v[j].y += gvC[b] * lo.y; v[j].z += gvC[b] * hi.x; v[j].w += gvC[b] * hi.y; }
        while (restC) {
            const int e = __builtin_ctzll(restC); restC &= restC - 1ull;
            const int sr = __builtin_amdgcn_readlane(svC, e); const float ge = __builtin_bit_cast(float, __builtin_amdgcn_readlane(__builtin_bit_cast(int, gvlC), e));
            const GAS unsigned* yr = (const GAS unsigned*)(YE + (size_t)sr * DM) + lane;
            unsigned w1[4];
#pragma unroll
            for (int j = 0; j < 4; ++j) w1[j] = yr[64 * j];
#pragma unroll
            for (int j = 0; j < 4; ++j) { const f32x2s lo = __builtin_amdgcn_cvt_pk_f32_fp8((int)w1[j], false), hi = __builtin_amdgcn_cvt_pk_f32_fp8((int)w1[j], true);
                v[j].x += ge * lo.x; v[j].y += ge * lo.y; v[j].z += ge * hi.x; v[j].w += ge * hi.y; }
        }
        float s = 0.f;
#pragma unroll
        for (int j = 0; j < 4; ++j) s += (v[j].x + v[j].y) + (v[j].z + v[j].w);
        const float mean = wave_sum_x(s) * (1.f / DM); float s2 = 0.f;
#pragma unroll
        for (int j = 0; j < 4; ++j) { v[j] = v[j] - mean; s2 += (v[j].x * v[j].x + v[j].y * v[j].y) + (v[j].z * v[j].z + v[j].w * v[j].w); }
        const float rstd = 1.f / sqrtf(wave_sum_x(s2) * (1.f / DM) + LN_EPS);
        GAS v2u* bo = (GAS v2u*)(XBO + (size_t)m * DM) + lane; GAS f32x4* xw = (GAS f32x4*)(XO + (size_t)m * DM) + lane;
#pragma unroll
        for (int j = 0; j < 4; ++j) { v[j] = v[j] * rstd * gp[64 * j] + bp[64 * j]; __builtin_nontemporal_store(v[j], &xw[64 * j]);
            if (FP8_G1) { if (!DRY && layer + 1 < DEPTH) ((GAS unsigned*)(WSP(unsigned char, WS_XB8) + (size_t)m * DM))[lane + 64 * j] = pg8::pack4_fp8(v[j].x, v[j].y, v[j].z, v[j].w); }
            else { v2u w2; w2.x = pk2(v[j].x, v[j].y); w2.y = pk2(v[j].z, v[j].w); bo[64 * j] = w2; } }
        float gvlNN = svNN >= 0 ? GVAL[svNN] : 0.f;
        __builtin_amdgcn_sched_barrier(0);
        svC = svB; gvlC = gvlB; stC = stB; restC = restN;
#pragma unroll
        for (int b = 0; b < 4; ++b) { srowC[b] = srowN[b]; gvC[b] = gvN[b];
#pragma unroll
            for (int j = 0; j < 4; ++j) wbC[b][j] = wbN[b][j]; }
#pragma unroll
        for (int j = 0; j < 4; ++j) { yC[j] = yN[j]; yCmx[j] = yNmx[j]; }
        svB = svNN; gvlB = gvlNN; stB = stNN;
    }
#undef LN2_DECODE
#undef LN2_LOADROW
}

__device__ __forceinline__ bool gqa_next(int i, int vcu, int G, long& qrow0, long& kvrow0, int& NT, int& h) {
    const long U = (long)i * G + vcu;
    if (U >= 3072) return false;
    if (U < 2048) { const int ii = (int)(U >> 8), v = (int)(U & 255), xcd = v >> 5, cu = v & 31;
        const int pair = 2 * xcd + (ii >> 2), b = pair >> 1, kvh = pair & 1; h = kvh * 4 + (ii & 3);
        kvrow0 = (long)NP + (long)b * SEQ_S; qrow0 = kvrow0 + 256 * cu; NT = SEQ_S / 64; }
    else { const int U2 = (int)(U - 2048), jj = U2 >> 8, v = U2 & 255, xcd = v >> 5, cu = v & 31;
        const int pair = 2 * xcd + (jj >> 1), b = pair >> 1, kvh = pair & 1; h = kvh * 4 + (jj & 1) * 2 + (cu >> 4);
        kvrow0 = (long)b * SEQ_P; qrow0 = kvrow0 + 256 * (cu & 15); NT = SEQ_P / 64; }
    return true;
}

__global__ void __launch_bounds__(NWAVES * 64, 2) trunk_fwd(Args A) {
    extern __shared__ __attribute__((aligned(16))) unsigned char lds[];
    Frame F;
    F.lds = (LAS unsigned char*)lds;
    F.tid = threadIdx.x; F.lane = F.tid & 63; F.wave = __builtin_amdgcn_readfirstlane(F.tid >> 6);
    F.G = gridDim.x; { const int bx = blockIdx.x; F.vcu = (F.G % 8 == 0) ? (bx % 8) * (F.G / 8) + bx / 8 : bx; }
#ifdef ZERO_ALL_LDS
    for (int u = F.tid; u < LDS_BYTES / 4; u += NWAVES * 64) ((LAS unsigned*)(F.lds))[u] = 0u;
#else
    for (int u = F.tid; u < (LDS_BYTES - LDSCTL_OFF) / 4; u += NWAVES * 64) ((LAS unsigned*)(F.lds + LDSCTL_OFF))[u] = 0u;
#endif
    __syncthreads();
    unsigned* barw = (unsigned*)(A.ws + WS_CTL) + CW_BAR;
    XcdBarrier bar; bar.bar = barw; bar.x = 0; bar.st = nullptr;
    if (N_LAUNCHES == 1) bar = xcd_barrier_post(barw, (volatile LAS unsigned*)(F.lds + MISC_OFF) + 8);

    const int lo = A.ph_lo, hi = A.ph_hi;
#ifdef TOUCH_PAGES
    { unsigned acc_ = 0u; const size_t gt_ = (size_t)blockIdx.x * 512 + threadIdx.x, NT_ = (size_t)gridDim.x * 512;
      for (size_t pg = gt_; pg < WS_END / 4096; pg += NT_) acc_ += *(const GAS unsigned*)(A.ws + pg * 4096);
      for (size_t pg = gt_; pg < (size_t)NTOK * DM * 4 / 4096; pg += NT_) acc_ += *(const GAS unsigned*)((const char*)A.out + pg * 4096);
      for (int k_ = 0; k_ < 17; ++k_) { const size_t nb_ = k_ < 2 ? (size_t)(k_ ? NS : NP) * DM * 4 : (k_ == I_WG || k_ == I_WU || k_ == I_WD) ? (size_t)DEPTH * NE * DM * DF * 4 : (k_ == I_WIN ? (size_t)DEPTH * DM * D_IN * 4 : (size_t)4096);
          for (size_t pg = gt_; pg < nb_ / 4096; pg += NT_) acc_ += *(const GAS unsigned*)((const char*)A.in[k_] + pg * 4096); }
      asm volatile("" :: "v"(acc_)); }
#endif
#define IN(k) (lo <= (k) && (k) < hi)
#ifndef PHASE_MASK
#define PHASE_MASK 0xFFF
#endif
#define PHON(p) (((PHASE_MASK) >> (p)) & 1)
#ifdef XB_DOUBLE
#define SEAM(k) do { if (N_LAUNCHES == 1) { if (IN((k) + 1)) { xcd_barrier(bar); xcd_barrier(bar); } } } while (0)
#else
#define SEAM(k) do { if (N_LAUNCHES == 1) { if (IN((k) + 1)) xcd_barrier(bar); } } while (0)
#endif
#define DET_COMPARE(offA, offB, nbytes) do { xcd_barrier(bar); const Frame F2 = fresh_frame(F); const size_t gt = (size_t)(F2.vcu * NWAVES + F2.wave) * 64 + F2.lane, NT_ = (size_t)F2.G * NWAVES * 64; unsigned bad = 0u; \
        for (size_t q = gt; q < (size_t)(nbytes) / 16; q += NT_) { const v4u a = ((const GAS v4u*)(A.ws + (offA)))[q], b = ((const GAS v4u*)(A.ws + (offB)))[q]; bad |= (a.x ^ b.x) | (a.y ^ b.y) | (a.z ^ b.z) | (a.w ^ b.w); } \
        if (bad) __hip_atomic_fetch_add((unsigned*)(A.ws + WS_CTL) + 8, 1u, __ATOMIC_RELAXED, __HIP_MEMORY_SCOPE_AGENT); } while (0)

#pragma unroll 1
    for (int layer = 0; layer < DEPTH; ++layer) {
        const int P0 = layer * PH_PER_LAYER;
        if (PHON(0) && IN(P0 + 0) && (layer == 0 || N_LAUNCHES != 1)) { phase_conv<0>(A, F, layer, F.vcu * NWAVES + F.wave, F.G * NWAVES); SEAM(P0 + 0); }
        if (PHON(1) && IN(P0 + 1)) {
            pg8::Gemm g{FP8_G1 ? WSP(bf16, WS_XB8) : WSP(bf16, WS_XB), WSP(bf16, WS_WIN), NTOK, D_IN, FP8_G1 ? DM / 2 : DM}; pg8::TileOrder<0> S; S.init(NTOK / 256, D_IN / 256, F.G, (int)blockIdx.x);
#if ROPE_FUSED
            pg8::EpiProjRope E{WSP(bf16, WS_NAQKV), WSP(bf16, WS_QKVB), WSP(unsigned char, WS_GATES), A.in[I_QN] + layer * 64, A.in[I_KN] + layer * 64, (PG8_LAS float*)(F.lds + LDSCTL_OFF + 512), QSCALE, FP8_G1 ? 1.0f / WIN_SCALE : 1.0f};
            for (int rep_ = 0; rep_ < NREP(1); ++rep_) pg8::gemm_phase<pg8::EpiProjRope, pg8::TileOrder<0>, true, true, FP8_G1 != 0>(F.lds + RING_OFF, g, S, E);
#else
            pg8::EpiProj E{WSP(bf16, WS_NAQKV), WSP(bf16, WS_RAWQK), WSP(unsigned char, WS_GATES), QSCALE, FP8_G1 ? 1.0f / WIN_SCALE : 1.0f};
            for (int rep_ = 0; rep_ < NREP(1); ++rep_) pg8::gemm_phase<pg8::EpiProj, pg8::TileOrder<0>, true, true, FP8_G1 != 0>(F.lds + RING_OFF, g, S, E);
#endif
#if defined(DETPROBE) && (DETPROBE & (1 << 1))
            { pg8::EpiProj E2{WSP(bf16, WS_R2), WSP(bf16, WS_R2 + (size_t)NTOK * 1536 * 2), WSP(unsigned char, WS_GATES), QSCALE, FP8_G1 ? 1.0f / WIN_SCALE : 1.0f};
              pg8::gemm_phase<pg8::EpiProj, pg8::TileOrder<0>, true, true, FP8_G1 != 0>(F.lds + RING_OFF, g, S, E2); }
            DET_COMPARE(WS_NAQKV, WS_R2, (size_t)NTOK * 1536 * 2 + (size_t)NTOK * 768 * 4);
#endif
            SEAM(P0 + 1);
        }
        if (PHON(2) && IN(P0 + 2)) { phase_na(A, F, layer);
#if defined(DETPROBE) && (DETPROBE & (1 << 2))
            xcd_barrier(bar);
            { const Frame F2 = fresh_frame(F); const int gw = F2.vcu * NWAVES + F2.wave, NGW = F2.G * NWAVES; unsigned bad = 0u;
              for (int m = gw; m < NTOK; m += NGW) { const v4u a = ((const GAS v4u*)(WSP(bf16, WS_ATT) + (size_t)m * 512))[F2.lane], b = ((const GAS v4u*)(WSP(bf16, WS_Z) + (size_t)m * 512))[F2.lane];
                  bad |= (a.x ^ b.x) | (a.y ^ b.y) | (a.z ^ b.z) | (a.w ^ b.w); }
              if (bad) __hip_atomic_fetch_add((unsigned*)(A.ws + WS_CTL) + 8, 1u, __ATOMIC_RELAXED, __HIP_MEMORY_SCOPE_AGENT); }
#endif
            if (!ROPE_FUSED) SEAM(P0 + 2); }
        if (PHON(3) && IN(P0 + 3)) {
            const attn_body::bf16* QKV = (const attn_body::bf16*)WSP(bf16, WS_QKVB); const unsigned char* QKV8 = WSP(unsigned char, WS_QKVB);
            long qrow0, kvrow0; int NT, h;
            float gb; { const Frame F2 = fresh_frame(F); float gq_ = fabsf(A.in[I_QN][layer * 64 + F2.lane]), gk_ = fabsf(A.in[I_KN][layer * 64 + F2.lane]);
#pragma unroll
                for (int o_ = 32; o_ >= 1; o_ >>= 1) { gq_ = fmaxf(gq_, __shfl_xor(gq_, o_)); gk_ = fmaxf(gk_, __shfl_xor(gk_, o_)); }
                gb = __builtin_amdgcn_readfirstlane(gq_ * gk_ * (8.0f * 1.4426950408889634f * 1.01f)); }
            for (int rep_ = 0; rep_ < NREP(3); ++rep_)
            if (gb < 64.0f) {
            for (int i = 0; gqa_next(i, F.vcu, F.G, qrow0, kvrow0, NT, h); ++i)
                attn_body::attn_unit<8, true, FP8_BR != 0, FP8_QK != 0>(qrow0, kvrow0, NT, FP8_QK ? (const attn_body::bf16*)(QKV8 + h * 64) : QKV + h * 64, FP8_QK ? (const attn_body::bf16*)(QKV8 + 512 + (h >> 2) * 64) : QKV + 512 + (h >> 2) * 64, FP8_QK ? (const attn_body::bf16*)(QKV8 + 640) + (h >> 2) * 64 : QKV + 640 + (h >> 2) * 64,
                                        FP8_BR ? (attn_body::bf16*)(WSP(unsigned char, WS_ATT) + (size_t)NTOK * 512 + h * 64) : (attn_body::bf16*)WSP(bf16, WS_ATT) + (size_t)NTOK * 512 + h * 64, (char*)lds + RING_OFF);
            } else {
            for (int i = 0; gqa_next(i, F.vcu, F.G, qrow0, kvrow0, NT, h); ++i)
                attn_body::attn_unit<8, false, FP8_BR != 0, FP8_QK != 0>(qrow0, kvrow0, NT, FP8_QK ? (const attn_body::bf16*)(QKV8 + h * 64) : QKV + h * 64, FP8_QK ? (const attn_body::bf16*)(QKV8 + 512 + (h >> 2) * 64) : QKV + 512 + (h >> 2) * 64, FP8_QK ? (const attn_body::bf16*)(QKV8 + 640) + (h >> 2) * 64 : QKV + 640 + (h >> 2) * 64,
                                        FP8_BR ? (attn_body::bf16*)(WSP(unsigned char, WS_ATT) + (size_t)NTOK * 512 + h * 64) : (attn_body::bf16*)WSP(bf16, WS_ATT) + (size_t)NTOK * 512 + h * 64, (char*)lds + RING_OFF);
            }
#if defined(DETPROBE) && (DETPROBE & (1 << 3))
            for (int i = 0; gqa_next(i, F.vcu, F.G, qrow0, kvrow0, NT, h); ++i)
                attn_body::attn_unit<8>(qrow0, kvrow0, NT, QKV + h * 64, QKV + 512 + (h >> 2) * 64, QKV + 640 + (h >> 2) * 64,
                                        (attn_body::bf16*)WSP(bf16, WS_Z) + h * 64, (char*)lds + RING_OFF);
            xcd_barrier(bar);
            { const Frame F2 = fresh_frame(F); const int gw = F2.vcu * NWAVES + F2.wave, NGW = F2.G * NWAVES; unsigned bad = 0u;
              for (int m = gw; m < NTOK; m += NGW) { const v4u a = ((const GAS v4u*)(WSP(bf16, WS_ATT) + (size_t)NTOK * 512 + (size_t)m * 512))[F2.lane], b = ((const GAS v4u*)(WSP(bf16, WS_Z) + (size_t)m * 512))[F2.lane];
                  bad |= (a.x ^ b.x) | (a.y ^ b.y) | (a.z ^ b.z) | (a.w ^ b.w); }
              if (bad) __hip_atomic_fetch_add((unsigned*)(A.ws + WS_CTL) + 8, 1u, __ATOMIC_RELAXED, __HIP_MEMORY_SCOPE_AGENT); }
#endif
            SEAM(P0 + 3);
        }
        if (PHON(4) && IN(P0 + 4)) {
            pg8::Gemm g{WSP(bf16, WS_ATT), WSP(bf16, WS_WBR), 2 * NTOK, 1024, FP8_BR ? 256 : 512}; pg8::TileOrder<3> S; S.init(NTOK / 256, 4, F.G, (int)blockIdx.x);
            pg8::EpiBranch E{WSP(unsigned char, WS_GATES), WSP(bf16, WS_Z), FP8_OUT ? WSP(unsigned char, WS_QKVB) : nullptr, FP8_BR ? 1.0f / (ATT_SCALE * WBR_SCALE) : 1.0f};
            for (int rep_ = 0; rep_ < NREP(4); ++rep_) pg8::gemm_phase<pg8::EpiBranch, pg8::TileOrder<3>, true, true, FP8_BR != 0>(F.lds + RING_OFF, g, S, E);
#if defined(DETPROBE) && (DETPROBE & (1 << 4))
            { pg8::EpiBranch E2{WSP(unsigned char, WS_GATES), WSP(bf16, WS_QKVB), nullptr, 1.0f}; pg8::gemm_phase<pg8::EpiBranch, pg8::TileOrder<3>, true, true>(F.lds + RING_OFF, g, S, E2); }
            DET_COMPARE(WS_Z, WS_QKVB, (size_t)NTOK * DM * 2);
#endif
            SEAM(P0 + 4);
        }
        if (PHON(5) && IN(P0 + 5)) {
            pg8::Gemm g{FP8_OUT ? WSP(bf16, WS_QKVB) : WSP(bf16, WS_Z), WSP(bf16, WS_WOUT), NTOK, DM, FP8_OUT ? DM / 2 : DM}; pg8::TileOrder<0> S; S.init(NTOK / 256, DM / 256, F.G, (int)blockIdx.x);
            pg8::EpiResid<FP8_MIX != 0> E{A.out, DN_ALPHA, FP8_OUT ? 1.0f / WOUT_SCALE : 1.0f, WSP(unsigned char, WS_MIX8)};
            for (int rep_ = 0; rep_ < NREP(5); ++rep_) pg8::gemm_phase<pg8::EpiResid<FP8_MIX != 0>, pg8::TileOrder<0>, false, true, FP8_OUT != 0>(F.lds + RING_OFF, g, S, E);
            SEAM(P0 + 5);
        }
        if (PHON(6) && IN(P0 + 6)) { if (NREP(13) > 1) { const Frame F2 = fresh_frame(F); const int gw = F2.vcu * NWAVES + F2.wave, NGW = F2.G * NWAVES, lane = F2.lane, d0 = 4 * (lane & 15);
                RopeLane L; L.gq = *(const GAS f32x4*)(A.in[I_QN] + layer * 64 + d0); L.gk = *(const GAS f32x4*)(A.in[I_KN] + layer * 64 + d0);
                for (int k = 0; k < 4; ++k) L.invf[k] = __builtin_amdgcn_exp2f(-(float)((d0 + k) & 15) * (13.287712379549449f / 16.0f));
#pragma unroll 1
                for (int m = gw; m < NTOK; m += NGW) { f32x4 v[3]; const GAS v2u* src = (const GAS v2u*)(WSP(bf16, WS_RAWQK) + (size_t)m * 768) + lane;
                    for (int j = 0; j < 3; ++j) { const v2u w_ = src[64 * j]; v[j].x = bf_lo(w_.x); v[j].y = bf_hi(w_.x); v[j].z = bf_lo(w_.y); v[j].w = bf_hi(w_.y); }
                    rope_compute<true>(A, L, v, m, lane); } }
            if (NREP(6) > 1) phase_ln1<true>(A, F, layer); phase_ln1<false>(A, F, layer);
#if defined(DETPROBE) && (DETPROBE & (1 << 6))
            DET_COMPARE(WS_AFFT, WS_R1 + 420 * MiB, (size_t)NTOK * NE * 4);
#endif
            SEAM(P0 + 6); }
        if (PHON(7) && IN(P0 + 7)) {
            for (int rep_ = 0; rep_ < NREP(7); ++rep_) {
            phase_select(A, F);
#if defined(DETPROBE) && (DETPROBE & (1 << 7))
            phase_select(A, F, SEL_ALT);
#endif
            if (F.G > 2 * NE) { if ((int)blockIdx.x >= 2 * NE) conv_experts(A, F, layer, ((int)blockIdx.x - 2 * NE) * NWAVES + F.wave, (F.G - 2 * NE) * NWAVES); }
            else conv_experts(A, F, layer, (int)blockIdx.x * NWAVES + F.wave, F.G * NWAVES);
            }
#if defined(DETPROBE) && (DETPROBE & (1 << 7))
            DET_COMPARE(WS_SLOT, WS_SLOT + SEL_ALT, (size_t)NTOK * NE * 4 + 2 * (size_t)NSLOTROWS * 4);
#endif
            SEAM(P0 + 7); }
        if (PHON(9) && IN(P0 + 9)) {
            pg8::Gemm g{FP8_E1 ? WSP(bf16, WS_XB8) : WSP(bf16, WS_XB), WSP(bf16, WS_W1), NSLOTROWS, 4096, FP8_E1 ? DM / 2 : DM}; pg8::TileOrderGather S; S.init(NSLOTROWS / 256, 16, F.G, (int)blockIdx.x); S.gidx = WSP(int, WS_IDX);
            pg8::EpiSwiGLU<FP8_E2 != 0> E{WSP(void, WS_H), FP8_E1 ? 1.0f / W1_SCALE : 1.0f};
            for (int rep_ = 0; rep_ < NREP(9); ++rep_) pg8::gemm_phase<pg8::EpiSwiGLU<FP8_E2 != 0>, pg8::TileOrderGather, true, true, FP8_E1 != 0>(F.lds + RING_OFF, g, S, E);
#if defined(DETPROBE) && (DETPROBE & (1 << 9))
            { pg8::EpiSwiGLU<FP8_E2 != 0> E2{WSP(void, WS_R1 + 448 * MiB), FP8_E1 ? 1.0f / W1_SCALE : 1.0f}; pg8::gemm_phase<pg8::EpiSwiGLU<FP8_E2 != 0>, pg8::TileOrderGather, true, true, FP8_E1 != 0>(F.lds + RING_OFF, g, S, E2); }
            DET_COMPARE(WS_H, WS_R1 + 448 * MiB, (size_t)NSLOTROWS * DF * (FP8_E2 ? 1 : 2));
#endif
            SEAM(P0 + 9);
        }
        if (PHON(10) && IN(P0 + 10)) {
            pg8::Gemm g{WSP(bf16, WS_H), WSP(bf16, WS_W2), NSLOTROWS, DM, FP8_E2 ? DF / 2 : DF}; pg8::TileOrder<2> S; S.init(NSLOTROWS / 256, 4, F.G, (int)blockIdx.x);
            pg8::EpiDown<FP8_YE != 0> E{WSP(void, WS_YE), FP8_E2 ? 1.0f / W2_SCALE : 1.0f};
            for (int rep_ = 0; rep_ < NREP(10); ++rep_) pg8::gemm_phase<pg8::EpiDown<FP8_YE != 0>, pg8::TileOrder<2>, false, true, FP8_E2 != 0>(F.lds + RING_OFF, g, S, E);
#if defined(DETPROBE) && (DETPROBE & (1 << 10))
            { pg8::EpiDown<FP8_YE != 0> E2{WSP(void, WS_R1 + 512 * MiB), FP8_E2 ? 1.0f / W2_SCALE : 1.0f}; pg8::gemm_phase<pg8::EpiDown<FP8_YE != 0>, pg8::TileOrder<2>, true, true, FP8_E2 != 0>(F.lds + RING_OFF, g, S, E2); }
            DET_COMPARE(WS_YE, WS_R1 + 512 * MiB, (size_t)NSLOTROWS * DM * 2);
#endif
            SEAM(P0 + 10);
        }
        if (PHON(11) && IN(P0 + 11)) { if (NREP(11) > 1) phase_ln2<true>(A, F, layer); phase_ln2<false>(A, F, layer);
            if (N_LAUNCHES == 1 && layer + 1 < DEPTH) phase_conv<0>(A, F, layer + 1, F.vcu * NWAVES + F.wave, F.G * NWAVES);
            SEAM(P0 + 11); }
    }
#if defined(DETPROBE)
    xcd_barrier(bar);
    if (blockIdx.x == 0 && threadIdx.x == 0 && __hip_atomic_load((unsigned*)(A.ws + WS_CTL) + 8, __ATOMIC_RELAXED, __HIP_MEMORY_SCOPE_AGENT) != 0u) A.out[0] = __builtin_nanf("");
#endif
#undef IN
#undef SEAM
}

extern "C" void kernel_launch(void* const* d_in, const int* in_sizes, int n_in, void* d_out, int out_size, void* d_ws, size_t ws_size, hipStream_t stream) {
    static int grid = 0;
    if (grid == 0) {
        if (n_in != 17 || out_size != NTOK * DM || ws_size < WS_END) { fprintf(stderr, "kernel_launch: built for 17 inputs, %d outputs, >= %zu bytes of workspace; got n_in %d, out %d, ws %zu; nothing launched\n", NTOK * DM, (size_t)WS_END, n_in, out_size, ws_size); grid = -1; return; }
        int dev = 0, cus = 0, per_cu = 0;
        if (hipGetDevice(&dev) != hipSuccess || hipDeviceGetAttribute(&cus, hipDeviceAttributeMultiprocessorCount, dev) != hipSuccess) { fprintf(stderr, "kernel_launch: hipGetDevice / hipDeviceGetAttribute failed\n"); grid = -1; return; }
        if (hipFuncSetAttribute((const void*)trunk_fwd, hipFuncAttributeMaxDynamicSharedMemorySize, LDS_BYTES) != hipSuccess) { fprintf(stderr, "kernel_launch: hipFuncSetAttribute failed\n"); grid = -1; return; }
        if (hipOccupancyMaxActiveBlocksPerMultiprocessor(&per_cu, (const void*)trunk_fwd, NWAVES * 64, LDS_BYTES) != hipSuccess || per_cu < 1)
            fprintf(stderr, "kernel_launch: note: occupancy query reports %d workgroups per CU\n", per_cu);
        (void)hipGetLastError();
        grid = cus;
    }
    if (grid < 0) return;
    if (hipMemsetAsync((char*)d_ws + WS_CTL, 0, CTL_ZERO_BYTES, stream) != hipSuccess) { fprintf(stderr, "kernel_launch: hipMemsetAsync failed\n"); return; }
#ifdef POISON_WS
    (void)hipMemsetAsync((char*)d_ws + 2 * MiB, 0xAA, WS_END - 2 * MiB, stream); (void)hipMemsetAsync(d_out, 0xAA, (size_t)NTOK * DM * 4, stream);
#endif
    Args a{};
    for (int i = 0; i < 17; ++i) a.in[i] = (const float*)d_in[i];
    a.out = (float*)d_out; a.ws = (unsigned char*)d_ws;
    for (int li = 0; li < N_LAUNCHES; ++li) {
        a.ph_lo = (N_LAUNCHES == 1) ? 0 : li; a.ph_hi = (N_LAUNCHES == 1) ? N_PHASES : li + 1;
        hipLaunchKernelGGL(trunk_fwd, dim3(grid), dim3(NWAVES * 64), LDS_BYTES, stream, a);
        const hipError_t le = hipPeekAtLastError();
        if (le != hipSuccess) { fprintf(stderr, "kernel_launch: launch %d failed: %s\n", li, hipGetErrorName(le)); break; }
    }
}
```

```cpp
#include <hip/hip_runtime.h>
#include <hip/hip_bf16.h>
#include <cstdio>
#include <cstdint>
#include <cmath>
#include <type_traits>

#ifndef MK_N_LAUNCHES
#define MK_N_LAUNCHES 1
#endif

namespace pg8 {
#define PG8_LAS __attribute__((address_space(3)))
typedef unsigned short bf16_t;
typedef short bf16x8 __attribute__((ext_vector_type(8)));
typedef float f32x4 __attribute__((ext_vector_type(4)));
typedef unsigned u32x4 __attribute__((ext_vector_type(4)));
constexpr int BM = 256, BK = 64, HALF = 128, HTB = HALF * BK * 2  , STAGE_BYTES = 8 * HTB, NXCD = 8, WGM = 8;

__host__ __device__ __forceinline__ int lds_byte(int r, int c) { const int st = (r >> 4) * 2 + (c >> 5), rr = r & 15, cc = c & 31, ob = rr * 64 + cc * 2; return st * 1024 + (ob ^ (((ob >> 9) & 1) << 5)); }
__host__ __device__ __forceinline__ void stage_rc(int b, int& R, int& C) { const int st = b / 1024, sb = b % 1024, swz = sb ^ (((sb >> 9) & 1) << 5); R = (st >> 1) * 16 + swz / 64; C = (st & 1) * 32 + (swz % 64) / 2; }
__host__ __device__ __forceinline__ int perm32(int rho) { const int n = rho >> 4, i = rho & 15; return 8 * (i >> 2) + 4 * n + (i & 3); }

struct Unit { int pm, pn; };
struct Gemm { const bf16_t* A; const bf16_t* Bt; int M, N, K; };

template <int MODE> struct TileOrder {
    int nM, nN, nwg, G, c;
    __host__ __device__ void init(int nM_, int nN_, int G_, int c_) { nM = nM_; nN = nN_; nwg = nM * nN; G = G_; c = c_; }
    __host__ __device__ bool next(int i, Unit& u) const {
        const long L = (MODE == 3) ? (long)(i >> 1) * G + c : (long)i * G + c; if (L >= nwg) return false;
        int wgid = (int)L; { const int q = nwg / NXCD, r = nwg % NXCD, xcd = wgid % NXCD, off = wgid / NXCD; wgid = (xcd < r ? xcd * (q + 1) : r * (q + 1) + (xcd - r) * q) + off; }
        const int nig = WGM * nN, gid = wgid / nig, fm = gid * WGM, gsz = (nM - fm) < WGM ? (nM - fm) : WGM;
        const int pm = fm + ((wgid % nig) % gsz), pn = (wgid % nig) / gsz;
        int grp = 0;
        if (MODE == 1) grp = pm / 384;
        if (MODE == 2) grp = pm < 256 ? (pm >> 4) : ((pm - 256) >> 5);
        if (MODE == 3) { grp = i & 1; u.pm = grp * nM + pm; u.pn = grp * nN + pn; return true; }
        u.pm = pm; u.pn = grp * nN + pn; return true;
    }
    static constexpr bool GATHER = false; const int* gidx;
    __device__ __forceinline__ void a_ready(const Unit&) const {}
    __device__ __forceinline__ void done(const Unit&) const {}
};
struct TileOrderGather : TileOrder<2> { static constexpr bool GATHER = true; };

typedef float f32x2_c __attribute__((ext_vector_type(2))); typedef __bf16 bf16x2_c __attribute__((ext_vector_type(2)));
__device__ __forceinline__ unsigned cvt_pk_bf16(float lo, float hi) { const f32x2_c v = {lo, hi}; const bf16x2_c b = __builtin_convertvector(v, bf16x2_c); return __builtin_bit_cast(unsigned, b); }
__device__ __forceinline__ u32x4 pack8(const f32x4 a, const f32x4 b) { u32x4 w; w.x = cvt_pk_bf16(a[0], a[1]); w.y = cvt_pk_bf16(a[2], a[3]); w.z = cvt_pk_bf16(b[0], b[1]); w.w = cvt_pk_bf16(b[2], b[3]); return w; }
__device__ __forceinline__ float bfbits2f(unsigned v16) { return __uint_as_float(v16 << 16); }
__device__ __forceinline__ float sigmoid_f(float v) { return __builtin_amdgcn_rcpf(1.0f + __builtin_amdgcn_exp2f(-1.4426950408889634f * v)); }
__device__ __forceinline__ f32x4 exp2_4(const f32x4 v) { return (f32x4){__builtin_amdgcn_exp2f(v[0]), __builtin_amdgcn_exp2f(v[1]), __builtin_amdgcn_exp2f(v[2]), __builtin_amdgcn_exp2f(v[3])}; }
__device__ __forceinline__ f32x4 rcp_4(const f32x4 v) { return (f32x4){__builtin_amdgcn_rcpf(v[0]), __builtin_amdgcn_rcpf(v[1]), __builtin_amdgcn_rcpf(v[2]), __builtin_amdgcn_rcpf(v[3])}; }
__device__ __forceinline__ f32x4 sigmoid_scaled4(const f32x4 a, const float cneg) { return rcp_4(exp2_4(a * cneg) + 1.0f); }

typedef unsigned u32x2 __attribute__((ext_vector_type(2)));
__device__ __forceinline__ unsigned pack4_fp8(float a, float b, float c, float d) { int w = 0; w = __builtin_amdgcn_cvt_pk_fp8_f32(a, b, w, false); w = __builtin_amdgcn_cvt_pk_fp8_f32(c, d, w, true); return (unsigned)w; }

struct EpiProj {
    static constexpr bool PERM = true, AFTER_DRAIN = false;
    bf16_t* NAQKV;
    bf16_t* RAW;
    unsigned char* GATES;
    float qscale, ascale;
    __device__ __forceinline__ void operator()(const f32x4 (&acc)[2][2][4][2], const Unit& u, int wr, int wc, int fr, int fq) const {
        const int pn = u.pn;
        const size_t row0 = (size_t)u.pm * BM + wr * 64 + fr; const int colw = wc * 32 + 8 * fq;
        if (pn < 6) {
            const float sc = (pn < 2 ? qscale : 1.0f) * ascale;
#pragma unroll
            for (int ai = 0; ai < 2; ++ai)
#pragma unroll
                for (int m = 0; m < 4; ++m)
#pragma unroll
                    for (int bj = 0; bj < 2; ++bj)
                        *(u32x4*)(NAQKV + (row0 + ai * HALF + m * 16) * 1536 + pn * BM + bj * HALF + colw) = pack8(acc[ai][bj][m][0] * sc, acc[ai][bj][m][1] * sc);
        } else if (pn < 9) {
#pragma unroll
            for (int ai = 0; ai < 2; ++ai)
#pragma unroll
                for (int m = 0; m < 4; ++m)
#pragma unroll
                    for (int bj = 0; bj < 2; ++bj) *(u32x4*)(RAW + (row0 + ai * HALF + m * 16) * 768 + (pn - 6) * BM + bj * HALF + colw) = pack8(acc[ai][bj][m][0] * ascale, acc[ai][bj][m][1] * ascale);
        } else {
#pragma unroll
            for (int ai = 0; ai < 2; ++ai)
#pragma unroll
                for (int m = 0; m < 4; ++m)
#pragma unroll
                    for (int bj = 0; bj < 2; ++bj) { f32x4 v0 = acc[ai][bj][m][0] * ascale, v1 = acc[ai][bj][m][1] * ascale;
#pragma unroll
                        for (int k = 0; k < 4; ++k) { v0[k] = sigmoid_f(v0[k]); v1[k] = sigmoid_f(v1[k]); }
                        u32x2 w8; w8.x = pack4_fp8(v0[0], v0[1], v0[2], v0[3]); w8.y = pack4_fp8(v1[0], v1[1], v1[2], v1[3]);
                        *(u32x2*)(GATES + (row0 + ai * HALF + m * 16) * 2048 + (pn - 9) * BM + bj * HALF + colw) = w8; }
        }
    }
};
struct EpiBranch {
    static constexpr bool PERM = true, AFTER_DRAIN = false;
    const unsigned char* GATES; bf16_t* Z; unsigned char* Z8; float ascale;
    template <bool G1> __device__ __forceinline__ void body8(const f32x4 (&acc)[2][2][4][2], const size_t row0, const int col0) const {
        typedef float f32x2g __attribute__((ext_vector_type(2)));
#pragma unroll
        for (int ai = 0; ai < 2; ++ai) {
            u32x2 g[4][2], z[4][2];
#pragma unroll
            for (int m = 0; m < 4; ++m)
#pragma unroll
                for (int bj = 0; bj < 2; ++bj) {
                    g[m][bj] = *(const u32x2*)(GATES + (row0 + ai * HALF + m * 16) * 2048 + (G1 ? 1024 : 0) + col0 + bj * HALF);
                    if (G1) z[m][bj] = *(const u32x2*)(Z8 + (row0 + ai * HALF + m * 16) * 1024 + col0 + bj * HALF); }
#pragma unroll
            for (int m = 0; m < 4; ++m)
#pragma unroll
                for (int bj = 0; bj < 2; ++bj) {
                    const u32x2 gw = g[m][bj];
                    const f32x2g a0 = __builtin_amdgcn_cvt_pk_f32_fp8((int)gw.x, false), a1 = __builtin_amdgcn_cvt_pk_f32_fp8((int)gw.x, true), a2 = __builtin_amdgcn_cvt_pk_f32_fp8((int)gw.y, false), a3 = __builtin_amdgcn_cvt_pk_f32_fp8((int)gw.y, true);
                    f32x4 v0 = acc[ai][bj][m][0] * ((f32x4){a0.x, a0.y, a1.x, a1.y} * ascale), v1 = acc[ai][bj][m][1] * ((f32x4){a2.x, a2.y, a3.x, a3.y} * ascale);
                    if (G1) { const u32x2 zw = z[m][bj];
                        const f32x2g b0 = __builtin_amdgcn_cvt_pk_f32_fp8((int)zw.x, false), b1 = __builtin_amdgcn_cvt_pk_f32_fp8((int)zw.x, true), b2 = __builtin_amdgcn_cvt_pk_f32_fp8((int)zw.y, false), b3 = __builtin_amdgcn_cvt_pk_f32_fp8((int)zw.y, true);
                        v0 = v0 + (f32x4){b0.x, b0.y, b1.x, b1.y}; v1 = v1 + (f32x4){b2.x, b2.y, b3.x, b3.y}; }
                    u32x2 w8; w8.x = pack4_fp8(v0[0], v0[1], v0[2], v0[3]); w8.y = pack4_fp8(v1[0], v1[1], v1[2], v1[3]);
                    *(u32x2*)(Z8 + (row0 + ai * HALF + m * 16) * 1024 + col0 + bj * HALF) = w8; }
            __builtin_amdgcn_sched_barrier(0);
        }
    }
    __device__ __forceinline__ void operator()(const f32x4 (&acc)[2][2][4][2], const Unit& u, int wr, int wc, int fr, int fq) const {
        const int grp = u.pm >= 384 ? 1 : 0, pm = u.pm - grp * 384, pn = u.pn & 3;
        if (Z8) { const size_t row0 = (size_t)pm * BM + wr * 64 + fr; const int col0 = pn * BM + wc * 32 + 8 * fq;
            if (grp) body8<true>(acc, row0, col0); else body8<false>(acc, row0, col0);
            return; }
#pragma unroll
        for (int ai = 0; ai < 2; ++ai)
#pragma unroll
            for (int m = 0; m < 4; ++m) {
                const size_t row = (size_t)pm * BM + ai * HALF + wr * 64 + m * 16 + fr;
#pragma unroll
                for (int bj = 0; bj < 2; ++bj) {
                    const int col = pn * BM + bj * HALF + wc * 32 + 8 * fq;
                    const u32x2 g = *(const u32x2*)(GATES + row * 2048 + grp * 1024 + col);
                    f32x4 v0 = acc[ai][bj][m][0], v1 = acc[ai][bj][m][1];
                    { typedef float f32x2g __attribute__((ext_vector_type(2)));
                      const f32x2g a0 = __builtin_amdgcn_cvt_pk_f32_fp8((int)g.x, false), a1 = __builtin_amdgcn_cvt_pk_f32_fp8((int)g.x, true), a2 = __builtin_amdgcn_cvt_pk_f32_fp8((int)g.y, false), a3 = __builtin_amdgcn_cvt_pk_f32_fp8((int)g.y, true);
                      v0[0] *= a0.x; v0[1] *= a0.y; v0[2] *= a1.x; v0[3] *= a1.y; v1[0] *= a2.x; v1[1] *= a2.y; v1[2] *= a3.x; v1[3] *= a3.y; }
                    bf16_t* zp = Z + row * 1024 + col;
                    if (grp) { const u32x4 z = *(const u32x4*)zp;
                        v0[0] += bfbits2f(z.x & 0xffffu); v0[1] += bfbits2f(z.x >> 16); v0[2] += bfbits2f(z.y & 0xffffu); v0[3] += bfbits2f(z.y >> 16);
                        v1[0] += bfbits2f(z.z & 0xffffu); v1[1] += bfbits2f(z.z >> 16); v1[2] += bfbits2f(z.w & 0xffffu); v1[3] += bfbits2f(z.w >> 16); }
                    *(u32x4*)zp = pack8(v0, v1);
                }
            }
    }
};
template <bool MIX8> struct EpiResid {
    static constexpr bool PERM = true, AFTER_DRAIN = false;
    float* X; float alpha, ascale; unsigned char* M8;
    __device__ __forceinline__ void operator()(const f32x4 (&acc)[2][2][4][2], const Unit& u, int wr, int wc, int fr, int fq) const {
#pragma unroll
        for (int ai = 0; ai < 2; ++ai)
#pragma unroll
            for (int m = 0; m < 4; ++m) {
                const size_t row = (size_t)u.pm * BM + ai * HALF + wr * 64 + m * 16 + fr;
#pragma unroll
                for (int bj = 0; bj < 2; ++bj) {
                    const size_t off = row * 1024 + u.pn * BM + bj * HALF + wc * 32 + 8 * fq;
                    if constexpr (MIX8) { const f32x4 m0 = acc[ai][bj][m][0] * ascale, m1 = acc[ai][bj][m][1] * ascale; u32x2 w8; w8.x = pack4_fp8(m0[0], m0[1], m0[2], m0[3]); w8.y = pack4_fp8(m1[0], m1[1], m1[2], m1[3]);
                        *(u32x2*)(M8 + off) = w8; }
                    else { float* p = X + off; const f32x4 x0 = *(const f32x4*)p, x1 = *(const f32x4*)(p + 4);
                        *(f32x4*)p = x0 * alpha + acc[ai][bj][m][0] * ascale; *(f32x4*)(p + 4) = x1 * alpha + acc[ai][bj][m][1] * ascale; }
                }
            }
    }
};
template <bool FP8OUT> struct EpiSwiGLU {
    static constexpr bool PERM = true, AFTER_DRAIN = false;
    void* H; float ascale;
    __device__ __forceinline__ void operator()(const f32x4 (&acc)[2][2][4][2], const Unit& u, int wr, int wc, int fr, int fq) const {
        const int pn = u.pn & 15;
#pragma unroll
        for (int ai = 0; ai < 2; ++ai)
#pragma unroll
            for (int m = 0; m < 4; ++m) {
                const size_t row = (size_t)u.pm * BM + ai * HALF + wr * 64 + m * 16 + fr;
                const float cneg = -1.4426950408889634f * ascale, s2 = ascale * ascale;
                const f32x4 h0 = (acc[ai][0][m][0] * acc[ai][1][m][0]) * (sigmoid_scaled4(acc[ai][0][m][0], cneg) * s2);
                const f32x4 h1 = (acc[ai][0][m][1] * acc[ai][1][m][1]) * (sigmoid_scaled4(acc[ai][0][m][1], cneg) * s2);
                const size_t off = row * 2048 + pn * HALF + wc * 32 + 8 * fq;
                if (FP8OUT) { u32x2 w; w.x = pack4_fp8(h0[0], h0[1], h0[2], h0[3]); w.y = pack4_fp8(h1[0], h1[1], h1[2], h1[3]); *(u32x2*)((unsigned char*)H + off) = w; }
                else *(u32x4*)((bf16_t*)H + off) = pack8(h0, h1);
            }
    }
};
template <bool FP8OUT> struct EpiDown {
    static constexpr bool PERM = true, AFTER_DRAIN = false;
    void* YE; float ascale;
    __device__ __forceinline__ void operator()(const f32x4 (&acc)[2][2][4][2], const Unit& u, int wr, int wc, int fr, int fq) const {
        const int pn = u.pn & 3;
#pragma unroll
        for (int ai = 0; ai < 2; ++ai)
#pragma unroll
            for (int m = 0; m < 4; ++m) {
                const size_t row = (size_t)u.pm * BM + ai * HALF + wr * 64 + m * 16 + fr;
#pragma unroll
                for (int bj = 0; bj < 2; ++bj)
                { const f32x4 v0 = acc[ai][bj][m][0] * ascale, v1 = acc[ai][bj][m][1] * ascale; const size_t off = row * 1024 + pn * BM + bj * HALF + wc * 32 + 8 * fq;
                  if (FP8OUT) { u32x2 w8; w8.x = pack4_fp8(v0[0], v0[1], v0[2], v0[3]); w8.y = pack4_fp8(v1[0], v1[1], v1[2], v1[3]); *(u32x2*)((unsigned char*)YE + off) = w8; }
                  else *(u32x4*)((bf16_t*)YE + off) = pack8(v0, v1); }
            }
    }
};

template <class Epi, class Sched, bool ALIGN_EPI = false, bool SP2 = false, bool FP8 = false>
__device__ __forceinline__ void gemm_phase(PG8_LAS unsigned char* lds, const Gemm g, const Sched& S, const Epi& E) {
    int tid_ = threadIdx.x; asm volatile("" : "+v"(tid_));
    const int tid = tid_, wid = __builtin_amdgcn_readfirstlane(tid >> 6), lane = tid & 63, wr = wid >> 2, wc = wid & 3, fr = lane & 15, fq = lane >> 4;
    const int K = g.K, nt = K / BK;
    unsigned voffA[2], voffB[2]; int gR[2]; unsigned gC[2];
#pragma unroll
    for (int i = 0; i < 2; ++i) { int R, C; stage_rc(tid * 16 + i * 8192, R, C); const int Rb = Epi::PERM ? ((R & ~31) + perm32(R & 31)) : R;
        voffA[i] = (unsigned)(R * K + C) * 2u; voffB[i] = (unsigned)(Rb * K + C) * 2u; gR[i] = R; gC[i] = (unsigned)C * 2u; }
    constexpr bool GATH = Sched::GATHER; static_assert(!GATH || SP2, "the gather variant is written for the SP2 loop");
    unsigned oc[2][2] = {{0u, 0u}, {0u, 0u}}, on[2][2] = {{0u, 0u}, {0u, 0u}};
#define PG8_GOFF(o, unit) do { _Pragma("unroll") for (int _h = 0; _h < 2; ++_h) _Pragma("unroll") for (int _i = 0; _i < 2; ++_i) \
        (o)[_h][_i] = (unsigned)S.gidx[(unit).pm * BM + _h * HALF + gR[_i]] * (unsigned)(K * 2) + gC[_i]; } while (0)
    const size_t kstep = (size_t)(BK * 2);
    const size_t hstep = (size_t)HALF * K * 2;
    const size_t tstep = 2 * hstep;
    const unsigned ldsw = (unsigned)wid * 1024u;
    const int aoff = lds_byte(wr * 64 + fr, fq * 8), boff = lds_byte(wc * 32 + fr, fq * 8);
    typedef int i32x4_t __attribute__((ext_vector_type(4))); typedef int i32x8_t __attribute__((ext_vector_type(8)));
    int sc8 = 0x7F7F7F7F; asm volatile("" : "+v"(sc8));
#define PG8_SA(b, h) (((b) * 2 + (h)) * HTB)
#define PG8_SB(b, h) ((4 + (b) * 2 + (h)) * HTB)
#define PG8_STAGE(bufoff, gbase, voff) do { _Pragma("unroll") for (int _i = 0; _i < 2; ++_i) \
        __builtin_amdgcn_global_load_lds((const unsigned*)((const char*)(gbase) + (voff)[_i]), (PG8_LAS unsigned*)(lds + (bufoff) + ldsw + _i * 8192), 16, 0, 0); } while (0)
#define PG8_LD32(p) __builtin_shufflevector(*(const PG8_LAS i32x4_t*)(p), *(const PG8_LAS i32x4_t*)((p) + 1024), 0, 1, 2, 3, 4, 5, 6, 7)
#define PG8_LDA(dst, b, h) do { if constexpr (FP8) { _Pragma("unroll") for (int m = 0; m < 4; ++m) dst##8[m] = PG8_LD32(lds + PG8_SA(b, h) + aoff + m * 2048); } else { \
        _Pragma("unroll") for (int m = 0; m < 4; ++m) _Pragma("unroll") for (int k = 0; k < 2; ++k) dst[m][k] = *(const PG8_LAS bf16x8*)(lds + PG8_SA(b, h) + aoff + m * 2048 + k * 1024); } } while (0)
#define PG8_LDB(dst, b, h) do { if constexpr (FP8) { _Pragma("unroll") for (int n = 0; n < 2; ++n) dst##8[n] = PG8_LD32(lds + PG8_SB(b, h) + boff + n * 2048); } else { \
        _Pragma("unroll") for (int n = 0; n < 2; ++n) _Pragma("unroll") for (int k = 0; k < 2; ++k) dst[n][k] = *(const PG8_LAS bf16x8*)(lds + PG8_SB(b, h) + boff + n * 2048 + k * 1024); } } while (0)
#define PG8_MMA(ai, bj, At, Bt) do { __builtin_amdgcn_s_setprio(1); if constexpr (FP8) { _Pragma("unroll") for (int m = 0; m < 4; ++m) _Pragma("unroll") for (int n = 0; n < 2; ++n) \
        asm volatile("v_mfma_scale_f32_16x16x128_f8f6f4 %0, %1, %2, %0, %3, %3 op_sel_hi:[0,0,0]" : "+v"(acc[ai][bj][m][n]) : "v"(Bt##8[n]), "v"(At##8[m]), "v"(sc8)); } else { \
        _Pragma("unroll") for (int m = 0; m < 4; ++m) _Pragma("unroll") for (int n = 0; n < 2; ++n) _Pragma("unroll") for (int k = 0; k < 2; ++k) \
        acc[ai][bj][m][n] = __builtin_amdgcn_mfma_f32_16x16x32_bf16(Bt[n][k], At[m][k], acc[ai][bj][m][n], 0, 0, 0); } __builtin_amdgcn_s_setprio(0); } while (0)
#define PG8_WAIT_V(n) asm volatile("s_waitcnt vmcnt(" #n ")" ::: "memory")
#define PG8_WAIT_L(n) asm volatile("s_waitcnt lgkmcnt(" #n ")" ::: "memory")
#define PG8_BAR __builtin_amdgcn_s_barrier()
#define PG8_SCHED __builtin_amdgcn_sched_barrier(0)
    Unit cur, nxt; int ui = 0;
    if (!S.next(0, cur)) return;
    f32x4 acc[2][2][4][2];
#pragma unroll
    for (int a = 0; a < 2; ++a)
#pragma unroll
        for (int b = 0; b < 2; ++b)
#pragma unroll
            for (int m = 0; m < 4; ++m)
#pragma unroll
                for (int n = 0; n < 2; ++n) acc[a][b][m][n] = (f32x4){0.f, 0.f, 0.f, 0.f};
    bf16x8 At[4][2], B0[2][2], B1[2][2]; i32x8_t At8[4], B08[2], B18[2];
    const char* const gA = (const char*)g.A;
    const char* cA = (const char*)g.A + (size_t)cur.pm * tstep; const char* cB = (const char*)g.Bt + (size_t)cur.pn * tstep;
    S.a_ready(cur);
    if constexpr (SP2) {
        if constexpr (GATH) { PG8_GOFF(oc, cur); }
        PG8_STAGE(PG8_SB(0, 0), cB, voffB); PG8_STAGE(PG8_SB(0, 1), cB + hstep, voffB);
        if constexpr (GATH) { PG8_STAGE(PG8_SA(0, 0), gA, oc[0]); PG8_STAGE(PG8_SA(0, 1), gA, oc[1]); } else { PG8_STAGE(PG8_SA(0, 0), cA, voffA); PG8_STAGE(PG8_SA(0, 1), cA + hstep, voffA); }
        if (wr == 1) PG8_BAR;
        PG8_WAIT_V(2); PG8_BAR;
        PG8_STAGE(PG8_SB(1, 0), cB + kstep, voffB); if constexpr (GATH) { PG8_STAGE(PG8_SA(1, 0), gA + kstep, oc[0]); } else { PG8_STAGE(PG8_SA(1, 0), cA + kstep, voffA); } PG8_STAGE(PG8_SB(1, 1), cB + hstep + kstep, voffB);
        PG8_WAIT_V(6); PG8_BAR;
    } else {
        PG8_STAGE(PG8_SB(0, 0), cB, voffB); PG8_STAGE(PG8_SA(0, 0), cA, voffA); PG8_STAGE(PG8_SB(0, 1), cB + hstep, voffB); PG8_STAGE(PG8_SA(0, 1), cA + hstep, voffA);
        if (wr == 1) PG8_BAR;
        PG8_WAIT_V(4); PG8_BAR;
        PG8_STAGE(PG8_SB(1, 0), cB + kstep, voffB); PG8_STAGE(PG8_SA(1, 0), cA + kstep, voffA); PG8_STAGE(PG8_SB(1, 1), cB + hstep + kstep, voffB);
        PG8_WAIT_V(6); PG8_BAR;
    }
    for (;;) {
        const bool has_next = S.next(ui + 1, nxt);
        if constexpr (GATH) { if (has_next) { PG8_GOFF(on, nxt); } else { _Pragma("unroll") for (int _h = 0; _h < 2; ++_h) _Pragma("unroll") for (int _i = 0; _i < 2; ++_i) on[_h][_i] = oc[_h][_i]; } }
        const char* nA = has_next ? (const char*)g.A + (size_t)nxt.pm * tstep : cA; const char* nB = has_next ? (const char*)g.Bt + (size_t)nxt.pn * tstep : cB;
        for (int t = 0; t < nt; t += 2) {
            const bool last = (t == nt - 2);
            const char* a1 = cA + (size_t)(t + 1) * kstep;
            const char* a2 = last ? nA : cA + (size_t)(t + 2) * kstep; const char* b2 = last ? nB : cB + (size_t)(t + 2) * kstep;
            const char* a3 = a2 + kstep; const char* b3 = b2 + kstep;
            if (last && has_next) S.a_ready(nxt);
            const char* ga1 = gA + (size_t)(t + 1) * kstep; const char* ga2 = last ? gA : gA + (size_t)(t + 2) * kstep;
            unsigned os0[2], os1[2];
            if constexpr (GATH) { os0[0] = last ? on[0][0] : oc[0][0]; os0[1] = last ? on[0][1] : oc[0][1]; os1[0] = last ? on[1][0] : oc[1][0]; os1[1] = last ? on[1][1] : oc[1][1]; }
            if constexpr (SP2) {
            PG8_LDB(B0, 0, 0); PG8_LDB(B1, 0, 1); PG8_SCHED; PG8_LDA(At, 0, 0); if constexpr (GATH) { PG8_STAGE(PG8_SA(1, 1), ga1, oc[1]); } else { PG8_STAGE(PG8_SA(1, 1), a1 + hstep, voffA); }
            PG8_WAIT_V(8); PG8_WAIT_L(0); PG8_BAR; PG8_MMA(0, 0, At, B0); PG8_MMA(0, 1, At, B1); PG8_BAR; PG8_SCHED;
            PG8_LDA(At, 0, 1); PG8_STAGE(PG8_SB(0, 0), b2, voffB); PG8_STAGE(PG8_SB(0, 1), b2 + hstep, voffB); if constexpr (GATH) { PG8_STAGE(PG8_SA(0, 0), ga2, os0); } else { PG8_STAGE(PG8_SA(0, 0), a2, voffA); }
            PG8_WAIT_V(8); PG8_WAIT_L(0); PG8_BAR; PG8_MMA(1, 0, At, B0); PG8_MMA(1, 1, At, B1); PG8_BAR; PG8_SCHED;
            PG8_LDB(B0, 1, 0); PG8_LDB(B1, 1, 1); PG8_SCHED; PG8_LDA(At, 1, 0); if constexpr (GATH) { PG8_STAGE(PG8_SA(0, 1), ga2, os1); } else { PG8_STAGE(PG8_SA(0, 1), a2 + hstep, voffA); }
            PG8_WAIT_V(8); PG8_WAIT_L(0); PG8_BAR; PG8_MMA(0, 0, At, B0); PG8_MMA(0, 1, At, B1); PG8_BAR; PG8_SCHED;
            PG8_LDA(At, 1, 1); PG8_STAGE(PG8_SB(1, 0), b3, voffB); PG8_STAGE(PG8_SB(1, 1), b3 + hstep, voffB); if constexpr (GATH) { PG8_STAGE(PG8_SA(1, 0), ga2 + kstep, os0); } else { PG8_STAGE(PG8_SA(1, 0), a3, voffA); }
            PG8_WAIT_V(8); PG8_WAIT_L(0); PG8_BAR; PG8_MMA(1, 0, At, B0); PG8_MMA(1, 1, At, B1); PG8_BAR; PG8_SCHED;
            } else {
            PG8_LDB(B0, 0, 0); PG8_SCHED; PG8_LDA(At, 0, 0); PG8_STAGE(PG8_SA(1, 1), a1 + hstep, voffA);
            PG8_WAIT_L(8); PG8_BAR; PG8_WAIT_L(0); PG8_MMA(0, 0, At, B0); PG8_BAR; PG8_SCHED;
            PG8_LDB(B1, 0, 1); PG8_STAGE(PG8_SB(0, 0), b2, voffB);
            PG8_BAR; PG8_WAIT_L(0); PG8_MMA(0, 1, At, B1); PG8_BAR;
            PG8_LDA(At, 0, 1); PG8_STAGE(PG8_SA(0, 0), a2, voffA);
            PG8_BAR; PG8_WAIT_L(0); PG8_MMA(1, 0, At, B0); PG8_BAR; PG8_SCHED;
            PG8_STAGE(PG8_SB(0, 1), b2 + hstep, voffB);
            PG8_WAIT_V(6); PG8_BAR; PG8_MMA(1, 1, At, B1); PG8_BAR;
            PG8_LDB(B0, 1, 0); PG8_SCHED; PG8_LDA(At, 1, 0); PG8_STAGE(PG8_SA(0, 1), a2 + hstep, voffA);
            PG8_WAIT_L(8); PG8_BAR; PG8_WAIT_L(0); PG8_MMA(0, 0, At, B0); PG8_BAR; PG8_SCHED;
            PG8_LDB(B1, 1, 1); PG8_STAGE(PG8_SB(1, 0), b3, voffB);
            PG8_BAR; PG8_WAIT_L(0); PG8_MMA(0, 1, At, B1); PG8_BAR;
            PG8_LDA(At, 1, 1); PG8_STAGE(PG8_SA(1, 0), a3, voffA);
            PG8_BAR; PG8_WAIT_L(0); PG8_MMA(1, 0, At, B0); PG8_BAR; PG8_SCHED;
            PG8_STAGE(PG8_SB(1, 1), b3 + hstep, voffB);
            PG8_WAIT_V(6); PG8_BAR; PG8_MMA(1, 1, At, B1); PG8_BAR;
            }
        }
        if constexpr (ALIGN_EPI) { if (wr == 0) PG8_BAR; }
        if constexpr (FP8) asm volatile("s_nop 15\n\ts_nop 15" ::: "memory");
        if constexpr (!Epi::AFTER_DRAIN) { E(acc, cur, wr, wc, fr, fq); S.done(cur); }
        if (!has_next) break;
#pragma unroll
        for (int a = 0; a < 2; ++a)
#pragma unroll
            for (int b = 0; b < 2; ++b)
#pragma unroll
                for (int m = 0; m < 4; ++m)
#pragma unroll
                    for (int n = 0; n < 2; ++n) acc[a][b][m][n] = (f32x4){0.f, 0.f, 0.f, 0.f};
        cur = nxt; cA = nA; cB = nB; ++ui;
        if constexpr (GATH) { _Pragma("unroll") for (int _h = 0; _h < 2; ++_h) _Pragma("unroll") for (int _i = 0; _i < 2; ++_i) oc[_h][_i] = on[_h][_i]; }
        if constexpr (ALIGN_EPI) { if (wr == 1) PG8_BAR; }
    }
    PG8_WAIT_V(0);
    if constexpr (!ALIGN_EPI) { if (wr == 0) PG8_BAR; }
    PG8_BAR;
    if constexpr (Epi::AFTER_DRAIN) { E.fused(acc, cur, wr, wc, fr, fq, lds, wid, lane); S.done(cur); }
#undef PG8_SA
#undef PG8_SB
#undef PG8_STAGE
#undef PG8_LDA
#undef PG8_LDB
#undef PG8_MMA
#undef PG8_WAIT_V
#undef PG8_WAIT_L
#undef PG8_BAR
#undef PG8_SCHED
#undef PG8_LD32
#undef PG8_GOFF
}

}

namespace attn_body {

using bf16=__hip_bfloat16;
using bf16x8=__attribute__((ext_vector_type(8)))short;
using s16x4=__attribute__((ext_vector_type(4)))short;
using f32x16=__attribute__((ext_vector_type(16)))float;
using u32x4=__attribute__((ext_vector_type(4)))unsigned;
constexpr int D=64,QP=768,KP=768,VP=768,OP=512;
constexpr int NW=8,QBLK=32,QB=QBLK*NW,KVBLK=64;
constexpr int ATTN_UNIT_ROWS=QB;
__device__ __forceinline__ int crow(int r,int hi){return (r&3)+8*(r>>2)+4*hi;}
#define SBAR() __builtin_amdgcn_sched_barrier(0)
constexpr int NSLOT=3, SLOTB=8192;
constexpr int LDS_K=0, LDS_V=NSLOT*SLOTB, LDS_WS=2*NSLOT*SLOTB, LDS_OST=LDS_WS+NW*64*4, LDS_BYTES=LDS_OST+NW*4096;
constexpr float C2=0.125f*1.4426950408889634f;
__device__ __forceinline__ void glds16(const void*gsrc,unsigned lds_dst){unsigned keep;
  asm volatile("s_mov_b32 %0, m0\n\ts_mov_b32 m0, %2\n\ts_nop 0\n\tglobal_load_lds_dwordx4 %1, off\n\ts_mov_b32 m0, %0":"=&s"(keep):"v"(gsrc),"s"(lds_dst):"memory");}
__device__ __forceinline__ float max3f(float a,float b,float c){float r;asm("v_max3_f32 %0, %1, %2, %3":"=v"(r):"v"(a),"v"(b),"v"(c));return r;}
__device__ __forceinline__ float max2f(float a,float b){float r;asm("v_max_f32_e32 %0, %1, %2":"=v"(r):"v"(a),"v"(b));return r;}
__device__ __forceinline__ float fadd_s(float a,float b){float r;asm("v_add_f32_e32 %0, %1, %2":"=v"(r):"v"(a),"v"(b));return r;}
__device__ __forceinline__ float fsub_s(float a,float b){float r;asm("v_sub_f32_e32 %0, %1, %2":"=v"(r):"v"(a),"v"(b));return r;}
typedef float f32x2_t __attribute__((ext_vector_type(2))); typedef __bf16 bf16x2_t __attribute__((ext_vector_type(2)));
__device__ __forceinline__ unsigned cvtpk_s(float lo,float hi){f32x2_t v={lo,hi};bf16x2_t b=__builtin_convertvector(v,bf16x2_t);return __builtin_bit_cast(unsigned,b);}
#define WAIT_BAR(N) asm volatile("s_waitcnt vmcnt(" #N ") lgkmcnt(0)\n\ts_barrier":::"memory")

__device__ __forceinline__ void qkt(f32x16&p0,f32x16&p1,const char*Kslot,const bf16x8*qr,const f32x16&negm,int r32,int hi){
  const char*kb=Kslot+hi*1024+r32*16;
  #pragma unroll
  for(int d0=0;d0<4;++d0){
    const bf16x8 b0=*reinterpret_cast<const bf16x8*>(kb+d0*2048);
    const bf16x8 b1=*reinterpret_cast<const bf16x8*>(kb+d0*2048+512);
    if(d0==0){p0=__builtin_amdgcn_mfma_f32_32x32x16_bf16(b0,qr[0],negm,0,0,0);p1=__builtin_amdgcn_mfma_f32_32x32x16_bf16(b1,qr[0],negm,0,0,0);}
    else{p0=__builtin_amdgcn_mfma_f32_32x32x16_bf16(b0,qr[d0],p0,0,0,0);p1=__builtin_amdgcn_mfma_f32_32x32x16_bf16(b1,qr[d0],p1,0,0,0);}}
}
typedef __attribute__((address_space(3))) const char* lds_cptr;
typedef short v4i16_t __attribute__((ext_vector_type(4)));
__device__ __forceinline__ void kload8(bf16x8*kf,lds_cptr kp){
  kf[0]=*(const __attribute__((address_space(3))) bf16x8*)(kp);      kf[1]=*(const __attribute__((address_space(3))) bf16x8*)(kp+512);
  kf[2]=*(const __attribute__((address_space(3))) bf16x8*)(kp+2048); kf[3]=*(const __attribute__((address_space(3))) bf16x8*)(kp+2560);
  kf[4]=*(const __attribute__((address_space(3))) bf16x8*)(kp+4096); kf[5]=*(const __attribute__((address_space(3))) bf16x8*)(kp+4608);
  kf[6]=*(const __attribute__((address_space(3))) bf16x8*)(kp+6144); kf[7]=*(const __attribute__((address_space(3))) bf16x8*)(kp+6656);
}
__device__ __forceinline__ void kload2(bf16x8*kf,lds_cptr kp,int j){ kf[2*j]=*(const __attribute__((address_space(3))) bf16x8*)(kp+j*2048); kf[2*j+1]=*(const __attribute__((address_space(3))) bf16x8*)(kp+j*2048+512); }
__device__ __forceinline__ s16x4 vtr(lds_cptr p){ return __builtin_bit_cast(s16x4,__builtin_amdgcn_ds_read_tr16_b64_v4i16((__attribute__((address_space(3))) v4i16_t*)p)); }
__device__ __forceinline__ float rowmax(const f32x16&p0,const f32x16&p1){
  float a=max3f(p0[0],p0[1],p1[0]),b=max3f(p0[2],p0[3],p1[1]);a=max3f(a,p1[2],p1[3]);
  #pragma unroll
  for(int r=4;r<16;r+=4){a=max3f(a,p0[r],p0[r+1]);b=max3f(b,p0[r+2],p0[r+3]);a=max3f(a,p1[r],p1[r+1]);b=max3f(b,p1[r+2],p1[r+3]);}
  const float m=max2f(a,b);
  auto rr=__builtin_amdgcn_permlane32_swap(__float_as_uint(m),__float_as_uint(m),false,false);
  return max2f(__uint_as_float(rr[0]),__uint_as_float(rr[1]));
}
__device__ __forceinline__ void pv(f32x16*o,int vb,bf16x8 pa0,bf16x8 pa1,bf16x8 pa2,bf16x8 pa3){
  #pragma unroll
  for(int d0=0;d0<2;++d0){s16x4 lo[4],hi[4];
    #pragma unroll
    for(int ks=0;ks<4;++ks){
      asm volatile("ds_read_b64_tr_b16 %0,%1 offset:%c2":"=&v"(lo[ks]):"v"(vb),"i"(d0*4096+ks*1024):"memory");
      asm volatile("ds_read_b64_tr_b16 %0,%1 offset:%c2":"=&v"(hi[ks]):"v"(vb),"i"(d0*4096+ks*1024+512):"memory");}
    asm volatile("s_waitcnt lgkmcnt(0)":::"memory");SBAR();
    #define PK(k) (bf16x8){lo[k][0],lo[k][1],lo[k][2],lo[k][3],hi[k][0],hi[k][1],hi[k][2],hi[k][3]}
    o[d0]=__builtin_amdgcn_mfma_f32_32x32x16_bf16(pa0,PK(0),o[d0],0,0,0);
    o[d0]=__builtin_amdgcn_mfma_f32_32x32x16_bf16(pa1,PK(1),o[d0],0,0,0);
    o[d0]=__builtin_amdgcn_mfma_f32_32x32x16_bf16(pa2,PK(2),o[d0],0,0,0);
    o[d0]=__builtin_amdgcn_mfma_f32_32x32x16_bf16(pa3,PK(3),o[d0],0,0,0);
    #undef PK
  }
}

#ifndef ATTN_STORE16
#define ATTN_STORE16(p,v) (*(u32x4*)(p)=(v))
#endif
constexpr float O8SCALE=32.f;
typedef int i32x8q __attribute__((ext_vector_type(8))); typedef int i32x4q __attribute__((ext_vector_type(4)));
#define MFMA8(a,b,c) __builtin_amdgcn_mfma_scale_f32_32x32x64_f8f6f4((a),(b),(c),0,0,0,0x7F7F7F7F,0,0x7F7F7F7F)
template<int THRL,bool NOMAX=false,bool O8=false,bool QK8=false> __device__ __forceinline__ void attn_unit(long qrow0,long kvrow0,int NT,const bf16*Qh,const bf16*__restrict__ Kh,const bf16*__restrict__ Vh,bf16*Oh,char*shm){
  int tid_=threadIdx.x; asm volatile("":"+v"(tid_)); const int tid=tid_,lane=tid&63,r32=lane&31,hi=lane>>5; const int wid=__builtin_amdgcn_readfirstlane(tid>>6);
  const bf16*Qw=Qh+(qrow0+wid*QBLK)*QP; constexpr int RB8=896, VPe=QK8?448:VP;
  const unsigned lds0=(unsigned)(uintptr_t)shm;
  float*wsf=(float*)(shm+LDS_WS)+wid*64;
  const char*ksrc=QK8?(const char*)Kh+(kvrow0+lane)*RB8+(wid&3)*16:(const char*)(Kh+(kvrow0+lane)*KP+wid*8);
  const long kstep=QK8?(long)KVBLK*RB8:(long)KVBLK*KP*2;
  const bf16*vsrc=Vh+(kvrow0+16*(wid&3)+(lane>>2))*VPe+(wid>>2)*32+(lane&3)*8;
  const unsigned kdst=lds0+LDS_K+(QK8?(wid&3):wid)*1024, vdst=lds0+LDS_V+wid*1024;
  #define DMA_K(t,slot) glds16(ksrc+(long)(t)*kstep,(unsigned)__builtin_amdgcn_readfirstlane(kdst+(slot)))
  #define DMA_V(t,slot) glds16(vsrc+(long)(t)*KVBLK*VPe,(unsigned)__builtin_amdgcn_readfirstlane(vdst+(slot)))
  const int vb0=(int)(lds0+LDS_V)+((lane>>4)&1)*32+(lane&3)*8+(4*hi+((lane&15)>>2))*64;
  const char*Kbase=shm+LDS_K; bf16x8 kf[8]; i32x8q kf8[2]; i32x8q qr8;
  const lds_cptr shm3=(lds_cptr)shm; const lds_cptr kp0=shm3+LDS_K+hi*(QK8?2048:1024)+r32*16;     const lds_cptr vp0=shm3+LDS_V+((lane>>4)&1)*32+(lane&3)*8+(4*hi+((lane&15)>>2))*64;
  DMA_K(0,0);DMA_V(0,0);DMA_K(1,SLOTB);
  bf16x8 qr[4];
  #pragma unroll
  for(int d0=0;d0<4;++d0)if constexpr(!QK8)qr[d0]=*reinterpret_cast<const bf16x8*>(&Qw[(long)r32*QP+d0*16+hi*8]);
  if constexpr(QK8){ const char*q8=(const char*)Qh+(qrow0+wid*QBLK+r32)*RB8+32*hi; const i32x4q a_=*reinterpret_cast<const i32x4q*>(q8), b_=*reinterpret_cast<const i32x4q*>(q8+16); qr8=__builtin_shufflevector(a_,b_,0,1,2,3,4,5,6,7); }
  float mhat=0.f,l_reg=0.f;f32x16 o[2];o[0]=f32x16{};o[1]=f32x16{};
  typedef float f32x4_t __attribute__((ext_vector_type(4)));
  f32x4_t lsum={0.f,0.f,0.f,0.f}; bf16x8 bones; { const short one_=((((lane>>4)&1)!=0)==((lane&15)>=8))?(short)0x3F80:(short)0; bones=(bf16x8){one_,one_,one_,one_,one_,one_,one_,one_}; }
  #define LSUM(k) do{ lsum=__builtin_amdgcn_mfma_f32_16x16x32_bf16(PAF(k),bones,lsum,0,0,0); }while(0)
f32x16 negm=f32x16{};if constexpr(!NOMAX)asm volatile("":"+v"(negm));
  #define CMASK(P0,P1,t) do{}while(0)
  bool resc=false;
  #define KLD8(blk,kp_) do{ const i32x4q a_=*(const __attribute__((address_space(3))) i32x4q*)((kp_)+(blk)*512), b_=*(const __attribute__((address_space(3))) i32x4q*)((kp_)+(blk)*512+1024); kf8[blk]=__builtin_shufflevector(a_,b_,0,1,2,3,4,5,6,7); }while(0)
  #define START(P0,P1) do{ if constexpr(!NOMAX){ const float rm=rowmax(P0,P1); resc=false; \
    { const float dl=rm; mhat=fadd_s(mhat,dl); \
      _Pragma("unroll") for(int r=0;r<16;++r){P0[r]=fsub_s(P0[r],dl);P1[r]=fsub_s(P1[r],dl);} \
      _Pragma("unroll") for(int r=0;r<16;++r)negm[r]=-mhat; asm volatile("":"+v"(negm)); } } \
    _Pragma("unroll") for(int r=0;r<16;++r)P0[r]=__builtin_amdgcn_exp2f(P0[r]); }while(0)
  #define RESC() do{ if constexpr(!NOMAX) if(resc){ asm volatile("s_waitcnt lgkmcnt(0)":::"memory"); \
      _Pragma("unroll") for(int d_=0;d_<2;++d_) _Pragma("unroll") for(int r=0;r<16;++r)o[d_][r]*=wsf[crow(r,hi)]; } }while(0)
  f32x16 pA0,pA1,pB0,pB1;
  int sl_prev=0,sl_cur=0,sl_next=SLOTB;
  #define ROT() do{sl_prev=sl_cur;sl_cur=sl_next;sl_next=(sl_next==(NSLOT-1)*SLOTB)?0:sl_next+SLOTB;}while(0)
  DMA_K(2,2*SLOTB);
  WAIT_BAR(3);
  if constexpr(QK8){ KLD8(0,kp0); KLD8(1,kp0); pA0=MFMA8(kf8[0],qr8,negm); pA1=MFMA8(kf8[1],qr8,negm); } else qkt(pA0,pA1,Kbase,qr,negm,r32,hi);
  asm volatile("s_nop 15\n\ts_nop 7":"+v"(pA0),"+v"(pA1));CMASK(pA0,pA1,0);
  START(pA0,pA1);
  if constexpr(!NOMAX){ _Pragma("unroll") for(int r=0;r<16;++r)pA1[r]=__builtin_amdgcn_exp2f(pA1[r]); }
  WAIT_BAR(0);
  DMA_K(3,0);DMA_V(1,SLOTB);
  ROT();
  if constexpr(QK8){ KLD8(0,kp0+sl_cur); KLD8(1,kp0+sl_cur); } else kload8(kf,kp0+sl_cur);
  WAIT_BAR(2);
  s16x4 vlo[8],vhi[8]; u32x4 pw0,pw1,pw2,pw3;
  #define PKW(P,B) cvtpk_s(P[B],P[B+1])
  #define PAF(k) __builtin_bit_cast(bf16x8,pw##k)
  #define VFR(i) (bf16x8){vlo[i][0],vlo[i][1],vlo[i][2],vlo[i][3],vhi[i][0],vhi[i][1],vhi[i][2],vhi[i][3]}
  #define PIN(x) asm volatile("":"+v"(x))
  #define MX3(a,b,c) __builtin_fmaxf(__builtin_fmaxf((a),(b)),(c))
  #define GAPA(MF,A0,A1,A2,A3,W0,W1,PW) do{ MF; sacc+=A0; sacc+=A1; sacc+=A2; sacc+=A3; PIN(sacc); W0; W1; PIN(PW); SBAR(); }while(0)
  #define EX(v) __builtin_amdgcn_exp2f(v)
  #define QKM(E8,E16) do{ if constexpr(QK8){ E8; } else { E16; } }while(0)
  #define GAPB(MF,X,B) do{ MF; X[B]=EX(X[B]); X[B+1]=EX(X[B+1]); X[B+2]=EX(X[B+2]); X[B+3]=EX(X[B+3]); PIN(X); SBAR(); }while(0)
  #define VRD(i) do{ vlo[i]=vtr(vp_+(((i)>>2)*4096+((i)&3)*1024)); vhi[i]=vtr(vp_+(((i)>>2)*4096+((i)&3)*1024+512)); }while(0)
  #define KRD(G,j) do{ if(G){ if constexpr(QK8){ if((j)<2){ KLD8((j),kp0+sl_next); SBAR(); } } else { kload2(kf,kp0+sl_next,j); SBAR(); } } }while(0)
  #define STEP(C0,C1,P0,P1,t,GK,GV,GL) do{ SBAR(); \
    const lds_cptr vp_=vp0+sl_prev; \
    VRD(0); SBAR(); float sacc=(P0[0]+P0[1]); \
    GAPA(QKM(C0=MFMA8(kf8[0],qr8,negm), C0=__builtin_amdgcn_mfma_f32_32x32x16_bf16(kf[0],qr[0],negm,0,0,0)), P0[2],P0[3],P0[4],P0[5],     pw0[0]=PKW(P0,0), pw0[1]=PKW(P0,2), pw0); \
    VRD(4); SBAR(); GAPA(QKM((void)0, C1=__builtin_amdgcn_mfma_f32_32x32x16_bf16(kf[1],qr[0],negm,0,0,0)), P0[6],P0[7],P0[8],P0[9],     pw0[2]=PKW(P0,4), pw0[3]=PKW(P0,6), pw0); \
    VRD(1); SBAR(); GAPA(QKM((void)0, C0=__builtin_amdgcn_mfma_f32_32x32x16_bf16(kf[2],qr[1],C0,0,0,0)),   P0[10],P0[11],P0[12],P0[13], pw1[0]=PKW(P0,8), pw1[1]=PKW(P0,10), pw1); \
    VRD(5); SBAR(); GAPA(QKM((void)0, C1=__builtin_amdgcn_mfma_f32_32x32x16_bf16(kf[3],qr[1],C1,0,0,0)),   P0[14],P0[15],P1[0],P1[1],   pw1[2]=PKW(P0,12),pw1[3]=PKW(P0,14), pw1); \
    VRD(2); SBAR(); GAPA(QKM(C1=MFMA8(kf8[1],qr8,negm), C0=__builtin_amdgcn_mfma_f32_32x32x16_bf16(kf[4],qr[2],C0,0,0,0)),   P1[2],P1[3],P1[4],P1[5],     pw2[0]=PKW(P1,0), pw2[1]=PKW(P1,2), pw2); \
    VRD(6); SBAR(); GAPA(QKM((void)0, C1=__builtin_amdgcn_mfma_f32_32x32x16_bf16(kf[5],qr[2],C1,0,0,0)),   P1[6],P1[7],P1[8],P1[9],     pw2[2]=PKW(P1,4), pw2[3]=PKW(P1,6), pw2); \
    VRD(3); SBAR(); GAPA(QKM((void)0, C0=__builtin_amdgcn_mfma_f32_32x32x16_bf16(kf[6],qr[3],C0,0,0,0)),   P1[10],P1[11],P1[12],P1[13], pw3[0]=PKW(P1,8), pw3[1]=PKW(P1,10), pw3); \
    VRD(7); SBAR(); GAPA(QKM((void)0, C1=__builtin_amdgcn_mfma_f32_32x32x16_bf16(kf[7],qr[3],C1,0,0,0)),   P1[14],P1[15],0.f,0.f,       pw3[2]=PKW(P1,12),pw3[3]=PKW(P1,14), pw3); \
    l_reg+=sacc; \
    if(GK){DMA_K((t)+3,sl_cur);} if(GV){DMA_V((t)+1,sl_next);} \
    CMASK(C0,C1,t); \
    if constexpr(!NOMAX){ float a=MX3(C0[0],C0[1],C1[0]),b=MX3(C0[2],C0[3],C1[1]); a=MX3(a,C1[2],C1[3]); \
      _Pragma("unroll") for(int r=4;r<16;r+=4){a=MX3(a,C0[r],C0[r+1]);b=MX3(b,C0[r+2],C0[r+3]);a=MX3(a,C1[r],C1[r+1]);b=MX3(b,C1[r+2],C1[r+3]);} \
      float rm=__builtin_fmaxf(a,b); { auto rr=__builtin_amdgcn_permlane32_swap(__float_as_uint(rm),__float_as_uint(rm),false,false); rm=__builtin_fmaxf(__uint_as_float(rr[0]),__uint_as_float(rr[1])); } \
      resc=false; \
      if(__builtin_expect(__any(rm>(float)THRL),0)){ const float dl=__builtin_fmaxf(rm,0.f); mhat+=dl; \
        _Pragma("unroll") for(int r=0;r<16;++r){C0[r]-=dl;C1[r]-=dl;} \
        _Pragma("unroll") for(int r=0;r<16;++r)negm[r]=-mhat; asm volatile("":"+v"(negm)); \
        const float f=__builtin_amdgcn_exp2f(-dl); l_reg*=f; if(hi==0)wsf[r32]=f; resc=true; } } \
    SBAR(); \
    GAPB(o[0]=__builtin_amdgcn_mfma_f32_32x32x16_bf16(PAF(0),VFR(0),o[0],0,0,0), C0,0); \
    GAPB(o[1]=__builtin_amdgcn_mfma_f32_32x32x16_bf16(PAF(0),VFR(4),o[1],0,0,0), C0,4); \
    KRD(GL,0); GAPB(o[0]=__builtin_amdgcn_mfma_f32_32x32x16_bf16(PAF(1),VFR(1),o[0],0,0,0), C0,8); \
    KRD(GL,1); GAPB(o[1]=__builtin_amdgcn_mfma_f32_32x32x16_bf16(PAF(1),VFR(5),o[1],0,0,0), C0,12); \
    KRD(GL,2); GAPB(o[0]=__builtin_amdgcn_mfma_f32_32x32x16_bf16(PAF(2),VFR(2),o[0],0,0,0), C1,0); \
    KRD(GL,3); GAPB(o[1]=__builtin_amdgcn_mfma_f32_32x32x16_bf16(PAF(2),VFR(6),o[1],0,0,0), C1,4); \
    GAPB(o[0]=__builtin_amdgcn_mfma_f32_32x32x16_bf16(PAF(3),VFR(3),o[0],0,0,0), C1,8); \
    GAPB(o[1]=__builtin_amdgcn_mfma_f32_32x32x16_bf16(PAF(3),VFR(7),o[1],0,0,0), C1,12); \
    }while(0)
  #define EX2(P,B) P[B]=EX(P[B]); P[(B)+1]=EX(P[(B)+1]);
  #define GAPX(MF,EXS,W0,W1,PW,PP) do{ MF; EXS PIN(PP); W0; W1; PIN(PW); SBAR(); }while(0)
  #define GAPY(MF,X,B) do{ MF; X[B]=EX(X[B]); X[(B)+1]=EX(X[(B)+1]); PIN(X); SBAR(); }while(0)
  #define STEPX(C0,C1,P0,P1,t,GK,GV,GL) do{ SBAR(); \
    const lds_cptr vp_=vp0+sl_prev; \
    VRD(0); SBAR(); \
    GAPX(QKM(C0=MFMA8(kf8[0],qr8,negm), C0=__builtin_amdgcn_mfma_f32_32x32x16_bf16(kf[0],qr[0],negm,0,0,0)), EX2(P1,0),             pw0[0]=PKW(P0,0), pw0[1]=PKW(P0,2), pw0, P1); \
    VRD(4); SBAR(); GAPX(QKM((void)0, C1=__builtin_amdgcn_mfma_f32_32x32x16_bf16(kf[1],qr[0],negm,0,0,0)), EX2(P1,2),  pw0[2]=PKW(P0,4), pw0[3]=PKW(P0,6), pw0, P1); \
    VRD(1); SBAR(); GAPX(QKM((void)0, C0=__builtin_amdgcn_mfma_f32_32x32x16_bf16(kf[2],qr[1],C0,0,0,0)),   EX2(P1,4),  pw1[0]=PKW(P0,8), pw1[1]=PKW(P0,10), pw1, P1); \
    VRD(5); SBAR(); GAPX(QKM((void)0, C1=__builtin_amdgcn_mfma_f32_32x32x16_bf16(kf[3],qr[1],C1,0,0,0)),   EX2(P1,6),  pw1[2]=PKW(P0,12),pw1[3]=PKW(P0,14), pw1, P1); \
    VRD(2); SBAR(); GAPX(QKM(C1=MFMA8(kf8[1],qr8,negm), C0=__builtin_amdgcn_mfma_f32_32x32x16_bf16(kf[4],qr[2],C0,0,0,0)),   EX2(P1,8) EX2(P1,10),  pw2[0]=PKW(P1,0), pw2[1]=PKW(P1,2), pw2, P1); \
    VRD(6); SBAR(); GAPX(QKM((void)0, C1=__builtin_amdgcn_mfma_f32_32x32x16_bf16(kf[5],qr[2],C1,0,0,0)),   EX2(P1,12) EX2(P1,14), pw2[2]=PKW(P1,4), pw2[3]=PKW(P1,6), pw2, P1); \
    VRD(3); SBAR(); GAPX(QKM((void)0, C0=__builtin_amdgcn_mfma_f32_32x32x16_bf16(kf[6],qr[3],C0,0,0,0)),   ,           pw3[0]=PKW(P1,8), pw3[1]=PKW(P1,10), pw3, P1); \
    VRD(7); SBAR(); GAPX(QKM((void)0, C1=__builtin_amdgcn_mfma_f32_32x32x16_bf16(kf[7],qr[3],C1,0,0,0)),   ,           pw3[2]=PKW(P1,12),pw3[3]=PKW(P1,14), pw3, P1); \
    if(GK){DMA_K((t)+3,sl_cur);} if(GV){DMA_V((t)+1,sl_next);} \
    SBAR(); \
    LSUM(0); GAPY(o[0]=__builtin_amdgcn_mfma_f32_32x32x16_bf16(PAF(0),VFR(0),o[0],0,0,0), C0,0); \
    GAPY(o[1]=__builtin_amdgcn_mfma_f32_32x32x16_bf16(PAF(0),VFR(4),o[1],0,0,0), C0,2); \
    KRD(GL,0); LSUM(1); GAPY(o[0]=__builtin_amdgcn_mfma_f32_32x32x16_bf16(PAF(1),VFR(1),o[0],0,0,0), C0,4); \
    KRD(GL,1); GAPY(o[1]=__builtin_amdgcn_mfma_f32_32x32x16_bf16(PAF(1),VFR(5),o[1],0,0,0), C0,6); \
    KRD(GL,2); LSUM(2); GAPY(o[0]=__builtin_amdgcn_mfma_f32_32x32x16_bf16(PAF(2),VFR(2),o[0],0,0,0), C0,8); \
    KRD(GL,3); GAPY(o[1]=__builtin_amdgcn_mfma_f32_32x32x16_bf16(PAF(2),VFR(6),o[1],0,0,0), C0,10); \
    LSUM(3); GAPY(o[0]=__builtin_amdgcn_mfma_f32_32x32x16_bf16(PAF(3),VFR(3),o[0],0,0,0), C0,12); \
    GAPY(o[1]=__builtin_amdgcn_mfma_f32_32x32x16_bf16(PAF(3),VFR(7),o[1],0,0,0), C0,14); \
    }while(0)
  #define STEPS(C0,C1,P0,P1,t,GK,GV,GL) do{ if constexpr(NOMAX) STEPX(C0,C1,P0,P1,t,GK,GV,GL); else STEP(C0,C1,P0,P1,t,GK,GV,GL); }while(0)
  int t=1;
  #undef CMASK
  #define CMASK(P0,P1,t) do{}while(0)
  for(;t+5<NT;t+=2){
    STEPS(pB0,pB1,pA0,pA1,t,true,true,true);     WAIT_BAR(2); RESC(); ROT();
    STEPS(pA0,pA1,pB0,pB1,t+1,true,true,true);   WAIT_BAR(2); RESC(); ROT();
  }
  #undef CMASK
  #define CMASK(P0,P1,t) do{}while(0)
  #define ENDW(tt) do{ if((tt)+3<NT){WAIT_BAR(2);} else if((tt)+2<NT){WAIT_BAR(1);} else {WAIT_BAR(0);} }while(0)
  for(;t+1<NT;t+=2){
    STEPS(pB0,pB1,pA0,pA1,t,(t+3<NT),(t+1<NT),(t+1<NT));       ENDW(t);   RESC(); ROT();
    STEPS(pA0,pA1,pB0,pB1,t+1,(t+4<NT),(t+2<NT),(t+2<NT));     ENDW(t+1); RESC(); ROT();
  }
  STEPS(pB0,pB1,pA0,pA1,NT-1,false,false,false); RESC();
  { if constexpr(NOMAX){ _Pragma("unroll") for(int r=0;r<16;++r)pB1[r]=__builtin_amdgcn_exp2f(pB1[r]); }
    else { float sacc=pB0[0]+pB0[1]; _Pragma("unroll") for(int r=2;r<16;++r)sacc+=pB0[r]; _Pragma("unroll") for(int r=0;r<16;++r)sacc+=pB1[r]; l_reg+=sacc; }
    pw0=(u32x4){PKW(pB0,0),PKW(pB0,2),PKW(pB0,4),PKW(pB0,6)};pw1=(u32x4){PKW(pB0,8),PKW(pB0,10),PKW(pB0,12),PKW(pB0,14)};pw2=(u32x4){PKW(pB1,0),PKW(pB1,2),PKW(pB1,4),PKW(pB1,6)};pw3=(u32x4){PKW(pB1,8),PKW(pB1,10),PKW(pB1,12),PKW(pB1,14)};
    SBAR(); if constexpr(NOMAX){ LSUM(0); LSUM(1); LSUM(2); LSUM(3); } pv(o,vb0+sl_cur,PAF(0),PAF(1),PAF(2),PAF(3)); }
  #undef LSUM
  #undef QKM
  #undef KLD8
  #undef EX2
  #undef GAPX
  #undef GAPY
  #undef STEPX
  #undef STEPS
  #undef PKW
  #undef PAF
  #undef VFR
  #undef PIN
  #undef MX3
  #undef GAPA
  #undef GAPB
  #undef EX
  #undef VRD
  #undef KRD
  #undef STEP
  #undef ENDW
  if constexpr(NOMAX){ asm volatile("s_nop 7":"+v"(lsum));
    if((lane&7)==0){ const int qb_=4*(lane>>4)+16*((lane>>3)&1); wsf[32+qb_]=lsum[0]; wsf[33+qb_]=lsum[1]; wsf[34+qb_]=lsum[2]; wsf[35+qb_]=lsum[3]; }
  } else {
  {auto rr=__builtin_amdgcn_permlane32_swap(__float_as_uint(l_reg),__float_as_uint(l_reg),false,false);l_reg=__uint_as_float(rr[0])+__uint_as_float(rr[1]);}
  if(hi==0)wsf[32+r32]=l_reg; }
  asm volatile("s_waitcnt lgkmcnt(0)":::"memory");
  float rli[16];
  #pragma unroll
  for(int r=0;r<16;++r)rli[r]=__builtin_amdgcn_rcpf(wsf[32+crow(r,hi)]);
  if constexpr(O8){ unsigned char*Ow8=(unsigned char*)Oh+(qrow0+wid*QBLK)*OP; unsigned char*stg8=(unsigned char*)(shm+LDS_OST)+wid*2048;
    #pragma unroll
    for(int r=0;r<16;++r){const int orow=crow(r,hi); const float sc=rli[r]*O8SCALE;
      #pragma unroll
      for(int d0=0;d0<2;++d0)stg8[orow*64+d0*32+r32]=(unsigned char)(__builtin_amdgcn_cvt_pk_fp8_f32(o[d0][r]*sc,o[d0][r]*sc,0,false)&0xff);}
    asm volatile("s_waitcnt lgkmcnt(0)":::"memory");
    #pragma unroll
    for(int i=0;i<2;++i){const int row=i*16+(lane>>2),ch=lane&3; const u32x4 v=*(const u32x4*)(stg8+row*64+ch*16); ATTN_STORE16(Ow8+(long)row*OP+ch*16,v);}
  } else {
  bf16*Ow=Oh+(qrow0+wid*QBLK)*OP;
  { bf16*stg=(bf16*)(shm+LDS_OST)+wid*2048;
    #pragma unroll
    for(int r=0;r<16;++r){const int orow=crow(r,hi);
      #pragma unroll
      for(int d0=0;d0<2;++d0)stg[orow*64+d0*32+r32]=__float2bfloat16(o[d0][r]*rli[r]);}
    asm volatile("s_waitcnt lgkmcnt(0)":::"memory");
    #pragma unroll
    for(int i=0;i<4;++i){const int row=i*8+(lane>>3),ch=lane&7; const u32x4 v=*(const u32x4*)(stg+row*64+ch*8); ATTN_STORE16(Ow+(long)row*OP+ch*8,v);} }
  }
  asm volatile("s_waitcnt lgkmcnt(0)\n\ts_barrier":::"memory");
  #undef DMA_K
  #undef DMA_V
  #undef CMASK
  #undef START
  #undef RESC
  #undef ROT
}
constexpr int ATTN_LDS_BYTES=LDS_BYTES;
#undef SBAR
#undef WAIT_BAR
}

#ifndef DUP_MASK
#define DUP_MASK 0
#endif
#ifndef ROPE_DRY_FIRST
#define ROPE_DRY_FIRST 0
#endif
#define NREP(p) (1 + (((DUP_MASK) >> (p)) & 1))
#ifndef FP8_E1
#define FP8_E1 1
#endif
#ifndef FP8_E2
#define FP8_E2 1
#endif
#ifndef FP8_G1
#define FP8_G1 1
#endif
#ifndef FP8_OUT
#define FP8_OUT 1
#endif
#ifndef FP8_MIX
#define FP8_MIX 1
#endif
#ifndef FP8_YE
#define FP8_YE 1
#endif
#ifndef FP8_NAQK
#define FP8_NAQK 1
#endif
#ifndef FP8_QK
#define FP8_QK 1
#endif
#ifndef FP8_BR
#define FP8_BR 1
#endif
constexpr float WIN_SCALE = 64.f, WOUT_SCALE = 64.f, ATT_SCALE = 32.f, WBR_SCALE = 16.f;
static_assert(!FP8_G1 || FP8_E1, "the e4m3 activation buffer sits in the upper half of the bf16 XB region: with FP8_G1 the bf16 x1 must not be written (needs FP8_E1)");
constexpr float W1_SCALE = 64.f, W2_SCALE = 128.f;
constexpr int NWAVES = 8;
constexpr int N_LAUNCHES = MK_N_LAUNCHES;
constexpr int DM = 1024, DEPTH = 4, NP = 32768, NS = 65536, NTOK = NP + NS;
constexpr int SEQ_P = 4096, SEQ_S = 8192;
constexpr int D_IN = 4352, NE = 16, DF = 2048;
constexpr int NSLOTROWS = 2 * NTOK;
constexpr int PH_PER_LAYER = 12, N_PHASES = DEPTH * PH_PER_LAYER;
constexpr float LN_EPS = 1e-5f, RMS_EPS = 1e-6f, LOG2E = 1.4426950408889634f;
constexpr float DN_ALPHA = 1.681792830507429f;
constexpr float QSCALE = 0.125f * LOG2E;
static_assert(N_LAUNCHES == 1 || N_LAUNCHES == N_PHASES, "MK_N_LAUNCHES is 1 or 48");

constexpr size_t MiB = 1u << 20;
constexpr size_t WS_CTL = 0, CTL_ZERO_BYTES = 1 * MiB;
constexpr size_t WS_WIN = 2 * MiB;
constexpr size_t WS_WBR = WS_WIN + (size_t)D_IN * DM * 2;
constexpr size_t WS_WOUT = WS_WBR + (size_t)2 * 1024 * 512 * 2;
constexpr size_t WS_W1 = WS_WOUT + (size_t)1024 * 2048 * 2;
constexpr size_t WS_W2 = WS_W1 + (size_t)NE * 4096 * 1024 * 2;
constexpr size_t WS_XB = WS_W2 + (size_t)NE * 1024 * 2048 * 2;
constexpr size_t WS_R1 = WS_XB + (size_t)NTOK * DM * 2;
constexpr size_t WS_NAQKV = WS_R1;
constexpr size_t WS_RAWQK = WS_NAQKV + (size_t)NTOK * 1536 * 2;
constexpr size_t WS_GATES = WS_RAWQK + (size_t)NTOK * 768 * 4;
constexpr size_t WS_R1_END = WS_GATES + (size_t)NTOK * 2048 * 2;
constexpr size_t WS_H = WS_R1;
constexpr size_t WS_XB8_OLD = WS_XB + (size_t)NTOK * DM;
static_assert(WS_H + (size_t)NSLOTROWS * DF * 2 <= WS_R1_END && (!(FP8_G1 || FP8_E1) || true), "H overlay fits R1");
constexpr size_t WS_R2 = WS_R1_END;
constexpr size_t WS_ATT = WS_R2;
constexpr size_t WS_Z = WS_ATT + (size_t)2 * NTOK * 512 * 2;
constexpr size_t WS_QKVB = WS_Z + (size_t)NTOK * 1024 * 2;
constexpr size_t WS_MIX8 = WS_QKVB + (size_t)NTOK * DM;
constexpr size_t WS_R2_END = WS_Z + (size_t)NTOK * 2048 * 2;
constexpr size_t WS_XG = WS_R2;
constexpr size_t WS_YE = WS_R2;
static_assert(WS_XG + (size_t)NSLOTROWS * DM * 2 <= WS_R2_END, "XG/YE overlay fits R2");
constexpr size_t WS_AFFT = WS_R2_END;
constexpr size_t WS_SLOT = WS_AFFT + (size_t)NTOK * NE * 4;
constexpr size_t WS_IDX = WS_SLOT + (size_t)NTOK * NE * 4;
constexpr size_t WS_GVAL = WS_IDX + (size_t)NSLOTROWS * 4;
constexpr size_t WS_XB8 = WS_GVAL + (size_t)NSLOTROWS * 4;
constexpr size_t WS_END = WS_XB8 + (size_t)NTOK * DM;
static_assert(WS_END <= (size_t)2047 * MiB, "d_ws map fits under 2 GiB");
constexpr size_t WS_STATS = 1 * MiB;
constexpr int CW_BAR = 4096;

constexpr int RING_OFF = 0, RING_BYTES = 131072;
constexpr int LDSCTL_OFF = RING_BYTES, MISC_OFF = LDSCTL_OFF + 320;
constexpr int LDS_BYTES = 147456;
static_assert(MISC_OFF + 128 <= LDS_BYTES, "LDS map");

#define GAS __attribute__((address_space(1)))
#define LAS __attribute__((address_space(3)))
typedef unsigned short bf16;
typedef unsigned v4u __attribute__((ext_vector_type(4)));
typedef unsigned v2u __attribute__((ext_vector_type(2)));
typedef float f32x4 __attribute__((ext_vector_type(4)));
typedef float f32x16 __attribute__((ext_vector_type(16)));
typedef short bf16x8 __attribute__((ext_vector_type(8)));
typedef GAS unsigned gu32;
#define RLX_AGENT __ATOMIC_RELAXED, __HIP_MEMORY_SCOPE_AGENT
#define LDS_WAIT() asm volatile("s_waitcnt lgkmcnt(0)" ::: "memory")
#define VM_WAIT() asm volatile("s_waitcnt vmcnt(0)" ::: "memory")
__device__ __forceinline__ unsigned f2bf(float f) { unsigned u = __builtin_bit_cast(unsigned, f); return (u + 0x7fffu + ((u >> 16) & 1u)) >> 16; }
__device__ __forceinline__ unsigned pk2(float lo, float hi) { typedef float f32x2p __attribute__((ext_vector_type(2))); typedef __bf16 bf16x2p __attribute__((ext_vector_type(2)));
    const f32x2p v = {lo, hi}; return __builtin_bit_cast(unsigned, __builtin_convertvector(v, bf16x2p)); }
__device__ __forceinline__ float bf_lo(unsigned w) { return __uint_as_float(w << 16); }
__device__ __forceinline__ float bf_hi(unsigned w) { return __uint_as_float(w & 0xffff0000u); }


#ifndef ROPE_FUSED
#define ROPE_FUSED 1
#endif
namespace pg8 {
struct EpiProjRope {
    static constexpr bool PERM = true, AFTER_DRAIN = false;
    bf16_t* NAQKV; bf16_t* QKVB; unsigned char* GATES; const float* qn; const float* kn; PG8_LAS float* xch; float qscale, ascale;
    __device__ __forceinline__ void operator()(const f32x4 (&acc)[2][2][4][2], const Unit& u, int wr, int wc, int fr, int fq) const {
        const int pn = u.pn;
        const size_t row0 = (size_t)u.pm * BM + wr * 64 + fr; const int colw = wc * 32 + 8 * fq;
        if (pn < 6) {
            const float sc = (pn < 2 ? qscale : 1.0f) * ascale;
#pragma unroll
            for (int ai = 0; ai < 2; ++ai)
#pragma unroll
                for (int m = 0; m < 4; ++m)
#pragma unroll
                    for (int bj = 0; bj < 2; ++bj) {
                        if (FP8_NAQK) { unsigned char* const rp = (unsigned char*)NAQKV + (row0 + ai * HALF + m * 16) * 2048; const f32x4 v0 = acc[ai][bj][m][0] * sc, v1 = acc[ai][bj][m][1] * sc;
                            if (pn < 4) { u32x2 w; w.x = pack4_fp8(v0[0], v0[1], v0[2], v0[3]); w.y = pack4_fp8(v1[0], v1[1], v1[2], v1[3]); *(u32x2*)(rp + pn * BM + bj * HALF + colw) = w; }
                            else *(u32x4*)(rp + 1024 + 2 * ((pn - 4) * BM + bj * HALF + colw)) = pack8(v0, v1); }
                        else *(u32x4*)(NAQKV + (row0 + ai * HALF + m * 16) * 1536 + pn * BM + bj * HALF + colw) = pack8(acc[ai][bj][m][0] * sc, acc[ai][bj][m][1] * sc); }
        } else if (pn < 9) {
            unsigned xo_mine = (unsigned)(size_t)xch + (unsigned)(((wr * 64 + fr) * 8 + wc) * 4), xo_part = (unsigned)(size_t)xch + (unsigned)(((wr * 64 + fr) * 8 + (wc ^ 1)) * 4);
            asm volatile("" : "+v"(xo_mine), "+v"(xo_part));
            PG8_LAS float* const xm = (PG8_LAS float*)(size_t)xo_mine; PG8_LAS float* const xp = (PG8_LAS float*)(size_t)xo_part;
#pragma unroll
            for (int ai = 0; ai < 2; ++ai)
#pragma unroll
                for (int m = 0; m < 4; ++m)
#pragma unroll
                    for (int bj = 0; bj < 2; ++bj) { const f32x4 a = acc[ai][bj][m][0], b = acc[ai][bj][m][1];
                        float s = ((a[0] * a[0] + a[1] * a[1]) + (a[2] * a[2] + a[3] * a[3])) + ((b[0] * b[0] + b[1] * b[1]) + (b[2] * b[2] + b[3] * b[3]));
                        s *= ascale * ascale; s += __shfl_xor(s, 16); s += __shfl_xor(s, 32);
                        if (fq == 0) xm[(ai * HALF + m * 16) * 8 + bj * 4] = s; }
            asm volatile("s_waitcnt lgkmcnt(0)\n\ts_barrier" ::: "memory");
            const int dq = 32 * (wc & 1) + 8 * fq;
            const int off0 = (pn - 6) * BM + colw, offv = 640 + 2 * colw;
            const float* gsrc = (pn == 8 ? kn : qn) + dq; const f32x4 g0 = *(const f32x4*)gsrc, g1 = *(const f32x4*)(gsrc + 4);
            const float invf0 = (fq & 1) ? 0.01f : 1.0f;
            constexpr float RJ[8] = {1.0f, 0.5623413251903491f, 0.31622776601683794f, 0.1778279410038923f, 0.1f, 0.05623413251903491f, 0.031622776601683794f, 0.01778279410038923f};
            const float sgn = (fq & 2) ? 1.f : -1.f;
            auto rows = [&](auto kv_) __attribute__((always_inline)) { constexpr bool KV = decltype(kv_)::value;
#pragma unroll
            for (int ai = 0; ai < 2; ++ai)
#pragma unroll
                for (int m = 0; m < 4; ++m) {
                    const int rl = ai * HALF + wr * 64 + m * 16 + fr; const int R = u.pm * BM + rl;
                    const int t = R < 32768 ? (R & 4095) : ((R - 32768) & 8191);
                    const float pos = (float)((wc & 1) ? (t & 63) : (t >> 6));
                    const float pf = pos * invf0;
                    const float tot0 = xm[(ai * HALF + m * 16) * 8] + xp[(ai * HALF + m * 16) * 8], tot1 = xm[(ai * HALF + m * 16) * 8 + 4] + xp[(ai * HALF + m * 16) * 8 + 4];
                    const float rn0 = 1.0f / sqrtf(tot0 * (1.0f / 64.0f) + 1e-6f), rn1 = 1.0f / sqrtf(tot1 * (1.0f / 64.0f) + 1e-6f), osc = pn < 8 ? qscale : 1.0f;
#pragma unroll
                    for (int hk = 0; hk < 2; ++hk) {
                        float cs[4], sn[4];
#pragma unroll
                        for (int k = 0; k < 4; ++k) { const float ang = pf * RJ[4 * hk + k]; cs[k] = __cosf(ang); sn[k] = __sinf(ang); }
#pragma unroll
                        for (int bj = 0; bj < 2; ++bj) {
                            constexpr bool plain_ct = KV; const bool plain = plain_ct && bj == 1;
                            const f32x4 a = acc[ai][bj][m][hk] * ascale, y = a * (bj ? rn1 : rn0) * (hk ? g1 : g0);
                            f32x4 r;
#pragma unroll
                            for (int k = 0; k < 4; ++k) { const float p = __shfl_xor(y[k], 32); r[k] = (y[k] * cs[k] + sgn * p * sn[k]) * osc; }
                            const f32x4 o = plain ? a : r;
                            if (FP8_QK) { unsigned char* const rowp = (unsigned char*)QKVB + (size_t)R * 896 + (bj ? (KV ? offv : off0 + HALF) : off0);
                                if (plain) { u32x2 w; w.x = cvt_pk_bf16(o[0], o[1]); w.y = cvt_pk_bf16(o[2], o[3]); *(u32x2*)(rowp + 8 * hk) = w; }
                                else *(unsigned*)(rowp + 4 * hk) = pack4_fp8(o[0], o[1], o[2], o[3]); }
                            else { u32x2 w; w.x = cvt_pk_bf16(o[0], o[1]); w.y = cvt_pk_bf16(o[2], o[3]);
                            *(u32x2*)(QKVB + (size_t)R * 768 + (pn - 6) * BM + bj * HALF + colw + 4 * hk) = w; }
                        }
                    }
                    __builtin_amdgcn_sched_barrier(0);
                }
            };
            if (pn == 8) rows(std::true_type{}); else rows(std::false_type{});
        } else {
#pragma unroll
            for (int ai = 0; ai < 2; ++ai)
#pragma unroll
                for (int m = 0; m < 4; ++m)
#pragma unroll
                    for (int bj = 0; bj < 2; ++bj) { const float cneg = -1.4426950408889634f * ascale; const f32x4 v0 = sigmoid_scaled4(acc[ai][bj][m][0], cneg), v1 = sigmoid_scaled4(acc[ai][bj][m][1], cneg);
                        u32x2 w8; w8.x = pack4_fp8(v0[0], v0[1], v0[2], v0[3]); w8.y = pack4_fp8(v1[0], v1[1], v1[2], v1[3]);
                        *(u32x2*)(GATES + (row0 + ai * HALF + m * 16) * 2048 + (pn - 9) * BM + bj * HALF + colw) = w8; }
        }
    }
};
}

#define XB_TMO      128
#define XB_XCNT(j)  (256  + 64 * (j))
#define XB_XSUB(j)  (1280 + 64 * (j))
#define XB_XGEN(j)  (2304 + 64 * (j))
#define XB_TOP      3328
#define XB_TOPGEN   3392
#define XCD_BAR_WORDS 3456
#define XB_SPIN_CAP (1u << 18)

__device__ __forceinline__ unsigned xb_ld(unsigned* p)              { return __hip_atomic_load(p, __ATOMIC_RELAXED, __HIP_MEMORY_SCOPE_AGENT); }
__device__ __forceinline__ unsigned xb_add(unsigned* p, unsigned v) { return __hip_atomic_fetch_add(p, v, __ATOMIC_RELAXED, __HIP_MEMORY_SCOPE_AGENT); }
__device__ __forceinline__ unsigned xb_xcc_id() { return (unsigned)__builtin_amdgcn_s_getreg((3 << 11) | 20) & 0xFu; }
#define XB_SPIN(cond, bar) do { unsigned _sp = 0; while (cond) { __builtin_amdgcn_s_sleep(1); \
    if ((++_sp & 255u) == 0u) { if (xb_ld(&(bar)[XB_TMO])) break; if (_sp > XB_SPIN_CAP) { atomicAdd(&(bar)[XB_TMO], 1u); break; } } } } while (0)

struct XcdBarrier {
    unsigned* bar; unsigned x;
    volatile LAS unsigned* st;
};

__device__ __forceinline__ XcdBarrier xcd_barrier_post(unsigned* bar, volatile LAS unsigned* st) {
    XcdBarrier b; b.bar = bar; b.x = xb_xcc_id(); b.st = st;
    if (threadIdx.x == 0) (void)xb_add(&bar[XB_XCNT(b.x)], 1u);
    return b;
}
__device__ __forceinline__ void xcd_barrier_complete(unsigned* bar, unsigned x, unsigned& nloc, unsigned& nx) {
    const unsigned G = gridDim.x * gridDim.y * gridDim.z;
    unsigned sum, cnt, mine, sp = 0u;
    for (;;) {
        sum = 0u; cnt = 0u; mine = 0u;
#pragma unroll
        for (unsigned j = 0; j < 16; ++j) { const unsigned c = xb_ld(&bar[XB_XCNT(j)]); sum += c; cnt += (c > 0u) ? 1u : 0u; mine = (j == x) ? c : mine; }
        if (sum == G) break;
        __builtin_amdgcn_s_sleep(1);
        if ((++sp & 255u) == 0u) { if (xb_ld(&bar[XB_TMO])) break; if (sp > XB_SPIN_CAP) { atomicAdd(&bar[XB_TMO], 1u); break; } }
    }
    nloc = mine > 0u ? mine : 1u; nx = cnt > 0u ? cnt : 1u;
}

__device__ __forceinline__ void xcd_barrier(const XcdBarrier& b) {
    asm volatile("s_waitcnt vmcnt(0)" ::: "memory");
    __syncthreads();
    if (threadIdx.x == 0) {
        unsigned* bar = b.bar;
        __builtin_amdgcn_s_waitcnt(0);
        unsigned nloc = b.st[0], nx = b.st[1];
        if (nloc == 0u) { xcd_barrier_complete(bar, b.x, nloc, nx); b.st[0] = nloc; b.st[1] = nx; }
        const unsigned old = xb_add(&bar[XB_XSUB(b.x)], 1u);
        const unsigned gen = old / nloc;
        if (old + 1u == (gen + 1u) * nloc) {
            __builtin_amdgcn_fence(__ATOMIC_RELEASE, "agent");
            asm volatile("s_waitcnt vmcnt(0)" ::: "memory");
            const unsigned og = xb_add(&bar[XB_TOP], 1u);
            const unsigned tg = og / nx;
            if (og + 1u == (tg + 1u) * nx) xb_add(&bar[XB_TOPGEN], 1u);
            else XB_SPIN(xb_ld(&bar[XB_TOPGEN]) == tg, bar);
            __builtin_amdgcn_fence(__ATOMIC_ACQUIRE, "agent");
            xb_add(&bar[XB_XGEN(b.x)], 1u);
            asm volatile("s_waitcnt vmcnt(0)" ::: "memory");
        } else {
            XB_SPIN(xb_ld(&bar[XB_XGEN(b.x)]) == gen, bar);
            __builtin_amdgcn_fence(__ATOMIC_ACQUIRE, "agent");
            asm volatile("s_waitcnt vmcnt(0)" ::: "memory");
        }
    }
    __syncthreads();
}


struct Args { const float* in[17]; float* out; unsigned char* ws; int ph_lo, ph_hi; };
enum { I_XP = 0, I_XS, I_WIN, I_RPB, I_QN, I_KN, I_WNA, I_WGQ, I_WOUT, I_L1G, I_L1B, I_WR, I_WG, I_WU, I_WD, I_L2G, I_L2B };
struct Frame {
    LAS unsigned char* lds;
    int tid, lane, wave;
    int vcu, G;
};
__device__ __forceinline__ GAS unsigned char* ws_here(unsigned char* p0) { GAS unsigned char* p = (GAS unsigned char*)p0; asm volatile("" : "+s"(p)); return p; }
#define WSP(T, off) ((T*)(ws_here(A.ws) + (off)))
__device__ __forceinline__ Frame fresh_frame(const Frame& F0) {
    Frame F = F0; int t = threadIdx.x; asm volatile("" : "+v"(t)); F.tid = t; F.lane = t & 63; F.wave = __builtin_amdgcn_readfirstlane(t >> 6); return F; }

__device__ __forceinline__ float wave_sum(float v) {
#pragma unroll
    for (int o = 1; o < 64; o <<= 1) v += __shfl_xor(v, o);
    return v;
}
__device__ __forceinline__ float wave_max(float v) {
#pragma unroll
    for (int o = 1; o < 64; o <<= 1) v = fmaxf(v, __shfl_xor(v, o));
    return v;
}

__device__ __forceinline__ void conv_item(const float* W, int N, int k0, int n0, bf16* dst, int dpitch, LAS float* scr, int lane) {
#pragma unroll 8
    for (int i = 0; i < 32; ++i) { const int kk = 2 * i + (lane >> 5); scr[kk * 33 + (lane & 31)] = W[(size_t)(k0 + kk) * N + n0 + (lane & 31)]; }
    LDS_WAIT(); asm volatile("" ::: "memory");
    const int c = lane & 7;
#pragma unroll
    for (int j = 0; j < 4; ++j) { const int n = (lane >> 3) + 8 * j; const LAS float* s = scr + (8 * c) * 33 + n;
        v4u o; o.x = pk2(s[0 * 33], s[1 * 33]); o.y = pk2(s[2 * 33], s[3 * 33]); o.z = pk2(s[4 * 33], s[5 * 33]); o.w = pk2(s[6 * 33], s[7 * 33]);
        *(GAS v4u*)(dst + (size_t)n * dpitch + 8 * c) = o; }
    LDS_WAIT(); asm volatile("" ::: "memory");
}
__device__ __forceinline__ void conv8_item(const float* W, int N, int k0, int n0, unsigned char* dst, int dpitch, float scale, LAS float* scr, int lane) {
#pragma unroll 8
    for (int i = 0; i < 32; ++i) { const int kk = 2 * i + (lane >> 5); scr[kk * 33 + (lane & 31)] = W[(size_t)(k0 + kk) * N + n0 + (lane & 31)] * scale; }
    LDS_WAIT(); asm volatile("" ::: "memory");
    const int n = lane >> 1, c2 = lane & 1; const LAS float* s = scr + (32 * c2) * 33 + n;
    v4u o0, o1;
    o0.x = pg8::pack4_fp8(s[0 * 33], s[1 * 33], s[2 * 33], s[3 * 33]);     o0.y = pg8::pack4_fp8(s[4 * 33], s[5 * 33], s[6 * 33], s[7 * 33]);
    o0.z = pg8::pack4_fp8(s[8 * 33], s[9 * 33], s[10 * 33], s[11 * 33]);   o0.w = pg8::pack4_fp8(s[12 * 33], s[13 * 33], s[14 * 33], s[15 * 33]);
    o1.x = pg8::pack4_fp8(s[16 * 33], s[17 * 33], s[18 * 33], s[19 * 33]); o1.y = pg8::pack4_fp8(s[20 * 33], s[21 * 33], s[22 * 33], s[23 * 33]);
    o1.z = pg8::pack4_fp8(s[24 * 33], s[25 * 33], s[26 * 33], s[27 * 33]); o1.w = pg8::pack4_fp8(s[28 * 33], s[29 * 33], s[30 * 33], s[31 * 33]);
    GAS v4u* d = (GAS v4u*)(dst + (size_t)n * dpitch + 32 * c2);
    d[0] = o0; d[1] = o1;
    LDS_WAIT(); asm volatile("" ::: "memory");
}
struct CItem { const float* src; unsigned char* dst; int N, dpitch; float scale; int f8; };
__device__ __forceinline__ CItem conv_expert_item(const Args& A, int layer, int r) {
    constexpr int I_E = 16 * 64, I_D = 32 * 32, per_e = 2 * I_E + I_D;
    CItem c; const int e = r / per_e; r -= e * per_e;
    if (r < 2 * I_E) { const int up = r / I_E, q = r % I_E, kb = q / 64, nb = q % 64, n0 = 32 * nb;
        c.src = (up ? A.in[I_WU] : A.in[I_WG]) + ((size_t)layer * NE + e) * DM * DF + (size_t)(64 * kb) * DF + n0; c.N = DF;
        const int drow = e * 4096 + (n0 >> 7) * 256 + up * 128 + (n0 & 127);
        c.f8 = FP8_E1; c.scale = FP8_E1 ? W1_SCALE : 1.f; c.dpitch = FP8_E1 ? DM : 2 * DM;
        c.dst = WSP(unsigned char, WS_W1) + (size_t)drow * c.dpitch + (size_t)(64 * kb) * (FP8_E1 ? 1 : 2);
    } else { r -= 2 * I_E; const int kb = r / 32, nb = r % 32;
        c.src = A.in[I_WD] + ((size_t)layer * NE + e) * DF * DM + (size_t)(64 * kb) * DM + 32 * nb; c.N = DM;
        c.f8 = FP8_E2; c.scale = FP8_E2 ? W2_SCALE : 1.f; c.dpitch = FP8_E2 ? DF : 2 * DF;
        c.dst = WSP(unsigned char, WS_W2) + (size_t)(e * 1024 + 32 * nb) * c.dpitch + (size_t)(64 * kb) * (FP8_E2 ? 1 : 2);
    }
    return c;
}
__device__ __forceinline__ void conv_experts(const Args& A, const Frame& F0, int layer, int gw, int NGW) {
    const Frame F = fresh_frame(F0);
    LAS float* scr = (LAS float*)(F.lds + RING_OFF + F.wave * 16384);
    const int lane = F.lane;
    constexpr int NIT = NE * (2 * 16 * 64 + 32 * 32);
    float ra[32], rb[32]; CItem cur, nxt;
    int it = gw;
    if (it < NIT) { cur = conv_expert_item(A, layer, it);
#pragma unroll
        for (int i = 0; i < 32; ++i) ra[i] = cur.src[(size_t)(2 * i + (lane >> 5)) * cur.N + (lane & 31)]; }
#pragma unroll 1
    while (it < NIT) {
        const int it2 = it + NGW;
        if (it2 < NIT) { nxt = conv_expert_item(A, layer, it2);
#pragma unroll
            for (int i = 0; i < 32; ++i) rb[i] = nxt.src[(size_t)(2 * i + (lane >> 5)) * nxt.N + (lane & 31)]; }
#pragma unroll
        for (int i = 0; i < 32; ++i) scr[(2 * i + (lane >> 5)) * 33 + (lane & 31)] = ra[i] * cur.scale;
        LDS_WAIT(); asm volatile("" ::: "memory");
        if (cur.f8) {
            const int n = lane >> 1, c2 = lane & 1; const LAS float* s = scr + (32 * c2) * 33 + n;
            v4u o0, o1;
            o0.x = pg8::pack4_fp8(s[0 * 33], s[1 * 33], s[2 * 33], s[3 * 33]);     o0.y = pg8::pack4_fp8(s[4 * 33], s[5 * 33], s[6 * 33], s[7 * 33]);
            o0.z = pg8::pack4_fp8(s[8 * 33], s[9 * 33], s[10 * 33], s[11 * 33]);   o0.w = pg8::pack4_fp8(s[12 * 33], s[13 * 33], s[14 * 33], s[15 * 33]);
            o1.x = pg8::pack4_fp8(s[16 * 33], s[17 * 33], s[18 * 33], s[19 * 33]); o1.y = pg8::pack4_fp8(s[20 * 33], s[21 * 33], s[22 * 33], s[23 * 33]);
            o1.z = pg8::pack4_fp8(s[24 * 33], s[25 * 33], s[26 * 33], s[27 * 33]); o1.w = pg8::pack4_fp8(s[28 * 33], s[29 * 33], s[30 * 33], s[31 * 33]);
            GAS v4u* d = (GAS v4u*)(cur.dst + (size_t)n * cur.dpitch + 32 * c2);
            d[0] = o0; d[1] = o1;
        } else {
            const int c = lane & 7;
#pragma unroll
            for (int j = 0; j < 4; ++j) { const int n = (lane >> 3) + 8 * j; const LAS float* s = scr + (8 * c) * 33 + n;
                v4u o; o.x = pk2(s[0 * 33], s[1 * 33]); o.y = pk2(s[2 * 33], s[3 * 33]); o.z = pk2(s[4 * 33], s[5 * 33]); o.w = pk2(s[6 * 33], s[7 * 33]);
                *(GAS v4u*)(cur.dst + (size_t)n * cur.dpitch + 16 * c) = o; }
        }
        LDS_WAIT(); asm volatile("" ::: "memory");
#pragma unroll
        for (int i = 0; i < 32; ++i) ra[i] = rb[i];
        cur = nxt; it = it2;
    }
}
template <int PART> __device__ __forceinline__ void phase_conv(const Args& A, const Frame& F0, int layer, int gw, int NGW) {
    const Frame F = fresh_frame(F0);
    LAS float* scr = (LAS float*)(F.lds + RING_OFF + F.wave * 16384);
    constexpr int I_IN = 16 * 136, I_BR = 8 * 32, I_OUT = 16 * 32, I_E = 16 * 64  , I_D = 32 * 32  ;
    constexpr int NSMALL = I_IN + 2 * I_BR + I_OUT, NITEMS = NSMALL + NE * (2 * I_E + I_D);
    for (int it = (PART == 0 ? 0 : NSMALL) + gw; it < (PART == 0 ? NSMALL : NITEMS); it += NGW) {
        int r = it;
        if (r < I_IN) { const int kb = r / 136, nb = r % 136;
            if (FP8_G1) conv8_item(A.in[I_WIN] + (size_t)layer * DM * D_IN, D_IN, 64 * kb, 32 * nb, WSP(unsigned char, WS_WIN) + (size_t)(32 * nb) * DM + 64 * kb, DM, WIN_SCALE, scr, F.lane);
            else conv_item(A.in[I_WIN] + (size_t)layer * DM * D_IN, D_IN, 64 * kb, 32 * nb, WSP(bf16, WS_WIN) + (size_t)(32 * nb) * DM + 64 * kb, DM, scr, F.lane);
            continue; } r -= I_IN;
        if (r < I_BR) { const int kb = r / 32, nb = r % 32;
            if (FP8_BR) conv8_item(A.in[I_WNA] + (size_t)layer * 512 * DM, DM, 64 * kb, 32 * nb, WSP(unsigned char, WS_WBR) + (size_t)(32 * nb) * 512 + 64 * kb, 512, WBR_SCALE, scr, F.lane);
            else conv_item(A.in[I_WNA] + (size_t)layer * 512 * DM, DM, 64 * kb, 32 * nb, WSP(bf16, WS_WBR) + (size_t)(32 * nb) * 512 + 64 * kb, 512, scr, F.lane); continue; } r -= I_BR;
        if (r < I_BR) { const int kb = r / 32, nb = r % 32;
            if (FP8_BR) conv8_item(A.in[I_WGQ] + (size_t)layer * 512 * DM, DM, 64 * kb, 32 * nb, WSP(unsigned char, WS_WBR) + (size_t)(1024 + 32 * nb) * 512 + 64 * kb, 512, WBR_SCALE, scr, F.lane);
            else conv_item(A.in[I_WGQ] + (size_t)layer * 512 * DM, DM, 64 * kb, 32 * nb, WSP(bf16, WS_WBR) + (size_t)(1024 + 32 * nb) * 512 + 64 * kb, 512, scr, F.lane); continue; } r -= I_BR;
        if (r < I_OUT) { const int kb = r / 32, nb = r % 32;
            if (FP8_OUT) conv8_item(A.in[I_WOUT] + (size_t)layer * DM * DM, DM, 64 * kb, 32 * nb, WSP(unsigned char, WS_WOUT) + (size_t)(32 * nb) * DM + 64 * kb, DM, WOUT_SCALE, scr, F.lane);
            else conv_item(A.in[I_WOUT] + (size_t)layer * DM * DM, DM, 64 * kb, 32 * nb, WSP(bf16, WS_WOUT) + (size_t)(32 * nb) * DM + 64 * kb, DM, scr, F.lane);
            continue; } r -= I_OUT;
        const int per_e = 2 * I_E + I_D, e = r / per_e; r -= e * per_e;
        if (r < 2 * I_E) { const int up = r / I_E, q = r % I_E, kb = q / 64, nb = q % 64, n0 = 32 * nb;
            const float* src = (up ? A.in[I_WU] : A.in[I_WG]) + ((size_t)layer * NE + e) * DM * DF;
            const int drow = e * 4096 + (n0 >> 7) * 256 + up * 128 + (n0 & 127);
            if (FP8_E1) conv8_item(src, DF, 64 * kb, n0, WSP(unsigned char, WS_W1) + (size_t)drow * DM + 64 * kb, DM, W1_SCALE, scr, F.lane);
            else conv_item(src, DF, 64 * kb, n0, WSP(bf16, WS_W1) + (size_t)drow * DM + 64 * kb, DM, scr, F.lane);
            continue; }
        r -= 2 * I_E;
        { const int kb = r / 32, nb = r % 32; const float* src = A.in[I_WD] + ((size_t)layer * NE + e) * DF * DM;
          if (FP8_E2) conv8_item(src, DM, 64 * kb, 32 * nb, WSP(unsigned char, WS_W2) + (size_t)(e * 1024 + 32 * nb) * DF + 64 * kb, DF, W2_SCALE, scr, F.lane);
          else conv_item(src, DM, 64 * kb, 32 * nb, WSP(bf16, WS_W2) + (size_t)(e * 1024 + 32 * nb) * DF + 64 * kb, DF, scr, F.lane); }
    }
    if (PART == 0 && layer == 0) {
        for (int m = gw; m < NTOK; m += 4 * NGW) {
            f32x4 v[4][4];
#pragma unroll
            for (int r = 0; r < 4; ++r) { const int mr = m + r * NGW; if (mr < NTOK) {
                const float* src = mr < NP ? A.in[I_XP] + (size_t)mr * DM : A.in[I_XS] + (size_t)(mr - NP) * DM;
                const GAS f32x4* xr = (const GAS f32x4*)src + F.lane;
#pragma unroll
                for (int j = 0; j < 4; ++j) v[r][j] = xr[64 * j]; } }
#pragma unroll
            for (int r = 0; r < 4; ++r) { const int mr = m + r * NGW; if (mr < NTOK) {
                GAS f32x4* xo = (GAS f32x4*)(A.out + (size_t)mr * DM) + F.lane;
                GAS v2u* bo = (GAS v2u*)(WSP(bf16, WS_XB) + (size_t)mr * DM) + F.lane;
#pragma unroll
                for (int j = 0; j < 4; ++j) { const f32x4 w4 = v[r][j]; if (!FP8_MIX) xo[64 * j] = w4;
                    if (FP8_G1) ((GAS unsigned*)(WSP(unsigned char, WS_XB8) + (size_t)mr * DM))[F.lane + 64 * j] = pg8::pack4_fp8(w4.x, w4.y, w4.z, w4.w);
                    else { v2u w; w.x = pk2(w4.x, w4.y); w.y = pk2(w4.z, w4.w); bo[64 * j] = w; } } } }
        }
    }
}

__device__ __forceinline__ int crow16(int rr, int hi) { return (rr & 3) + 8 * (rr >> 2) + 4 * hi; }
#define NA_COMPUTE1(CUR_, KR_) { \
            const LAS unsigned char* trow = (const LAS unsigned char*)(tab + ((KR_) - rA + 7) * 32) + blane; \
            f32x16 c0; \
            if (FP8_NAQK) { const attn_body::i32x4q a_ = *(const LAS attn_body::i32x4q*)((CUR_) + kroff), b_ = *(const LAS attn_body::i32x4q*)((CUR_) + kroff + 1040); c0 = MFMA8(__builtin_shufflevector(a_, b_, 0, 1, 2, 3, 4, 5, 6, 7), qf8, am0v); } else \
    _Pragma("unroll") \
            for (int ds = 0; ds < 4; ++ds) { \
                const bf16x8 k0 = *(const LAS bf16x8*)((CUR_) + kroff + ds * 2080); \
                c0 = __builtin_amdgcn_mfma_f32_32x32x16_bf16(k0, qf[ds], ds == 0 ? am0v : c0, 0, 0, 0);     \
            } \
            float mx = -INFINITY; \
    _Pragma("unroll") \
            for (int rr = 0; rr < 16; rr += 2) { \
                const float b0 = *(const LAS float*)(trow + 4 * ((rr & 3) + 8 * (rr >> 2))), b1 = *(const LAS float*)(trow + 4 * (((rr + 1) & 3) + 8 * ((rr + 1) >> 2))); \
                c0[rr] += b0; c0[rr + 1] += b1; \
                mx = fmaxf(mx, fmaxf(c0[rr], c0[rr + 1])); \
            } \
            { const auto rr_ = __builtin_amdgcn_permlane32_swap(__float_as_uint(mx), __float_as_uint(mx), false, false); mx = fmaxf(__uint_as_float(rr_[0]), __uint_as_float(rr_[1])); }     \
            const bool rowlive = ((KR_) >= rsq) && ((KR_) < rsq + 8);      \
            { const bool need = rowlive && (mx > mrun + 8.0f);     \
              if (__any(need)) { const float mnew = need ? mx : mrun, alpha = need ? __builtin_amdgcn_exp2f(mrun - mnew) : 1.0f; mrun = mnew; lrun *= alpha; \
    _Pragma("unroll") \
                for (int db = 0; db < 2; ++db) \
    _Pragma("unroll") \
                    for (int k = 0; k < 16; ++k) o[db][k] *= alpha; } } \
            const float msub = rowlive ? mrun : INFINITY;                   \
            float ps = 0.f; \
    _Pragma("unroll") \
            for (int rr = 0; rr < 16; ++rr) { c0[rr] = __builtin_amdgcn_exp2f(c0[rr] - msub); ps += c0[rr]; } \
            lrun += ps; \
            bf16x8 pb[2]; \
    _Pragma("unroll") \
            for (int s = 0; s < 2; ++s) { \
                v4u w0; \
                w0.x = pk2(c0[8 * s + 0], c0[8 * s + 1]); w0.y = pk2(c0[8 * s + 2], c0[8 * s + 3]); w0.z = pk2(c0[8 * s + 4], c0[8 * s + 5]); w0.w = pk2(c0[8 * s + 6], c0[8 * s + 7]); \
                pb[s] = __builtin_bit_cast(bf16x8, w0); \
            } \
    _Pragma("unroll") \
            for (int s = 0; s < 2; ++s) \
    _Pragma("unroll") \
                for (int db = 0; db < 2; ++db) { \
                    const LAS unsigned char* vp = (CUR_) + vroff + db * 4160 + s * 1024; \
                    const attn_body::s16x4 lo = attn_body::vtr((attn_body::lds_cptr)vp), hi2 = attn_body::vtr((attn_body::lds_cptr)(vp + 512)); \
                    const bf16x8 vfr = (bf16x8){lo[0], lo[1], lo[2], lo[3], hi2[0], hi2[1], hi2[2], hi2[3]}; \
                    o[db] = __builtin_amdgcn_mfma_f32_32x32x16_bf16(vfr, pb[s], o[db], 0, 0, 0); } }
#define NA_COMPUTE2(CUR0_, CUR1_, KR_) { \
            const LAS unsigned char* trow = (const LAS unsigned char*)(tab + ((KR_) - rA + 7) * 32) + blane; \
            f32x16 c0, c1; \
            if (FP8_NAQK) { const attn_body::i32x4q a0_ = *(const LAS attn_body::i32x4q*)((CUR0_) + kroff), b0_ = *(const LAS attn_body::i32x4q*)((CUR0_) + kroff + 1040), a1_ = *(const LAS attn_body::i32x4q*)((CUR1_) + kroff), b1_ = *(const LAS attn_body::i32x4q*)((CUR1_) + kroff + 1040); \
                c0 = MFMA8(__builtin_shufflevector(a0_, b0_, 0, 1, 2, 3, 4, 5, 6, 7), qf8, am0v); c1 = MFMA8(__builtin_shufflevector(a1_, b1_, 0, 1, 2, 3, 4, 5, 6, 7), qf8, am0v); } else \
    _Pragma("unroll") \
            for (int ds = 0; ds < 4; ++ds) { \
                const bf16x8 k0 = *(const LAS bf16x8*)((CUR0_) + kroff + ds * 2080), k1 = *(const LAS bf16x8*)((CUR1_) + kroff + ds * 2080); \
                c0 = __builtin_amdgcn_mfma_f32_32x32x16_bf16(k0, qf[ds], ds == 0 ? am0v : c0, 0, 0, 0); \
                c1 = __builtin_amdgcn_mfma_f32_32x32x16_bf16(k1, qf[ds], ds == 0 ? am0v : c1, 0, 0, 0); \
            } \
            float mx0 = -INFINITY, mx1 = -INFINITY; \
    _Pragma("unroll") \
            for (int rr = 0; rr < 16; rr += 2) { \
                const float b0 = *(const LAS float*)(trow + 4 * ((rr & 3) + 8 * (rr >> 2))), b1 = *(const LAS float*)(trow + 4 * (((rr + 1) & 3) + 8 * ((rr + 1) >> 2))); \
                const float d0 = *(const LAS float*)(trow + 128 + 4 * ((rr & 3) + 8 * (rr >> 2))), d1 = *(const LAS float*)(trow + 128 + 4 * (((rr + 1) & 3) + 8 * ((rr + 1) >> 2))); \
                c0[rr] += b0; c0[rr + 1] += b1; c1[rr] += d0; c1[rr + 1] += d1; \
                mx0 = fmaxf(mx0, fmaxf(c0[rr], c0[rr + 1])); mx1 = fmaxf(mx1, fmaxf(c1[rr], c1[rr + 1])); \
            } \
            const bool rowlive0 = ((KR_) >= rsq) && ((KR_) < rsq + 8), rowlive1 = ((KR_) + 1 >= rsq) && ((KR_) + 1 < rsq + 8); \
            float mx = fmaxf(rowlive0 ? mx0 : -INFINITY, rowlive1 ? mx1 : -INFINITY); \
            { const auto rr_ = __builtin_amdgcn_permlane32_swap(__float_as_uint(mx), __float_as_uint(mx), false, false); mx = fmaxf(__uint_as_float(rr_[0]), __uint_as_float(rr_[1])); } \
            { const bool need = mx > mrun + 8.0f;                           \
              if (__any(need)) { const float mnew = need ? mx : mrun, alpha = need ? __builtin_amdgcn_exp2f(mrun - mnew) : 1.0f; mrun = mnew; lrun *= alpha; \
    _Pragma("unroll") \
                for (int db = 0; db < 2; ++db) \
    _Pragma("unroll") \
                    for (int k = 0; k < 16; ++k) o[db][k] *= alpha; } } \
            const float msub0 = rowlive0 ? mrun : INFINITY, msub1 = rowlive1 ? mrun : INFINITY; \
            float ps = 0.f; \
    _Pragma("unroll") \
            for (int rr = 0; rr < 16; ++rr) { c0[rr] = __builtin_amdgcn_exp2f(c0[rr] - msub0); c1[rr] = __builtin_amdgcn_exp2f(c1[rr] - msub1); ps += c0[rr] + c1[rr]; } \
            lrun += ps; \
            bf16x8 pb[2][2]; \
    _Pragma("unroll") \
            for (int s = 0; s < 2; ++s) { \
                v4u w0, w1; \
                w0.x = pk2(c0[8 * s + 0], c0[8 * s + 1]); w0.y = pk2(c0[8 * s + 2], c0[8 * s + 3]); w0.z = pk2(c0[8 * s + 4], c0[8 * s + 5]); w0.w = pk2(c0[8 * s + 6], c0[8 * s + 7]); \
                w1.x = pk2(c1[8 * s + 0], c1[8 * s + 1]); w1.y = pk2(c1[8 * s + 2], c1[8 * s + 3]); w1.z = pk2(c1[8 * s + 4], c1[8 * s + 5]); w1.w = pk2(c1[8 * s + 6], c1[8 * s + 7]); \
                pb[0][s] = __builtin_bit_cast(bf16x8, w0); pb[1][s] = __builtin_bit_cast(bf16x8, w1); \
            } \
    _Pragma("unroll") \
            for (int kb2 = 0; kb2 < 2; ++kb2) \
    _Pragma("unroll") \
                for (int s = 0; s < 2; ++s) \
    _Pragma("unroll") \
                    for (int db = 0; db < 2; ++db) { \
                        const LAS unsigned char* vp = (kb2 ? (CUR1_) : (CUR0_)) + vroff + db * 4160 + s * 1024; \
                        const attn_body::s16x4 lo = attn_body::vtr((attn_body::lds_cptr)vp), hi2 = attn_body::vtr((attn_body::lds_cptr)(vp + 512)); \
                        const bf16x8 vfr = (bf16x8){lo[0], lo[1], lo[2], lo[3], hi2[0], hi2[1], hi2[2], hi2[3]}; \
                        o[db] = __builtin_amdgcn_mfma_f32_32x32x16_bf16(vfr, pb[kb2][s], o[db], 0, 0, 0); } }
constexpr int NA_KBUF = 8 * 1040, NA_VBUF = 2 * 4160, NA_BUF = NA_KBUF + NA_VBUF;
__device__ __forceinline__ void na_unitset(const bf16* __restrict__ QKV, bf16* __restrict__ OUT, const LAS float* tab, LAS unsigned char* stg  , size_t tok0, int rows, int h, int r0, int tid, int lane, int wave) {
    const int r32 = lane & 31, hi = lane >> 5;
    const int rA = r0 + 2 * (wave >> 2), ag = wave & 3, rq = rA + (r32 >> 4);
    int rsA = rA - 4; rsA = rsA < 0 ? 0 : rsA; rsA = rsA > rows - 8 ? rows - 8 : rsA;
    int rsB = rA - 3; rsB = rsB < 0 ? 0 : rsB; rsB = rsB > rows - 8 ? rows - 8 : rsB;
    const int rsq = (r32 >> 4) ? rsB : rsA;
    int kr_lo = r0 - 4; kr_lo = kr_lo < 0 ? 0 : kr_lo; kr_lo = kr_lo > rows - 8 ? rows - 8 : kr_lo;
    int kr_hi = r0 - 1; kr_hi = kr_hi < 0 ? 0 : kr_hi; kr_hi = kr_hi > rows - 8 ? rows - 8 : kr_hi; kr_hi += 7;
    const int nk = kr_hi - kr_lo + 1;
    const int c = 16 * ag + (r32 & 15);
    int cs = c - 8; cs = cs < 0 ? 0 : cs; cs = cs > 48 ? 48 : cs;
    int kb = 16 * ag - 8; kb = kb < 0 ? 0 : kb; kb = kb > 32 ? 32 : kb;
    bf16x8 qf[4];
#pragma unroll
    for (int ds = 0; ds < 4; ++ds) qf[ds] = FP8_NAQK ? (bf16x8){} : *(const bf16x8*)(QKV + (tok0 + (size_t)rq * 64 + c) * 1536 + h * 64 + 16 * ds + 8 * hi);
    const unsigned char* const N8 = (const unsigned char*)QKV; attn_body::i32x8q qf8 = {};
    if (FP8_NAQK) { const unsigned char* qp = N8 + (tok0 + (size_t)rq * 64 + c) * 2048 + h * 64 + 32 * hi; const attn_body::i32x4q a_ = *(const attn_body::i32x4q*)qp, b_ = *(const attn_body::i32x4q*)(qp + 16); qf8 = __builtin_shufflevector(a_, b_, 0, 1, 2, 3, 4, 5, 6, 7); }
    f32x16 o[2];
#pragma unroll
    for (int b = 0; b < 2; ++b)
#pragma unroll
        for (int k = 0; k < 16; ++k) o[b][k] = 0.f;
    float mrun = -INFINITY, lrun = 0.f;
    f32x16 am0v;
#pragma unroll
    for (int rr = 0; rr < 16; ++rr) { const int kc0 = kb + crow16(rr, hi); am0v[rr] = (kc0 >= cs && kc0 < cs + 16) ? 0.f : -INFINITY; }
    const int blane = 4 * (15 - c + kb + 4 * hi) - 128 * (r32 >> 4);
    const int skey = tid >> 3, sch = tid & 7;
    const bf16* gk = QKV + (tok0 + (size_t)kr_lo * 64 + skey) * 1536 + 512 + h * 64 + 8 * sch;
    const unsigned char* const gkk = N8 + (tok0 + (size_t)kr_lo * 64 + skey) * 2048 + 512 + h * 64 + (sch & 3) * 16;
    const unsigned char* const gkv = N8 + (tok0 + (size_t)kr_lo * 64 + skey) * 2048 + 1024 + h * 128 + sch * 16;
#define NA_LDK(j_) (FP8_NAQK ? *(const GAS v4u*)(gkk + (size_t)(j_) * 131072) : *(const GAS v4u*)(gk + (size_t)(j_) * 64 * 1536))
#define NA_LDV(j_) (FP8_NAQK ? *(const GAS v4u*)(gkv + (size_t)(j_) * 131072) : *(const GAS v4u*)(gk + (size_t)(j_) * 64 * 1536 + 512))
    const int kwoff = (FP8_NAQK ? (sch & 3) : sch) * 1040 + skey * 16, vwoff = NA_KBUF + (sch >> 2) * 4160 + skey * 64 + (sch & 3) * 16;
    const int kroff = FP8_NAQK ? hi * 2080 + (kb + r32) * 16 : hi * 1040 + (kb + r32) * 16;
    const int vroff = NA_KBUF + kb * 64 + ((lane >> 4) & 1) * 32 + (lane & 3) * 8 + (4 * hi + ((lane & 15) >> 2)) * 64;
    v4u kq0 = NA_LDK(0), vq0 = NA_LDV(0), kq1 = kq0, vq1 = vq0, kq2 = kq0, vq2 = vq0, kq3 = kq0, vq3 = vq0;
    if (1 < nk) { kq1 = NA_LDK(1); vq1 = NA_LDV(1); }
    if (2 < nk) { kq2 = NA_LDK(2); vq2 = NA_LDV(2); }
    if (3 < nk) { kq3 = NA_LDK(3); vq3 = NA_LDV(3); }
    *(LAS v4u*)(stg + kwoff) = kq0; *(LAS v4u*)(stg + vwoff) = vq0;
    if (1 < nk) { *(LAS v4u*)(stg + NA_BUF + kwoff) = kq1; *(LAS v4u*)(stg + NA_BUF + vwoff) = vq1; }
    __syncthreads();
    if (4 < nk) { kq0 = NA_LDK(4); vq0 = NA_LDV(4); }
    if (5 < nk) { kq1 = NA_LDK(5); vq1 = NA_LDV(5); }
#define NA_STEP(t, KA, VA, KB, VB) do { \
        LAS unsigned char* cur0 = stg + ((t) & 3) * NA_BUF; LAS unsigned char* cur1 = stg + (((t) + 1) & 3) * NA_BUF; \
        const int kr = kr_lo + (t); \
        const bool live0 = kr >= rsA && kr < rsB + 8, live1 = ((t) + 1 < nk) && kr + 1 >= rsA && kr + 1 < rsB + 8; \
        if (live0 && live1) NA_COMPUTE2(cur0, cur1, kr) else if (live0) NA_COMPUTE1(cur0, kr) else if (live1) NA_COMPUTE1(cur1, kr + 1) \
        if ((t) + 2 < nk) { LAS unsigned char* nxt = stg + (((t) + 2) & 3) * NA_BUF; *(LAS v4u*)(nxt + kwoff) = KA; *(LAS v4u*)(nxt + vwoff) = VA; } \
        if ((t) + 3 < nk) { LAS unsigned char* nxt = stg + (((t) + 3) & 3) * NA_BUF; *(LAS v4u*)(nxt + kwoff) = KB; *(LAS v4u*)(nxt + vwoff) = VB; } \
        if ((t) + 6 < nk) { KA = NA_LDK((t) + 6); VA = NA_LDV((t) + 6); } \
        if ((t) + 7 < nk) { KB = NA_LDK((t) + 7); VB = NA_LDV((t) + 7); } \
        __syncthreads(); } while (0)
#pragma unroll 1
    for (int t0 = 0; t0 < nk; t0 += 4) {
        NA_STEP(t0, kq2, vq2, kq3, vq3);
        if (t0 + 2 < nk) NA_STEP(t0 + 2, kq0, vq0, kq1, vq1);
    }
#undef NA_STEP
    float l; { const auto rr_ = __builtin_amdgcn_permlane32_swap(__float_as_uint(lrun), __float_as_uint(lrun), false, false); l = __uint_as_float(rr_[0]) + __uint_as_float(rr_[1]); } const float inv = 1.0f / l;
    if (FP8_BR) { unsigned char* orow8 = (unsigned char*)OUT + (tok0 + (size_t)rq * 64 + c) * 512 + h * 64; const float sc = inv * ATT_SCALE;
#pragma unroll
        for (int db = 0; db < 2; ++db)
#pragma unroll
            for (int g = 0; g < 4; ++g) *(GAS unsigned*)(orow8 + 32 * db + 8 * g + 4 * hi) = pg8::pack4_fp8(o[db][4 * g + 0] * sc, o[db][4 * g + 1] * sc, o[db][4 * g + 2] * sc, o[db][4 * g + 3] * sc);
        return; }
    bf16* orow = OUT + (tok0 + (size_t)rq * 64 + c) * 512 + h * 64;
#pragma unroll
    for (int db = 0; db < 2; ++db)
#pragma unroll
        for (int g = 0; g < 4; ++g) { v2u w; w.x = pk2(o[db][4 * g + 0] * inv, o[db][4 * g + 1] * inv); w.y = pk2(o[db][4 * g + 2] * inv, o[db][4 * g + 3] * inv);
            *(GAS v2u*)(orow + 32 * db + 8 * g + 4 * hi) = w; }
}
struct RopeLane { f32x4 gq, gk; float invf[4]; };
template <bool DRY> __device__ __forceinline__ void rope_compute(const Args& A, const RopeLane& L, const f32x4 (&v)[3], int m, int lane) {
    bf16* outrow = (DRY ? WSP(bf16, WS_Z) : WSP(bf16, WS_QKVB)) + (size_t)m * 768;
    const int t = m < NP ? (m & (SEQ_P - 1)) : ((m - NP) & (SEQ_S - 1));
    const int pos = (lane & 8) ? (t & 63) : (t >> 6);
    float cs[4], sn[4];
#pragma unroll
    for (int k = 0; k < 4; ++k) { const float ang = (float)pos * L.invf[k]; cs[k] = __cosf(ang); sn[k] = __sinf(ang); }
    const float sgn = (lane & 4) ? 1.f : -1.f;
    v2u ob[3];
#pragma unroll
    for (int j = 0; j < 3; ++j) {
        f32x4 x = v[j];
        const bool is_v = (j == 2) && (lane >= 32);
        float ss = (x.x * x.x + x.y * x.y) + (x.z * x.z + x.w * x.w);
        ss += __shfl_xor(ss, 1); ss += __shfl_xor(ss, 2); ss += __shfl_xor(ss, 4); ss += __shfl_xor(ss, 8);
        const float rn = 1.0f / sqrtf(ss * (1.0f / 64.0f) + RMS_EPS);
        const f32x4 gn = (j < 2) ? L.gq : L.gk;
        f32x4 y = x * rn * gn;
        f32x4 pr; pr.x = __shfl_xor(y.x, 4); pr.y = __shfl_xor(y.y, 4); pr.z = __shfl_xor(y.z, 4); pr.w = __shfl_xor(y.w, 4);
        f32x4 o;
        o.x = y.x * cs[0] + sgn * pr.x * sn[0]; o.y = y.y * cs[1] + sgn * pr.y * sn[1]; o.z = y.z * cs[2] + sgn * pr.z * sn[2]; o.w = y.w * cs[3] + sgn * pr.w * sn[3];
        if (j < 2) o = o * QSCALE;
        if (is_v) o = x;
        ob[j].x = pk2(o.x, o.y); ob[j].y = pk2(o.z, o.w);
    }
    GAS v2u* dst = (GAS v2u*)outrow + lane;
#ifdef ROPE_DRY_NOSTORE
    if (DRY) { asm volatile("" :: "v"(ob[0].x), "v"(ob[0].y), "v"(ob[1].x), "v"(ob[1].y), "v"(ob[2].x), "v"(ob[2].y)); return; }
#endif
#pragma unroll
    for (int j = 0; j < 3; ++j) dst[64 * j] = ob[j];
}
__device__ __forceinline__ void phase_na(const Args& A, const Frame& F0, int layer) {
    const Frame F = fresh_frame(F0);
    LAS float* tab = (LAS float*)(F.lds + RING_OFF) + 64;
    const float* rpb = A.in[I_RPB] + (size_t)layer * 8 * 15 * 31;
    for (int idx = F.tid; idx < 128; idx += NWAVES * 64) { (idx < 64 ? tab - 64 : tab + 8 * 15 * 32 - 64)[idx] = 0.f; }
    for (int idx = F.tid; idx < 8 * 15 * 32; idx += NWAVES * 64) { const int h = idx / 480, rem = idx % 480, dr = rem >> 5, dc = rem & 31;
        tab[idx] = dc < 31 ? rpb[(h * 15 + dr) * 31 + dc] * LOG2E : 0.f; }
    __syncthreads();
    const int gw = F.vcu * NWAVES + F.wave, NGW = F.G * NWAVES;
    constexpr int NUS_P = 8 * 8 * 16, NUS = NUS_P + 8 * 8 * 32;
#pragma unroll 1
    for (int rep_ = 0; rep_ < NREP(2); ++rep_)
#pragma unroll 1
    for (int us = F.vcu; us < NUS; us += F.G) {
        size_t tok0; int rows, h, r0;
        if (us < NUS_P) { const int b = us >> 7; h = (us >> 4) & 7; r0 = (us & 15) * 4; tok0 = (size_t)b * SEQ_P; rows = 64; }
        else { const int q = us - NUS_P, b = q >> 8; h = (q >> 5) & 7; r0 = (q & 31) * 4; tok0 = (size_t)NP + (size_t)b * SEQ_S; rows = 128; }
        na_unitset(WSP(bf16, WS_NAQKV), rep_ ? WSP(bf16, WS_Z) : WSP(bf16, WS_ATT), tab + h * 480, F.lds + RING_OFF + 16384, tok0, rows, h, r0, F.tid, F.lane, F.wave);
    }
#pragma unroll 1
    for (int rq_ = 0; rq_ < (ROPE_FUSED ? 0 : NREP(12)); ++rq_) { const int rp_ = ROPE_DRY_FIRST ? (NREP(12) - 1 - rq_) : rq_;
        RopeLane L; const int lane = F.lane, d0 = 4 * (lane & 15);
        L.gq = *(const GAS f32x4*)(A.in[I_QN] + layer * 64 + d0); L.gk = *(const GAS f32x4*)(A.in[I_KN] + layer * 64 + d0);
#pragma unroll
        for (int k = 0; k < 4; ++k) L.invf[k] = __builtin_amdgcn_exp2f(-(float)((d0 + k) & 15) * (13.287712379549449f / 16.0f));
        v2u nxb[3];
        if (gw < NTOK) { const GAS v2u* src = (const GAS v2u*)(WSP(bf16, WS_RAWQK) + (size_t)gw * 768) + lane;
#pragma unroll
            for (int j = 0; j < 3; ++j) nxb[j] = src[64 * j]; }
#pragma unroll 1
        for (int m = gw; m < NTOK; m += NGW) {
            f32x4 v[3];
#pragma unroll
            for (int j = 0; j < 3; ++j) { v[j].x = bf_lo(nxb[j].x); v[j].y = bf_hi(nxb[j].x); v[j].z = bf_lo(nxb[j].y); v[j].w = bf_hi(nxb[j].y); }
            const int m2 = m + NGW;
            if (m2 < NTOK) { const GAS v2u* src = (const GAS v2u*)(WSP(bf16, WS_RAWQK) + (size_t)m2 * 768) + lane;
#pragma unroll
                for (int j = 0; j < 3; ++j) nxb[j] = src[64 * j]; }
            if (rp_) rope_compute<true>(A, L, v, m, lane); else rope_compute<false>(A, L, v, m, lane);
        }
    }
    __syncthreads();
}

#define XIN_BASES() const float* const XLO = (FP8_MIX && layer == 0) ? A.in[I_XP] : A.out; const float* const XHI = (FP8_MIX && layer == 0) ? A.in[I_XS] - (size_t)NP * DM : A.out
#define XIN_ROW(m_) (((m_) < NP ? XLO : XHI) + (size_t)(m_) * DM)
template <int CTRL> __device__ __forceinline__ float dpp_mov(float v) { return __int_as_float(__builtin_amdgcn_update_dpp(0, __float_as_int(v), CTRL, 0xF, 0xF, true)); }
__device__ __forceinline__ float row16_sum(float v) { v += dpp_mov<0x128>(v); v += dpp_mov<0x124>(v); v += dpp_mov<0x122>(v); v += dpp_mov<0x121>(v); return v; }
__device__ __forceinline__ float swap16_sum(float a, float b) { const auto rr = __builtin_amdgcn_permlane16_swap(__float_as_uint(a), __float_as_uint(b), false, false); return __uint_as_float(rr[0]) + __uint_as_float(rr[1]); }
__device__ __forceinline__ float swap32_sum(float a, float b) { const auto rr = __builtin_amdgcn_permlane32_swap(__float_as_uint(a), __float_as_uint(b), false, false); return __uint_as_float(rr[0]) + __uint_as_float(rr[1]); }
__device__ __forceinline__ float swap16_max(float a) { const auto rr = __builtin_amdgcn_permlane16_swap(__float_as_uint(a), __float_as_uint(a), false, false); return fmaxf(__uint_as_float(rr[0]), __uint_as_float(rr[1])); }
__device__ __forceinline__ float swap32_max(float a) { const auto rr = __builtin_amdgcn_permlane32_swap(__float_as_uint(a), __float_as_uint(a), false, false); return fmaxf(__uint_as_float(rr[0]), __uint_as_float(rr[1])); }
__device__ __forceinline__ float wave_sum_x(float v) { v = row16_sum(v); v = swap16_sum(v, v); return swap32_sum(v, v); }
template <bool DRY> __device__ __forceinline__ void phase_ln1(const Args& A, const Frame& F0, int layer) {
    const Frame F = fresh_frame(F0);
    constexpr int NR = 2;
    typedef float f32x2v __attribute__((ext_vector_type(2)));
    const int gw = F.vcu * NWAVES + F.wave, NGW = F.G * NWAVES, lane = F.lane;
    const GAS f32x4* gp = (const GAS f32x4*)(A.in[I_L1G] + (size_t)layer * DM) + lane;
    const GAS f32x4* bp = (const GAS f32x4*)(A.in[I_L1B] + (size_t)layer * DM) + lane;
    XIN_BASES();
    float* AFFT = DRY ? WSP(float, WS_R1 + 420 * MiB) : WSP(float, WS_AFFT);
    float* XO = DRY ? WSP(float, WS_R1) : A.out; bf16* XBO = DRY ? WSP(bf16, WS_Z + 201326592) : WSP(bf16, WS_XB);
    { const GAS f32x4* wsrc = (const GAS f32x4*)(A.in[I_WR] + (size_t)layer * DM * NE);
      for (int idx = F.tid; idx < DM * 4; idx += NWAVES * 64) { const int d = idx >> 2, q = idx & 3; *(LAS f32x4*)(F.lds + RING_OFF + d * 64 + (d >> 2) * 16 + q * 16) = wsrc[idx]; }
      __syncthreads(); }
    f32x4 nx[NR][4]; unsigned nmx[NR][4];
#define LN1_LOADSET(mb_) do { const GAS f32x4* src = (const GAS f32x4*)XIN_ROW(mb_) + lane; const GAS unsigned* ms = (const GAS unsigned*)(WSP(unsigned char, WS_MIX8) + (size_t)(mb_) * DM) + lane; \
        _Pragma("unroll") for (int r = 0; r < NR; ++r) { \
            _Pragma("unroll") for (int j = 0; j < 4; ++j) nx[r][j] = __builtin_nontemporal_load(&src[r * (DM / 4) + 64 * j]); \
            _Pragma("unroll") for (int j = 0; j < 4; ++j) nmx[r][j] = FP8_MIX ? ms[r * (DM / 4) + 64 * j] : 0u; } } while (0)
    if (NR * gw < NTOK) LN1_LOADSET(NR * gw);
#pragma unroll 1
    for (int m0 = NR * gw; m0 < NTOK; m0 += NR * NGW) {
        int wlo = lane * 272; asm volatile("" : "+v"(wlo));
        const LAS unsigned char* wl = F.lds + RING_OFF + wlo;
        f32x4 v[NR][4]; float mean[NR], rstd[NR];
#pragma unroll
        for (int r = 0; r < NR; ++r) {
            float s = 0.f;
#pragma unroll
            for (int j = 0; j < 4; ++j) { v[r][j] = nx[r][j];
                if (FP8_MIX) { const f32x2v lo = __builtin_amdgcn_cvt_pk_f32_fp8((int)nmx[r][j], false), hi = __builtin_amdgcn_cvt_pk_f32_fp8((int)nmx[r][j], true);
                    v[r][j].x = __builtin_fmaf(v[r][j].x, DN_ALPHA, lo.x); v[r][j].y = __builtin_fmaf(v[r][j].y, DN_ALPHA, lo.y); v[r][j].z = __builtin_fmaf(v[r][j].z, DN_ALPHA, hi.x); v[r][j].w = __builtin_fmaf(v[r][j].w, DN_ALPHA, hi.y); }
                s += (v[r][j].x + v[r][j].y) + (v[r][j].z + v[r][j].w); }
            mean[r] = wave_sum_x(s) * (1.f / DM);
        }
        __builtin_amdgcn_sched_barrier(0);
        { const int m2 = m0 + NR * NGW; if (m2 < NTOK) LN1_LOADSET(m2); }
        __builtin_amdgcn_sched_barrier(0);
#pragma unroll
        for (int r = 0; r < NR; ++r) { float s2 = 0.f;
#pragma unroll
            for (int j = 0; j < 4; ++j) { v[r][j] = v[r][j] - mean[r]; s2 += (v[r][j].x * v[r][j].x + v[r][j].y * v[r][j].y) + (v[r][j].z * v[r][j].z + v[r][j].w * v[r][j].w); }
            rstd[r] = 1.f / sqrtf(wave_sum_x(s2) * (1.f / DM) + LN_EPS);
            if (!DRY && lane == 0) { *(GAS f32x2v*)(WSP(float, WS_STATS) + (size_t)(m0 + r) * 2) = (f32x2v){mean[r], rstd[r]}; } }
        { int go = lane; asm volatile("" : "+v"(go));
#pragma unroll
          for (int j = 0; j < 4; ++j) { const f32x4 g4 = gp[go - lane + 64 * j], b4 = bp[go - lane + 64 * j];
#pragma unroll
            for (int r = 0; r < NR; ++r) { v[r][j] = v[r][j] * rstd[r] * g4 + b4;
                if (DRY) ((GAS f32x4*)(XO + (size_t)(m0 + r) * DM) + lane)[64 * j] = v[r][j];
                if (FP8_E1 && !DRY) ((GAS unsigned*)(WSP(unsigned char, WS_XB8) + (size_t)(m0 + r) * DM))[lane + 64 * j] = pg8::pack4_fp8(v[r][j].x, v[r][j].y, v[r][j].z, v[r][j].w);
                if (!FP8_E1) { v2u w; w.x = pk2(v[r][j].x, v[r][j].y); w.y = pk2(v[r][j].z, v[r][j].w); ((GAS v2u*)(XBO + (size_t)(m0 + r) * DM) + lane)[64 * j] = w; } } } }
        f32x2v lg[NR][8];
#pragma unroll
        for (int r = 0; r < NR; ++r)
#pragma unroll
            for (int e = 0; e < 8; ++e) lg[r][e] = (f32x2v){0.f, 0.f};
        {
            f32x4 wc[4], wn[4];
#pragma unroll
            for (int q = 0; q < 4; ++q) wc[q] = *(const LAS f32x4*)(wl + 16 * q);
#pragma unroll
            for (int g = 0; g < 16; ++g) {
                if (g + 1 < 16) {
#pragma unroll
                    for (int q = 0; q < 4; ++q) wn[q] = *(const LAS f32x4*)(wl + 17408 * ((g + 1) >> 2) + 64 * ((g + 1) & 3) + 16 * q); }
                __builtin_amdgcn_sched_barrier(0);
#pragma unroll
                for (int q = 0; q < 4; ++q) { const f32x2v wa = {wc[q].x, wc[q].y}, wb = {wc[q].z, wc[q].w};
#pragma unroll
                    for (int r = 0; r < NR; ++r) { const float xv = v[r][g >> 2][g & 3]; const f32x2v x2 = {xv, xv};
                        lg[r][2 * q] = __builtin_elementwise_fma(x2, wa, lg[r][2 * q]); lg[r][2 * q + 1] = __builtin_elementwise_fma(x2, wb, lg[r][2 * q + 1]); } }
                static_assert(NR == 2, "the pin below names both rows' accumulators");
                asm volatile("" : "+v"(lg[0][0]), "+v"(lg[0][1]), "+v"(lg[0][2]), "+v"(lg[0][3]), "+v"(lg[0][4]), "+v"(lg[0][5]), "+v"(lg[0][6]), "+v"(lg[0][7]),
                                  "+v"(lg[1][0]), "+v"(lg[1][1]), "+v"(lg[1][2]), "+v"(lg[1][3]), "+v"(lg[1][4]), "+v"(lg[1][5]), "+v"(lg[1][6]), "+v"(lg[1][7]));
                __builtin_amdgcn_sched_barrier(0);
#pragma unroll
                for (int q = 0; q < 4; ++q) wc[q] = wn[q];
            }
        }
#pragma unroll
        for (int r = 0; r < NR; ++r) {
            float t[8], u[4];
#pragma unroll
            for (int i = 0; i < 8; ++i) t[i] = swap32_sum(lg[r][i >> 1][i & 1], lg[r][4 + (i >> 1)][i & 1]);
#pragma unroll
            for (int i = 0; i < 4; ++i) u[i] = row16_sum(swap16_sum(t[i], t[i + 4]));
            float mx = fmaxf(fmaxf(u[0], u[1]), fmaxf(u[2], u[3])); mx = swap32_max(swap16_max(mx));
            float den = 0.f;
#pragma unroll
            for (int i = 0; i < 4; ++i) { u[i] = __expf(u[i] - mx); den += u[i]; }
            den = swap16_sum(den, den); den = swap32_sum(den, den);
            const float inv = 1.0f / den;
            const int i4 = lane & 3, e = 4 * (lane >> 4) + i4;
            const float mine = (i4 == 0 ? u[0] : i4 == 1 ? u[1] : i4 == 2 ? u[2] : u[3]) * inv;
            const int m = m0 + r;
            if ((lane & 15) < 4) { float* dst = m < NP ? AFFT + (size_t)e * NP + m : AFFT + (size_t)NE * NP + (size_t)e * NS + (m - NP); *dst = mine; }
        }
    }
}

constexpr size_t SEL_ALT = WS_R1 + 900 * MiB - WS_SLOT;
__device__ __forceinline__ void select_slow(const Args& A, const Frame& F, int task, size_t alt = 0) {
    const int grp = task >> 4, e = task & 15, n = grp ? NS : NP, cap = n >> 3;
    const unsigned* keys = (const unsigned*)(grp ? WSP(float, WS_AFFT) + (size_t)NE * NP + (size_t)e * NS : WSP(float, WS_AFFT) + (size_t)e * NP);
    const int tokbase = grp ? NP : 0, slotbase = grp ? NE * (NP >> 3) + e * cap : e * cap;
    int* SLOT = WSP(int, WS_SLOT + alt); int* IDX = WSP(int, WS_IDX + alt); float* GVAL = WSP(float, WS_GVAL + alt);
    LAS unsigned* hist = (LAS unsigned*)(F.lds + RING_OFF);
    LAS unsigned* wsum = hist + 2048;
    LAS unsigned* bc = hist + 2048 + 64;
    const int tid = F.tid, lane = F.lane, wid = F.wave;
    unsigned prefix = 0u, pmask = 0u, k = (unsigned)cap;
#pragma unroll 1
    for (int pass = 0; pass < 3; ++pass) {
        const int shift = pass == 0 ? 21 : (pass == 1 ? 10 : 0);
        const unsigned dmask = pass == 2 ? 1023u : 2047u;
        for (int i = tid; i < 2048; i += NWAVES * 64) hist[i] = 0u;
        __syncthreads();
        for (int i = tid; i < n; i += NWAVES * 64) { const unsigned key = keys[i]; if ((key & pmask) == prefix) __hip_atomic_fetch_add(&hist[(key >> shift) & dmask], 1u, __ATOMIC_RELAXED, __HIP_MEMORY_SCOPE_WORKGROUP); }
        __syncthreads();
        const unsigned c0 = hist[4 * tid], c1 = hist[4 * tid + 1], c2 = hist[4 * tid + 2], c3 = hist[4 * tid + 3];
        const unsigned tsum = c0 + c1 + c2 + c3;
        unsigned inc = tsum;
#pragma unroll
        for (int o = 1; o < 64; o <<= 1) { const unsigned t2 = __shfl_down(inc, o); if (lane + o < 64) inc += t2; }
        if (lane == 0) wsum[wid] = inc;
        __syncthreads();
        unsigned above = inc - tsum;
        for (int w = wid + 1; w < NWAVES; ++w) above += wsum[w];
        unsigned a = above;
        if (a < k && a + c3 >= k) { bc[0] = 4 * tid + 3; bc[1] = k - a; } a += c3;
        if (a < k && a + c2 >= k) { bc[0] = 4 * tid + 2; bc[1] = k - a; } a += c2;
        if (a < k && a + c1 >= k) { bc[0] = 4 * tid + 1; bc[1] = k - a; } a += c1;
        if (a < k && a + c0 >= k) { bc[0] = 4 * tid + 0; bc[1] = k - a; }
        __syncthreads();
        const unsigned bin = bc[0]; k = bc[1];
        prefix |= bin << shift; pmask |= dmask << shift;
        __syncthreads();
    }
    const unsigned thr = prefix, need = k;
    const unsigned cnt_gt = (unsigned)cap - need;
    unsigned base_gt = 0u, base_eq = 0u;
    const unsigned long long lt_mask = (1ull << lane) - 1ull;
#pragma unroll 1
    for (int base = 0, it = 0; base < n; base += NWAVES * 64, ++it) {
        const unsigned key = keys[base + tid];
        const bool gt = key > thr, eq = key == thr;
        const unsigned long long bg = __ballot(gt), be = __ballot(eq);
        LAS unsigned* ws = wsum + 16 + (it & 1) * 16;
        if (lane == 0) { ws[wid] = (unsigned)__popcll(bg); ws[8 + wid] = (unsigned)__popcll(be); }
        __syncthreads();
        unsigned og = 0u, oe = 0u, tg = 0u, te = 0u;
#pragma unroll
        for (int w = 0; w < NWAVES; ++w) { const unsigned a = ws[w], b = ws[8 + w]; if (w < wid) { og += a; oe += b; } tg += a; te += b; }
        const unsigned rg = base_gt + og + (unsigned)__popcll(bg & lt_mask), re = base_eq + oe + (unsigned)__popcll(be & lt_mask);
        int srow = -1;
        if (gt) srow = slotbase + (int)rg;
        else if (eq && re < need) srow = slotbase + (int)(cnt_gt + re);
        const int tok = tokbase + base + tid;
        SLOT[(size_t)tok * NE + e] = srow;
        if (srow >= 0) { IDX[srow] = tok; GVAL[srow] = __uint_as_float(key); }
        base_gt += tg; base_eq += te;
    }
    __syncthreads();
}

constexpr int SEL_LISTCAP = 2048;
#define SEL_BIN(kk) ({ int b_ = (int)(__uint_as_float(kk) * 2048.0f); b_ = b_ > 2047 ? 2047 : b_; b_; })
#define SEL_LOAD64(hb) _Pragma("unroll") for (int i = 0; i < 64; ++i) key[i] = (unsigned)__builtin_amdgcn_raw_buffer_load_b32(krs, tid * 4, ((hb) * 64 + i) * 2048, 0)
template <int NH  > __device__ __forceinline__ bool select_fast(const Args& A, const Frame& F, int task, size_t alt = 0) {
    const int grp = task >> 4, e = task & 15, cap = NH * 64 * 64;
    const unsigned* keys = (const unsigned*)(grp ? WSP(float, WS_AFFT) + (size_t)NE * NP + (size_t)e * NS : WSP(float, WS_AFFT) + (size_t)e * NP);
    const int tokbase = grp ? NP : 0, slotbase = grp ? NE * (NP >> 3) + e * cap : e * cap;
    GAS int* SLOT = (GAS int*)WSP(int, WS_SLOT + alt); GAS int* IDX = (GAS int*)WSP(int, WS_IDX + alt); GAS float* GVAL = (GAS float*)WSP(float, WS_GVAL + alt);
    LAS unsigned* hist = (LAS unsigned*)(F.lds + RING_OFF);
    LAS unsigned* wsum = hist + 2048;
    LAS unsigned* bc = hist + 2048 + 64;
    LAS unsigned* lkey = hist + 4096;
    LAS unsigned* lidx = lkey + SEL_LISTCAP;
    LAS unsigned* tabc = lidx + SEL_LISTCAP;
    const int tid = F.tid, lane = F.lane, wid = F.wave;
    const __amdgpu_buffer_rsrc_t krs = __builtin_amdgcn_make_buffer_rsrc((void*)keys, 0, NH * 64 * 512 * 4, 0x00020000);
    unsigned key[64];
    for (int i = tid; i < 2048; i += NWAVES * 64) hist[i] = 0u;
    if (tid == 0) bc[2] = 0u;
    __syncthreads();
#pragma unroll 1
    for (int hb = 0; hb < NH; ++hb) {
        SEL_LOAD64(hb);
#pragma unroll
        for (int i = 0; i < 64; ++i) __hip_atomic_fetch_add(&hist[SEL_BIN(key[i])], 1u, __ATOMIC_RELAXED, __HIP_MEMORY_SCOPE_WORKGROUP);
    }
    __syncthreads();
    {
        const unsigned c0 = hist[4 * tid], c1 = hist[4 * tid + 1], c2 = hist[4 * tid + 2], c3 = hist[4 * tid + 3];
        const unsigned tsum = c0 + c1 + c2 + c3, k = (unsigned)cap;
        unsigned inc = tsum;
#pragma unroll
        for (int o = 1; o < 64; o <<= 1) { const unsigned t2 = __shfl_down(inc, o); if (lane + o < 64) inc += t2; }
        if (lane == 0) wsum[wid] = inc;
        __syncthreads();
        unsigned a = inc - tsum;
        for (int w = wid + 1; w < NWAVES; ++w) a += wsum[w];
        if (a < k && a + c3 >= k) { bc[0] = 4 * tid + 3; bc[1] = k - a; bc[3] = c3; } a += c3;
        if (a < k && a + c2 >= k) { bc[0] = 4 * tid + 2; bc[1] = k - a; bc[3] = c2; } a += c2;
        if (a < k && a + c1 >= k) { bc[0] = 4 * tid + 1; bc[1] = k - a; bc[3] = c1; } a += c1;
        if (a < k && a + c0 >= k) { bc[0] = 4 * tid + 0; bc[1] = k - a; bc[3] = c0; }
        __syncthreads();
    }
    const int tbin = (int)bc[0]; const unsigned kin = bc[1], m = bc[3];
    if (m > (unsigned)SEL_LISTCAP) return false;
#pragma unroll 1
    for (int hb = 0; hb < NH; ++hb) {
        SEL_LOAD64(hb);
#pragma unroll
        for (int i = 0; i < 64; ++i) if (SEL_BIN(key[i]) == tbin) { const unsigned p = __hip_atomic_fetch_add(&bc[2], 1u, __ATOMIC_RELAXED, __HIP_MEMORY_SCOPE_WORKGROUP); lkey[p] = key[i]; lidx[p] = (unsigned)((hb * 64 + i) * 512 + tid); }
    }
    __syncthreads();
    for (unsigned p = tid; p < m; p += NWAVES * 64) {
        const unsigned kp = lkey[p], ip = lidx[p]; unsigned rank = 0u;
        for (unsigned q = 0; q < m; ++q) { const unsigned kq = lkey[q], iq = lidx[q]; rank += (kq > kp || (kq == kp && iq < ip)) ? 1u : 0u; }
        if (rank == kin - 1u) { bc[4] = kp; bc[5] = ip; }
    }
    __syncthreads();
    const unsigned tkey = bc[4], tidx = bc[5];
    const unsigned long long lt_mask = (1ull << lane) - 1ull;
#pragma unroll 1
    for (int hb = 0; hb < NH; ++hb) {
        SEL_LOAD64(hb);
#pragma unroll
        for (int i = 0; i < 64; ++i) {
            const int b = SEL_BIN(key[i]); const unsigned ti = (unsigned)((hb * 64 + i) * 512 + tid);
            const bool sel = b > tbin || (b == tbin && (key[i] > tkey || (key[i] == tkey && ti <= tidx)));
            const unsigned long long bal = __ballot(sel);
            if (lane == 0) tabc[(hb * 64 + i) * 8 + wid] = (unsigned)__popcll(bal);
            if ((i & 7) == 7) __builtin_amdgcn_sched_barrier(0);
        }
    }
    __syncthreads();
    {
        unsigned v[NH], s = 0u;
#pragma unroll
        for (int q = 0; q < NH; ++q) { v[q] = tabc[NH * tid + q]; s += v[q]; }
        unsigned inc = s;
#pragma unroll
        for (int o = 1; o < 64; o <<= 1) { const unsigned t2 = __shfl_up(inc, o); if (lane >= o) inc += t2; }
        if (lane == 63) wsum[wid] = inc;
        __syncthreads();
        unsigned base = inc - s;
        for (int w = 0; w < wid; ++w) base += wsum[w];
#pragma unroll
        for (int q = 0; q < NH; ++q) { tabc[NH * tid + q] = base; base += v[q]; }
        __syncthreads();
    }
#pragma unroll 1
    for (int hb = 0; hb < NH; ++hb) {
        SEL_LOAD64(hb);
#pragma unroll
        for (int i = 0; i < 64; ++i) {
            const int b = SEL_BIN(key[i]); const unsigned ti = (unsigned)((hb * 64 + i) * 512 + tid);
            const bool sel = b > tbin || (b == tbin && (key[i] > tkey || (key[i] == tkey && ti <= tidx)));
            const unsigned long long bal = __ballot(sel);
            const int tok = tokbase + (hb * 64 + i) * 512 + tid;
            int srow = -1;
            if (sel) srow = slotbase + (int)(tabc[(hb * 64 + i) * 8 + wid] + (unsigned)__popcll(bal & lt_mask));
            SLOT[(size_t)tok * NE + e] = srow;
            if (sel) { IDX[srow] = tok; GVAL[srow] = __uint_as_float(key[i]); }
            if ((i & 7) == 7) __builtin_amdgcn_sched_barrier(0);
        }
    }
    __syncthreads();
    return true;
}
#undef SEL_BIN
#undef SEL_LOAD64
__device__ __forceinline__ void phase_select(const Args& A, const Frame& F0, size_t alt = 0) {
    const Frame F = fresh_frame(F0);
    const int task = blockIdx.x;
    if (task >= 2 * NE) return;
    const bool ok = (task >> 4) ? select_fast<NS / 32768>(A, F, task, alt) : select_fast<NP / 32768>(A, F, task, alt);
    if (!ok) { __syncthreads(); select_slow(A, F, task, alt); }
}

__device__ __forceinline__ void phase_gather(const Args& A, const Frame& F0) {
    const Frame F = fresh_frame(F0);
    const int gw = F.vcu * NWAVES + F.wave, NGW = F.G * NWAVES, lane = F.lane;
    const int* IDX = WSP(int, WS_IDX);
#pragma unroll 1
    for (int s = gw; s < NSLOTROWS; s += NGW) {
        const int tok = IDX[s];
        const GAS v4u* src = (const GAS v4u*)(WSP(bf16, WS_XB) + (size_t)tok * DM);
        GAS v4u* dst = (GAS v4u*)(WSP(bf16, WS_XG) + (size_t)s * DM);
        const v4u a = src[lane], b = src[lane + 64];
        dst[lane] = a; dst[lane + 64] = b;
    }
}

template <bool DRY> __device__ __forceinline__ void phase_ln2(const Args& A, const Frame& F0, int layer) {
    static_assert(FP8_YE, "the pipelined combine reads e4m3 expert rows");
    const Frame F = fresh_frame(F0);
    const int gw = F.vcu * NWAVES + F.wave, NGW = F.G * NWAVES, lane = F.lane;
    const GAS f32x4* gp = (const GAS f32x4*)(A.in[I_L2G] + (size_t)layer * DM) + lane;
    const GAS f32x4* bp = (const GAS f32x4*)(A.in[I_L2B] + (size_t)layer * DM) + lane;
    XIN_BASES();
    const int* SLOT = WSP(int, WS_SLOT); const float* GVAL = WSP(float, WS_GVAL);
    const unsigned char* YE = WSP(unsigned char, WS_YE);
    float* XO = DRY ? WSP(float, WS_R1) : A.out; bf16* XBO = DRY ? WSP(bf16, WS_Z + 201326592) : WSP(bf16, WS_XB);
    const GAS f32x4* g1p = (const GAS f32x4*)(A.in[I_L1G] + (size_t)layer * DM) + lane;
    const GAS f32x4* b1p = (const GAS f32x4*)(A.in[I_L1B] + (size_t)layer * DM) + lane;
    f32x4 g1[4], b1[4];
#pragma unroll
    for (int j = 0; j < 4; ++j) { g1[j] = g1p[64 * j]; b1[j] = b1p[64 * j]; }
    typedef float f32x2s __attribute__((ext_vector_type(2)));
    const GAS f32x2s* STATS = (const GAS f32x2s*)WSP(float, WS_STATS);
#define LN2_DECODE(sv_, gvl_, srow_, gv_, rest_) do { unsigned long long mk_ = __ballot((sv_) >= 0); \
        _Pragma("unroll") for (int b = 0; b < 4; ++b) { if (mk_) { const int e_ = __builtin_ctzll(mk_); mk_ &= mk_ - 1ull; srow_[b] = __builtin_amdgcn_readlane((sv_), e_); \
            gv_[b] = __builtin_bit_cast(float, __builtin_amdgcn_readlane(__builtin_bit_cast(int, (gvl_)), e_)); } else { srow_[b] = -1; gv_[b] = 0.f; } } rest_ = mk_; } while (0)
#define LN2_LOADROW(m_, y_, wb_, srow_) do { const GAS f32x4* xr_ = (const GAS f32x4*)XIN_ROW(m_) + lane; \
        _Pragma("unroll") for (int j = 0; j < 4; ++j) y_[j] = __builtin_nontemporal_load(&xr_[64 * j]);     \
        if (FP8_MIX) { const GAS unsigned* ms_ = (const GAS unsigned*)(WSP(unsigned char, WS_MIX8) + (size_t)(m_) * DM) + lane; _Pragma("unroll") for (int j = 0; j < 4; ++j) y_##mx[j] = ms_[64 * j]; } \
        _Pragma("unroll") for (int b = 0; b < 4; ++b) { if (srow_[b] >= 0) { const GAS unsigned* yr_ = (const GAS unsigned*)(YE + (size_t)srow_[b] * DM) + lane; \
            _Pragma("unroll") for (int j = 0; j < 4; ++j) wb_[b][j] = yr_[64 * j]; } else { _Pragma("unroll") for (int j = 0; j < 4; ++j) wb_[b][j] = 0u; } } } while (0)
    int svC = -1; float gvlC = 0.f; f32x2s stC = (f32x2s){0.f, 1.f};
    if (gw < NTOK) { svC = lane < NE ? SLOT[(size_t)gw * NE + lane] : -1; gvlC = svC >= 0 ? GVAL[svC] : 0.f; stC = STATS[gw]; }
    int svB = -1; float gvlB = 0.f; f32x2s stB = (f32x2s){0.f, 1.f};
    if (gw + NGW < NTOK) { svB = lane < NE ? SLOT[(size_t)(gw + NGW) * NE + lane] : -1; gvlB = svB >= 0 ? GVAL[svB] : 0.f; stB = STATS[gw + NGW]; }
    int srowC[4]; float gvC[4]; unsigned long long restC; f32x4 yC[4]; unsigned wbC[4][4]; unsigned yCmx[4] = {0u, 0u, 0u, 0u};
    LN2_DECODE(svC, gvlC, srowC, gvC, restC);
    if (gw < NTOK) LN2_LOADROW(gw, yC, wbC, srowC);
#pragma unroll 1
    for (int m = gw; m < NTOK; m += NGW) {
        const int m2 = m + NGW, m3 = m + 2 * NGW;
        int srowN[4]; float gvN[4]; unsigned long long restN; f32x4 yN[4]; unsigned wbN[4][4]; unsigned yNmx[4] = {0u, 0u, 0u, 0u};
        LN2_DECODE(svB, gvlB, srowN, gvN, restN);
        if (m2 < NTOK) LN2_LOADROW(m2, yN, wbN, srowN);
        int svNN = -1; f32x2s stNN = (f32x2s){0.f, 1.f};
        if (m3 < NTOK) { svNN = lane < NE ? SLOT[(size_t)m3 * NE + lane] : -1; stNN = STATS[m3]; }
        f32x4 v[4];
#pragma unroll
        for (int j = 0; j < 4; ++j) { f32x4 y = yC[j];
            if (FP8_MIX) { const f32x2s lo = __builtin_amdgcn_cvt_pk_f32_fp8((int)yCmx[j], false), hi = __builtin_amdgcn_cvt_pk_f32_fp8((int)yCmx[j], true);
                y.x = __builtin_fmaf(y.x, DN_ALPHA, lo.x); y.y = __builtin_fmaf(y.y, DN_ALPHA, lo.y); y.z = __builtin_fmaf(y.z, DN_ALPHA, hi.x); y.w = __builtin_fmaf(y.w, DN_ALPHA, hi.y); }
            v[j] = (((y - stC.x) * stC.y) * g1[j] + b1[j]) * DN_ALPHA; }
#pragma unroll
        for (int b = 0; b < 4; ++b)
#pragma unroll
            for (int j = 0; j < 4; ++j) { const f32x2s lo = __builtin_amdgcn_cvt_pk_f32_fp8((int)wbC[b][j], false), hi = __builtin_amdgcn_cvt_pk_f32_fp8((int)wbC[b][j], true);
                v[j].x += gvC[b] * lo.x; v[j].y += gvC[b] * lo.y; v[j].z += gvC[b] * hi.x; v[j].w += gvC[b] * hi.y; }
        while (restC) {
            const int e = __builtin_ctzll(restC); restC &= restC - 1ull;
            const int sr = __builtin_amdgcn_readlane(svC, e); const float ge = __builtin_bit_cast(float, __builtin_amdgcn_readlane(__builtin_bit_cast(int, gvlC), e));
            const GAS unsigned* yr = (const GAS unsigned*)(YE + (size_t)sr * DM) + lane;
            unsigned w1[4];
#pragma unroll
            for (int j = 0; j < 4; ++j) w1[j] = yr[64 * j];
#pragma unroll
            for (int j = 0; j < 4; ++j) { const f32x2s lo = __builtin_amdgcn_cvt_pk_f32_fp8((int)w1[j], false), hi = __builtin_amdgcn_cvt_pk_f32_fp8((int)w1[j], true);
                v[j].x += ge * lo.x; v[j].y += ge * lo.y; v[j].z += ge * hi.x; v[j].w += ge * hi.y; }
        }
        float s = 0.f;
#pragma unroll
        for (int j = 0; j < 4; ++j) s += (v[j].x + v[j].y) + (v[j].z + v[j].w);
        const float mean = wave_sum_x(s) * (1.f / DM); float s2 = 0.f;
#pragma unroll
        for (int j = 0; j < 4; ++j) { v[j] = v[j] - mean; s2 += (v[j].x * v[j].x + v[j].y * v[j].y) + (v[j].z * v[j].z + v[j].w * v[j].w); }
        const float rstd = 1.f / sqrtf(wave_sum_x(s2) * (1.f / DM) + LN_EPS);
        GAS v2u* bo = (GAS v2u*)(XBO + (size_t)m * DM) + lane; GAS f32x4* xw = (GAS f32x4*)(XO + (size_t)m * DM) + lane;
#pragma unroll
        for (int j = 0; j < 4; ++j) { v[j] = v[j] * rstd * gp[64 * j] + bp[64 * j]; __builtin_nontemporal_store(v[j], &xw[64 * j]);
            if (FP8_G1) { if (!DRY && layer + 1 < DEPTH) ((GAS unsigned*)(WSP(unsigned char, WS_XB8) + (size_t)m * DM))[lane + 64 * j] = pg8::pack4_fp8(v[j].x, v[j].y, v[j].z, v[j].w); }
            else { v2u w2; w2.x = pk2(v[j].x, v[j].y); w2.y = pk2(v[j].z, v[j].w); bo[64 * j] = w2; } }
        float gvlNN = svNN >= 0 ? GVAL[svNN] : 0.f;
        __builtin_amdgcn_sched_barrier(0);
        svC = svB; gvlC = gvlB; stC = stB; restC = restN;
#pragma unroll
        for (int b = 0; b < 4; ++b) { srowC[b] = srowN[b]; gvC[b] = gvN[b];
#pragma unroll
            for (int j = 0; j < 4; ++j) wbC[b][j] = wbN[b][j]; }
#pragma unroll
        for (int j = 0; j < 4; ++j) { yC[j] = yN[j]; yCmx[j] = yNmx[j]; }
        svB = svNN; gvlB = gvlNN; stB = stNN;
    }
#undef LN2_DECODE
#undef LN2_LOADROW
}

__device__ __forceinline__ bool gqa_next(int i, int vcu, int G, long& qrow0, long& kvrow0, int& NT, int& h) {
    const long U = (long)i * G + vcu;
    if (U >= 3072) return false;
    if (U < 2048) { const int ii = (int)(U >> 8), v = (int)(U & 255), xcd = v >> 5, cu = v & 31;
        const int pair = 2 * xcd + (ii >> 2), b = pair >> 1, kvh = pair & 1; h = kvh * 4 + (ii & 3);
        kvrow0 = (long)NP + (long)b * SEQ_S; qrow0 = kvrow0 + 256 * cu; NT = SEQ_S / 64; }
    else { const int U2 = (int)(U - 2048), jj = U2 >> 8, v = U2 & 255, xcd = v >> 5, cu = v & 31;
        const int pair = 2 * xcd + (jj >> 1), b = pair >> 1, kvh = pair & 1; h = kvh * 4 + (jj & 1) * 2 + (cu >> 4);
        kvrow0 = (long)b * SEQ_P; qrow0 = kvrow0 + 256 * (cu & 15); NT = SEQ_P / 64; }
    return true;
}

__global__ void __launch_bounds__(NWAVES * 64, 2) trunk_fwd(Args A) {
    extern __shared__ __attribute__((aligned(16))) unsigned char lds[];
    Frame F;
    F.lds = (LAS unsigned char*)lds;
    F.tid = threadIdx.x; F.lane = F.tid & 63; F.wave = __builtin_amdgcn_readfirstlane(F.tid >> 6);
    F.G = gridDim.x; { const int bx = blockIdx.x; F.vcu = (F.G % 8 == 0) ? (bx % 8) * (F.G / 8) + bx / 8 : bx; }
#ifdef ZERO_ALL_LDS
    for (int u = F.tid; u < LDS_BYTES / 4; u += NWAVES * 64) ((LAS unsigned*)(F.lds))[u] = 0u;
#else
    for (int u = F.tid; u < (LDS_BYTES - LDSCTL_OFF) / 4; u += NWAVES * 64) ((LAS unsigned*)(F.lds + LDSCTL_OFF))[u] = 0u;
#endif
    __syncthreads();
    unsigned* barw = (unsigned*)(A.ws + WS_CTL) + CW_BAR;
    XcdBarrier bar; bar.bar = barw; bar.x = 0; bar.st = nullptr;
    if (N_LAUNCHES == 1) bar = xcd_barrier_post(barw, (volatile LAS unsigned*)(F.lds + MISC_OFF) + 8);

    const int lo = A.ph_lo, hi = A.ph_hi;
#ifdef TOUCH_PAGES
    { unsigned acc_ = 0u; const size_t gt_ = (size_t)blockIdx.x * 512 + threadIdx.x, NT_ = (size_t)gridDim.x * 512;
      for (size_t pg = gt_; pg < WS_END / 4096; pg += NT_) acc_ += *(const GAS unsigned*)(A.ws + pg * 4096);
      for (size_t pg = gt_; pg < (size_t)NTOK * DM * 4 / 4096; pg += NT_) acc_ += *(const GAS unsigned*)((const char*)A.out + pg * 4096);
      for (int k_ = 0; k_ < 17; ++k_) { const size_t nb_ = k_ < 2 ? (size_t)(k_ ? NS : NP) * DM * 4 : (k_ == I_WG || k_ == I_WU || k_ == I_WD) ? (size_t)DEPTH * NE * DM * DF * 4 : (k_ == I_WIN ? (size_t)DEPTH * DM * D_IN * 4 : (size_t)4096);
          for (size_t pg = gt_; pg < nb_ / 4096; pg += NT_) acc_ += *(const GAS unsigned*)((const char*)A.in[k_] + pg * 4096); }
      asm volatile("" :: "v"(acc_)); }
#endif
#define IN(k) (lo <= (k) && (k) < hi)
#ifndef PHASE_MASK
#define PHASE_MASK 0xFFF
#endif
#define PHON(p) (((PHASE_MASK) >> (p)) & 1)
#ifdef XB_DOUBLE
#define SEAM(k) do { if (N_LAUNCHES == 1) { if (IN((k) + 1)) { xcd_barrier(bar); xcd_barrier(bar); } } } while (0)
#else
#define SEAM(k) do { if (N_LAUNCHES == 1) { if (IN((k) + 1)) xcd_barrier(bar); } } while (0)
#endif
#define DET_COMPARE(offA, offB, nbytes) do { xcd_barrier(bar); const Frame F2 = fresh_frame(F); const size_t gt = (size_t)(F2.vcu * NWAVES + F2.wave) * 64 + F2.lane, NT_ = (size_t)F2.G * NWAVES * 64; unsigned bad = 0u; \
        for (size_t q = gt; q < (size_t)(nbytes) / 16; q += NT_) { const v4u a = ((const GAS v4u*)(A.ws + (offA)))[q], b = ((const GAS v4u*)(A.ws + (offB)))[q]; bad |= (a.x ^ b.x) | (a.y ^ b.y) | (a.z ^ b.z) | (a.w ^ b.w); } \
        if (bad) __hip_atomic_fetch_add((unsigned*)(A.ws + WS_CTL) + 8, 1u, __ATOMIC_RELAXED, __HIP_MEMORY_SCOPE_AGENT); } while (0)

#pragma unroll 1
    for (int layer = 0; layer < DEPTH; ++layer) {
        const int P0 = layer * PH_PER_LAYER;
        if (PHON(0) && IN(P0 + 0) && (layer == 0 || N_LAUNCHES != 1)) { phase_conv<0>(A, F, layer, F.vcu * NWAVES + F.wave, F.G * NWAVES); SEAM(P0 + 0); }
        if (PHON(1) && IN(P0 + 1)) {
            pg8::Gemm g{FP8_G1 ? WSP(bf16, WS_XB8) : WSP(bf16, WS_XB), WSP(bf16, WS_WIN), NTOK, D_IN, FP8_G1 ? DM / 2 : DM}; pg8::TileOrder<0> S; S.init(NTOK / 256, D_IN / 256, F.G, (int)blockIdx.x);
#if ROPE_FUSED
            pg8::EpiProjRope E{WSP(bf16, WS_NAQKV), WSP(bf16, WS_QKVB), WSP(unsigned char, WS_GATES), A.in[I_QN] + layer * 64, A.in[I_KN] + layer * 64, (PG8_LAS float*)(F.lds + LDSCTL_OFF + 512), QSCALE, FP8_G1 ? 1.0f / WIN_SCALE : 1.0f};
            for (int rep_ = 0; rep_ < NREP(1); ++rep_) pg8::gemm_phase<pg8::EpiProjRope, pg8::TileOrder<0>, true, true, FP8_G1 != 0>(F.lds + RING_OFF, g, S, E);
#else
            pg8::EpiProj E{WSP(bf16, WS_NAQKV), WSP(bf16, WS_RAWQK), WSP(unsigned char, WS_GATES), QSCALE, FP8_G1 ? 1.0f / WIN_SCALE : 1.0f};
            for (int rep_ = 0; rep_ < NREP(1); ++rep_) pg8::gemm_phase<pg8::EpiProj, pg8::TileOrder<0>, true, true, FP8_G1 != 0>(F.lds + RING_OFF, g, S, E);
#endif
#if defined(DETPROBE) && (DETPROBE & (1 << 1))
            { pg8::EpiProj E2{WSP(bf16, WS_R2), WSP(bf16, WS_R2 + (size_t)NTOK * 1536 * 2), WSP(unsigned char, WS_GATES), QSCALE, FP8_G1 ? 1.0f / WIN_SCALE : 1.0f};
              pg8::gemm_phase<pg8::EpiProj, pg8::TileOrder<0>, true, true, FP8_G1 != 0>(F.lds + RING_OFF, g, S, E2); }
            DET_COMPARE(WS_NAQKV, WS_R2, (size_t)NTOK * 1536 * 2 + (size_t)NTOK * 768 * 4);
#endif
            SEAM(P0 + 1);
        }
        if (PHON(2) && IN(P0 + 2)) { phase_na(A, F, layer);
#if defined(DETPROBE) && (DETPROBE & (1 << 2))
            xcd_barrier(bar);
            { const Frame F2 = fresh_frame(F); const int gw = F2.vcu * NWAVES + F2.wave, NGW = F2.G * NWAVES; unsigned bad = 0u;
              for (int m = gw; m < NTOK; m += NGW) { const v4u a = ((const GAS v4u*)(WSP(bf16, WS_ATT) + (size_t)m * 512))[F2.lane], b = ((const GAS v4u*)(WSP(bf16, WS_Z) + (size_t)m * 512))[F2.lane];
                  bad |= (a.x ^ b.x) | (a.y ^ b.y) | (a.z ^ b.z) | (a.w ^ b.w); }
              if (bad) __hip_atomic_fetch_add((unsigned*)(A.ws + WS_CTL) + 8, 1u, __ATOMIC_RELAXED, __HIP_MEMORY_SCOPE_AGENT); }
#endif
            if (!ROPE_FUSED) SEAM(P0 + 2); }
        if (PHON(3) && IN(P0 + 3)) {
            const attn_body::bf16* QKV = (const attn_body::bf16*)WSP(bf16, WS_QKVB); const unsigned char* QKV8 = WSP(unsigned char, WS_QKVB);
            long qrow0, kvrow0; int NT, h;
            float gb; { const Frame F2 = fresh_frame(F); float gq_ = fabsf(A.in[I_QN][layer * 64 + F2.lane]), gk_ = fabsf(A.in[I_KN][layer * 64 + F2.lane]);
#pragma unroll
                for (int o_ = 32; o_ >= 1; o_ >>= 1) { gq_ = fmaxf(gq_, __shfl_xor(gq_, o_)); gk_ = fmaxf(gk_, __shfl_xor(gk_, o_)); }
                gb = __builtin_amdgcn_readfirstlane(gq_ * gk_ * (8.0f * 1.4426950408889634f * 1.01f)); }
            for (int rep_ = 0; rep_ < NREP(3); ++rep_)
            if (gb < 64.0f) {
            for (int i = 0; gqa_next(i, F.vcu, F.G, qrow0, kvrow0, NT, h); ++i)
                attn_body::attn_unit<8, true, FP8_BR != 0, FP8_QK != 0>(qrow0, kvrow0, NT, FP8_QK ? (const attn_body::bf16*)(QKV8 + h * 64) : QKV + h * 64, FP8_QK ? (const attn_body::bf16*)(QKV8 + 512 + (h >> 2) * 64) : QKV + 512 + (h >> 2) * 64, FP8_QK ? (const attn_body::bf16*)(QKV8 + 640) + (h >> 2) * 64 : QKV + 640 + (h >> 2) * 64,
                                        FP8_BR ? (attn_body::bf16*)(WSP(unsigned char, WS_ATT) + (size_t)NTOK * 512 + h * 64) : (attn_body::bf16*)WSP(bf16, WS_ATT) + (size_t)NTOK * 512 + h * 64, (char*)lds + RING_OFF);
            } else {
            for (int i = 0; gqa_next(i, F.vcu, F.G, qrow0, kvrow0, NT, h); ++i)
                attn_body::attn_unit<8, false, FP8_BR != 0, FP8_QK != 0>(qrow0, kvrow0, NT, FP8_QK ? (const attn_body::bf16*)(QKV8 + h * 64) : QKV + h * 64, FP8_QK ? (const attn_body::bf16*)(QKV8 + 512 + (h >> 2) * 64) : QKV + 512 + (h >> 2) * 64, FP8_QK ? (const attn_body::bf16*)(QKV8 + 640) + (h >> 2) * 64 : QKV + 640 + (h >> 2) * 64,
                                        FP8_BR ? (attn_body::bf16*)(WSP(unsigned char, WS_ATT) + (size_t)NTOK * 512 + h * 64) : (attn_body::bf16*)WSP(bf16, WS_ATT) + (size_t)NTOK * 512 + h * 64, (char*)lds + RING_OFF);
            }
#if defined(DETPROBE) && (DETPROBE & (1 << 3))
            for (int i = 0; gqa_next(i, F.vcu, F.G, qrow0, kvrow0, NT, h); ++i)
                attn_body::attn_unit<8>(qrow0, kvrow0, NT, QKV + h * 64, QKV + 512 + (h >> 2) * 64, QKV + 640 + (h >> 2) * 64,
                                        (attn_body::bf16*)WSP(bf16, WS_Z) + h * 64, (char*)lds + RING_OFF);
            xcd_barrier(bar);
            { const Frame F2 = fresh_frame(F); const int gw = F2.vcu * NWAVES + F2.wave, NGW = F2.G * NWAVES; unsigned bad = 0u;
              for (int m = gw; m < NTOK; m += NGW) { const v4u a = ((const GAS v4u*)(WSP(bf16, WS_ATT) + (size_t)NTOK * 512 + (size_t)m * 512))[F2.lane], b = ((const GAS v4u*)(WSP(bf16, WS_Z) + (size_t)m * 512))[F2.lane];
                  bad |= (a.x ^ b.x) | (a.y ^ b.y) | (a.z ^ b.z) | (a.w ^ b.w); }
              if (bad) __hip_atomic_fetch_add((unsigned*)(A.ws + WS_CTL) + 8, 1u, __ATOMIC_RELAXED, __HIP_MEMORY_SCOPE_AGENT); }
#endif
            SEAM(P0 + 3);
        }
        if (PHON(4) && IN(P0 + 4)) {
            pg8::Gemm g{WSP(bf16, WS_ATT), WSP(bf16, WS_WBR), 2 * NTOK, 1024, FP8_BR ? 256 : 512}; pg8::TileOrder<3> S; S.init(NTOK / 256, 4, F.G, (int)blockIdx.x);
            pg8::EpiBranch E{WSP(unsigned char, WS_GATES), WSP(bf16, WS_Z), FP8_OUT ? WSP(unsigned char, WS_QKVB) : nullptr, FP8_BR ? 1.0f / (ATT_SCALE * WBR_SCALE) : 1.0f};
            for (int rep_ = 0; rep_ < NREP(4); ++rep_) pg8::gemm_phase<pg8::EpiBranch, pg8::TileOrder<3>, true, true, FP8_BR != 0>(F.lds + RING_OFF, g, S, E);
#if defined(DETPROBE) && (DETPROBE & (1 << 4))
            { pg8::EpiBranch E2{WSP(unsigned char, WS_GATES), WSP(bf16, WS_QKVB), nullptr, 1.0f}; pg8::gemm_phase<pg8::EpiBranch, pg8::TileOrder<3>, true, true>(F.lds + RING_OFF, g, S, E2); }
            DET_COMPARE(WS_Z, WS_QKVB, (size_t)NTOK * DM * 2);
#endif
            SEAM(P0 + 4);
        }
        if (PHON(5) && IN(P0 + 5)) {
            pg8::Gemm g{FP8_OUT ? WSP(bf16, WS_QKVB) : WSP(bf16, WS_Z), WSP(bf16, WS_WOUT), NTOK, DM, FP8_OUT ? DM / 2 : DM}; pg8::TileOrder<0> S; S.init(NTOK / 256, DM / 256, F.G, (int)blockIdx.x);
            pg8::EpiResid<FP8_MIX != 0> E{A.out, DN_ALPHA, FP8_OUT ? 1.0f / WOUT_SCALE : 1.0f, WSP(unsigned char, WS_MIX8)};
            for (int rep_ = 0; rep_ < NREP(5); ++rep_) pg8::gemm_phase<pg8::EpiResid<FP8_MIX != 0>, pg8::TileOrder<0>, true, true, FP8_OUT != 0>(F.lds + RING_OFF, g, S, E);
            SEAM(P0 + 5);
        }
        if (PHON(6) && IN(P0 + 6)) { if (NREP(13) > 1) { const Frame F2 = fresh_frame(F); const int gw = F2.vcu * NWAVES + F2.wave, NGW = F2.G * NWAVES, lane = F2.lane, d0 = 4 * (lane & 15);
                RopeLane L; L.gq = *(const GAS f32x4*)(A.in[I_QN] + layer * 64 + d0); L.gk = *(const GAS f32x4*)(A.in[I_KN] + layer * 64 + d0);
                for (int k = 0; k < 4; ++k) L.invf[k] = __builtin_amdgcn_exp2f(-(float)((d0 + k) & 15) * (13.287712379549449f / 16.0f));
#pragma unroll 1
                for (int m = gw; m < NTOK; m += NGW) { f32x4 v[3]; const GAS v2u* src = (const GAS v2u*)(WSP(bf16, WS_RAWQK) + (size_t)m * 768) + lane;
                    for (int j = 0; j < 3; ++j) { const v2u w_ = src[64 * j]; v[j].x = bf_lo(w_.x); v[j].y = bf_hi(w_.x); v[j].z = bf_lo(w_.y); v[j].w = bf_hi(w_.y); }
                    rope_compute<true>(A, L, v, m, lane); } }
            if (NREP(6) > 1) phase_ln1<true>(A, F, layer); phase_ln1<false>(A, F, layer);
#if defined(DETPROBE) && (DETPROBE & (1 << 6))
            DET_COMPARE(WS_AFFT, WS_R1 + 420 * MiB, (size_t)NTOK * NE * 4);
#endif
            SEAM(P0 + 6); }
        if (PHON(7) && IN(P0 + 7)) {
            for (int rep_ = 0; rep_ < NREP(7); ++rep_) {
            phase_select(A, F);
#if defined(DETPROBE) && (DETPROBE & (1 << 7))
            phase_select(A, F, SEL_ALT);
#endif
            if (F.G > 2 * NE) { if ((int)blockIdx.x >= 2 * NE) conv_experts(A, F, layer, ((int)blockIdx.x - 2 * NE) * NWAVES + F.wave, (F.G - 2 * NE) * NWAVES); }
            else conv_experts(A, F, layer, (int)blockIdx.x * NWAVES + F.wave, F.G * NWAVES);
            }
#if defined(DETPROBE) && (DETPROBE & (1 << 7))
            DET_COMPARE(WS_SLOT, WS_SLOT + SEL_ALT, (size_t)NTOK * NE * 4 + 2 * (size_t)NSLOTROWS * 4);
#endif
            SEAM(P0 + 7); }
        if (PHON(9) && IN(P0 + 9)) {
            pg8::Gemm g{FP8_E1 ? WSP(bf16, WS_XB8) : WSP(bf16, WS_XB), WSP(bf16, WS_W1), NSLOTROWS, 4096, FP8_E1 ? DM / 2 : DM}; pg8::TileOrderGather S; S.init(NSLOTROWS / 256, 16, F.G, (int)blockIdx.x); S.gidx = WSP(int, WS_IDX);
            pg8::EpiSwiGLU<FP8_E2 != 0> E{WSP(void, WS_H), FP8_E1 ? 1.0f / W1_SCALE : 1.0f};
            for (int rep_ = 0; rep_ < NREP(9); ++rep_) pg8::gemm_phase<pg8::EpiSwiGLU<FP8_E2 != 0>, pg8::TileOrderGather, true, true, FP8_E1 != 0>(F.lds + RING_OFF, g, S, E);
#if defined(DETPROBE) && (DETPROBE & (1 << 9))
            { pg8::EpiSwiGLU<FP8_E2 != 0> E2{WSP(void, WS_R1 + 448 * MiB), FP8_E1 ? 1.0f / W1_SCALE : 1.0f}; pg8::gemm_phase<pg8::EpiSwiGLU<FP8_E2 != 0>, pg8::TileOrderGather, true, true, FP8_E1 != 0>(F.lds + RING_OFF, g, S, E2); }
            DET_COMPARE(WS_H, WS_R1 + 448 * MiB, (size_t)NSLOTROWS * DF * (FP8_E2 ? 1 : 2));
#endif
            SEAM(P0 + 9);
        }
        if (PHON(10) && IN(P0 + 10)) {
            pg8::Gemm g{WSP(bf16, WS_H), WSP(bf16, WS_W2), NSLOTROWS, DM, FP8_E2 ? DF / 2 : DF}; pg8::TileOrder<2> S; S.init(NSLOTROWS / 256, 4, F.G, (int)blockIdx.x);
            pg8::EpiDown<FP8_YE != 0> E{WSP(void, WS_YE), FP8_E2 ? 1.0f / W2_SCALE : 1.0f};
            for (int rep_ = 0; rep_ < NREP(10); ++rep_) pg8::gemm_phase<pg8::EpiDown<FP8_YE != 0>, pg8::TileOrder<2>, true, true, FP8_E2 != 0>(F.lds + RING_OFF, g, S, E);
#if defined(DETPROBE) && (DETPROBE & (1 << 10))
            { pg8::EpiDown<FP8_YE != 0> E2{WSP(void, WS_R1 + 512 * MiB), FP8_E2 ? 1.0f / W2_SCALE : 1.0f}; pg8::gemm_phase<pg8::EpiDown<FP8_YE != 0>, pg8::TileOrder<2>, true, true, FP8_E2 != 0>(F.lds + RING_OFF, g, S, E2); }
            DET_COMPARE(WS_YE, WS_R1 + 512 * MiB, (size_t)NSLOTROWS * DM * 2);
#endif
            SEAM(P0 + 10);
        }
        if (PHON(11) && IN(P0 + 11)) { if (NREP(11) > 1) phase_ln2<true>(A, F, layer); phase_ln2<false>(A, F, layer);
            if (N_LAUNCHES == 1 && layer + 1 < DEPTH) phase_conv<0>(A, F, layer + 1, F.vcu * NWAVES + F.wave, F.G * NWAVES);
            SEAM(P0 + 11); }
    }
#if defined(DETPROBE)
    xcd_barrier(bar);
    if (blockIdx.x == 0 && threadIdx.x == 0 && __hip_atomic_load((unsigned*)(A.ws + WS_CTL) + 8, __ATOMIC_RELAXED, __HIP_MEMORY_SCOPE_AGENT) != 0u) A.out[0] = __builtin_nanf("");
#endif
#undef IN
#undef SEAM
}

extern "C" void kernel_launch(void* const* d_in, const int* in_sizes, int n_in, void* d_out, int out_size, void* d_ws, size_t ws_size, hipStream_t stream) {
    static int grid = 0;
    if (grid == 0) {
        if (n_in != 17 || out_size != NTOK * DM || ws_size < WS_END) { fprintf(stderr, "kernel_launch: built for 17 inputs, %d outputs, >= %zu bytes of workspace; got n_in %d, out %d, ws %zu; nothing launched\n", NTOK * DM, (size_t)WS_END, n_in, out_size, ws_size); grid = -1; return; }
        int dev = 0, cus = 0, per_cu = 0;
        if (hipGetDevice(&dev) != hipSuccess || hipDeviceGetAttribute(&cus, hipDeviceAttributeMultiprocessorCount, dev) != hipSuccess) { fprintf(stderr, "kernel_launch: hipGetDevice / hipDeviceGetAttribute failed\n"); grid = -1; return; }
        if (hipFuncSetAttribute((const void*)trunk_fwd, hipFuncAttributeMaxDynamicSharedMemorySize, LDS_BYTES) != hipSuccess) { fprintf(stderr, "kernel_launch: hipFuncSetAttribute failed\n"); grid = -1; return; }
        if (hipOccupancyMaxActiveBlocksPerMultiprocessor(&per_cu, (const void*)trunk_fwd, NWAVES * 64, LDS_BYTES) != hipSuccess || per_cu < 1)
            fprintf(stderr, "kernel_launch: note: occupancy query reports %d workgroups per CU\n", per_cu);
        (void)hipGetLastError();
        grid = cus;
    }
    if (grid < 0) return;
    if (hipMemsetAsync((char*)d_ws + WS_CTL, 0, CTL_ZERO_BYTES, stream) != hipSuccess) { fprintf(stderr, "kernel_launch: hipMemsetAsync failed\n"); return; }
#ifdef POISON_WS
    (void)hipMemsetAsync((char*)d_ws + 2 * MiB, 0xAA, WS_END - 2 * MiB, stream); (void)hipMemsetAsync(d_out, 0xAA, (size_t)NTOK * DM * 4, stream);
#endif
    Args a{};
    for (int i = 0; i < 17; ++i) a.in[i] = (const float*)d_in[i];
    a.out = (float*)d_out; a.ws = (unsigned char*)d_ws;
    for (int li = 0; li < N_LAUNCHES; ++li) {
        a.ph_lo = (N_LAUNCHES == 1) ? 0 : li; a.ph_hi = (N_LAUNCHES == 1) ? N_PHASES : li + 1;
        hipLaunchKernelGGL(trunk_fwd, dim3(grid), dim3(NWAVES * 64), LDS_BYTES, stream, a);
        const hipError_t le = hipPeekAtLastError();
        if (le != hipSuccess) { fprintf(stderr, "kernel_launch: launch %d failed: %s\n", li, hipGetErrorName(le)); break; }
    }
}
```

```cpp
#include <hip/hip_runtime.h>
#include <hip/hip_bf16.h>
#include <cstdio>
#include <cstdint>
#include <cmath>
#include <type_traits>

#ifndef MK_N_LAUNCHES
#define MK_N_LAUNCHES 1
#endif

namespace pg8 {
#define PG8_LAS __attribute__((address_space(3)))
typedef unsigned short bf16_t;
typedef short bf16x8 __attribute__((ext_vector_type(8)));
typedef float f32x4 __attribute__((ext_vector_type(4)));
typedef unsigned u32x4 __attribute__((ext_vector_type(4)));
constexpr int BM = 256, BK = 64, HALF = 128, HTB = HALF * BK * 2  , STAGE_BYTES = 8 * HTB, NXCD = 8, WGM = 8;

__host__ __device__ __forceinline__ int lds_byte(int r, int c) { const int st = (r >> 4) * 2 + (c >> 5), rr = r & 15, cc = c & 31, ob = rr * 64 + cc * 2; return st * 1024 + (ob ^ (((ob >> 9) & 1) << 5)); }
__host__ __device__ __forceinline__ void stage_rc(int b, int& R, int& C) { const int st = b / 1024, sb = b % 1024, swz = sb ^ (((sb >> 9) & 1) << 5); R = (st >> 1) * 16 + swz / 64; C = (st & 1) * 32 + (swz % 64) / 2; }
__host__ __device__ __forceinline__ int perm32(int rho) { const int n = rho >> 4, i = rho & 15; return 8 * (i >> 2) + 4 * n + (i & 3); }

struct Unit { int pm, pn; };
struct Gemm { const bf16_t* A; const bf16_t* Bt; int M, N, K; };

template <int MODE> struct TileOrder {
    int nM, nN, nwg, G, c;
    __host__ __device__ void init(int nM_, int nN_, int G_, int c_) { nM = nM_; nN = nN_; nwg = nM * nN; G = G_; c = c_; }
    __host__ __device__ bool next(int i, Unit& u) const {
        const long L = (MODE == 3) ? (long)(i >> 1) * G + c : (long)i * G + c; if (L >= nwg) return false;
        int wgid = (int)L; { const int q = nwg / NXCD, r = nwg % NXCD, xcd = wgid % NXCD, off = wgid / NXCD; wgid = (xcd < r ? xcd * (q + 1) : r * (q + 1) + (xcd - r) * q) + off; }
        const int nig = WGM * nN, gid = wgid / nig, fm = gid * WGM, gsz = (nM - fm) < WGM ? (nM - fm) : WGM;
        const int pm = fm + ((wgid % nig) % gsz), pn = (wgid % nig) / gsz;
        int grp = 0;
        if (MODE == 1) grp = pm / 384;
        if (MODE == 2) grp = pm < 256 ? (pm >> 4) : ((pm - 256) >> 5);
        if (MODE == 3) { grp = i & 1; u.pm = grp * nM + pm; u.pn = grp * nN + pn; return true; }
        u.pm = pm; u.pn = grp * nN + pn; return true;
    }
    static constexpr bool GATHER = false; const int* gidx;
    __device__ __forceinline__ void a_ready(const Unit&) const {}
    __device__ __forceinline__ void done(const Unit&) const {}
};
struct TileOrderGather : TileOrder<2> { static constexpr bool GATHER = true; };

typedef float f32x2_c __attribute__((ext_vector_type(2))); typedef __bf16 bf16x2_c __attribute__((ext_vector_type(2)));
__device__ __forceinline__ unsigned cvt_pk_bf16(float lo, float hi) { const f32x2_c v = {lo, hi}; const bf16x2_c b = __builtin_convertvector(v, bf16x2_c); return __builtin_bit_cast(unsigned, b); }
__device__ __forceinline__ u32x4 pack8(const f32x4 a, const f32x4 b) { u32x4 w; w.x = cvt_pk_bf16(a[0], a[1]); w.y = cvt_pk_bf16(a[2], a[3]); w.z = cvt_pk_bf16(b[0], b[1]); w.w = cvt_pk_bf16(b[2], b[3]); return w; }
__device__ __forceinline__ float bfbits2f(unsigned v16) { return __uint_as_float(v16 << 16); }
__device__ __forceinline__ float sigmoid_f(float v) { return __builtin_amdgcn_rcpf(1.0f + __builtin_amdgcn_exp2f(-1.4426950408889634f * v)); }
__device__ __forceinline__ f32x4 exp2_4(const f32x4 v) { return (f32x4){__builtin_amdgcn_exp2f(v[0]), __builtin_amdgcn_exp2f(v[1]), __builtin_amdgcn_exp2f(v[2]), __builtin_amdgcn_exp2f(v[3])}; }
__device__ __forceinline__ f32x4 rcp_4(const f32x4 v) { return (f32x4){__builtin_amdgcn_rcpf(v[0]), __builtin_amdgcn_rcpf(v[1]), __builtin_amdgcn_rcpf(v[2]), __builtin_amdgcn_rcpf(v[3])}; }
__device__ __forceinline__ f32x4 sigmoid_scaled4(const f32x4 a, const float cneg) { return rcp_4(exp2_4(a * cneg) + 1.0f); }

typedef unsigned u32x2 __attribute__((ext_vector_type(2)));
__device__ __forceinline__ unsigned pack4_fp8(float a, float b, float c, float d) { int w = 0; w = __builtin_amdgcn_cvt_pk_fp8_f32(a, b, w, false); w = __builtin_amdgcn_cvt_pk_fp8_f32(c, d, w, true); return (unsigned)w; }

struct EpiProj {
    static constexpr bool PERM = true, AFTER_DRAIN = false;
    bf16_t* NAQKV;
    bf16_t* RAW;
    unsigned char* GATES;
    float qscale, ascale;
    __device__ __forceinline__ void operator()(const f32x4 (&acc)[2][2][4][2], const Unit& u, int wr, int wc, int fr, int fq) const {
        const int pn = u.pn;
        const size_t row0 = (size_t)u.pm * BM + wr * 64 + fr; const int colw = wc * 32 + 8 * fq;
        if (pn < 6) {
            const float sc = (pn < 2 ? qscale : 1.0f) * ascale;
#pragma unroll
            for (int ai = 0; ai < 2; ++ai)
#pragma unroll
                for (int m = 0; m < 4; ++m)
#pragma unroll
                    for (int bj = 0; bj < 2; ++bj)
                        *(u32x4*)(NAQKV + (row0 + ai * HALF + m * 16) * 1536 + pn * BM + bj * HALF + colw) = pack8(acc[ai][bj][m][0] * sc, acc[ai][bj][m][1] * sc);
        } else if (pn < 9) {
#pragma unroll
            for (int ai = 0; ai < 2; ++ai)
#pragma unroll
                for (int m = 0; m < 4; ++m)
#pragma unroll
                    for (int bj = 0; bj < 2; ++bj) *(u32x4*)(RAW + (row0 + ai * HALF + m * 16) * 768 + (pn - 6) * BM + bj * HALF + colw) = pack8(acc[ai][bj][m][0] * ascale, acc[ai][bj][m][1] * ascale);
        } else {
#pragma unroll
            for (int ai = 0; ai < 2; ++ai)
#pragma unroll
                for (int m = 0; m < 4; ++m)
#pragma unroll
                    for (int bj = 0; bj < 2; ++bj) { f32x4 v0 = acc[ai][bj][m][0] * ascale, v1 = acc[ai][bj][m][1] * ascale;
#pragma unroll
                        for (int k = 0; k < 4; ++k) { v0[k] = sigmoid_f(v0[k]); v1[k] = sigmoid_f(v1[k]); }
                        u32x2 w8; w8.x = pack4_fp8(v0[0], v0[1], v0[2], v0[3]); w8.y = pack4_fp8(v1[0], v1[1], v1[2], v1[3]);
                        *(u32x2*)(GATES + (row0 + ai * HALF + m * 16) * 2048 + (pn - 9) * BM + bj * HALF + colw) = w8; }
        }
    }
};
struct EpiBranch {
    static constexpr bool PERM = true, AFTER_DRAIN = false;
    const unsigned char* GATES; bf16_t* Z; unsigned char* Z8; float ascale;
    template <bool G1> __device__ __forceinline__ void body8(const f32x4 (&acc)[2][2][4][2], const size_t row0, const int col0) const {
        typedef float f32x2g __attribute__((ext_vector_type(2)));
#pragma unroll
        for (int ai = 0; ai < 2; ++ai) {
            u32x2 g[4][2], z[4][2];
#pragma unroll
            for (int m = 0; m < 4; ++m)
#pragma unroll
                for (int bj = 0; bj < 2; ++bj) {
                    g[m][bj] = *(const u32x2*)(GATES + (row0 + ai * HALF + m * 16) * 2048 + (G1 ? 1024 : 0) + col0 + bj * HALF);
                    if (G1) z[m][bj] = *(const u32x2*)(Z8 + (row0 + ai * HALF + m * 16) * 1024 + col0 + bj * HALF); }
#pragma unroll
            for (int m = 0; m < 4; ++m)
#pragma unroll
                for (int bj = 0; bj < 2; ++bj) {
                    const u32x2 gw = g[m][bj];
                    const f32x2g a0 = __builtin_amdgcn_cvt_pk_f32_fp8((int)gw.x, false), a1 = __builtin_amdgcn_cvt_pk_f32_fp8((int)gw.x, true), a2 = __builtin_amdgcn_cvt_pk_f32_fp8((int)gw.y, false), a3 = __builtin_amdgcn_cvt_pk_f32_fp8((int)gw.y, true);
                    f32x4 v0 = acc[ai][bj][m][0] * ((f32x4){a0.x, a0.y, a1.x, a1.y} * ascale), v1 = acc[ai][bj][m][1] * ((f32x4){a2.x, a2.y, a3.x, a3.y} * ascale);
                    if (G1) { const u32x2 zw = z[m][bj];
                        const f32x2g b0 = __builtin_amdgcn_cvt_pk_f32_fp8((int)zw.x, false), b1 = __builtin_amdgcn_cvt_pk_f32_fp8((int)zw.x, true), b2 = __builtin_amdgcn_cvt_pk_f32_fp8((int)zw.y, false), b3 = __builtin_amdgcn_cvt_pk_f32_fp8((int)zw.y, true);
                        v0 = v0 + (f32x4){b0.x, b0.y, b1.x, b1.y}; v1 = v1 + (f32x4){b2.x, b2.y, b3.x, b3.y}; }
                    u32x2 w8; w8.x = pack4_fp8(v0[0], v0[1], v0[2], v0[3]); w8.y = pack4_fp8(v1[0], v1[1], v1[2], v1[3]);
                    *(u32x2*)(Z8 + (row0 + ai * HALF + m * 16) * 1024 + col0 + bj * HALF) = w8; }
            __builtin_amdgcn_sched_barrier(0);
        }
    }
    __device__ __forceinline__ void operator()(const f32x4 (&acc)[2][2][4][2], const Unit& u, int wr, int wc, int fr, int fq) const {
        const int grp = u.pm >= 384 ? 1 : 0, pm = u.pm - grp * 384, pn = u.pn & 3;
        if (Z8) { const size_t row0 = (size_t)pm * BM + wr * 64 + fr; const int col0 = pn * BM + wc * 32 + 8 * fq;
            if (grp) body8<true>(acc, row0, col0); else body8<false>(acc, row0, col0);
            return; }
#pragma unroll
        for (int ai = 0; ai < 2; ++ai)
#pragma unroll
            for (int m = 0; m < 4; ++m) {
                const size_t row = (size_t)pm * BM + ai * HALF + wr * 64 + m * 16 + fr;
#pragma unroll
                for (int bj = 0; bj < 2; ++bj) {
                    const int col = pn * BM + bj * HALF + wc * 32 + 8 * fq;
                    const u32x2 g = *(const u32x2*)(GATES + row * 2048 + grp * 1024 + col);
                    f32x4 v0 = acc[ai][bj][m][0], v1 = acc[ai][bj][m][1];
                    { typedef float f32x2g __attribute__((ext_vector_type(2)));
                      const f32x2g a0 = __builtin_amdgcn_cvt_pk_f32_fp8((int)g.x, false), a1 = __builtin_amdgcn_cvt_pk_f32_fp8((int)g.x, true), a2 = __builtin_amdgcn_cvt_pk_f32_fp8((int)g.y, false), a3 = __builtin_amdgcn_cvt_pk_f32_fp8((int)g.y, true);
                      v0[0] *= a0.x; v0[1] *= a0.y; v0[2] *= a1.x; v0[3] *= a1.y; v1[0] *= a2.x; v1[1] *= a2.y; v1[2] *= a3.x; v1[3] *= a3.y; }
                    bf16_t* zp = Z + row * 1024 + col;
                    if (grp) { const u32x4 z = *(const u32x4*)zp;
                        v0[0] += bfbits2f(z.x & 0xffffu); v0[1] += bfbits2f(z.x >> 16); v0[2] += bfbits2f(z.y & 0xffffu); v0[3] += bfbits2f(z.y >> 16);
                        v1[0] += bfbits2f(z.z & 0xffffu); v1[1] += bfbits2f(z.z >> 16); v1[2] += bfbits2f(z.w & 0xffffu); v1[3] += bfbits2f(z.w >> 16); }
                    *(u32x4*)zp = pack8(v0, v1);
                }
            }
    }
};
template <bool MIX8> struct EpiResid {
    static constexpr bool PERM = true, AFTER_DRAIN = false;
    float* X; float alpha, ascale; unsigned char* M8;
    __device__ __forceinline__ void operator()(const f32x4 (&acc)[2][2][4][2], const Unit& u, int wr, int wc, int fr, int fq) const {
#pragma unroll
        for (int ai = 0; ai < 2; ++ai)
#pragma unroll
            for (int m = 0; m < 4; ++m) {
                const size_t row = (size_t)u.pm * BM + ai * HALF + wr * 64 + m * 16 + fr;
#pragma unroll
                for (int bj = 0; bj < 2; ++bj) {
                    const size_t off = row * 1024 + u.pn * BM + bj * HALF + wc * 32 + 8 * fq;
                    if constexpr (MIX8) { const f32x4 m0 = acc[ai][bj][m][0] * ascale, m1 = acc[ai][bj][m][1] * ascale; u32x2 w8; w8.x = pack4_fp8(m0[0], m0[1], m0[2], m0[3]); w8.y = pack4_fp8(m1[0], m1[1], m1[2], m1[3]);
                        *(u32x2*)(M8 + off) = w8; }
                    else { float* p = X + off; const f32x4 x0 = *(const f32x4*)p, x1 = *(const f32x4*)(p + 4);
                        *(f32x4*)p = x0 * alpha + acc[ai][bj][m][0] * ascale; *(f32x4*)(p + 4) = x1 * alpha + acc[ai][bj][m][1] * ascale; }
                }
            }
    }
};
template <bool FP8OUT> struct EpiSwiGLU {
    static constexpr bool PERM = true, AFTER_DRAIN = false;
    void* H; float ascale;
    __device__ __forceinline__ void operator()(const f32x4 (&acc)[2][2][4][2], const Unit& u, int wr, int wc, int fr, int fq) const {
        const int pn = u.pn & 15;
#pragma unroll
        for (int ai = 0; ai < 2; ++ai)
#pragma unroll
            for (int m = 0; m < 4; ++m) {
                const size_t row = (size_t)u.pm * BM + ai * HALF + wr * 64 + m * 16 + fr;
                const float cneg = -1.4426950408889634f * ascale, s2 = ascale * ascale;
                const f32x4 h0 = (acc[ai][0][m][0] * acc[ai][1][m][0]) * (sigmoid_scaled4(acc[ai][0][m][0], cneg) * s2);
                const f32x4 h1 = (acc[ai][0][m][1] * acc[ai][1][m][1]) * (sigmoid_scaled4(acc[ai][0][m][1], cneg) * s2);
                const size_t off = row * 2048 + pn * HALF + wc * 32 + 8 * fq;
                if (FP8OUT) { u32x2 w; w.x = pack4_fp8(h0[0], h0[1], h0[2], h0[3]); w.y = pack4_fp8(h1[0], h1[1], h1[2], h1[3]); *(u32x2*)((unsigned char*)H + off) = w; }
                else *(u32x4*)((bf16_t*)H + off) = pack8(h0, h1);
            }
    }
};
template <bool FP8OUT> struct EpiDown {
    static constexpr bool PERM = true, AFTER_DRAIN = false;
    void* YE; float ascale;
    __device__ __forceinline__ void operator()(const f32x4 (&acc)[2][2][4][2], const Unit& u, int wr, int wc, int fr, int fq) const {
        const int pn = u.pn & 3;
#pragma unroll
        for (int ai = 0; ai < 2; ++ai)
#pragma unroll
            for (int m = 0; m < 4; ++m) {
                const size_t row = (size_t)u.pm * BM + ai * HALF + wr * 64 + m * 16 + fr;
#pragma unroll
                for (int bj = 0; bj < 2; ++bj)
                { const f32x4 v0 = acc[ai][bj][m][0] * ascale, v1 = acc[ai][bj][m][1] * ascale; const size_t off = row * 1024 + pn * BM + bj * HALF + wc * 32 + 8 * fq;
                  if (FP8OUT) { u32x2 w8; w8.x = pack4_fp8(v0[0], v0[1], v0[2], v0[3]); w8.y = pack4_fp8(v1[0], v1[1], v1[2], v1[3]); *(u32x2*)((unsigned char*)YE + off) = w8; }
                  else *(u32x4*)((bf16_t*)YE + off) = pack8(v0, v1); }
            }
    }
};

template <class Epi, class Sched, bool ALIGN_EPI = false, bool SP2 = false, bool FP8 = false>
__device__ __forceinline__ void gemm_phase(PG8_LAS unsigned char* lds, const Gemm g, const Sched& S, const Epi& E) {
    int tid_ = threadIdx.x; asm volatile("" : "+v"(tid_));
    const int tid = tid_, wid = __builtin_amdgcn_readfirstlane(tid >> 6), lane = tid & 63, wr = wid >> 2, wc = wid & 3, fr = lane & 15, fq = lane >> 4;
    const int K = g.K, nt = K / BK;
    unsigned voffA[2], voffB[2]; int gR[2]; unsigned gC[2];
#pragma unroll
    for (int i = 0; i < 2; ++i) { int R, C; stage_rc(tid * 16 + i * 8192, R, C); const int Rb = Epi::PERM ? ((R & ~31) + perm32(R & 31)) : R;
        voffA[i] = (unsigned)(R * K + C) * 2u; voffB[i] = (unsigned)(Rb * K + C) * 2u; gR[i] = R; gC[i] = (unsigned)C * 2u; }
    constexpr bool GATH = Sched::GATHER; static_assert(!GATH || SP2, "the gather variant is written for the SP2 loop");
    unsigned oc[2][2] = {{0u, 0u}, {0u, 0u}}, on[2][2] = {{0u, 0u}, {0u, 0u}};
#define PG8_GOFF(o, unit) do { _Pragma("unroll") for (int _h = 0; _h < 2; ++_h) _Pragma("unroll") for (int _i = 0; _i < 2; ++_i) \
        (o)[_h][_i] = (unsigned)S.gidx[(unit).pm * BM + _h * HALF + gR[_i]] * (unsigned)(K * 2) + gC[_i]; } while (0)
    const size_t kstep = (size_t)(BK * 2);
    const size_t hstep = (size_t)HALF * K * 2;
    const size_t tstep = 2 * hstep;
    const unsigned ldsw = (unsigned)wid * 1024u;
    const int aoff = lds_byte(wr * 64 + fr, fq * 8), boff = lds_byte(wc * 32 + fr, fq * 8);
    typedef int i32x4_t __attribute__((ext_vector_type(4))); typedef int i32x8_t __attribute__((ext_vector_type(8)));
    int sc8 = 0x7F7F7F7F; asm volatile("" : "+v"(sc8));
#define PG8_SA(b, h) (((b) * 2 + (h)) * HTB)
#define PG8_SB(b, h) ((4 + (b) * 2 + (h)) * HTB)
#define PG8_STAGE(bufoff, gbase, voff) do { _Pragma("unroll") for (int _i = 0; _i < 2; ++_i) \
        __builtin_amdgcn_global_load_lds((const unsigned*)((const char*)(gbase) + (voff)[_i]), (PG8_LAS unsigned*)(lds + (bufoff) + ldsw + _i * 8192), 16, 0, 0); } while (0)
#define PG8_LD32(p) __builtin_shufflevector(*(const PG8_LAS i32x4_t*)(p), *(const PG8_LAS i32x4_t*)((p) + 1024), 0, 1, 2, 3, 4, 5, 6, 7)
#define PG8_LDA(dst, b, h) do { if constexpr (FP8) { _Pragma("unroll") for (int m = 0; m < 4; ++m) dst##8[m] = PG8_LD32(lds + PG8_SA(b, h) + aoff + m * 2048); } else { \
        _Pragma("unroll") for (int m = 0; m < 4; ++m) _Pragma("unroll") for (int k = 0; k < 2; ++k) dst[m][k] = *(const PG8_LAS bf16x8*)(lds + PG8_SA(b, h) + aoff + m * 2048 + k * 1024); } } while (0)
#define PG8_LDB(dst, b, h) do { if constexpr (FP8) { _Pragma("unroll") for (int n = 0; n < 2; ++n) dst##8[n] = PG8_LD32(lds + PG8_SB(b, h) + boff + n * 2048); } else { \
        _Pragma("unroll") for (int n = 0; n < 2; ++n) _Pragma("unroll") for (int k = 0; k < 2; ++k) dst[n][k] = *(const PG8_LAS bf16x8*)(lds + PG8_SB(b, h) + boff + n * 2048 + k * 1024); } } while (0)
#define PG8_MMA(ai, bj, At, Bt) do { __builtin_amdgcn_s_setprio(1); if constexpr (FP8) { _Pragma("unroll") for (int m = 0; m < 4; ++m) _Pragma("unroll") for (int n = 0; n < 2; ++n) \
        asm volatile("v_mfma_scale_f32_16x16x128_f8f6f4 %0, %1, %2, %0, %3, %3 op_sel_hi:[0,0,0]" : "+v"(acc[ai][bj][m][n]) : "v"(Bt##8[n]), "v"(At##8[m]), "v"(sc8)); } else { \
        _Pragma("unroll") for (int m = 0; m < 4; ++m) _Pragma("unroll") for (int n = 0; n < 2; ++n) _Pragma("unroll") for (int k = 0; k < 2; ++k) \
        acc[ai][bj][m][n] = __builtin_amdgcn_mfma_f32_16x16x32_bf16(Bt[n][k], At[m][k], acc[ai][bj][m][n], 0, 0, 0); } __builtin_amdgcn_s_setprio(0); } while (0)
#define PG8_WAIT_V(n) asm volatile("s_waitcnt vmcnt(" #n ")" ::: "memory")
#define PG8_WAIT_L(n) asm volatile("s_waitcnt lgkmcnt(" #n ")" ::: "memory")
#define PG8_BAR __builtin_amdgcn_s_barrier()
#define PG8_SCHED __builtin_amdgcn_sched_barrier(0)
    Unit cur, nxt; int ui = 0;
    if (!S.next(0, cur)) return;
    f32x4 acc[2][2][4][2];
#pragma unroll
    for (int a = 0; a < 2; ++a)
#pragma unroll
        for (int b = 0; b < 2; ++b)
#pragma unroll
            for (int m = 0; m < 4; ++m)
#pragma unroll
                for (int n = 0; n < 2; ++n) acc[a][b][m][n] = (f32x4){0.f, 0.f, 0.f, 0.f};
    bf16x8 At[4][2], B0[2][2], B1[2][2]; i32x8_t At8[4], B08[2], B18[2];
    const char* const gA = (const char*)g.A;
    const char* cA = (const char*)g.A + (size_t)cur.pm * tstep; const char* cB = (const char*)g.Bt + (size_t)cur.pn * tstep;
    S.a_ready(cur);
    if constexpr (SP2) {
        if constexpr (GATH) { PG8_GOFF(oc, cur); }
        PG8_STAGE(PG8_SB(0, 0), cB, voffB); PG8_STAGE(PG8_SB(0, 1), cB + hstep, voffB);
        if constexpr (GATH) { PG8_STAGE(PG8_SA(0, 0), gA, oc[0]); PG8_STAGE(PG8_SA(0, 1), gA, oc[1]); } else { PG8_STAGE(PG8_SA(0, 0), cA, voffA); PG8_STAGE(PG8_SA(0, 1), cA + hstep, voffA); }
        if (wr == 1) PG8_BAR;
        PG8_WAIT_V(2); PG8_BAR;
        PG8_STAGE(PG8_SB(1, 0), cB + kstep, voffB); if constexpr (GATH) { PG8_STAGE(PG8_SA(1, 0), gA + kstep, oc[0]); } else { PG8_STAGE(PG8_SA(1, 0), cA + kstep, voffA); } PG8_STAGE(PG8_SB(1, 1), cB + hstep + kstep, voffB);
        PG8_WAIT_V(6); PG8_BAR;
    } else {
        PG8_STAGE(PG8_SB(0, 0), cB, voffB); PG8_STAGE(PG8_SA(0, 0), cA, voffA); PG8_STAGE(PG8_SB(0, 1), cB + hstep, voffB); PG8_STAGE(PG8_SA(0, 1), cA + hstep, voffA);
        if (wr == 1) PG8_BAR;
        PG8_WAIT_V(4); PG8_BAR;
        PG8_STAGE(PG8_SB(1, 0), cB + kstep, voffB); PG8_STAGE(PG8_SA(1, 0), cA + kstep, voffA); PG8_STAGE(PG8_SB(1, 1), cB + hstep + kstep, voffB);
        PG8_WAIT_V(6); PG8_BAR;
    }
    for (;;) {
        const bool has_next = S.next(ui + 1, nxt);
        if constexpr (GATH) { if (has_next) { PG8_GOFF(on, nxt); } else { _Pragma("unroll") for (int _h = 0; _h < 2; ++_h) _Pragma("unroll") for (int _i = 0; _i < 2; ++_i) on[_h][_i] = oc[_h][_i]; } }
        const char* nA = has_next ? (const char*)g.A + (size_t)nxt.pm * tstep : cA; const char* nB = has_next ? (const char*)g.Bt + (size_t)nxt.pn * tstep : cB;
        for (int t = 0; t < nt; t += 2) {
            const bool last = (t == nt - 2);
            const char* a1 = cA + (size_t)(t + 1) * kstep;
            const char* a2 = last ? nA : cA + (size_t)(t + 2) * kstep; const char* b2 = last ? nB : cB + (size_t)(t + 2) * kstep;
            const char* a3 = a2 + kstep; const char* b3 = b2 + kstep;
            if (last && has_next) S.a_ready(nxt);
            const char* ga1 = gA + (size_t)(t + 1) * kstep; const char* ga2 = last ? gA : gA + (size_t)(t + 2) * kstep;
            unsigned os0[2], os1[2];
            if constexpr (GATH) { os0[0] = last ? on[0][0] : oc[0][0]; os0[1] = last ? on[0][1] : oc[0][1]; os1[0] = last ? on[1][0] : oc[1][0]; os1[1] = last ? on[1][1] : oc[1][1]; }
            if constexpr (SP2) {
            PG8_LDB(B0, 0, 0); PG8_LDB(B1, 0, 1); PG8_SCHED; PG8_LDA(At, 0, 0); if constexpr (GATH) { PG8_STAGE(PG8_SA(1, 1), ga1, oc[1]); } else { PG8_STAGE(PG8_SA(1, 1), a1 + hstep, voffA); }
            PG8_WAIT_V(8); PG8_WAIT_L(0); PG8_BAR; PG8_MMA(0, 0, At, B0); PG8_MMA(0, 1, At, B1); PG8_BAR; PG8_SCHED;
            PG8_LDA(At, 0, 1); PG8_STAGE(PG8_SB(0, 0), b2, voffB); PG8_STAGE(PG8_SB(0, 1), b2 + hstep, voffB); if constexpr (GATH) { PG8_STAGE(PG8_SA(0, 0), ga2, os0); } else { PG8_STAGE(PG8_SA(0, 0), a2, voffA); }
            PG8_WAIT_V(8); PG8_WAIT_L(0); PG8_BAR; PG8_MMA(1, 0, At, B0); PG8_MMA(1, 1, At, B1); PG8_BAR; PG8_SCHED;
            PG8_LDB(B0, 1, 0); PG8_LDB(B1, 1, 1); PG8_SCHED; PG8_LDA(At, 1, 0); if constexpr (GATH) { PG8_STAGE(PG8_SA(0, 1), ga2, os1); } else { PG8_STAGE(PG8_SA(0, 1), a2 + hstep, voffA); }
            PG8_WAIT_V(8); PG8_WAIT_L(0); PG8_BAR; PG8_MMA(0, 0, At, B0); PG8_MMA(0, 1, At, B1); PG8_BAR; PG8_SCHED;
            PG8_LDA(At, 1, 1); PG8_STAGE(PG8_SB(1, 0), b3, voffB); PG8_STAGE(PG8_SB(1, 1), b3 + hstep, voffB); if constexpr (GATH) { PG8_STAGE(PG8_SA(1, 0), ga2 + kstep, os0); } else { PG8_STAGE(PG8_SA(1, 0), a3, voffA); }
            PG8_WAIT_V(8); PG8_WAIT_L(0); PG8_BAR; PG8_MMA(1, 0, At, B0); PG8_MMA(1, 1, At, B1); PG8_BAR; PG8_SCHED;
            } else {
            PG8_LDB(B0, 0, 0); PG8_SCHED; PG8_LDA(At, 0, 0); PG8_STAGE(PG8_SA(1, 1), a1 + hstep, voffA);
            PG8_WAIT_L(8); PG8_BAR; PG8_WAIT_L(0); PG8_MMA(0, 0, At, B0); PG8_BAR; PG8_SCHED;
            PG8_LDB(B1, 0, 1); PG8_STAGE(PG8_SB(0, 0), b2, voffB);
            PG8_BAR; PG8_WAIT_L(0); PG8_MMA(0, 1, At, B1); PG8_BAR;
            PG8_LDA(At, 0, 1); PG8_STAGE(PG8_SA(0, 0), a2, voffA);
            PG8_BAR; PG8_WAIT_L(0); PG8_MMA(1, 0, At, B0); PG8_BAR; PG8_SCHED;
            PG8_STAGE(PG8_SB(0, 1), b2 + hstep, voffB);
            PG8_WAIT_V(6); PG8_BAR; PG8_MMA(1, 1, At, B1); PG8_BAR;
            PG8_LDB(B0, 1, 0); PG8_SCHED; PG8_LDA(At, 1, 0); PG8_STAGE(PG8_SA(0, 1), a2 + hstep, voffA);
            PG8_WAIT_L(8); PG8_BAR; PG8_WAIT_L(0); PG8_MMA(0, 0, At, B0); PG8_BAR; PG8_SCHED;
            PG8_LDB(B1, 1, 1); PG8_STAGE(PG8_SB(1, 0), b3, voffB);
            PG8_BAR; PG8_WAIT_L(0); PG8_MMA(0, 1, At, B1); PG8_BAR;
            PG8_LDA(At, 1, 1); PG8_STAGE(PG8_SA(1, 0), a3, voffA);
            PG8_BAR; PG8_WAIT_L(0); PG8_MMA(1, 0, At, B0); PG8_BAR; PG8_SCHED;
            PG8_STAGE(PG8_SB(1, 1), b3 + hstep, voffB);
            PG8_WAIT_V(6); PG8_BAR; PG8_MMA(1, 1, At, B1); PG8_BAR;
            }
        }
        if constexpr (ALIGN_EPI) { if (wr == 0) PG8_BAR; }
        if constexpr (FP8) asm volatile("s_nop 15\n\ts_nop 15" ::: "memory");
        if constexpr (!Epi::AFTER_DRAIN) { E(acc, cur, wr, wc, fr, fq); S.done(cur); }
        if (!has_next) break;
#pragma unroll
        for (int a = 0; a < 2; ++a)
#pragma unroll
            for (int b = 0; b < 2; ++b)
#pragma unroll
                for (int m = 0; m < 4; ++m)
#pragma unroll
                    for (int n = 0; n < 2; ++n) acc[a][b][m][n] = (f32x4){0.f, 0.f, 0.f, 0.f};
        cur = nxt; cA = nA; cB = nB; ++ui;
        if constexpr (GATH) { _Pragma("unroll") for (int _h = 0; _h < 2; ++_h) _Pragma("unroll") for (int _i = 0; _i < 2; ++_i) oc[_h][_i] = on[_h][_i]; }
        if constexpr (ALIGN_EPI) { if (wr == 1) PG8_BAR; }
    }
    PG8_WAIT_V(0);
    if constexpr (!ALIGN_EPI) { if (wr == 0) PG8_BAR; }
    PG8_BAR;
    if constexpr (Epi::AFTER_DRAIN) { E.fused(acc, cur, wr, wc, fr, fq, lds, wid, lane); S.done(cur); }
#undef PG8_SA
#undef PG8_SB
#undef PG8_STAGE
#undef PG8_LDA
#undef PG8_LDB
#undef PG8_MMA
#undef PG8_WAIT_V
#undef PG8_WAIT_L
#undef PG8_BAR
#undef PG8_SCHED
#undef PG8_LD32
#undef PG8_GOFF
}

}

namespace attn_body {

using bf16=__hip_bfloat16;
using bf16x8=__attribute__((ext_vector_type(8)))short;
using s16x4=__attribute__((ext_vector_type(4)))short;
using f32x16=__attribute__((ext_vector_type(16)))float;
using u32x4=__attribute__((ext_vector_type(4)))unsigned;
constexpr int D=64,QP=768,KP=768,VP=768,OP=512;
constexpr int NW=8,QBLK=32,QB=QBLK*NW,KVBLK=64;
constexpr int ATTN_UNIT_ROWS=QB;
__device__ __forceinline__ int crow(int r,int hi){return (r&3)+8*(r>>2)+4*hi;}
#define SBAR() __builtin_amdgcn_sched_barrier(0)
constexpr int NSLOT=3, SLOTB=8192;
constexpr int LDS_K=0, LDS_V=NSLOT*SLOTB, LDS_WS=2*NSLOT*SLOTB, LDS_OST=LDS_WS+NW*64*4, LDS_BYTES=LDS_OST+NW*4096;
constexpr float C2=0.125f*1.4426950408889634f;
__device__ __forceinline__ void glds16(const void*gsrc,unsigned lds_dst){unsigned keep;
  asm volatile("s_mov_b32 %0, m0\n\ts_mov_b32 m0, %2\n\ts_nop 0\n\tglobal_load_lds_dwordx4 %1, off\n\ts_mov_b32 m0, %0":"=&s"(keep):"v"(gsrc),"s"(lds_dst):"memory");}
__device__ __forceinline__ float max3f(float a,float b,float c){float r;asm("v_max3_f32 %0, %1, %2, %3":"=v"(r):"v"(a),"v"(b),"v"(c));return r;}
__device__ __forceinline__ float max2f(float a,float b){float r;asm("v_max_f32_e32 %0, %1, %2":"=v"(r):"v"(a),"v"(b));return r;}
__device__ __forceinline__ float fadd_s(float a,float b){float r;asm("v_add_f32_e32 %0, %1, %2":"=v"(r):"v"(a),"v"(b));return r;}
__device__ __forceinline__ float fsub_s(float a,float b){float r;asm("v_sub_f32_e32 %0, %1, %2":"=v"(r):"v"(a),"v"(b));return r;}
typedef float f32x2_t __attribute__((ext_vector_type(2))); typedef __bf16 bf16x2_t __attribute__((ext_vector_type(2)));
__device__ __forceinline__ unsigned cvtpk_s(float lo,float hi){f32x2_t v={lo,hi};bf16x2_t b=__builtin_convertvector(v,bf16x2_t);return __builtin_bit_cast(unsigned,b);}
#define WAIT_BAR(N) asm volatile("s_waitcnt vmcnt(" #N ") lgkmcnt(0)\n\ts_barrier":::"memory")

__device__ __forceinline__ void qkt(f32x16&p0,f32x16&p1,const char*Kslot,const bf16x8*qr,const f32x16&negm,int r32,int hi){
  const char*kb=Kslot+hi*1024+r32*16;
  #pragma unroll
  for(int d0=0;d0<4;++d0){
    const bf16x8 b0=*reinterpret_cast<const bf16x8*>(kb+d0*2048);
    const bf16x8 b1=*reinterpret_cast<const bf16x8*>(kb+d0*2048+512);
    if(d0==0){p0=__builtin_amdgcn_mfma_f32_32x32x16_bf16(b0,qr[0],negm,0,0,0);p1=__builtin_amdgcn_mfma_f32_32x32x16_bf16(b1,qr[0],negm,0,0,0);}
    else{p0=__builtin_amdgcn_mfma_f32_32x32x16_bf16(b0,qr[d0],p0,0,0,0);p1=__builtin_amdgcn_mfma_f32_32x32x16_bf16(b1,qr[d0],p1,0,0,0);}}
}
typedef __attribute__((address_space(3))) const char* lds_cptr;
typedef short v4i16_t __attribute__((ext_vector_type(4)));
__device__ __forceinline__ void kload8(bf16x8*kf,lds_cptr kp){
  kf[0]=*(const __attribute__((address_space(3))) bf16x8*)(kp);      kf[1]=*(const __attribute__((address_space(3))) bf16x8*)(kp+512);
  kf[2]=*(const __attribute__((address_space(3))) bf16x8*)(kp+2048); kf[3]=*(const __attribute__((address_space(3))) bf16x8*)(kp+2560);
  kf[4]=*(const __attribute__((address_space(3))) bf16x8*)(kp+4096); kf[5]=*(const __attribute__((address_space(3))) bf16x8*)(kp+4608);
  kf[6]=*(const __attribute__((address_space(3))) bf16x8*)(kp+6144); kf[7]=*(const __attribute__((address_space(3))) bf16x8*)(kp+6656);
}
__device__ __forceinline__ void kload2(bf16x8*kf,lds_cptr kp,int j){ kf[2*j]=*(const __attribute__((address_space(3))) bf16x8*)(kp+j*2048); kf[2*j+1]=*(const __attribute__((address_space(3))) bf16x8*)(kp+j*2048+512); }
__device__ __forceinline__ s16x4 vtr(lds_cptr p){ return __builtin_bit_cast(s16x4,__builtin_amdgcn_ds_read_tr16_b64_v4i16((__attribute__((address_space(3))) v4i16_t*)p)); }
__device__ __forceinline__ float rowmax(const f32x16&p0,const f32x16&p1){
  float a=max3f(p0[0],p0[1],p1[0]),b=max3f(p0[2],p0[3],p1[1]);a=max3f(a,p1[2],p1[3]);
  #pragma unroll
  for(int r=4;r<16;r+=4){a=max3f(a,p0[r],p0[r+1]);b=max3f(b,p0[r+2],p0[r+3]);a=max3f(a,p1[r],p1[r+1]);b=max3f(b,p1[r+2],p1[r+3]);}
  const float m=max2f(a,b);
  auto rr=__builtin_amdgcn_permlane32_swap(__float_as_uint(m),__float_as_uint(m),false,false);
  return max2f(__uint_as_float(rr[0]),__uint_as_float(rr[1]));
}
__device__ __forceinline__ void pv(f32x16*o,int vb,bf16x8 pa0,bf16x8 pa1,bf16x8 pa2,bf16x8 pa3){
  #pragma unroll
  for(int d0=0;d0<2;++d0){s16x4 lo[4],hi[4];
    #pragma unroll
    for(int ks=0;ks<4;++ks){
      asm volatile("ds_read_b64_tr_b16 %0,%1 offset:%c2":"=&v"(lo[ks]):"v"(vb),"i"(d0*4096+ks*1024):"memory");
      asm volatile("ds_read_b64_tr_b16 %0,%1 offset:%c2":"=&v"(hi[ks]):"v"(vb),"i"(d0*4096+ks*1024+512):"memory");}
    asm volatile("s_waitcnt lgkmcnt(0)":::"memory");SBAR();
    #define PK(k) (bf16x8){lo[k][0],lo[k][1],lo[k][2],lo[k][3],hi[k][0],hi[k][1],hi[k][2],hi[k][3]}
    o[d0]=__builtin_amdgcn_mfma_f32_32x32x16_bf16(pa0,PK(0),o[d0],0,0,0);
    o[d0]=__builtin_amdgcn_mfma_f32_32x32x16_bf16(pa1,PK(1),o[d0],0,0,0);
    o[d0]=__builtin_amdgcn_mfma_f32_32x32x16_bf16(pa2,PK(2),o[d0],0,0,0);
    o[d0]=__builtin_amdgcn_mfma_f32_32x32x16_bf16(pa3,PK(3),o[d0],0,0,0);
    #undef PK
  }
}

#ifndef ATTN_STORE16
#define ATTN_STORE16(p,v) (*(u32x4*)(p)=(v))
#endif
constexpr float O8SCALE=32.f;
typedef int i32x8q __attribute__((ext_vector_type(8))); typedef int i32x4q __attribute__((ext_vector_type(4)));
#define MFMA8(a,b,c) __builtin_amdgcn_mfma_scale_f32_32x32x64_f8f6f4((a),(b),(c),0,0,0,0x7F7F7F7F,0,0x7F7F7F7F)
template<int THRL,bool NOMAX=false,bool O8=false,bool QK8=false> __device__ __forceinline__ void attn_unit(long qrow0,long kvrow0,int NT,const bf16*Qh,const bf16*__restrict__ Kh,const bf16*__restrict__ Vh,bf16*Oh,char*shm){
  int tid_=threadIdx.x; asm volatile("":"+v"(tid_)); const int tid=tid_,lane=tid&63,r32=lane&31,hi=lane>>5; const int wid=__builtin_amdgcn_readfirstlane(tid>>6);
  const bf16*Qw=Qh+(qrow0+wid*QBLK)*QP; constexpr int RB8=896, VPe=QK8?448:VP;
  const unsigned lds0=(unsigned)(uintptr_t)shm;
  float*wsf=(float*)(shm+LDS_WS)+wid*64;
  const char*ksrc=QK8?(const char*)Kh+(kvrow0+lane)*RB8+(wid&3)*16:(const char*)(Kh+(kvrow0+lane)*KP+wid*8);
  const long kstep=QK8?(long)KVBLK*RB8:(long)KVBLK*KP*2;
  const bf16*vsrc=Vh+(kvrow0+16*(wid&3)+(lane>>2))*VPe+(wid>>2)*32+(lane&3)*8;
  const unsigned kdst=lds0+LDS_K+(QK8?(wid&3):wid)*1024, vdst=lds0+LDS_V+wid*1024;
  #define DMA_K(t,slot) glds16(ksrc+(long)(t)*kstep,(unsigned)__builtin_amdgcn_readfirstlane(kdst+(slot)))
  #define DMA_V(t,slot) glds16(vsrc+(long)(t)*KVBLK*VPe,(unsigned)__builtin_amdgcn_readfirstlane(vdst+(slot)))
  const int vb0=(int)(lds0+LDS_V)+((lane>>4)&1)*32+(lane&3)*8+(4*hi+((lane&15)>>2))*64;
  const char*Kbase=shm+LDS_K; bf16x8 kf[8]; i32x8q kf8[2]; i32x8q qr8;
  const lds_cptr shm3=(lds_cptr)shm; const lds_cptr kp0=shm3+LDS_K+hi*(QK8?2048:1024)+r32*16;     const lds_cptr vp0=shm3+LDS_V+((lane>>4)&1)*32+(lane&3)*8+(4*hi+((lane&15)>>2))*64;
  DMA_K(0,0);DMA_V(0,0);DMA_K(1,SLOTB);
  bf16x8 qr[4];
  #pragma unroll
  for(int d0=0;d0<4;++d0)if constexpr(!QK8)qr[d0]=*reinterpret_cast<const bf16x8*>(&Qw[(long)r32*QP+d0*16+hi*8]);
  if constexpr(QK8){ const char*q8=(const char*)Qh+(qrow0+wid*QBLK+r32)*RB8+32*hi; const i32x4q a_=*reinterpret_cast<const i32x4q*>(q8), b_=*reinterpret_cast<const i32x4q*>(q8+16); qr8=__builtin_shufflevector(a_,b_,0,1,2,3,4,5,6,7); }
  float mhat=0.f,l_reg=0.f;f32x16 o[2];o[0]=f32x16{};o[1]=f32x16{};
  typedef float f32x4_t __attribute__((ext_vector_type(4)));
  f32x4_t lsum={0.f,0.f,0.f,0.f}; bf16x8 bones; { const short one_=((((lane>>4)&1)!=0)==((lane&15)>=8))?(short)0x3F80:(short)0; bones=(bf16x8){one_,one_,one_,one_,one_,one_,one_,one_}; }
  #define LSUM(k) do{ lsum=__builtin_amdgcn_mfma_f32_16x16x32_bf16(PAF(k),bones,lsum,0,0,0); }while(0)
f32x16 negm=f32x16{};if constexpr(!NOMAX)asm volatile("":"+v"(negm));
  #define CMASK(P0,P1,t) do{}while(0)
  bool resc=false;
  #define KLD8(blk,kp_) do{ const i32x4q a_=*(const __attribute__((address_space(3))) i32x4q*)((kp_)+(blk)*512), b_=*(const __attribute__((address_space(3))) i32x4q*)((kp_)+(blk)*512+1024); kf8[blk]=__builtin_shufflevector(a_,b_,0,1,2,3,4,5,6,7); }while(0)
  #define START(P0,P1) do{ if constexpr(!NOMAX){ const float rm=rowmax(P0,P1); resc=false; \
    { const float dl=rm; mhat=fadd_s(mhat,dl); \
      _Pragma("unroll") for(int r=0;r<16;++r){P0[r]=fsub_s(P0[r],dl);P1[r]=fsub_s(P1[r],dl);} \
      _Pragma("unroll") for(int r=0;r<16;++r)negm[r]=-mhat; asm volatile("":"+v"(negm)); } } \
    _Pragma("unroll") for(int r=0;r<16;++r)P0[r]=__builtin_amdgcn_exp2f(P0[r]); }while(0)
  #define RESC() do{ if constexpr(!NOMAX) if(resc){ asm volatile("s_waitcnt lgkmcnt(0)":::"memory"); \
      _Pragma("unroll") for(int d_=0;d_<2;++d_) _Pragma("unroll") for(int r=0;r<16;++r)o[d_][r]*=wsf[crow(r,hi)]; } }while(0)
  f32x16 pA0,pA1,pB0,pB1;
  int sl_prev=0,sl_cur=0,sl_next=SLOTB;
  #define ROT() do{sl_prev=sl_cur;sl_cur=sl_next;sl_next=(sl_next==(NSLOT-1)*SLOTB)?0:sl_next+SLOTB;}while(0)
  DMA_K(2,2*SLOTB);
  WAIT_BAR(3);
  if constexpr(QK8){ KLD8(0,kp0); KLD8(1,kp0); pA0=MFMA8(kf8[0],qr8,negm); pA1=MFMA8(kf8[1],qr8,negm); } else qkt(pA0,pA1,Kbase,qr,negm,r32,hi);
  asm volatile("s_nop 15\n\ts_nop 7":"+v"(pA0),"+v"(pA1));CMASK(pA0,pA1,0);
  START(pA0,pA1);
  if constexpr(!NOMAX){ _Pragma("unroll") for(int r=0;r<16;++r)pA1[r]=__builtin_amdgcn_exp2f(pA1[r]); }
  WAIT_BAR(0);
  DMA_K(3,0);DMA_V(1,SLOTB);
  ROT();
  if constexpr(QK8){ KLD8(0,kp0+sl_cur); KLD8(1,kp0+sl_cur); } else kload8(kf,kp0+sl_cur);
  WAIT_BAR(2);
  s16x4 vlo[8],vhi[8]; u32x4 pw0,pw1,pw2,pw3;
  #define PKW(P,B) cvtpk_s(P[B],P[B+1])
  #define PAF(k) __builtin_bit_cast(bf16x8,pw##k)
  #define VFR(i) (bf16x8){vlo[i][0],vlo[i][1],vlo[i][2],vlo[i][3],vhi[i][0],vhi[i][1],vhi[i][2],vhi[i][3]}
  #define PIN(x) asm volatile("":"+v"(x))
  #define MX3(a,b,c) __builtin_fmaxf(__builtin_fmaxf((a),(b)),(c))
  #define GAPA(MF,A0,A1,A2,A3,W0,W1,PW) do{ MF; sacc+=A0; sacc+=A1; sacc+=A2; sacc+=A3; PIN(sacc); W0; W1; PIN(PW); SBAR(); }while(0)
  #define EX(v) __builtin_amdgcn_exp2f(v)
  #define QKM(E8,E16) do{ if constexpr(QK8){ E8; } else { E16; } }while(0)
  #define GAPB(MF,X,B) do{ MF; X[B]=EX(X[B]); X[B+1]=EX(X[B+1]); X[B+2]=EX(X[B+2]); X[B+3]=EX(X[B+3]); PIN(X); SBAR(); }while(0)
  #define VRD(i) do{ vlo[i]=vtr(vp_+(((i)>>2)*4096+((i)&3)*1024)); vhi[i]=vtr(vp_+(((i)>>2)*4096+((i)&3)*1024+512)); }while(0)
  #define KRD(G,j) do{ if(G){ if constexpr(QK8){ if((j)<2){ KLD8((j),kp0+sl_next); SBAR(); } } else { kload2(kf,kp0+sl_next,j); SBAR(); } } }while(0)
  #define STEP(C0,C1,P0,P1,t,GK,GV,GL) do{ SBAR(); \
    const lds_cptr vp_=vp0+sl_prev; \
    VRD(0); SBAR(); float sacc=(P0[0]+P0[1]); \
    GAPA(QKM(C0=MFMA8(kf8[0],qr8,negm), C0=__builtin_amdgcn_mfma_f32_32x32x16_bf16(kf[0],qr[0],negm,0,0,0)), P0[2],P0[3],P0[4],P0[5],     pw0[0]=PKW(P0,0), pw0[1]=PKW(P0,2), pw0); \
    VRD(4); SBAR(); GAPA(QKM((void)0, C1=__builtin_amdgcn_mfma_f32_32x32x16_bf16(kf[1],qr[0],negm,0,0,0)), P0[6],P0[7],P0[8],P0[9],     pw0[2]=PKW(P0,4), pw0[3]=PKW(P0,6), pw0); \
    VRD(1); SBAR(); GAPA(QKM((void)0, C0=__builtin_amdgcn_mfma_f32_32x32x16_bf16(kf[2],qr[1],C0,0,0,0)),   P0[10],P0[11],P0[12],P0[13], pw1[0]=PKW(P0,8), pw1[1]=PKW(P0,10), pw1); \
    VRD(5); SBAR(); GAPA(QKM((void)0, C1=__builtin_amdgcn_mfma_f32_32x32x16_bf16(kf[3],qr[1],C1,0,0,0)),   P0[14],P0[15],P1[0],P1[1],   pw1[2]=PKW(P0,12),pw1[3]=PKW(P0,14), pw1); \
    VRD(2); SBAR(); GAPA(QKM(C1=MFMA8(kf8[1],qr8,negm), C0=__builtin_amdgcn_mfma_f32_32x32x16_bf16(kf[4],qr[2],C0,0,0,0)),   P1[2],P1[3],P1[4],P1[5],     pw2[0]=PKW(P1,0), pw2[1]=PKW(P1,2), pw2); \
    VRD(6); SBAR(); GAPA(QKM((void)0, C1=__builtin_amdgcn_mfma_f32_32x32x16_bf16(kf[5],qr[2],C1,0,0,0)),   P1[6],P1[7],P1[8],P1[9],     pw2[2]=PKW(P1,4), pw2[3]=PKW(P1,6), pw2); \
    VRD(3); SBAR(); GAPA(QKM((void)0, C0=__builtin_amdgcn_mfma_f32_32x32x16_bf16(kf[6],qr[3],C0,0,0,0)),   P1[10],P1[11],P1[12],P1[13], pw3[0]=PKW(P1,8), pw3[1]=PKW(P1,10), pw3); \
    VRD(7); SBAR(); GAPA(QKM((void)0, C1=__builtin_amdgcn_mfma_f32_32x32x16_bf16(kf[7],qr[3],C1,0,0,0)),   P1[14],P1[15],0.f,0.f,       pw3[2]=PKW(P1,12),pw3[3]=PKW(P1,14), pw3); \
    l_reg+=sacc; \
    if(GK){DMA_K((t)+3,sl_cur);} if(GV){DMA_V((t)+1,sl_next);} \
    CMASK(C0,C1,t); \
    if constexpr(!NOMAX){ float a=MX3(C0[0],C0[1],C1[0]),b=MX3(C0[2],C0[3],C1[1]); a=MX3(a,C1[2],C1[3]); \
      _Pragma("unroll") for(int r=4;r<16;r+=4){a=MX3(a,C0[r],C0[r+1]);b=MX3(b,C0[r+2],C0[r+3]);a=MX3(a,C1[r],C1[r+1]);b=MX3(b,C1[r+2],C1[r+3]);} \
      float rm=__builtin_fmaxf(a,b); { auto rr=__builtin_amdgcn_permlane32_swap(__float_as_uint(rm),__float_as_uint(rm),false,false); rm=__builtin_fmaxf(__uint_as_float(rr[0]),__uint_as_float(rr[1])); } \
      resc=false; \
      if(__builtin_expect(__any(rm>(float)THRL),0)){ const float dl=__builtin_fmaxf(rm,0.f); mhat+=dl; \
        _Pragma("unroll") for(int r=0;r<16;++r){C0[r]-=dl;C1[r]-=dl;} \
        _Pragma("unroll") for(int r=0;r<16;++r)negm[r]=-mhat; asm volatile("":"+v"(negm)); \
        const float f=__builtin_amdgcn_exp2f(-dl); l_reg*=f; if(hi==0)wsf[r32]=f; resc=true; } } \
    SBAR(); \
    GAPB(o[0]=__builtin_amdgcn_mfma_f32_32x32x16_bf16(PAF(0),VFR(0),o[0],0,0,0), C0,0); \
    GAPB(o[1]=__builtin_amdgcn_mfma_f32_32x32x16_bf16(PAF(0),VFR(4),o[1],0,0,0), C0,4); \
    KRD(GL,0); GAPB(o[0]=__builtin_amdgcn_mfma_f32_32x32x16_bf16(PAF(1),VFR(1),o[0],0,0,0), C0,8); \
    KRD(GL,1); GAPB(o[1]=__builtin_amdgcn_mfma_f32_32x32x16_bf16(PAF(1),VFR(5),o[1],0,0,0), C0,12); \
    KRD(GL,2); GAPB(o[0]=__builtin_amdgcn_mfma_f32_32x32x16_bf16(PAF(2),VFR(2),o[0],0,0,0), C1,0); \
    KRD(GL,3); GAPB(o[1]=__builtin_amdgcn_mfma_f32_32x32x16_bf16(PAF(2),VFR(6),o[1],0,0,0), C1,4); \
    GAPB(o[0]=__builtin_amdgcn_mfma_f32_32x32x16_bf16(PAF(3),VFR(3),o[0],0,0,0), C1,8); \
    GAPB(o[1]=__builtin_amdgcn_mfma_f32_32x32x16_bf16(PAF(3),VFR(7),o[1],0,0,0), C1,12); \
    }while(0)
  #define EX2(P,B) P[B]=EX(P[B]); P[(B)+1]=EX(P[(B)+1]);
  #define GAPX(MF,EXS,W0,W1,PW,PP) do{ MF; EXS PIN(PP); W0; W1; PIN(PW); SBAR(); }while(0)
  #define GAPY(MF,X,B) do{ MF; X[B]=EX(X[B]); X[(B)+1]=EX(X[(B)+1]); PIN(X); SBAR(); }while(0)
  #define STEPX(C0,C1,P0,P1,t,GK,GV,GL) do{ SBAR(); \
    const lds_cptr vp_=vp0+sl_prev; \
    VRD(0); SBAR(); \
    GAPX(QKM(C0=MFMA8(kf8[0],qr8,negm), C0=__builtin_amdgcn_mfma_f32_32x32x16_bf16(kf[0],qr[0],negm,0,0,0)), EX2(P1,0),             pw0[0]=PKW(P0,0), pw0[1]=PKW(P0,2), pw0, P1); \
    VRD(4); SBAR(); GAPX(QKM((void)0, C1=__builtin_amdgcn_mfma_f32_32x32x16_bf16(kf[1],qr[0],negm,0,0,0)), EX2(P1,2),  pw0[2]=PKW(P0,4), pw0[3]=PKW(P0,6), pw0, P1); \
    VRD(1); SBAR(); GAPX(QKM((void)0, C0=__builtin_amdgcn_mfma_f32_32x32x16_bf16(kf[2],qr[1],C0,0,0,0)),   EX2(P1,4),  pw1[0]=PKW(P0,8), pw1[1]=PKW(P0,10), pw1, P1); \
    VRD(5); SBAR(); GAPX(QKM((void)0, C1=__builtin_amdgcn_mfma_f32_32x32x16_bf16(kf[3],qr[1],C1,0,0,0)),   EX2(P1,6),  pw1[2]=PKW(P0,12),pw1[3]=PKW(P0,14), pw1, P1); \
    VRD(2); SBAR(); GAPX(QKM(C1=MFMA8(kf8[1],qr8,negm), C0=__builtin_amdgcn_mfma_f32_32x32x16_bf16(kf[4],qr[2],C0,0,0,0)),   EX2(P1,8) EX2(P1,10),  pw2[0]=PKW(P1,0), pw2[1]=PKW(P1,2), pw2, P1); \
    VRD(6); SBAR(); GAPX(QKM((void)0, C1=__builtin_amdgcn_mfma_f32_32x32x16_bf16(kf[5],qr[2],C1,0,0,0)),   EX2(P1,12) EX2(P1,14), pw2[2]=PKW(P1,4), pw2[3]=PKW(P1,6), pw2, P1); \
    VRD(3); SBAR(); GAPX(QKM((void)0, C0=__builtin_amdgcn_mfma_f32_32x32x16_bf16(kf[6],qr[3],C0,0,0,0)),   ,           pw3[0]=PKW(P1,8), pw3[1]=PKW(P1,10), pw3, P1); \
    VRD(7); SBAR(); GAPX(QKM((void)0, C1=__builtin_amdgcn_mfma_f32_32x32x16_bf16(kf[7],qr[3],C1,0,0,0)),   ,           pw3[2]=PKW(P1,12),pw3[3]=PKW(P1,14), pw3, P1); \
    if(GK){DMA_K((t)+3,sl_cur);} if(GV){DMA_V((t)+1,sl_next);} \
    SBAR(); \
    LSUM(0); GAPY(o[0]=__builtin_amdgcn_mfma_f32_32x32x16_bf16(PAF(0),VFR(0),o[0],0,0,0), C0,0); \
    GAPY(o[1]=__builtin_amdgcn_mfma_f32_32x32x16_bf16(PAF(0),VFR(4),o[1],0,0,0), C0,2); \
    KRD(GL,0); LSUM(1); GAPY(o[0]=__builtin_amdgcn_mfma_f32_32x32x16_bf16(PAF(1),VFR(1),o[0],0,0,0), C0,4); \
    KRD(GL,1); GAPY(o[1]=__builtin_amdgcn_mfma_f32_32x32x16_bf16(PAF(1),VFR(5),o[1],0,0,0), C0,6); \
    KRD(GL,2); LSUM(2); GAPY(o[0]=__builtin_amdgcn_mfma_f32_32x32x16_bf16(PAF(2),VFR(2),o[0],0,0,0), C0,8); \
    KRD(GL,3); GAPY(o[1]=__builtin_amdgcn_mfma_f32_32x32x16_bf16(PAF(2),VFR(6),o[1],0,0,0), C0,10); \
    LSUM(3); GAPY(o[0]=__builtin_amdgcn_mfma_f32_32x32x16_bf16(PAF(3),VFR(3),o[0],0,0,0), C0,12); \
    GAPY(o[1]=__builtin_amdgcn_mfma_f32_32x32x16_bf16(PAF(3),VFR(7),o[1],0,0,0), C0,14); \
    }while(0)
  #define STEPS(C0,C1,P0,P1,t,GK,GV,GL) do{ if constexpr(NOMAX) STEPX(C0,C1,P0,P1,t,GK,GV,GL); else STEP(C0,C1,P0,P1,t,GK,GV,GL); }while(0)
  int t=1;
  #undef CMASK
  #define CMASK(P0,P1,t) do{}while(0)
  for(;t+5<NT;t+=2){
    STEPS(pB0,pB1,pA0,pA1,t,true,true,true);     WAIT_BAR(2); RESC(); ROT();
    STEPS(pA0,pA1,pB0,pB1,t+1,true,true,true);   WAIT_BAR(2); RESC(); ROT();
  }
  #undef CMASK
  #define CMASK(P0,P1,t) do{}while(0)
  #define ENDW(tt) do{ if((tt)+3<NT){WAIT_BAR(2);} else if((tt)+2<NT){WAIT_BAR(1);} else {WAIT_BAR(0);} }while(0)
  for(;t+1<NT;t+=2){
    STEPS(pB0,pB1,pA0,pA1,t,(t+3<NT),(t+1<NT),(t+1<NT));       ENDW(t);   RESC(); ROT();
    STEPS(pA0,pA1,pB0,pB1,t+1,(t+4<NT),(t+2<NT),(t+2<NT));     ENDW(t+1); RESC(); ROT();
  }
  STEPS(pB0,pB1,pA0,pA1,NT-1,false,false,false); RESC();
  { if constexpr(NOMAX){ _Pragma("unroll") for(int r=0;r<16;++r)pB1[r]=__builtin_amdgcn_exp2f(pB1[r]); }
    else { float sacc=pB0[0]+pB0[1]; _Pragma("unroll") for(int r=2;r<16;++r)sacc+=pB0[r]; _Pragma("unroll") for(int r=0;r<16;++r)sacc+=pB1[r]; l_reg+=sacc; }
    pw0=(u32x4){PKW(pB0,0),PKW(pB0,2),PKW(pB0,4),PKW(pB0,6)};pw1=(u32x4){PKW(pB0,8),PKW(pB0,10),PKW(pB0,12),PKW(pB0,14)};pw2=(u32x4){PKW(pB1,0),PKW(pB1,2),PKW(pB1,4),PKW(pB1,6)};pw3=(u32x4){PKW(pB1,8),PKW(pB1,10),PKW(pB1,12),PKW(pB1,14)};
    SBAR(); if constexpr(NOMAX){ LSUM(0); LSUM(1); LSUM(2); LSUM(3); } pv(o,vb0+sl_cur,PAF(0),PAF(1),PAF(2),PAF(3)); }
  #undef LSUM
  #undef QKM
  #undef KLD8
  #undef EX2
  #undef GAPX
  #undef GAPY
  #undef STEPX
  #undef STEPS
  #undef PKW
  #undef PAF
  #undef VFR
  #undef PIN
  #undef MX3
  #undef GAPA
  #undef GAPB
  #undef EX
  #undef VRD
  #undef KRD
  #undef STEP
  #undef ENDW
  if constexpr(NOMAX){ asm volatile("s_nop 7":"+v"(lsum));
    if((lane&7)==0){ const int qb_=4*(lane>>4)+16*((lane>>3)&1); wsf[32+qb_]=lsum[0]; wsf[33+qb_]=lsum[1]; wsf[34+qb_]=lsum[2]; wsf[35+qb_]=lsum[3]; }
  } else {
  {auto rr=__builtin_amdgcn_permlane32_swap(__float_as_uint(l_reg),__float_as_uint(l_reg),false,false);l_reg=__uint_as_float(rr[0])+__uint_as_float(rr[1]);}
  if(hi==0)wsf[32+r32]=l_reg; }
  asm volatile("s_waitcnt lgkmcnt(0)":::"memory");
  float rli[16];
  #pragma unroll
  for(int r=0;r<16;++r)rli[r]=__builtin_amdgcn_rcpf(wsf[32+crow(r,hi)]);
  if constexpr(O8){ unsigned char*Ow8=(unsigned char*)Oh+(qrow0+wid*QBLK)*OP; unsigned char*stg8=(unsigned char*)(shm+LDS_OST)+wid*2048;
    #pragma unroll
    for(int r=0;r<16;++r){const int orow=crow(r,hi); const float sc=rli[r]*O8SCALE;
      #pragma unroll
      for(int d0=0;d0<2;++d0)stg8[orow*64+d0*32+r32]=(unsigned char)(__builtin_amdgcn_cvt_pk_fp8_f32(o[d0][r]*sc,o[d0][r]*sc,0,false)&0xff);}
    asm volatile("s_waitcnt lgkmcnt(0)":::"memory");
    #pragma unroll
    for(int i=0;i<2;++i){const int row=i*16+(lane>>2),ch=lane&3; const u32x4 v=*(const u32x4*)(stg8+row*64+ch*16); ATTN_STORE16(Ow8+(long)row*OP+ch*16,v);}
  } else {
  bf16*Ow=Oh+(qrow0+wid*QBLK)*OP;
  { bf16*stg=(bf16*)(shm+LDS_OST)+wid*2048;
    #pragma unroll
    for(int r=0;r<16;++r){const int orow=crow(r,hi);
      #pragma unroll
      for(int d0=0;d0<2;++d0)stg[orow*64+d0*32+r32]=__float2bfloat16(o[d0][r]*rli[r]);}
    asm volatile("s_waitcnt lgkmcnt(0)":::"memory");
    #pragma unroll
    for(int i=0;i<4;++i){const int row=i*8+(lane>>3),ch=lane&7; const u32x4 v=*(const u32x4*)(stg+row*64+ch*8); ATTN_STORE16(Ow+(long)row*OP+ch*8,v);} }
  }
  asm volatile("s_waitcnt lgkmcnt(0)\n\ts_barrier":::"memory");
  #undef DMA_K
  #undef DMA_V
  #undef CMASK
  #undef START
  #undef RESC
  #undef ROT
}
constexpr int ATTN_LDS_BYTES=LDS_BYTES;
#undef SBAR
#undef WAIT_BAR
}

#ifndef DUP_MASK
#define DUP_MASK 0
#endif
#ifndef ROPE_DRY_FIRST
#define ROPE_DRY_FIRST 0
#endif
#define NREP(p) (1 + (((DUP_MASK) >> (p)) & 1))
#ifndef FP8_E1
#define FP8_E1 1
#endif
#ifndef FP8_E2
#define FP8_E2 1
#endif
#ifndef FP8_G1
#define FP8_G1 1
#endif
#ifndef FP8_OUT
#define FP8_OUT 1
#endif
#ifndef FP8_MIX
#define FP8_MIX 1
#endif
#ifndef FP8_YE
#define FP8_YE 1
#endif
#ifndef FP8_NAQK
#define FP8_NAQK 1
#endif
#ifndef FP8_QK
#define FP8_QK 1
#endif
#ifndef FP8_BR
#define FP8_BR 1
#endif
constexpr float WIN_SCALE = 64.f, WOUT_SCALE = 64.f, ATT_SCALE = 32.f, WBR_SCALE = 16.f;
static_assert(!FP8_G1 || FP8_E1, "the e4m3 activation buffer sits in the upper half of the bf16 XB region: with FP8_G1 the bf16 x1 must not be written (needs FP8_E1)");
constexpr float W1_SCALE = 64.f, W2_SCALE = 128.f;
constexpr int NWAVES = 8;
constexpr int N_LAUNCHES = MK_N_LAUNCHES;
constexpr int DM = 1024, DEPTH = 4, NP = 32768, NS = 65536, NTOK = NP + NS;
constexpr int SEQ_P = 4096, SEQ_S = 8192;
constexpr int D_IN = 4352, NE = 16, DF = 2048;
constexpr int NSLOTROWS = 2 * NTOK;
constexpr int PH_PER_LAYER = 12, N_PHASES = DEPTH * PH_PER_LAYER;
constexpr float LN_EPS = 1e-5f, RMS_EPS = 1e-6f, LOG2E = 1.4426950408889634f;
constexpr float DN_ALPHA = 1.681792830507429f;
constexpr float QSCALE = 0.125f * LOG2E;
static_assert(N_LAUNCHES == 1 || N_LAUNCHES == N_PHASES, "MK_N_LAUNCHES is 1 or 48");

constexpr size_t MiB = 1u << 20;
constexpr size_t WS_CTL = 0, CTL_ZERO_BYTES = 32 * 1024;
constexpr size_t WS_WIN = 2 * MiB;
constexpr size_t WS_WBR = WS_WIN + (size_t)D_IN * DM * 2;
constexpr size_t WS_WOUT = WS_WBR + (size_t)2 * 1024 * 512 * 2;
constexpr size_t WS_W1 = WS_WOUT + (size_t)1024 * 2048 * 2;
constexpr size_t WS_W2 = WS_W1 + (size_t)NE * 4096 * 1024 * 2;
constexpr size_t WS_XB = WS_W2 + (size_t)NE * 1024 * 2048 * 2;
constexpr size_t WS_R1 = WS_XB + (size_t)NTOK * DM * 2;
constexpr size_t WS_NAQKV = WS_R1;
constexpr size_t WS_RAWQK = WS_NAQKV + (size_t)NTOK * 1536 * 2;
constexpr size_t WS_GATES = WS_RAWQK + (size_t)NTOK * 768 * 4;
constexpr size_t WS_R1_END = WS_GATES + (size_t)NTOK * 2048 * 2;
constexpr size_t WS_H = WS_R1;
constexpr size_t WS_XB8_OLD = WS_XB + (size_t)NTOK * DM;
static_assert(WS_H + (size_t)NSLOTROWS * DF * 2 <= WS_R1_END && (!(FP8_G1 || FP8_E1) || true), "H overlay fits R1");
constexpr size_t WS_R2 = WS_R1_END;
constexpr size_t WS_ATT = WS_R2;
constexpr size_t WS_Z = WS_ATT + (size_t)2 * NTOK * 512 * 2;
constexpr size_t WS_QKVB = WS_Z + (size_t)NTOK * 1024 * 2;
constexpr size_t WS_MIX8 = WS_QKVB + (size_t)NTOK * DM;
constexpr size_t WS_R2_END = WS_Z + (size_t)NTOK * 2048 * 2;
constexpr size_t WS_XG = WS_R2;
constexpr size_t WS_YE = WS_R2;
static_assert(WS_XG + (size_t)NSLOTROWS * DM * 2 <= WS_R2_END, "XG/YE overlay fits R2");
constexpr size_t WS_AFFT = WS_R2_END;
constexpr size_t WS_SLOT = WS_AFFT + (size_t)NTOK * NE * 4;
constexpr size_t WS_IDX = WS_SLOT + (size_t)NTOK * NE * 4;
constexpr size_t WS_GVAL = WS_IDX + (size_t)NSLOTROWS * 4;
constexpr size_t WS_XB8 = WS_GVAL + (size_t)NSLOTROWS * 4;
constexpr size_t WS_END = WS_XB8 + (size_t)NTOK * DM;
static_assert(WS_END <= (size_t)2047 * MiB, "d_ws map fits under 2 GiB");
constexpr size_t WS_STATS = 1 * MiB;
constexpr int CW_BAR = 4096;
static_assert((size_t)(CW_BAR + 3456) * 4 <= CTL_ZERO_BYTES, "the barrier words lie inside the per-call memset");

constexpr int RING_OFF = 0, RING_BYTES = 131072;
constexpr int LDSCTL_OFF = RING_BYTES, MISC_OFF = LDSCTL_OFF + 320;
constexpr int LDS_BYTES = 147456;
static_assert(MISC_OFF + 128 <= LDS_BYTES, "LDS map");

#define GAS __attribute__((address_space(1)))
#define LAS __attribute__((address_space(3)))
typedef unsigned short bf16;
typedef unsigned v4u __attribute__((ext_vector_type(4)));
typedef unsigned v2u __attribute__((ext_vector_type(2)));
typedef float f32x4 __attribute__((ext_vector_type(4)));
typedef float f32x16 __attribute__((ext_vector_type(16)));
typedef short bf16x8 __attribute__((ext_vector_type(8)));
typedef GAS unsigned gu32;
#define RLX_AGENT __ATOMIC_RELAXED, __HIP_MEMORY_SCOPE_AGENT
#define LDS_WAIT() asm volatile("s_waitcnt lgkmcnt(0)" ::: "memory")
#define VM_WAIT() asm volatile("s_waitcnt vmcnt(0)" ::: "memory")
__device__ __forceinline__ unsigned f2bf(float f) { unsigned u = __builtin_bit_cast(unsigned, f); return (u + 0x7fffu + ((u >> 16) & 1u)) >> 16; }
__device__ __forceinline__ unsigned pk2(float lo, float hi) { typedef float f32x2p __attribute__((ext_vector_type(2))); typedef __bf16 bf16x2p __attribute__((ext_vector_type(2)));
    const f32x2p v = {lo, hi}; return __builtin_bit_cast(unsigned, __builtin_convertvector(v, bf16x2p)); }
__device__ __forceinline__ float bf_lo(unsigned w) { return __uint_as_float(w << 16); }
__device__ __forceinline__ float bf_hi(unsigned w) { return __uint_as_float(w & 0xffff0000u); }


#ifndef ROPE_FUSED
#define ROPE_FUSED 1
#endif
namespace pg8 {
struct EpiProjRope {
    static constexpr bool PERM = true, AFTER_DRAIN = false;
    bf16_t* NAQKV; bf16_t* QKVB; unsigned char* GATES; const float* qn; const float* kn; PG8_LAS float* xch; float qscale, ascale;
    __device__ __forceinline__ void operator()(const f32x4 (&acc)[2][2][4][2], const Unit& u, int wr, int wc, int fr, int fq) const {
        const int pn = u.pn;
        const size_t row0 = (size_t)u.pm * BM + wr * 64 + fr; const int colw = wc * 32 + 8 * fq;
        if (pn < 6) {
            const float sc = (pn < 2 ? qscale : 1.0f) * ascale;
#pragma unroll
            for (int ai = 0; ai < 2; ++ai)
#pragma unroll
                for (int m = 0; m < 4; ++m)
#pragma unroll
                    for (int bj = 0; bj < 2; ++bj) {
                        if (FP8_NAQK) { unsigned char* const rp = (unsigned char*)NAQKV + (row0 + ai * HALF + m * 16) * 2048; const f32x4 v0 = acc[ai][bj][m][0] * sc, v1 = acc[ai][bj][m][1] * sc;
                            if (pn < 4) { u32x2 w; w.x = pack4_fp8(v0[0], v0[1], v0[2], v0[3]); w.y = pack4_fp8(v1[0], v1[1], v1[2], v1[3]); *(u32x2*)(rp + pn * BM + bj * HALF + colw) = w; }
                            else *(u32x4*)(rp + 1024 + 2 * ((pn - 4) * BM + bj * HALF + colw)) = pack8(v0, v1); }
                        else *(u32x4*)(NAQKV + (row0 + ai * HALF + m * 16) * 1536 + pn * BM + bj * HALF + colw) = pack8(acc[ai][bj][m][0] * sc, acc[ai][bj][m][1] * sc); }
        } else if (pn < 9) {
            unsigned xo_mine = (unsigned)(size_t)xch + (unsigned)(((wr * 64 + fr) * 8 + wc) * 4), xo_part = (unsigned)(size_t)xch + (unsigned)(((wr * 64 + fr) * 8 + (wc ^ 1)) * 4);
            asm volatile("" : "+v"(xo_mine), "+v"(xo_part));
            PG8_LAS float* const xm = (PG8_LAS float*)(size_t)xo_mine; PG8_LAS float* const xp = (PG8_LAS float*)(size_t)xo_part;
#pragma unroll
            for (int ai = 0; ai < 2; ++ai)
#pragma unroll
                for (int m = 0; m < 4; ++m)
#pragma unroll
                    for (int bj = 0; bj < 2; ++bj) { const f32x4 a = acc[ai][bj][m][0], b = acc[ai][bj][m][1];
                        float s = ((a[0] * a[0] + a[1] * a[1]) + (a[2] * a[2] + a[3] * a[3])) + ((b[0] * b[0] + b[1] * b[1]) + (b[2] * b[2] + b[3] * b[3]));
                        s *= ascale * ascale; s += __shfl_xor(s, 16); s += __shfl_xor(s, 32);
                        if (fq == 0) xm[(ai * HALF + m * 16) * 8 + bj * 4] = s; }
            asm volatile("s_waitcnt lgkmcnt(0)\n\ts_barrier" ::: "memory");
            const int dq = 32 * (wc & 1) + 8 * fq;
            const int off0 = (pn - 6) * BM + colw, offv = 640 + 2 * colw;
            const float* gsrc = (pn == 8 ? kn : qn) + dq; const f32x4 g0 = *(const f32x4*)gsrc, g1 = *(const f32x4*)(gsrc + 4);
            const float invf0 = (fq & 1) ? 0.01f : 1.0f;
            constexpr float RJ[8] = {1.0f, 0.5623413251903491f, 0.31622776601683794f, 0.1778279410038923f, 0.1f, 0.05623413251903491f, 0.031622776601683794f, 0.01778279410038923f};
            const float sgn = (fq & 2) ? 1.f : -1.f;
            auto rows = [&](auto kv_) __attribute__((always_inline)) { constexpr bool KV = decltype(kv_)::value;
#pragma unroll
            for (int ai = 0; ai < 2; ++ai)
#pragma unroll
                for (int m = 0; m < 4; ++m) {
                    const int rl = ai * HALF + wr * 64 + m * 16 + fr; const int R = u.pm * BM + rl;
                    const int t = R < 32768 ? (R & 4095) : ((R - 32768) & 8191);
                    const float pos = (float)((wc & 1) ? (t & 63) : (t >> 6));
                    const float pf = pos * invf0;
                    const float tot0 = xm[(ai * HALF + m * 16) * 8] + xp[(ai * HALF + m * 16) * 8], tot1 = xm[(ai * HALF + m * 16) * 8 + 4] + xp[(ai * HALF + m * 16) * 8 + 4];
                    const float rn0 = 1.0f / sqrtf(tot0 * (1.0f / 64.0f) + 1e-6f), rn1 = 1.0f / sqrtf(tot1 * (1.0f / 64.0f) + 1e-6f), osc = pn < 8 ? qscale : 1.0f;
#pragma unroll
                    for (int hk = 0; hk < 2; ++hk) {
                        float cs[4], sn[4];
#pragma unroll
                        for (int k = 0; k < 4; ++k) { const float ang = pf * RJ[4 * hk + k]; cs[k] = __cosf(ang); sn[k] = __sinf(ang); }
#pragma unroll
                        for (int bj = 0; bj < 2; ++bj) {
                            constexpr bool plain_ct = KV; const bool plain = plain_ct && bj == 1;
                            const f32x4 a = acc[ai][bj][m][hk] * ascale, y = a * (bj ? rn1 : rn0) * (hk ? g1 : g0);
                            f32x4 r;
#pragma unroll
                            for (int k = 0; k < 4; ++k) { const float p = __shfl_xor(y[k], 32); r[k] = (y[k] * cs[k] + sgn * p * sn[k]) * osc; }
                            const f32x4 o = plain ? a : r;
                            if (FP8_QK) { unsigned char* const rowp = (unsigned char*)QKVB + (size_t)R * 896 + (bj ? (KV ? offv : off0 + HALF) : off0);
                                if (plain) { u32x2 w; w.x = cvt_pk_bf16(o[0], o[1]); w.y = cvt_pk_bf16(o[2], o[3]); *(u32x2*)(rowp + 8 * hk) = w; }
                                else *(unsigned*)(rowp + 4 * hk) = pack4_fp8(o[0], o[1], o[2], o[3]); }
                            else { u32x2 w; w.x = cvt_pk_bf16(o[0], o[1]); w.y = cvt_pk_bf16(o[2], o[3]);
                            *(u32x2*)(QKVB + (size_t)R * 768 + (pn - 6) * BM + bj * HALF + colw + 4 * hk) = w; }
                        }
                    }
                    __builtin_amdgcn_sched_barrier(0);
                }
            };
            if (pn == 8) rows(std::true_type{}); else rows(std::false_type{});
        } else {
#pragma unroll
            for (int ai = 0; ai < 2; ++ai)
#pragma unroll
                for (int m = 0; m < 4; ++m)
#pragma unroll
                    for (int bj = 0; bj < 2; ++bj) { const float cneg = -1.4426950408889634f * ascale; const f32x4 v0 = sigmoid_scaled4(acc[ai][bj][m][0], cneg), v1 = sigmoid_scaled4(acc[ai][bj][m][1], cneg);
                        u32x2 w8; w8.x = pack4_fp8(v0[0], v0[1], v0[2], v0[3]); w8.y = pack4_fp8(v1[0], v1[1], v1[2], v1[3]);
                        *(u32x2*)(GATES + (row0 + ai * HALF + m * 16) * 2048 + (pn - 9) * BM + bj * HALF + colw) = w8; }
        }
    }
};
}

#define XB_TMO      128
#define XB_XCNT(j)  (256  + 64 * (j))
#define XB_XSUB(j)  (1280 + 64 * (j))
#define XB_XGEN(j)  (2304 + 64 * (j))
#define XB_TOP      3328
#define XB_TOPGEN   3392
#define XCD_BAR_WORDS 3456
#define XB_SPIN_CAP (1u << 18)

__device__ __forceinline__ unsigned xb_ld(unsigned* p)              { return __hip_atomic_load(p, __ATOMIC_RELAXED, __HIP_MEMORY_SCOPE_AGENT); }
__device__ __forceinline__ unsigned xb_add(unsigned* p, unsigned v) { return __hip_atomic_fetch_add(p, v, __ATOMIC_RELAXED, __HIP_MEMORY_SCOPE_AGENT); }
__device__ __forceinline__ unsigned xb_xcc_id() { return (unsigned)__builtin_amdgcn_s_getreg((3 << 11) | 20) & 0xFu; }
#define XB_SPIN(cond, bar) do { unsigned _sp = 0; while (cond) { __builtin_amdgcn_s_sleep(1); \
    if ((++_sp & 255u) == 0u) { if (xb_ld(&(bar)[XB_TMO])) break; if (_sp > XB_SPIN_CAP) { atomicAdd(&(bar)[XB_TMO], 1u); break; } } } } while (0)

struct XcdBarrier {
    unsigned* bar; unsigned x;
    volatile LAS unsigned* st;
};

__device__ __forceinline__ XcdBarrier xcd_barrier_post(unsigned* bar, volatile LAS unsigned* st) {
    XcdBarrier b; b.bar = bar; b.x = xb_xcc_id(); b.st = st;
    if (threadIdx.x == 0) (void)xb_add(&bar[XB_XCNT(b.x)], 1u);
    return b;
}
__device__ __forceinline__ void xcd_barrier_complete(unsigned* bar, unsigned x, unsigned& nloc, unsigned& nx) {
    const unsigned G = gridDim.x * gridDim.y * gridDim.z;
    unsigned sum, cnt, mine, sp = 0u;
    for (;;) {
        sum = 0u; cnt = 0u; mine = 0u;
#pragma unroll
        for (unsigned j = 0; j < 16; ++j) { const unsigned c = xb_ld(&bar[XB_XCNT(j)]); sum += c; cnt += (c > 0u) ? 1u : 0u; mine = (j == x) ? c : mine; }
        if (sum == G) break;
        __builtin_amdgcn_s_sleep(1);
        if ((++sp & 255u) == 0u) { if (xb_ld(&bar[XB_TMO])) break; if (sp > XB_SPIN_CAP) { atomicAdd(&bar[XB_TMO], 1u); break; } }
    }
    nloc = mine > 0u ? mine : 1u; nx = cnt > 0u ? cnt : 1u;
}

__device__ __forceinline__ void xcd_barrier(const XcdBarrier& b) {
    asm volatile("s_waitcnt vmcnt(0)" ::: "memory");
    __syncthreads();
    if (threadIdx.x == 0) {
        unsigned* bar = b.bar;
        __builtin_amdgcn_s_waitcnt(0);
        unsigned nloc = b.st[0], nx = b.st[1];
        if (nloc == 0u) { xcd_barrier_complete(bar, b.x, nloc, nx); b.st[0] = nloc; b.st[1] = nx; }
        const unsigned old = xb_add(&bar[XB_XSUB(b.x)], 1u);
        const unsigned gen = old / nloc;
        if (old + 1u == (gen + 1u) * nloc) {
            __builtin_amdgcn_fence(__ATOMIC_RELEASE, "agent");
            asm volatile("s_waitcnt vmcnt(0)" ::: "memory");
            const unsigned og = xb_add(&bar[XB_TOP], 1u);
            const unsigned tg = og / nx;
            if (og + 1u == (tg + 1u) * nx) xb_add(&bar[XB_TOPGEN], 1u);
            else XB_SPIN(xb_ld(&bar[XB_TOPGEN]) == tg, bar);
            __builtin_amdgcn_fence(__ATOMIC_ACQUIRE, "agent");
            xb_add(&bar[XB_XGEN(b.x)], 1u);
            asm volatile("s_waitcnt vmcnt(0)" ::: "memory");
        } else {
            XB_SPIN(xb_ld(&bar[XB_XGEN(b.x)]) == gen, bar);
            __builtin_amdgcn_fence(__ATOMIC_ACQUIRE, "agent");
            asm volatile("s_waitcnt vmcnt(0)" ::: "memory");
        }
    }
    __syncthreads();
}


struct Args { const float* in[17]; float* out; unsigned char* ws; int ph_lo, ph_hi; };
enum { I_XP = 0, I_XS, I_WIN, I_RPB, I_QN, I_KN, I_WNA, I_WGQ, I_WOUT, I_L1G, I_L1B, I_WR, I_WG, I_WU, I_WD, I_L2G, I_L2B };
struct Frame {
    LAS unsigned char* lds;
    int tid, lane, wave;
    int vcu, G;
};
__device__ __forceinline__ GAS unsigned char* ws_here(unsigned char* p0) { GAS unsigned char* p = (GAS unsigned char*)p0; asm volatile("" : "+s"(p)); return p; }
#define WSP(T, off) ((T*)(ws_here(A.ws) + (off)))
__device__ __forceinline__ Frame fresh_frame(const Frame& F0) {
    Frame F = F0; int t = threadIdx.x; asm volatile("" : "+v"(t)); F.tid = t; F.lane = t & 63; F.wave = __builtin_amdgcn_readfirstlane(t >> 6); return F; }

__device__ __forceinline__ float wave_sum(float v) {
#pragma unroll
    for (int o = 1; o < 64; o <<= 1) v += __shfl_xor(v, o);
    return v;
}
__device__ __forceinline__ float wave_max(float v) {
#pragma unroll
    for (int o = 1; o < 64; o <<= 1) v = fmaxf(v, __shfl_xor(v, o));
    return v;
}

__device__ __forceinline__ void conv_item(const float* W, int N, int k0, int n0, bf16* dst, int dpitch, LAS float* scr, int lane) {
#pragma unroll 8
    for (int i = 0; i < 32; ++i) { const int kk = 2 * i + (lane >> 5); scr[kk * 33 + (lane & 31)] = W[(size_t)(k0 + kk) * N + n0 + (lane & 31)]; }
    LDS_WAIT(); asm volatile("" ::: "memory");
    const int c = lane & 7;
#pragma unroll
    for (int j = 0; j < 4; ++j) { const int n = (lane >> 3) + 8 * j; const LAS float* s = scr + (8 * c) * 33 + n;
        v4u o; o.x = pk2(s[0 * 33], s[1 * 33]); o.y = pk2(s[2 * 33], s[3 * 33]); o.z = pk2(s[4 * 33], s[5 * 33]); o.w = pk2(s[6 * 33], s[7 * 33]);
        *(GAS v4u*)(dst + (size_t)n * dpitch + 8 * c) = o; }
    LDS_WAIT(); asm volatile("" ::: "memory");
}
__device__ __forceinline__ void conv8_item(const float* W, int N, int k0, int n0, unsigned char* dst, int dpitch, float scale, LAS float* scr, int lane) {
#pragma unroll 8
    for (int i = 0; i < 32; ++i) { const int kk = 2 * i + (lane >> 5); scr[kk * 33 + (lane & 31)] = W[(size_t)(k0 + kk) * N + n0 + (lane & 31)] * scale; }
    LDS_WAIT(); asm volatile("" ::: "memory");
    const int n = lane >> 1, c2 = lane & 1; const LAS float* s = scr + (32 * c2) * 33 + n;
    v4u o0, o1;
    o0.x = pg8::pack4_fp8(s[0 * 33], s[1 * 33], s[2 * 33], s[3 * 33]);     o0.y = pg8::pack4_fp8(s[4 * 33], s[5 * 33], s[6 * 33], s[7 * 33]);
    o0.z = pg8::pack4_fp8(s[8 * 33], s[9 * 33], s[10 * 33], s[11 * 33]);   o0.w = pg8::pack4_fp8(s[12 * 33], s[13 * 33], s[14 * 33], s[15 * 33]);
    o1.x = pg8::pack4_fp8(s[16 * 33], s[17 * 33], s[18 * 33], s[19 * 33]); o1.y = pg8::pack4_fp8(s[20 * 33], s[21 * 33], s[22 * 33], s[23 * 33]);
    o1.z = pg8::pack4_fp8(s[24 * 33], s[25 * 33], s[26 * 33], s[27 * 33]); o1.w = pg8::pack4_fp8(s[28 * 33], s[29 * 33], s[30 * 33], s[31 * 33]);
    GAS v4u* d = (GAS v4u*)(dst + (size_t)n * dpitch + 32 * c2);
    d[0] = o0; d[1] = o1;
    LDS_WAIT(); asm volatile("" ::: "memory");
}
struct CItem { const float* src; unsigned char* dst; int N, dpitch; float scale; int f8; };
__device__ __forceinline__ CItem conv_expert_item(const Args& A, int layer, int r) {
    constexpr int I_E = 16 * 64, I_D = 32 * 32, per_e = 2 * I_E + I_D;
    CItem c; const int e = r / per_e; r -= e * per_e;
    if (r < 2 * I_E) { const int up = r / I_E, q = r % I_E, kb = q / 64, nb = q % 64, n0 = 32 * nb;
        c.src = (up ? A.in[I_WU] : A.in[I_WG]) + ((size_t)layer * NE + e) * DM * DF + (size_t)(64 * kb) * DF + n0; c.N = DF;
        const int drow = e * 4096 + (n0 >> 7) * 256 + up * 128 + (n0 & 127);
        c.f8 = FP8_E1; c.scale = FP8_E1 ? W1_SCALE : 1.f; c.dpitch = FP8_E1 ? DM : 2 * DM;
        c.dst = WSP(unsigned char, WS_W1) + (size_t)drow * c.dpitch + (size_t)(64 * kb) * (FP8_E1 ? 1 : 2);
    } else { r -= 2 * I_E; const int kb = r / 32, nb = r % 32;
        c.src = A.in[I_WD] + ((size_t)layer * NE + e) * DF * DM + (size_t)(64 * kb) * DM + 32 * nb; c.N = DM;
        c.f8 = FP8_E2; c.scale = FP8_E2 ? W2_SCALE : 1.f; c.dpitch = FP8_E2 ? DF : 2 * DF;
        c.dst = WSP(unsigned char, WS_W2) + (size_t)(e * 1024 + 32 * nb) * c.dpitch + (size_t)(64 * kb) * (FP8_E2 ? 1 : 2);
    }
    return c;
}
__device__ __forceinline__ void conv_experts(const Args& A, const Frame& F0, int layer, int gw, int NGW) {
    const Frame F = fresh_frame(F0);
    LAS float* scr = (LAS float*)(F.lds + RING_OFF + F.wave * 16384);
    const int lane = F.lane;
    constexpr int NIT = NE * (2 * 16 * 64 + 32 * 32);
    float ra[32], rb[32]; CItem cur, nxt;
    int it = gw;
    if (it < NIT) { cur = conv_expert_item(A, layer, it);
#pragma unroll
        for (int i = 0; i < 32; ++i) ra[i] = cur.src[(size_t)(2 * i + (lane >> 5)) * cur.N + (lane & 31)]; }
#pragma unroll 1
    while (it < NIT) {
        const int it2 = it + NGW;
        if (it2 < NIT) { nxt = conv_expert_item(A, layer, it2);
#pragma unroll
            for (int i = 0; i < 32; ++i) rb[i] = nxt.src[(size_t)(2 * i + (lane >> 5)) * nxt.N + (lane & 31)]; }
#pragma unroll
        for (int i = 0; i < 32; ++i) scr[(2 * i + (lane >> 5)) * 33 + (lane & 31)] = ra[i] * cur.scale;
        LDS_WAIT(); asm volatile("" ::: "memory");
        if (cur.f8) {
            const int n = lane >> 1, c2 = lane & 1; const LAS float* s = scr + (32 * c2) * 33 + n;
            v4u o0, o1;
            o0.x = pg8::pack4_fp8(s[0 * 33], s[1 * 33], s[2 * 33], s[3 * 33]);     o0.y = pg8::pack4_fp8(s[4 * 33], s[5 * 33], s[6 * 33], s[7 * 33]);
            o0.z = pg8::pack4_fp8(s[8 * 33], s[9 * 33], s[10 * 33], s[11 * 33]);   o0.w = pg8::pack4_fp8(s[12 * 33], s[13 * 33], s[14 * 33], s[15 * 33]);
            o1.x = pg8::pack4_fp8(s[16 * 33], s[17 * 33], s[18 * 33], s[19 * 33]); o1.y = pg8::pack4_fp8(s[20 * 33], s[21 * 33], s[22 * 33], s[23 * 33]);
            o1.z = pg8::pack4_fp8(s[24 * 33], s[25 * 33], s[26 * 33], s[27 * 33]); o1.w = pg8::pack4_fp8(s[28 * 33], s[29 * 33], s[30 * 33], s[31 * 33]);
            GAS v4u* d = (GAS v4u*)(cur.dst + (size_t)n * cur.dpitch + 32 * c2);
            d[0] = o0; d[1] = o1;
        } else {
            const int c = lane & 7;
#pragma unroll
            for (int j = 0; j < 4; ++j) { const int n = (lane >> 3) + 8 * j; const LAS float* s = scr + (8 * c) * 33 + n;
                v4u o; o.x = pk2(s[0 * 33], s[1 * 33]); o.y = pk2(s[2 * 33], s[3 * 33]); o.z = pk2(s[4 * 33], s[5 * 33]); o.w = pk2(s[6 * 33], s[7 * 33]);
                *(GAS v4u*)(cur.dst + (size_t)n * cur.dpitch + 16 * c) = o; }
        }
        LDS_WAIT(); asm volatile("" ::: "memory");
#pragma unroll
        for (int i = 0; i < 32; ++i) ra[i] = rb[i];
        cur = nxt; it = it2;
    }
}
template <int PART> __device__ __forceinline__ void phase_conv(const Args& A, const Frame& F0, int layer, int gw, int NGW) {
    const Frame F = fresh_frame(F0);
    LAS float* scr = (LAS float*)(F.lds + RING_OFF + F.wave * 16384);
    constexpr int I_IN = 16 * 136, I_BR = 8 * 32, I_OUT = 16 * 32, I_E = 16 * 64  , I_D = 32 * 32  ;
    constexpr int NSMALL = I_IN + 2 * I_BR + I_OUT, NITEMS = NSMALL + NE * (2 * I_E + I_D);
    for (int it = (PART == 0 ? 0 : NSMALL) + gw; it < (PART == 0 ? NSMALL : NITEMS); it += NGW) {
        int r = it;
        if (r < I_IN) { const int kb = r / 136, nb = r % 136;
            if (FP8_G1) conv8_item(A.in[I_WIN] + (size_t)layer * DM * D_IN, D_IN, 64 * kb, 32 * nb, WSP(unsigned char, WS_WIN) + (size_t)(32 * nb) * DM + 64 * kb, DM, WIN_SCALE, scr, F.lane);
            else conv_item(A.in[I_WIN] + (size_t)layer * DM * D_IN, D_IN, 64 * kb, 32 * nb, WSP(bf16, WS_WIN) + (size_t)(32 * nb) * DM + 64 * kb, DM, scr, F.lane);
            continue; } r -= I_IN;
        if (r < I_BR) { const int kb = r / 32, nb = r % 32;
            if (FP8_BR) conv8_item(A.in[I_WNA] + (size_t)layer * 512 * DM, DM, 64 * kb, 32 * nb, WSP(unsigned char, WS_WBR) + (size_t)(32 * nb) * 512 + 64 * kb, 512, WBR_SCALE, scr, F.lane);
            else conv_item(A.in[I_WNA] + (size_t)layer * 512 * DM, DM, 64 * kb, 32 * nb, WSP(bf16, WS_WBR) + (size_t)(32 * nb) * 512 + 64 * kb, 512, scr, F.lane); continue; } r -= I_BR;
        if (r < I_BR) { const int kb = r / 32, nb = r % 32;
            if (FP8_BR) conv8_item(A.in[I_WGQ] + (size_t)layer * 512 * DM, DM, 64 * kb, 32 * nb, WSP(unsigned char, WS_WBR) + (size_t)(1024 + 32 * nb) * 512 + 64 * kb, 512, WBR_SCALE, scr, F.lane);
            else conv_item(A.in[I_WGQ] + (size_t)layer * 512 * DM, DM, 64 * kb, 32 * nb, WSP(bf16, WS_WBR) + (size_t)(1024 + 32 * nb) * 512 + 64 * kb, 512, scr, F.lane); continue; } r -= I_BR;
        if (r < I_OUT) { const int kb = r / 32, nb = r % 32;
            if (FP8_OUT) conv8_item(A.in[I_WOUT] + (size_t)layer * DM * DM, DM, 64 * kb, 32 * nb, WSP(unsigned char, WS_WOUT) + (size_t)(32 * nb) * DM + 64 * kb, DM, WOUT_SCALE, scr, F.lane);
            else conv_item(A.in[I_WOUT] + (size_t)layer * DM * DM, DM, 64 * kb, 32 * nb, WSP(bf16, WS_WOUT) + (size_t)(32 * nb) * DM + 64 * kb, DM, scr, F.lane);
            continue; } r -= I_OUT;
        const int per_e = 2 * I_E + I_D, e = r / per_e; r -= e * per_e;
        if (r < 2 * I_E) { const int up = r / I_E, q = r % I_E, kb = q / 64, nb = q % 64, n0 = 32 * nb;
            const float* src = (up ? A.in[I_WU] : A.in[I_WG]) + ((size_t)layer * NE + e) * DM * DF;
            const int drow = e * 4096 + (n0 >> 7) * 256 + up * 128 + (n0 & 127);
            if (FP8_E1) conv8_item(src, DF, 64 * kb, n0, WSP(unsigned char, WS_W1) + (size_t)drow * DM + 64 * kb, DM, W1_SCALE, scr, F.lane);
            else conv_item(src, DF, 64 * kb, n0, WSP(bf16, WS_W1) + (size_t)drow * DM + 64 * kb, DM, scr, F.lane);
            continue; }
        r -= 2 * I_E;
        { const int kb = r / 32, nb = r % 32; const float* src = A.in[I_WD] + ((size_t)layer * NE + e) * DF * DM;
          if (FP8_E2) conv8_item(src, DM, 64 * kb, 32 * nb, WSP(unsigned char, WS_W2) + (size_t)(e * 1024 + 32 * nb) * DF + 64 * kb, DF, W2_SCALE, scr, F.lane);
          else conv_item(src, DM, 64 * kb, 32 * nb, WSP(bf16, WS_W2) + (size_t)(e * 1024 + 32 * nb) * DF + 64 * kb, DF, scr, F.lane); }
    }
    if (PART == 0 && layer == 0) {
        for (int m = gw; m < NTOK; m += NGW) {
            const float* src = m < NP ? A.in[I_XP] + (size_t)m * DM : A.in[I_XS] + (size_t)(m - NP) * DM;
            const GAS f32x4* xr = (const GAS f32x4*)src + F.lane;
            GAS f32x4* xo = (GAS f32x4*)(A.out + (size_t)m * DM) + F.lane;
            GAS v2u* bo = (GAS v2u*)(WSP(bf16, WS_XB) + (size_t)m * DM) + F.lane;
#pragma unroll
            for (int j = 0; j < 4; ++j) { const f32x4 v = xr[64 * j]; if (!FP8_MIX) xo[64 * j] = v;
                if (FP8_G1) ((GAS unsigned*)(WSP(unsigned char, WS_XB8) + (size_t)m * DM))[F.lane + 64 * j] = pg8::pack4_fp8(v.x, v.y, v.z, v.w);
                else { v2u w; w.x = pk2(v.x, v.y); w.y = pk2(v.z, v.w); bo[64 * j] = w; } }
        }
    }
}

__device__ __forceinline__ int crow16(int rr, int hi) { return (rr & 3) + 8 * (rr >> 2) + 4 * hi; }
#define NA_COMPUTE1(CUR_, KR_) { \
            const LAS unsigned char* trow = (const LAS unsigned char*)(tab + ((KR_) - rA + 7) * 32) + blane; \
            f32x16 c0; \
            if (FP8_NAQK) { const attn_body::i32x4q a_ = *(const LAS attn_body::i32x4q*)((CUR_) + kroff), b_ = *(const LAS attn_body::i32x4q*)((CUR_) + kroff + 1040); c0 = MFMA8(__builtin_shufflevector(a_, b_, 0, 1, 2, 3, 4, 5, 6, 7), qf8, am0v); } else \
    _Pragma("unroll") \
            for (int ds = 0; ds < 4; ++ds) { \
                const bf16x8 k0 = *(const LAS bf16x8*)((CUR_) + kroff + ds * 2080); \
                c0 = __builtin_amdgcn_mfma_f32_32x32x16_bf16(k0, qf[ds], ds == 0 ? am0v : c0, 0, 0, 0);     \
            } \
            float mx = -INFINITY; \
    _Pragma("unroll") \
            for (int rr = 0; rr < 16; rr += 2) { \
                const float b0 = *(const LAS float*)(trow + 4 * ((rr & 3) + 8 * (rr >> 2))), b1 = *(const LAS float*)(trow + 4 * (((rr + 1) & 3) + 8 * ((rr + 1) >> 2))); \
                c0[rr] += b0; c0[rr + 1] += b1; \
                mx = fmaxf(mx, fmaxf(c0[rr], c0[rr + 1])); \
            } \
            { const auto rr_ = __builtin_amdgcn_permlane32_swap(__float_as_uint(mx), __float_as_uint(mx), false, false); mx = fmaxf(__uint_as_float(rr_[0]), __uint_as_float(rr_[1])); }     \
            const bool rowlive = ((KR_) >= rsq) && ((KR_) < rsq + 8);      \
            { const bool need = rowlive && (mx > mrun + 8.0f);     \
              if (__any(need)) { const float mnew = need ? mx : mrun, alpha = need ? __builtin_amdgcn_exp2f(mrun - mnew) : 1.0f; mrun = mnew; lrun *= alpha; \
    _Pragma("unroll") \
                for (int db = 0; db < 2; ++db) \
    _Pragma("unroll") \
                    for (int k = 0; k < 16; ++k) o[db][k] *= alpha; } } \
            const float msub = rowlive ? mrun : INFINITY;                   \
            float ps = 0.f; \
    _Pragma("unroll") \
            for (int rr = 0; rr < 16; ++rr) { c0[rr] = __builtin_amdgcn_exp2f(c0[rr] - msub); ps += c0[rr]; } \
            lrun += ps; \
            bf16x8 pb[2]; \
    _Pragma("unroll") \
            for (int s = 0; s < 2; ++s) { \
                v4u w0; \
                w0.x = pk2(c0[8 * s + 0], c0[8 * s + 1]); w0.y = pk2(c0[8 * s + 2], c0[8 * s + 3]); w0.z = pk2(c0[8 * s + 4], c0[8 * s + 5]); w0.w = pk2(c0[8 * s + 6], c0[8 * s + 7]); \
                pb[s] = __builtin_bit_cast(bf16x8, w0); \
            } \
    _Pragma("unroll") \
            for (int s = 0; s < 2; ++s) \
    _Pragma("unroll") \
                for (int db = 0; db < 2; ++db) { \
                    const LAS unsigned char* vp = (CUR_) + vroff + db * 4160 + s * 1024; \
                    const attn_body::s16x4 lo = attn_body::vtr((attn_body::lds_cptr)vp), hi2 = attn_body::vtr((attn_body::lds_cptr)(vp + 512)); \
                    const bf16x8 vfr = (bf16x8){lo[0], lo[1], lo[2], lo[3], hi2[0], hi2[1], hi2[2], hi2[3]}; \
                    o[db] = __builtin_amdgcn_mfma_f32_32x32x16_bf16(vfr, pb[s], o[db], 0, 0, 0); } }
#define NA_COMPUTE2(CUR0_, CUR1_, KR_) { \
            const LAS unsigned char* trow = (const LAS unsigned char*)(tab + ((KR_) - rA + 7) * 32) + blane; \
            f32x16 c0, c1; \
            if (FP8_NAQK) { const attn_body::i32x4q a0_ = *(const LAS attn_body::i32x4q*)((CUR0_) + kroff), b0_ = *(const LAS attn_body::i32x4q*)((CUR0_) + kroff + 1040), a1_ = *(const LAS attn_body::i32x4q*)((CUR1_) + kroff), b1_ = *(const LAS attn_body::i32x4q*)((CUR1_) + kroff + 1040); \
                c0 = MFMA8(__builtin_shufflevector(a0_, b0_, 0, 1, 2, 3, 4, 5, 6, 7), qf8, am0v); c1 = MFMA8(__builtin_shufflevector(a1_, b1_, 0, 1, 2, 3, 4, 5, 6, 7), qf8, am0v); } else \
    _Pragma("unroll") \
            for (int ds = 0; ds < 4; ++ds) { \
                const bf16x8 k0 = *(const LAS bf16x8*)((CUR0_) + kroff + ds * 2080), k1 = *(const LAS bf16x8*)((CUR1_) + kroff + ds * 2080); \
                c0 = __builtin_amdgcn_mfma_f32_32x32x16_bf16(k0, qf[ds], ds == 0 ? am0v : c0, 0, 0, 0); \
                c1 = __builtin_amdgcn_mfma_f32_32x32x16_bf16(k1, qf[ds], ds == 0 ? am0v : c1, 0, 0, 0); \
            } \
            float mx0 = -INFINITY, mx1 = -INFINITY; \
    _Pragma("unroll") \
            for (int rr = 0; rr < 16; rr += 2) { \
                const float b0 = *(const LAS float*)(trow + 4 * ((rr & 3) + 8 * (rr >> 2))), b1 = *(const LAS float*)(trow + 4 * (((rr + 1) & 3) + 8 * ((rr + 1) >> 2))); \
                const float d0 = *(const LAS float*)(trow + 128 + 4 * ((rr & 3) + 8 * (rr >> 2))), d1 = *(const LAS float*)(trow + 128 + 4 * (((rr + 1) & 3) + 8 * ((rr + 1) >> 2))); \
                c0[rr] += b0; c0[rr + 1] += b1; c1[rr] += d0; c1[rr + 1] += d1; \
                mx0 = fmaxf(mx0, fmaxf(c0[rr], c0[rr + 1])); mx1 = fmaxf(mx1, fmaxf(c1[rr], c1[rr + 1])); \
            } \
            const bool rowlive0 = ((KR_) >= rsq) && ((KR_) < rsq + 8), rowlive1 = ((KR_) + 1 >= rsq) && ((KR_) + 1 < rsq + 8); \
            float mx = fmaxf(rowlive0 ? mx0 : -INFINITY, rowlive1 ? mx1 : -INFINITY); \
            { const auto rr_ = __builtin_amdgcn_permlane32_swap(__float_as_uint(mx), __float_as_uint(mx), false, false); mx = fmaxf(__uint_as_float(rr_[0]), __uint_as_float(rr_[1])); } \
            { const bool need = mx > mrun + 8.0f;                           \
              if (__any(need)) { const float mnew = need ? mx : mrun, alpha = need ? __builtin_amdgcn_exp2f(mrun - mnew) : 1.0f; mrun = mnew; lrun *= alpha; \
    _Pragma("unroll") \
                for (int db = 0; db < 2; ++db) \
    _Pragma("unroll") \
                    for (int k = 0; k < 16; ++k) o[db][k] *= alpha; } } \
            const float msub0 = rowlive0 ? mrun : INFINITY, msub1 = rowlive1 ? mrun : INFINITY; \
            float ps = 0.f; \
    _Pragma("unroll") \
            for (int rr = 0; rr < 16; ++rr) { c0[rr] = __builtin_amdgcn_exp2f(c0[rr] - msub0); c1[rr] = __builtin_amdgcn_exp2f(c1[rr] - msub1); ps += c0[rr] + c1[rr]; } \
            lrun += ps; \
            bf16x8 pb[2][2]; \
    _Pragma("unroll") \
            for (int s = 0; s < 2; ++s) { \
                v4u w0, w1; \
                w0.x = pk2(c0[8 * s + 0], c0[8 * s + 1]); w0.y = pk2(c0[8 * s + 2], c0[8 * s + 3]); w0.z = pk2(c0[8 * s + 4], c0[8 * s + 5]); w0.w = pk2(c0[8 * s + 6], c0[8 * s + 7]); \
                w1.x = pk2(c1[8 * s + 0], c1[8 * s + 1]); w1.y = pk2(c1[8 * s + 2], c1[8 * s + 3]); w1.z = pk2(c1[8 * s + 4], c1[8 * s + 5]); w1.w = pk2(c1[8 * s + 6], c1[8 * s + 7]); \
                pb[0][s] = __builtin_bit_cast(bf16x8, w0); pb[1][s] = __builtin_bit_cast(bf16x8, w1); \
            } \
    _Pragma("unroll") \
            for (int kb2 = 0; kb2 < 2; ++kb2) \
    _Pragma("unroll") \
                for (int s = 0; s < 2; ++s) \
    _Pragma("unroll") \
                    for (int db = 0; db < 2; ++db) { \
                        const LAS unsigned char* vp = (kb2 ? (CUR1_) : (CUR0_)) + vroff + db * 4160 + s * 1024; \
                        const attn_body::s16x4 lo = attn_body::vtr((attn_body::lds_cptr)vp), hi2 = attn_body::vtr((attn_body::lds_cptr)(vp + 512)); \
                        const bf16x8 vfr = (bf16x8){lo[0], lo[1], lo[2], lo[3], hi2[0], hi2[1], hi2[2], hi2[3]}; \
                        o[db] = __builtin_amdgcn_mfma_f32_32x32x16_bf16(vfr, pb[kb2][s], o[db], 0, 0, 0); } }
constexpr int NA_KBUF = 8 * 1040, NA_VBUF = 2 * 4160, NA_BUF = NA_KBUF + NA_VBUF;
__device__ __forceinline__ void na_unitset(const bf16* __restrict__ QKV, bf16* __restrict__ OUT, const LAS float* tab, LAS unsigned char* stg  , size_t tok0, int rows, int h, int r0, int tid, int lane, int wave) {
    const int r32 = lane & 31, hi = lane >> 5;
    const int rA = r0 + 2 * (wave >> 2), ag = wave & 3, rq = rA + (r32 >> 4);
    int rsA = rA - 4; rsA = rsA < 0 ? 0 : rsA; rsA = rsA > rows - 8 ? rows - 8 : rsA;
    int rsB = rA - 3; rsB = rsB < 0 ? 0 : rsB; rsB = rsB > rows - 8 ? rows - 8 : rsB;
    const int rsq = (r32 >> 4) ? rsB : rsA;
    int kr_lo = r0 - 4; kr_lo = kr_lo < 0 ? 0 : kr_lo; kr_lo = kr_lo > rows - 8 ? rows - 8 : kr_lo;
    int kr_hi = r0 - 1; kr_hi = kr_hi < 0 ? 0 : kr_hi; kr_hi = kr_hi > rows - 8 ? rows - 8 : kr_hi; kr_hi += 7;
    const int nk = kr_hi - kr_lo + 1;
    const int c = 16 * ag + (r32 & 15);
    int cs = c - 8; cs = cs < 0 ? 0 : cs; cs = cs > 48 ? 48 : cs;
    int kb = 16 * ag - 8; kb = kb < 0 ? 0 : kb; kb = kb > 32 ? 32 : kb;
    bf16x8 qf[4];
#pragma unroll
    for (int ds = 0; ds < 4; ++ds) qf[ds] = FP8_NAQK ? (bf16x8){} : *(const bf16x8*)(QKV + (tok0 + (size_t)rq * 64 + c) * 1536 + h * 64 + 16 * ds + 8 * hi);
    const unsigned char* const N8 = (const unsigned char*)QKV; attn_body::i32x8q qf8 = {};
    if (FP8_NAQK) { const unsigned char* qp = N8 + (tok0 + (size_t)rq * 64 + c) * 2048 + h * 64 + 32 * hi; const attn_body::i32x4q a_ = *(const attn_body::i32x4q*)qp, b_ = *(const attn_body::i32x4q*)(qp + 16); qf8 = __builtin_shufflevector(a_, b_, 0, 1, 2, 3, 4, 5, 6, 7); }
    f32x16 o[2];
#pragma unroll
    for (int b = 0; b < 2; ++b)
#pragma unroll
        for (int k = 0; k < 16; ++k) o[b][k] = 0.f;
    float mrun = -INFINITY, lrun = 0.f;
    f32x16 am0v;
#pragma unroll
    for (int rr = 0; rr < 16; ++rr) { const int kc0 = kb + crow16(rr, hi); am0v[rr] = (kc0 >= cs && kc0 < cs + 16) ? 0.f : -INFINITY; }
    const int blane = 4 * (15 - c + kb + 4 * hi) - 128 * (r32 >> 4);
    const int skey = tid >> 3, sch = tid & 7;
    const bf16* gk = QKV + (tok0 + (size_t)kr_lo * 64 + skey) * 1536 + 512 + h * 64 + 8 * sch;
    const unsigned char* const gkk = N8 + (tok0 + (size_t)kr_lo * 64 + skey) * 2048 + 512 + h * 64 + (sch & 3) * 16;
    const unsigned char* const gkv = N8 + (tok0 + (size_t)kr_lo * 64 + skey) * 2048 + 1024 + h * 128 + sch * 16;
#define NA_LDK(j_) (FP8_NAQK ? *(const GAS v4u*)(gkk + (size_t)(j_) * 131072) : *(const GAS v4u*)(gk + (size_t)(j_) * 64 * 1536))
#define NA_LDV(j_) (FP8_NAQK ? *(const GAS v4u*)(gkv + (size_t)(j_) * 131072) : *(const GAS v4u*)(gk + (size_t)(j_) * 64 * 1536 + 512))
    const int kwoff = (FP8_NAQK ? (sch & 3) : sch) * 1040 + skey * 16, vwoff = NA_KBUF + (sch >> 2) * 4160 + skey * 64 + (sch & 3) * 16;
    const int kroff = FP8_NAQK ? hi * 2080 + (kb + r32) * 16 : hi * 1040 + (kb + r32) * 16;
    const int vroff = NA_KBUF + kb * 64 + ((lane >> 4) & 1) * 32 + (lane & 3) * 8 + (4 * hi + ((lane & 15) >> 2)) * 64;
    v4u kq0 = NA_LDK(0), vq0 = NA_LDV(0), kq1 = kq0, vq1 = vq0, kq2 = kq0, vq2 = vq0, kq3 = kq0, vq3 = vq0;
    if (1 < nk) { kq1 = NA_LDK(1); vq1 = NA_LDV(1); }
    if (2 < nk) { kq2 = NA_LDK(2); vq2 = NA_LDV(2); }
    if (3 < nk) { kq3 = NA_LDK(3); vq3 = NA_LDV(3); }
    *(LAS v4u*)(stg + kwoff) = kq0; *(LAS v4u*)(stg + vwoff) = vq0;
    if (1 < nk) { *(LAS v4u*)(stg + NA_BUF + kwoff) = kq1; *(LAS v4u*)(stg + NA_BUF + vwoff) = vq1; }
    __syncthreads();
    if (4 < nk) { kq0 = NA_LDK(4); vq0 = NA_LDV(4); }
    if (5 < nk) { kq1 = NA_LDK(5); vq1 = NA_LDV(5); }
#define NA_STEP(t, KA, VA, KB, VB) do { \
        LAS unsigned char* cur0 = stg + ((t) & 3) * NA_BUF; LAS unsigned char* cur1 = stg + (((t) + 1) & 3) * NA_BUF; \
        const int kr = kr_lo + (t); \
        const bool live0 = kr >= rsA && kr < rsB + 8, live1 = ((t) + 1 < nk) && kr + 1 >= rsA && kr + 1 < rsB + 8; \
        if (live0 && live1) NA_COMPUTE2(cur0, cur1, kr) else if (live0) NA_COMPUTE1(cur0, kr) else if (live1) NA_COMPUTE1(cur1, kr + 1) \
        if ((t) + 2 < nk) { LAS unsigned char* nxt = stg + (((t) + 2) & 3) * NA_BUF; *(LAS v4u*)(nxt + kwoff) = KA; *(LAS v4u*)(nxt + vwoff) = VA; } \
        if ((t) + 3 < nk) { LAS unsigned char* nxt = stg + (((t) + 3) & 3) * NA_BUF; *(LAS v4u*)(nxt + kwoff) = KB; *(LAS v4u*)(nxt + vwoff) = VB; } \
        if ((t) + 6 < nk) { KA = NA_LDK((t) + 6); VA = NA_LDV((t) + 6); } \
        if ((t) + 7 < nk) { KB = NA_LDK((t) + 7); VB = NA_LDV((t) + 7); } \
        __syncthreads(); } while (0)
#pragma unroll 1
    for (int t0 = 0; t0 < nk; t0 += 4) {
        NA_STEP(t0, kq2, vq2, kq3, vq3);
        if (t0 + 2 < nk) NA_STEP(t0 + 2, kq0, vq0, kq1, vq1);
    }
#undef NA_STEP
    float l; { const auto rr_ = __builtin_amdgcn_permlane32_swap(__float_as_uint(lrun), __float_as_uint(lrun), false, false); l = __uint_as_float(rr_[0]) + __uint_as_float(rr_[1]); } const float inv = 1.0f / l;
    if (FP8_BR) { unsigned char* orow8 = (unsigned char*)OUT + (tok0 + (size_t)rq * 64 + c) * 512 + h * 64; const float sc = inv * ATT_SCALE;
#pragma unroll
        for (int db = 0; db < 2; ++db)
#pragma unroll
            for (int g = 0; g < 4; ++g) *(GAS unsigned*)(orow8 + 32 * db + 8 * g + 4 * hi) = pg8::pack4_fp8(o[db][4 * g + 0] * sc, o[db][4 * g + 1] * sc, o[db][4 * g + 2] * sc, o[db][4 * g + 3] * sc);
        return; }
    bf16* orow = OUT + (tok0 + (size_t)rq * 64 + c) * 512 + h * 64;
#pragma unroll
    for (int db = 0; db < 2; ++db)
#pragma unroll
        for (int g = 0; g < 4; ++g) { v2u w; w.x = pk2(o[db][4 * g + 0] * inv, o[db][4 * g + 1] * inv); w.y = pk2(o[db][4 * g + 2] * inv, o[db][4 * g + 3] * inv);
            *(GAS v2u*)(orow + 32 * db + 8 * g + 4 * hi) = w; }
}
struct RopeLane { f32x4 gq, gk; float invf[4]; };
template <bool DRY> __device__ __forceinline__ void rope_compute(const Args& A, const RopeLane& L, const f32x4 (&v)[3], int m, int lane) {
    bf16* outrow = (DRY ? WSP(bf16, WS_Z) : WSP(bf16, WS_QKVB)) + (size_t)m * 768;
    const int t = m < NP ? (m & (SEQ_P - 1)) : ((m - NP) & (SEQ_S - 1));
    const int pos = (lane & 8) ? (t & 63) : (t >> 6);
    float cs[4], sn[4];
#pragma unroll
    for (int k = 0; k < 4; ++k) { const float ang = (float)pos * L.invf[k]; cs[k] = __cosf(ang); sn[k] = __sinf(ang); }
    const float sgn = (lane & 4) ? 1.f : -1.f;
    v2u ob[3];
#pragma unroll
    for (int j = 0; j < 3; ++j) {
        f32x4 x = v[j];
        const bool is_v = (j == 2) && (lane >= 32);
        float ss = (x.x * x.x + x.y * x.y) + (x.z * x.z + x.w * x.w);
        ss += __shfl_xor(ss, 1); ss += __shfl_xor(ss, 2); ss += __shfl_xor(ss, 4); ss += __shfl_xor(ss, 8);
        const float rn = 1.0f / sqrtf(ss * (1.0f / 64.0f) + RMS_EPS);
        const f32x4 gn = (j < 2) ? L.gq : L.gk;
        f32x4 y = x * rn * gn;
        f32x4 pr; pr.x = __shfl_xor(y.x, 4); pr.y = __shfl_xor(y.y, 4); pr.z = __shfl_xor(y.z, 4); pr.w = __shfl_xor(y.w, 4);
        f32x4 o;
        o.x = y.x * cs[0] + sgn * pr.x * sn[0]; o.y = y.y * cs[1] + sgn * pr.y * sn[1]; o.z = y.z * cs[2] + sgn * pr.z * sn[2]; o.w = y.w * cs[3] + sgn * pr.w * sn[3];
        if (j < 2) o = o * QSCALE;
        if (is_v) o = x;
        ob[j].x = pk2(o.x, o.y); ob[j].y = pk2(o.z, o.w);
    }
    GAS v2u* dst = (GAS v2u*)outrow + lane;
#ifdef ROPE_DRY_NOSTORE
    if (DRY) { asm volatile("" :: "v"(ob[0].x), "v"(ob[0].y), "v"(ob[1].x), "v"(ob[1].y), "v"(ob[2].x), "v"(ob[2].y)); return; }
#endif
#pragma unroll
    for (int j = 0; j < 3; ++j) dst[64 * j] = ob[j];
}
__device__ __forceinline__ void phase_na(const Args& A, const Frame& F0, int layer) {
    const Frame F = fresh_frame(F0);
    LAS float* tab = (LAS float*)(F.lds + RING_OFF) + 64;
    const float* rpb = A.in[I_RPB] + (size_t)layer * 8 * 15 * 31;
    for (int idx = F.tid; idx < 128; idx += NWAVES * 64) { (idx < 64 ? tab - 64 : tab + 8 * 15 * 32 - 64)[idx] = 0.f; }
    for (int idx = F.tid; idx < 8 * 15 * 32; idx += NWAVES * 64) { const int h = idx / 480, rem = idx % 480, dr = rem >> 5, dc = rem & 31;
        tab[idx] = dc < 31 ? rpb[(h * 15 + dr) * 31 + dc] * LOG2E : 0.f; }
    __syncthreads();
    const int gw = F.vcu * NWAVES + F.wave, NGW = F.G * NWAVES;
    constexpr int NUS_P = 8 * 8 * 16, NUS = NUS_P + 8 * 8 * 32;
#pragma unroll 1
    for (int rep_ = 0; rep_ < NREP(2); ++rep_)
#pragma unroll 1
    for (int us = F.vcu; us < NUS; us += F.G) {
        size_t tok0; int rows, h, r0;
        if (us < NUS_P) { const int b = us >> 7; h = (us >> 4) & 7; r0 = (us & 15) * 4; tok0 = (size_t)b * SEQ_P; rows = 64; }
        else { const int q = us - NUS_P, b = q >> 8; h = (q >> 5) & 7; r0 = (q & 31) * 4; tok0 = (size_t)NP + (size_t)b * SEQ_S; rows = 128; }
        na_unitset(WSP(bf16, WS_NAQKV), rep_ ? WSP(bf16, WS_Z) : WSP(bf16, WS_ATT), tab + h * 480, F.lds + RING_OFF + 16384, tok0, rows, h, r0, F.tid, F.lane, F.wave);
    }
#pragma unroll 1
    for (int rq_ = 0; rq_ < (ROPE_FUSED ? 0 : NREP(12)); ++rq_) { const int rp_ = ROPE_DRY_FIRST ? (NREP(12) - 1 - rq_) : rq_;
        RopeLane L; const int lane = F.lane, d0 = 4 * (lane & 15);
        L.gq = *(const GAS f32x4*)(A.in[I_QN] + layer * 64 + d0); L.gk = *(const GAS f32x4*)(A.in[I_KN] + layer * 64 + d0);
#pragma unroll
        for (int k = 0; k < 4; ++k) L.invf[k] = __builtin_amdgcn_exp2f(-(float)((d0 + k) & 15) * (13.287712379549449f / 16.0f));
        v2u nxb[3];
        if (gw < NTOK) { const GAS v2u* src = (const GAS v2u*)(WSP(bf16, WS_RAWQK) + (size_t)gw * 768) + lane;
#pragma unroll
            for (int j = 0; j < 3; ++j) nxb[j] = src[64 * j]; }
#pragma unroll 1
        for (int m = gw; m < NTOK; m += NGW) {
            f32x4 v[3];
#pragma unroll
            for (int j = 0; j < 3; ++j) { v[j].x = bf_lo(nxb[j].x); v[j].y = bf_hi(nxb[j].x); v[j].z = bf_lo(nxb[j].y); v[j].w = bf_hi(nxb[j].y); }
            const int m2 = m + NGW;
            if (m2 < NTOK) { const GAS v2u* src = (const GAS v2u*)(WSP(bf16, WS_RAWQK) + (size_t)m2 * 768) + lane;
#pragma unroll
                for (int j = 0; j < 3; ++j) nxb[j] = src[64 * j]; }
            if (rp_) rope_compute<true>(A, L, v, m, lane); else rope_compute<false>(A, L, v, m, lane);
        }
    }
    __syncthreads();
}

#define XIN_BASES() const float* const XLO = (FP8_MIX && layer == 0) ? A.in[I_XP] : A.out; const float* const XHI = (FP8_MIX && layer == 0) ? A.in[I_XS] - (size_t)NP * DM : A.out
#define XIN_ROW(m_) (((m_) < NP ? XLO : XHI) + (size_t)(m_) * DM)
template <int CTRL> __device__ __forceinline__ float dpp_mov(float v) { return __int_as_float(__builtin_amdgcn_update_dpp(0, __float_as_int(v), CTRL, 0xF, 0xF, true)); }
__device__ __forceinline__ float row16_sum(float v) { v += dpp_mov<0x128>(v); v += dpp_mov<0x124>(v); v += dpp_mov<0x122>(v); v += dpp_mov<0x121>(v); return v; }
__device__ __forceinline__ float swap16_sum(float a, float b) { const auto rr = __builtin_amdgcn_permlane16_swap(__float_as_uint(a), __float_as_uint(b), false, false); return __uint_as_float(rr[0]) + __uint_as_float(rr[1]); }
__device__ __forceinline__ float swap32_sum(float a, float b) { const auto rr = __builtin_amdgcn_permlane32_swap(__float_as_uint(a), __float_as_uint(b), false, false); return __uint_as_float(rr[0]) + __uint_as_float(rr[1]); }
__device__ __forceinline__ float swap16_max(float a) { const auto rr = __builtin_amdgcn_permlane16_swap(__float_as_uint(a), __float_as_uint(a), false, false); return fmaxf(__uint_as_float(rr[0]), __uint_as_float(rr[1])); }
__device__ __forceinline__ float swap32_max(float a) { const auto rr = __builtin_amdgcn_permlane32_swap(__float_as_uint(a), __float_as_uint(a), false, false); return fmaxf(__uint_as_float(rr[0]), __uint_as_float(rr[1])); }
__device__ __forceinline__ float wave_sum_x(float v) { v = row16_sum(v); v = swap16_sum(v, v); return swap32_sum(v, v); }
template <bool DRY> __device__ __forceinline__ void phase_ln1(const Args& A, const Frame& F0, int layer) {
    const Frame F = fresh_frame(F0);
    constexpr int NR = 2;
    typedef float f32x2v __attribute__((ext_vector_type(2)));
    const int gw = F.vcu * NWAVES + F.wave, NGW = F.G * NWAVES, lane = F.lane;
    const GAS f32x4* gp = (const GAS f32x4*)(A.in[I_L1G] + (size_t)layer * DM) + lane;
    const GAS f32x4* bp = (const GAS f32x4*)(A.in[I_L1B] + (size_t)layer * DM) + lane;
    XIN_BASES();
    float* AFFT = DRY ? WSP(float, WS_R1 + 420 * MiB) : WSP(float, WS_AFFT);
    float* XO = DRY ? WSP(float, WS_R1) : A.out; bf16* XBO = DRY ? WSP(bf16, WS_Z + 201326592) : WSP(bf16, WS_XB);
    { const GAS f32x4* wsrc = (const GAS f32x4*)(A.in[I_WR] + (size_t)layer * DM * NE);
      for (int idx = F.tid; idx < DM * 4; idx += NWAVES * 64) { const int d = idx >> 2, q = idx & 3; *(LAS f32x4*)(F.lds + RING_OFF + d * 64 + (d >> 2) * 16 + q * 16) = wsrc[idx]; }
      __syncthreads(); }
    f32x4 nx[NR][4]; unsigned nmx[NR][4];
#define LN1_LOADSET(mb_) do { const GAS f32x4* src = (const GAS f32x4*)XIN_ROW(mb_) + lane; const GAS unsigned* ms = (const GAS unsigned*)(WSP(unsigned char, WS_MIX8) + (size_t)(mb_) * DM) + lane; \
        _Pragma("unroll") for (int r = 0; r < NR; ++r) { \
            _Pragma("unroll") for (int j = 0; j < 4; ++j) nx[r][j] = __builtin_nontemporal_load(&src[r * (DM / 4) + 64 * j]); \
            _Pragma("unroll") for (int j = 0; j < 4; ++j) nmx[r][j] = FP8_MIX ? ms[r * (DM / 4) + 64 * j] : 0u; } } while (0)
    if (NR * gw < NTOK) LN1_LOADSET(NR * gw);
#pragma unroll 1
    for (int m0 = NR * gw; m0 < NTOK; m0 += NR * NGW) {
        int wlo = lane * 272; asm volatile("" : "+v"(wlo));
        const LAS unsigned char* wl = F.lds + RING_OFF + wlo;
        f32x4 v[NR][4]; float mean[NR], rstd[NR];
#pragma unroll
        for (int r = 0; r < NR; ++r) {
            float s = 0.f;
#pragma unroll
            for (int j = 0; j < 4; ++j) { v[r][j] = nx[r][j];
                if (FP8_MIX) { const f32x2v lo = __builtin_amdgcn_cvt_pk_f32_fp8((int)nmx[r][j], false), hi = __builtin_amdgcn_cvt_pk_f32_fp8((int)nmx[r][j], true);
                    v[r][j].x = __builtin_fmaf(v[r][j].x, DN_ALPHA, lo.x); v[r][j].y = __builtin_fmaf(v[r][j].y, DN_ALPHA, lo.y); v[r][j].z = __builtin_fmaf(v[r][j].z, DN_ALPHA, hi.x); v[r][j].w = __builtin_fmaf(v[r][j].w, DN_ALPHA, hi.y); }
                s += (v[r][j].x + v[r][j].y) + (v[r][j].z + v[r][j].w); }
            mean[r] = wave_sum_x(s) * (1.f / DM);
        }
        __builtin_amdgcn_sched_barrier(0);
        { const int m2 = m0 + NR * NGW; if (m2 < NTOK) LN1_LOADSET(m2); }
        __builtin_amdgcn_sched_barrier(0);
#pragma unroll
        for (int r = 0; r < NR; ++r) { float s2 = 0.f;
#pragma unroll
            for (int j = 0; j < 4; ++j) { v[r][j] = v[r][j] - mean[r]; s2 += (v[r][j].x * v[r][j].x + v[r][j].y * v[r][j].y) + (v[r][j].z * v[r][j].z + v[r][j].w * v[r][j].w); }
            rstd[r] = 1.f / sqrtf(wave_sum_x(s2) * (1.f / DM) + LN_EPS);
            if (!DRY && lane == 0) { *(GAS f32x2v*)(WSP(float, WS_STATS) + (size_t)(m0 + r) * 2) = (f32x2v){mean[r], rstd[r]}; } }
        { int go = lane; asm volatile("" : "+v"(go));
#pragma unroll
          for (int j = 0; j < 4; ++j) { const f32x4 g4 = gp[go - lane + 64 * j], b4 = bp[go - lane + 64 * j];
#pragma unroll
            for (int r = 0; r < NR; ++r) { v[r][j] = v[r][j] * rstd[r] * g4 + b4;
                if (DRY) ((GAS f32x4*)(XO + (size_t)(m0 + r) * DM) + lane)[64 * j] = v[r][j];
                if (FP8_E1 && !DRY) ((GAS unsigned*)(WSP(unsigned char, WS_XB8) + (size_t)(m0 + r) * DM))[lane + 64 * j] = pg8::pack4_fp8(v[r][j].x, v[r][j].y, v[r][j].z, v[r][j].w);
                if (!FP8_E1) { v2u w; w.x = pk2(v[r][j].x, v[r][j].y); w.y = pk2(v[r][j].z, v[r][j].w); ((GAS v2u*)(XBO + (size_t)(m0 + r) * DM) + lane)[64 * j] = w; } } } }
        f32x2v lg[NR][8];
#pragma unroll
        for (int r = 0; r < NR; ++r)
#pragma unroll
            for (int e = 0; e < 8; ++e) lg[r][e] = (f32x2v){0.f, 0.f};
        {
            f32x4 wc[4], wn[4];
#pragma unroll
            for (int q = 0; q < 4; ++q) wc[q] = *(const LAS f32x4*)(wl + 16 * q);
#pragma unroll
            for (int g = 0; g < 16; ++g) {
                if (g + 1 < 16) {
#pragma unroll
                    for (int q = 0; q < 4; ++q) wn[q] = *(const LAS f32x4*)(wl + 17408 * ((g + 1) >> 2) + 64 * ((g + 1) & 3) + 16 * q); }
                __builtin_amdgcn_sched_barrier(0);
#pragma unroll
                for (int q = 0; q < 4; ++q) { const f32x2v wa = {wc[q].x, wc[q].y}, wb = {wc[q].z, wc[q].w};
#pragma unroll
                    for (int r = 0; r < NR; ++r) { const float xv = v[r][g >> 2][g & 3]; const f32x2v x2 = {xv, xv};
                        lg[r][2 * q] = __builtin_elementwise_fma(x2, wa, lg[r][2 * q]); lg[r][2 * q + 1] = __builtin_elementwise_fma(x2, wb, lg[r][2 * q + 1]); } }
                static_assert(NR == 2, "the pin below names both rows' accumulators");
                asm volatile("" : "+v"(lg[0][0]), "+v"(lg[0][1]), "+v"(lg[0][2]), "+v"(lg[0][3]), "+v"(lg[0][4]), "+v"(lg[0][5]), "+v"(lg[0][6]), "+v"(lg[0][7]),
                                  "+v"(lg[1][0]), "+v"(lg[1][1]), "+v"(lg[1][2]), "+v"(lg[1][3]), "+v"(lg[1][4]), "+v"(lg[1][5]), "+v"(lg[1][6]), "+v"(lg[1][7]));
                __builtin_amdgcn_sched_barrier(0);
#pragma unroll
                for (int q = 0; q < 4; ++q) wc[q] = wn[q];
            }
        }
#pragma unroll
        for (int r = 0; r < NR; ++r) {
            float t[8], u[4];
#pragma unroll
            for (int i = 0; i < 8; ++i) t[i] = swap32_sum(lg[r][i >> 1][i & 1], lg[r][4 + (i >> 1)][i & 1]);
#pragma unroll
            for (int i = 0; i < 4; ++i) u[i] = row16_sum(swap16_sum(t[i], t[i + 4]));
            float mx = fmaxf(fmaxf(u[0], u[1]), fmaxf(u[2], u[3])); mx = swap32_max(swap16_max(mx));
            float den = 0.f;
#pragma unroll
            for (int i = 0; i < 4; ++i) { u[i] = __expf(u[i] - mx); den += u[i]; }
            den = swap16_sum(den, den); den = swap32_sum(den, den);
            const float inv = 1.0f / den;
            const int i4 = lane & 3, e = 4 * (lane >> 4) + i4;
            const float mine = (i4 == 0 ? u[0] : i4 == 1 ? u[1] : i4 == 2 ? u[2] : u[3]) * inv;
            const int m = m0 + r;
            if ((lane & 15) < 4) { float* dst = m < NP ? AFFT + (size_t)e * NP + m : AFFT + (size_t)NE * NP + (size_t)e * NS + (m - NP); *dst = mine; }
        }
    }
}

constexpr size_t SEL_ALT = WS_R1 + 900 * MiB - WS_SLOT;
__device__ __forceinline__ void select_slow(const Args& A, const Frame& F, int task, size_t alt = 0) {
    const int grp = task >> 4, e = task & 15, n = grp ? NS : NP, cap = n >> 3;
    const unsigned* keys = (const unsigned*)(grp ? WSP(float, WS_AFFT) + (size_t)NE * NP + (size_t)e * NS : WSP(float, WS_AFFT) + (size_t)e * NP);
    const int tokbase = grp ? NP : 0, slotbase = grp ? NE * (NP >> 3) + e * cap : e * cap;
    int* SLOT = WSP(int, WS_SLOT + alt); int* IDX = WSP(int, WS_IDX + alt); float* GVAL = WSP(float, WS_GVAL + alt);
    LAS unsigned* hist = (LAS unsigned*)(F.lds + RING_OFF);
    LAS unsigned* wsum = hist + 2048;
    LAS unsigned* bc = hist + 2048 + 64;
    const int tid = F.tid, lane = F.lane, wid = F.wave;
    unsigned prefix = 0u, pmask = 0u, k = (unsigned)cap;
#pragma unroll 1
    for (int pass = 0; pass < 3; ++pass) {
        const int shift = pass == 0 ? 21 : (pass == 1 ? 10 : 0);
        const unsigned dmask = pass == 2 ? 1023u : 2047u;
        for (int i = tid; i < 2048; i += NWAVES * 64) hist[i] = 0u;
        __syncthreads();
        for (int i = tid; i < n; i += NWAVES * 64) { const unsigned key = keys[i]; if ((key & pmask) == prefix) __hip_atomic_fetch_add(&hist[(key >> shift) & dmask], 1u, __ATOMIC_RELAXED, __HIP_MEMORY_SCOPE_WORKGROUP); }
        __syncthreads();
        const unsigned c0 = hist[4 * tid], c1 = hist[4 * tid + 1], c2 = hist[4 * tid + 2], c3 = hist[4 * tid + 3];
        const unsigned tsum = c0 + c1 + c2 + c3;
        unsigned inc = tsum;
#pragma unroll
        for (int o = 1; o < 64; o <<= 1) { const unsigned t2 = __shfl_down(inc, o); if (lane + o < 64) inc += t2; }
        if (lane == 0) wsum[wid] = inc;
        __syncthreads();
        unsigned above = inc - tsum;
        for (int w = wid + 1; w < NWAVES; ++w) above += wsum[w];
        unsigned a = above;
        if (a < k && a + c3 >= k) { bc[0] = 4 * tid + 3; bc[1] = k - a; } a += c3;
        if (a < k && a + c2 >= k) { bc[0] = 4 * tid + 2; bc[1] = k - a; } a += c2;
        if (a < k && a + c1 >= k) { bc[0] = 4 * tid + 1; bc[1] = k - a; } a += c1;
        if (a < k && a + c0 >= k) { bc[0] = 4 * tid + 0; bc[1] = k - a; }
        __syncthreads();
        const unsigned bin = bc[0]; k = bc[1];
        prefix |= bin << shift; pmask |= dmask << shift;
        __syncthreads();
    }
    const unsigned thr = prefix, need = k;
    const unsigned cnt_gt = (unsigned)cap - need;
    unsigned base_gt = 0u, base_eq = 0u;
    const unsigned long long lt_mask = (1ull << lane) - 1ull;
#pragma unroll 1
    for (int base = 0, it = 0; base < n; base += NWAVES * 64, ++it) {
        const unsigned key = keys[base + tid];
        const bool gt = key > thr, eq = key == thr;
        const unsigned long long bg = __ballot(gt), be = __ballot(eq);
        LAS unsigned* ws = wsum + 16 + (it & 1) * 16;
        if (lane == 0) { ws[wid] = (unsigned)__popcll(bg); ws[8 + wid] = (unsigned)__popcll(be); }
        __syncthreads();
        unsigned og = 0u, oe = 0u, tg = 0u, te = 0u;
#pragma unroll
        for (int w = 0; w < NWAVES; ++w) { const unsigned a = ws[w], b = ws[8 + w]; if (w < wid) { og += a; oe += b; } tg += a; te += b; }
        const unsigned rg = base_gt + og + (unsigned)__popcll(bg & lt_mask), re = base_eq + oe + (unsigned)__popcll(be & lt_mask);
        int srow = -1;
        if (gt) srow = slotbase + (int)rg;
        else if (eq && re < need) srow = slotbase + (int)(cnt_gt + re);
        const int tok = tokbase + base + tid;
        SLOT[(size_t)tok * NE + e] = srow;
        if (srow >= 0) { IDX[srow] = tok; GVAL[srow] = __uint_as_float(key); }
        base_gt += tg; base_eq += te;
    }
    __syncthreads();
}

constexpr int SEL_LISTCAP = 2048;
#define SEL_BIN(kk) ({ int b_ = (int)(__uint_as_float(kk) * 2048.0f); b_ = b_ > 2047 ? 2047 : b_; b_; })
#define SEL_LOAD64(hb) _Pragma("unroll") for (int i = 0; i < 64; ++i) key[i] = (unsigned)__builtin_amdgcn_raw_buffer_load_b32(krs, tid * 4, ((hb) * 64 + i) * 2048, 0)
template <int NH  > __device__ __forceinline__ bool select_fast(const Args& A, const Frame& F, int task, size_t alt = 0) {
    const int grp = task >> 4, e = task & 15, cap = NH * 64 * 64;
    const unsigned* keys = (const unsigned*)(grp ? WSP(float, WS_AFFT) + (size_t)NE * NP + (size_t)e * NS : WSP(float, WS_AFFT) + (size_t)e * NP);
    const int tokbase = grp ? NP : 0, slotbase = grp ? NE * (NP >> 3) + e * cap : e * cap;
    GAS int* SLOT = (GAS int*)WSP(int, WS_SLOT + alt); GAS int* IDX = (GAS int*)WSP(int, WS_IDX + alt); GAS float* GVAL = (GAS float*)WSP(float, WS_GVAL + alt);
    LAS unsigned* hist = (LAS unsigned*)(F.lds + RING_OFF);
    LAS unsigned* wsum = hist + 2048;
    LAS unsigned* bc = hist + 2048 + 64;
    LAS unsigned* lkey = hist + 4096;
    LAS unsigned* lidx = lkey + SEL_LISTCAP;
    LAS unsigned* tabc = lidx + SEL_LISTCAP;
    const int tid = F.tid, lane = F.lane, wid = F.wave;
    const __amdgpu_buffer_rsrc_t krs = __builtin_amdgcn_make_buffer_rsrc((void*)keys, 0, NH * 64 * 512 * 4, 0x00020000);
    unsigned key[64];
    for (int i = tid; i < 2048; i += NWAVES * 64) hist[i] = 0u;
    if (tid == 0) bc[2] = 0u;
    __syncthreads();
#pragma unroll 1
    for (int hb = 0; hb < NH; ++hb) {
        SEL_LOAD64(hb);
#pragma unroll
        for (int i = 0; i < 64; ++i) __hip_atomic_fetch_add(&hist[SEL_BIN(key[i])], 1u, __ATOMIC_RELAXED, __HIP_MEMORY_SCOPE_WORKGROUP);
    }
    __syncthreads();
    {
        const unsigned c0 = hist[4 * tid], c1 = hist[4 * tid + 1], c2 = hist[4 * tid + 2], c3 = hist[4 * tid + 3];
        const unsigned tsum = c0 + c1 + c2 + c3, k = (unsigned)cap;
        unsigned inc = tsum;
#pragma unroll
        for (int o = 1; o < 64; o <<= 1) { const unsigned t2 = __shfl_down(inc, o); if (lane + o < 64) inc += t2; }
        if (lane == 0) wsum[wid] = inc;
        __syncthreads();
        unsigned a = inc - tsum;
        for (int w = wid + 1; w < NWAVES; ++w) a += wsum[w];
        if (a < k && a + c3 >= k) { bc[0] = 4 * tid + 3; bc[1] = k - a; bc[3] = c3; } a += c3;
        if (a < k && a + c2 >= k) { bc[0] = 4 * tid + 2; bc[1] = k - a; bc[3] = c2; } a += c2;
        if (a < k && a + c1 >= k) { bc[0] = 4 * tid + 1; bc[1] = k - a; bc[3] = c1; } a += c1;
        if (a < k && a + c0 >= k) { bc[0] = 4 * tid + 0; bc[1] = k - a; bc[3] = c0; }
        __syncthreads();
    }
    const int tbin = (int)bc[0]; const unsigned kin = bc[1], m = bc[3];
    if (m > (unsigned)SEL_LISTCAP) return false;
#pragma unroll 1
    for (int hb = 0; hb < NH; ++hb) {
        SEL_LOAD64(hb);
#pragma unroll
        for (int i = 0; i < 64; ++i) if (SEL_BIN(key[i]) == tbin) { const unsigned p = __hip_atomic_fetch_add(&bc[2], 1u, __ATOMIC_RELAXED, __HIP_MEMORY_SCOPE_WORKGROUP); lkey[p] = key[i]; lidx[p] = (unsigned)((hb * 64 + i) * 512 + tid); }
    }
    __syncthreads();
    for (unsigned p = tid; p < m; p += NWAVES * 64) {
        const unsigned kp = lkey[p], ip = lidx[p]; unsigned rank = 0u;
        for (unsigned q = 0; q < m; ++q) { const unsigned kq = lkey[q], iq = lidx[q]; rank += (kq > kp || (kq == kp && iq < ip)) ? 1u : 0u; }
        if (rank == kin - 1u) { bc[4] = kp; bc[5] = ip; }
    }
    __syncthreads();
    const unsigned tkey = bc[4], tidx = bc[5];
    const unsigned long long lt_mask = (1ull << lane) - 1ull;
#pragma unroll 1
    for (int hb = 0; hb < NH; ++hb) {
        SEL_LOAD64(hb);
#pragma unroll
        for (int i = 0; i < 64; ++i) {
            const int b = SEL_BIN(key[i]); const unsigned ti = (unsigned)((hb * 64 + i) * 512 + tid);
            const bool sel = b > tbin || (b == tbin && (key[i] > tkey || (key[i] == tkey && ti <= tidx)));
            const unsigned long long bal = __ballot(sel);
            if (lane == 0) tabc[(hb * 64 + i) * 8 + wid] = (unsigned)__popcll(bal);
            if ((i & 7) == 7) __builtin_amdgcn_sched_barrier(0);
        }
    }
    __syncthreads();
    {
        unsigned v[NH], s = 0u;
#pragma unroll
        for (int q = 0; q < NH; ++q) { v[q] = tabc[NH * tid + q]; s += v[q]; }
        unsigned inc = s;
#pragma unroll
        for (int o = 1; o < 64; o <<= 1) { const unsigned t2 = __shfl_up(inc, o); if (lane >= o) inc += t2; }
        if (lane == 63) wsum[wid] = inc;
        __syncthreads();
        unsigned base = inc - s;
        for (int w = 0; w < wid; ++w) base += wsum[w];
#pragma unroll
        for (int q = 0; q < NH; ++q) { tabc[NH * tid + q] = base; base += v[q]; }
        __syncthreads();
    }
#pragma unroll 1
    for (int hb = 0; hb < NH; ++hb) {
        SEL_LOAD64(hb);
#pragma unroll
        for (int i = 0; i < 64; ++i) {
            const int b = SEL_BIN(key[i]); const unsigned ti = (unsigned)((hb * 64 + i) * 512 + tid);
            const bool sel = b > tbin || (b == tbin && (key[i] > tkey || (key[i] == tkey && ti <= tidx)));
            const unsigned long long bal = __ballot(sel);
            const int tok = tokbase + (hb * 64 + i) * 512 + tid;
            int srow = -1;
            if (sel) srow = slotbase + (int)(tabc[(hb * 64 + i) * 8 + wid] + (unsigned)__popcll(bal & lt_mask));
            SLOT[(size_t)tok * NE + e] = srow;
            if (sel) { IDX[srow] = tok; GVAL[srow] = __uint_as_float(key[i]); }
            if ((i & 7) == 7) __builtin_amdgcn_sched_barrier(0);
        }
    }
    __syncthreads();
    return true;
}
#undef SEL_BIN
#undef SEL_LOAD64
__device__ __forceinline__ void phase_select(const Args& A, const Frame& F0, size_t alt = 0) {
    const Frame F = fresh_frame(F0);
    const int task = blockIdx.x;
    if (task >= 2 * NE) return;
    const bool ok = (task >> 4) ? select_fast<NS / 32768>(A, F, task, alt) : select_fast<NP / 32768>(A, F, task, alt);
    if (!ok) { __syncthreads(); select_slow(A, F, task, alt); }
}

__device__ __forceinline__ void phase_gather(const Args& A, const Frame& F0) {
    const Frame F = fresh_frame(F0);
    const int gw = F.vcu * NWAVES + F.wave, NGW = F.G * NWAVES, lane = F.lane;
    const int* IDX = WSP(int, WS_IDX);
#pragma unroll 1
    for (int s = gw; s < NSLOTROWS; s += NGW) {
        const int tok = IDX[s];
        const GAS v4u* src = (const GAS v4u*)(WSP(bf16, WS_XB) + (size_t)tok * DM);
        GAS v4u* dst = (GAS v4u*)(WSP(bf16, WS_XG) + (size_t)s * DM);
        const v4u a = src[lane], b = src[lane + 64];
        dst[lane] = a; dst[lane + 64] = b;
    }
}

template <bool DRY> __device__ __forceinline__ void phase_ln2(const Args& A, const Frame& F0, int layer) {
    static_assert(FP8_YE, "the pipelined combine reads e4m3 expert rows");
    const Frame F = fresh_frame(F0);
    const int gw = F.vcu * NWAVES + F.wave, NGW = F.G * NWAVES, lane = F.lane;
    const GAS f32x4* gp = (const GAS f32x4*)(A.in[I_L2G] + (size_t)layer * DM) + lane;
    const GAS f32x4* bp = (const GAS f32x4*)(A.in[I_L2B] + (size_t)layer * DM) + lane;
    XIN_BASES();
    const int* SLOT = WSP(int, WS_SLOT); const float* GVAL = WSP(float, WS_GVAL);
    const unsigned char* YE = WSP(unsigned char, WS_YE);
    float* XO = DRY ? WSP(float, WS_R1) : A.out; bf16* XBO = DRY ? WSP(bf16, WS_Z + 201326592) : WSP(bf16, WS_XB);
    const GAS f32x4* g1p = (const GAS f32x4*)(A.in[I_L1G] + (size_t)layer * DM) + lane;
    const GAS f32x4* b1p = (const GAS f32x4*)(A.in[I_L1B] + (size_t)layer * DM) + lane;
    f32x4 g1[4], b1[4];
#pragma unroll
    for (int j = 0; j < 4; ++j) { g1[j] = g1p[64 * j]; b1[j] = b1p[64 * j]; }
    typedef float f32x2s __attribute__((ext_vector_type(2)));
    const GAS f32x2s* STATS = (const GAS f32x2s*)WSP(float, WS_STATS);
#define LN2_DECODE(sv_, gvl_, srow_, gv_, rest_) do { unsigned long long mk_ = __ballot((sv_) >= 0); \
        _Pragma("unroll") for (int b = 0; b < 4; ++b) { if (mk_) { const int e_ = __builtin_ctzll(mk_); mk_ &= mk_ - 1ull; srow_[b] = __builtin_amdgcn_readlane((sv_), e_); \
            gv_[b] = __builtin_bit_cast(float, __builtin_amdgcn_readlane(__builtin_bit_cast(int, (gvl_)), e_)); } else { srow_[b] = -1; gv_[b] = 0.f; } } rest_ = mk_; } while (0)
#define LN2_LOADROW(m_, y_, wb_, srow_) do { const GAS f32x4* xr_ = (const GAS f32x4*)XIN_ROW(m_) + lane; \
        _Pragma("unroll") for (int j = 0; j < 4; ++j) y_[j] = __builtin_nontemporal_load(&xr_[64 * j]);     \
        if (FP8_MIX) { const GAS unsigned* ms_ = (const GAS unsigned*)(WSP(unsigned char, WS_MIX8) + (size_t)(m_) * DM) + lane; _Pragma("unroll") for (int j = 0; j < 4; ++j) y_##mx[j] = ms_[64 * j]; } \
        _Pragma("unroll") for (int b = 0; b < 4; ++b) { if (srow_[b] >= 0) { const GAS unsigned* yr_ = (const GAS unsigned*)(YE + (size_t)srow_[b] * DM) + lane; \
            _Pragma("unroll") for (int j = 0; j < 4; ++j) wb_[b][j] = yr_[64 * j]; } else { _Pragma("unroll") for (int j = 0; j < 4; ++j) wb_[b][j] = 0u; } } } while (0)
    int svC = -1; float gvlC = 0.f; f32x2s stC = (f32x2s){0.f, 1.f};
    if (gw < NTOK) { svC = lane < NE ? SLOT[(size_t)gw * NE + lane] : -1; gvlC = svC >= 0 ? GVAL[svC] : 0.f; stC = STATS[gw]; }
    int svB = -1; float gvlB = 0.f; f32x2s stB = (f32x2s){0.f, 1.f};
    if (gw + NGW < NTOK) { svB = lane < NE ? SLOT[(size_t)(gw + NGW) * NE + lane] : -1; gvlB = svB >= 0 ? GVAL[svB] : 0.f; stB = STATS[gw + NGW]; }
    int srowC[4]; float gvC[4]; unsigned long long restC; f32x4 yC[4]; unsigned wbC[4][4]; unsigned yCmx[4] = {0u, 0u, 0u, 0u};
    LN2_DECODE(svC, gvlC, srowC, gvC, restC);
    if (gw < NTOK) LN2_LOADROW(gw, yC, wbC, srowC);
#pragma unroll 1
    for (int m = gw; m < NTOK; m += NGW) {
        const int m2 = m + NGW, m3 = m + 2 * NGW;
        int srowN[4]; float gvN[4]; unsigned long long restN; f32x4 yN[4]; unsigned wbN[4][4]; unsigned yNmx[4] = {0u, 0u, 0u, 0u};
        LN2_DECODE(svB, gvlB, srowN, gvN, restN);
        if (m2 < NTOK) LN2_LOADROW(m2, yN, wbN, srowN);
        int svNN = -1; f32x2s stNN = (f32x2s){0.f, 1.f};
        if (m3 < NTOK) { svNN = lane < NE ? SLOT[(size_t)m3 * NE + lane] : -1; stNN = STATS[m3]; }
        f32x4 v[4];
#pragma unroll
        for (int j = 0; j < 4; ++j) { f32x4 y = yC[j];
            if (FP8_MIX) { const f32x2s lo = __builtin_amdgcn_cvt_pk_f32_fp8((int)yCmx[j], false), hi = __builtin_amdgcn_cvt_pk_f32_fp8((int)yCmx[j], true);
                y.x = __builtin_fmaf(y.x, DN_ALPHA, lo.x); y.y = __builtin_fmaf(y.y, DN_ALPHA, lo.y); y.z = __builtin_fmaf(y.z, DN_ALPHA, hi.x); y.w = __builtin_fmaf(y.w, DN_ALPHA, hi.y); }
            v[j] = (((y - stC.x) * stC.y) * g1[j] + b1[j]) * DN_ALPHA; }
#pragma unroll
        for (int b = 0; b < 4; ++b)
#pragma unroll
            for (int j = 0; j < 4; ++j) { const f32x2s lo = __builtin_amdgcn_cvt_pk_f32_fp8((int)wbC[b][j], false), hi = __builtin_amdgcn_cvt_pk_f32_fp8((int)wbC[b][j], true);
                v[j].x += gvC[b] * lo.x; v[j].y += gvC[b] * lo.y; v[j].z += gvC[b] * hi.x; v[j].w += gvC[b] * hi.y; }
        while (restC) {
            const int e = __builtin_ctzll(restC); restC &= restC - 1ull;
            const int sr = __builtin_amdgcn_readlane(svC, e); const float ge = __builtin_bit_cast(float, __builtin_amdgcn_readlane(__builtin_bit_cast(int, gvlC), e));
            const GAS unsigned* yr = (const GAS unsigned*)(YE + (size_t)sr * DM) + lane;
            unsigned w1[4];
#pragma unroll
            for (int j = 0; j < 4; ++j) w1[j] = yr[64 * j];
#pragma unroll
            for (int j = 0; j < 4; ++j) { const f32x2s lo = __builtin_amdgcn_cvt_pk_f32_fp8((int)w1[j], false), hi = __builtin_amdgcn_cvt_pk_f32_fp8((int)w1[j], true);
                v[j].x += ge * lo.x; v[j].y += ge * lo.y; v[j].z += ge * hi.x; v[j].w += ge * hi.y; }
        }
        float s = 0.f;
#pragma unroll
        for (int j = 0; j < 4; ++j) s += (v[j].x + v[j].y) + (v[j].z + v[j].w);
        const float mean = wave_sum_x(s) * (1.f / DM); float s2 = 0.f;
#pragma unroll
        for (int j = 0; j < 4; ++j) { v[j] = v[j] - mean; s2 += (v[j].x * v[j].x + v[j].y * v[j].y) + (v[j].z * v[j].z + v[j].w * v[j].w); }
        const float rstd = 1.f / sqrtf(wave_sum_x(s2) * (1.f / DM) + LN_EPS);
        GAS v2u* bo = (GAS v2u*)(XBO + (size_t)m * DM) + lane; GAS f32x4* xw = (GAS f32x4*)(XO + (size_t)m * DM) + lane;
#pragma unroll
        for (int j = 0; j < 4; ++j) { v[j] = v[j] * rstd * gp[64 * j] + bp[64 * j]; __builtin_nontemporal_store(v[j], &xw[64 * j]);
            if (FP8_G1) { if (!DRY && layer + 1 < DEPTH) ((GAS unsigned*)(WSP(unsigned char, WS_XB8) + (size_t)m * DM))[lane + 64 * j] = pg8::pack4_fp8(v[j].x, v[j].y, v[j].z, v[j].w); }
            else { v2u w2; w2.x = pk2(v[j].x, v[j].y); w2.y = pk2(v[j].z, v[j].w); bo[64 * j] = w2; } }
        float gvlNN = svNN >= 0 ? GVAL[svNN] : 0.f;
        __builtin_amdgcn_sched_barrier(0);
        svC = svB; gvlC = gvlB; stC = stB; restC = restN;
#pragma unroll
        for (int b = 0; b < 4; ++b) { srowC[b] = srowN[b]; gvC[b] = gvN[b];
#pragma unroll
            for (int j = 0; j < 4; ++j) wbC[b][j] = wbN[b][j]; }
#pragma unroll
        for (int j = 0; j < 4; ++j) { yC[j] = yN[j]; yCmx[j] = yNmx[j]; }
        svB = svNN; gvlB = gvlNN; stB = stNN;
    }
#undef LN2_DECODE
#undef LN2_LOADROW
}

__device__ __forceinline__ bool gqa_next(int i, int vcu, int G, long& qrow0, long& kvrow0, int& NT, int& h) {
    const long U = (long)i * G + vcu;
    if (U >= 3072) return false;
    if (U < 2048) { const int ii = (int)(U >> 8), v = (int)(U & 255), xcd = v >> 5, cu = v & 31;
        const int pair = 2 * xcd + (ii >> 2), b = pair >> 1, kvh = pair & 1; h = kvh * 4 + (ii & 3);
        kvrow0 = (long)NP + (long)b * SEQ_S; qrow0 = kvrow0 + 256 * cu; NT = SEQ_S / 64; }
    else { const int U2 = (int)(U - 2048), jj = U2 >> 8, v = U2 & 255, xcd = v >> 5, cu = v & 31;
        const int pair = 2 * xcd + (jj >> 1), b = pair >> 1, kvh = pair & 1; h = kvh * 4 + (jj & 1) * 2 + (cu >> 4);
        kvrow0 = (long)b * SEQ_P; qrow0 = kvrow0 + 256 * (cu & 15); NT = SEQ_P / 64; }
    return true;
}

__global__ void __launch_bounds__(NWAVES * 64, 2) trunk_fwd(Args A) {
    extern __shared__ __attribute__((aligned(16))) unsigned char lds[];
    Frame F;
    F.lds = (LAS unsigned char*)lds;
    F.tid = threadIdx.x; F.lane = F.tid & 63; F.wave = __builtin_amdgcn_readfirstlane(F.tid >> 6);
    F.G = gridDim.x; { const int bx = blockIdx.x; F.vcu = (F.G % 8 == 0) ? (bx % 8) * (F.G / 8) + bx / 8 : bx; }
#ifdef ZERO_ALL_LDS
    for (int u = F.tid; u < LDS_BYTES / 4; u += NWAVES * 64) ((LAS unsigned*)(F.lds))[u] = 0u;
#else
    for (int u = F.tid; u < (LDS_BYTES - LDSCTL_OFF) / 4; u += NWAVES * 64) ((LAS unsigned*)(F.lds + LDSCTL_OFF))[u] = 0u;
#endif
    __syncthreads();
    unsigned* barw = (unsigned*)(A.ws + WS_CTL) + CW_BAR;
    XcdBarrier bar; bar.bar = barw; bar.x = 0; bar.st = nullptr;
    if (N_LAUNCHES == 1) bar = xcd_barrier_post(barw, (volatile LAS unsigned*)(F.lds + MISC_OFF) + 8);

    const int lo = A.ph_lo, hi = A.ph_hi;
#ifdef TOUCH_PAGES
    { unsigned acc_ = 0u; const size_t gt_ = (size_t)blockIdx.x * 512 + threadIdx.x, NT_ = (size_t)gridDim.x * 512;
      for (size_t pg = gt_; pg < WS_END / 4096; pg += NT_) acc_ += *(const GAS unsigned*)(A.ws + pg * 4096);
      for (size_t pg = gt_; pg < (size_t)NTOK * DM * 4 / 4096; pg += NT_) acc_ += *(const GAS unsigned*)((const char*)A.out + pg * 4096);
      for (int k_ = 0; k_ < 17; ++k_) { const size_t nb_ = k_ < 2 ? (size_t)(k_ ? NS : NP) * DM * 4 : (k_ == I_WG || k_ == I_WU || k_ == I_WD) ? (size_t)DEPTH * NE * DM * DF * 4 : (k_ == I_WIN ? (size_t)DEPTH * DM * D_IN * 4 : (size_t)4096);
          for (size_t pg = gt_; pg < nb_ / 4096; pg += NT_) acc_ += *(const GAS unsigned*)((const char*)A.in[k_] + pg * 4096); }
      asm volatile("" :: "v"(acc_)); }
#endif
#define IN(k) (lo <= (k) && (k) < hi)
#ifndef PHASE_MASK
#define PHASE_MASK 0xFFF
#endif
#define PHON(p) (((PHASE_MASK) >> (p)) & 1)
#ifdef XB_DOUBLE
#define SEAM(k) do { if (N_LAUNCHES == 1) { if (IN((k) + 1)) { xcd_barrier(bar); xcd_barrier(bar); } } } while (0)
#else
#define SEAM(k) do { if (N_LAUNCHES == 1) { if (IN((k) + 1)) xcd_barrier(bar); } } while (0)
#endif
#define DET_COMPARE(offA, offB, nbytes) do { xcd_barrier(bar); const Frame F2 = fresh_frame(F); const size_t gt = (size_t)(F2.vcu * NWAVES + F2.wave) * 64 + F2.lane, NT_ = (size_t)F2.G * NWAVES * 64; unsigned bad = 0u; \
        for (size_t q = gt; q < (size_t)(nbytes) / 16; q += NT_) { const v4u a = ((const GAS v4u*)(A.ws + (offA)))[q], b = ((const GAS v4u*)(A.ws + (offB)))[q]; bad |= (a.x ^ b.x) | (a.y ^ b.y) | (a.z ^ b.z) | (a.w ^ b.w); } \
        if (bad) __hip_atomic_fetch_add((unsigned*)(A.ws + WS_CTL) + 8, 1u, __ATOMIC_RELAXED, __HIP_MEMORY_SCOPE_AGENT); } while (0)

#pragma unroll 1
    for (int layer = 0; layer < DEPTH; ++layer) {
        const int P0 = layer * PH_PER_LAYER;
        if (PHON(0) && IN(P0 + 0) && (layer == 0 || N_LAUNCHES != 1)) { phase_conv<0>(A, F, layer, F.vcu * NWAVES + F.wave, F.G * NWAVES); SEAM(P0 + 0); }
        if (PHON(1) && IN(P0 + 1)) {
            pg8::Gemm g{FP8_G1 ? WSP(bf16, WS_XB8) : WSP(bf16, WS_XB), WSP(bf16, WS_WIN), NTOK, D_IN, FP8_G1 ? DM / 2 : DM}; pg8::TileOrder<0> S; S.init(NTOK / 256, D_IN / 256, F.G, (int)blockIdx.x);
#if ROPE_FUSED
            pg8::EpiProjRope E{WSP(bf16, WS_NAQKV), WSP(bf16, WS_QKVB), WSP(unsigned char, WS_GATES), A.in[I_QN] + layer * 64, A.in[I_KN] + layer * 64, (PG8_LAS float*)(F.lds + LDSCTL_OFF + 512), QSCALE, FP8_G1 ? 1.0f / WIN_SCALE : 1.0f};
            for (int rep_ = 0; rep_ < NREP(1); ++rep_) pg8::gemm_phase<pg8::EpiProjRope, pg8::TileOrder<0>, true, true, FP8_G1 != 0>(F.lds + RING_OFF, g, S, E);
#else
            pg8::EpiProj E{WSP(bf16, WS_NAQKV), WSP(bf16, WS_RAWQK), WSP(unsigned char, WS_GATES), QSCALE, FP8_G1 ? 1.0f / WIN_SCALE : 1.0f};
            for (int rep_ = 0; rep_ < NREP(1); ++rep_) pg8::gemm_phase<pg8::EpiProj, pg8::TileOrder<0>, true, true, FP8_G1 != 0>(F.lds + RING_OFF, g, S, E);
#endif
#if defined(DETPROBE) && (DETPROBE & (1 << 1))
            { pg8::EpiProj E2{WSP(bf16, WS_R2), WSP(bf16, WS_R2 + (size_t)NTOK * 1536 * 2), WSP(unsigned char, WS_GATES), QSCALE, FP8_G1 ? 1.0f / WIN_SCALE : 1.0f};
              pg8::gemm_phase<pg8::EpiProj, pg8::TileOrder<0>, true, true, FP8_G1 != 0>(F.lds + RING_OFF, g, S, E2); }
            DET_COMPARE(WS_NAQKV, WS_R2, (size_t)NTOK * 1536 * 2 + (size_t)NTOK * 768 * 4);
#endif
            SEAM(P0 + 1);
        }
        if (PHON(2) && IN(P0 + 2)) { phase_na(A, F, layer);
#if defined(DETPROBE) && (DETPROBE & (1 << 2))
            xcd_barrier(bar);
            { const Frame F2 = fresh_frame(F); const int gw = F2.vcu * NWAVES + F2.wave, NGW = F2.G * NWAVES; unsigned bad = 0u;
              for (int m = gw; m < NTOK; m += NGW) { const v4u a = ((const GAS v4u*)(WSP(bf16, WS_ATT) + (size_t)m * 512))[F2.lane], b = ((const GAS v4u*)(WSP(bf16, WS_Z) + (size_t)m * 512))[F2.lane];
                  bad |= (a.x ^ b.x) | (a.y ^ b.y) | (a.z ^ b.z) | (a.w ^ b.w); }
              if (bad) __hip_atomic_fetch_add((unsigned*)(A.ws + WS_CTL) + 8, 1u, __ATOMIC_RELAXED, __HIP_MEMORY_SCOPE_AGENT); }
#endif
            if (!ROPE_FUSED) SEAM(P0 + 2); }
        if (PHON(3) && IN(P0 + 3)) {
            const attn_body::bf16* QKV = (const attn_body::bf16*)WSP(bf16, WS_QKVB); const unsigned char* QKV8 = WSP(unsigned char, WS_QKVB);
            long qrow0, kvrow0; int NT, h;
            float gb; { const Frame F2 = fresh_frame(F); float gq_ = fabsf(A.in[I_QN][layer * 64 + F2.lane]), gk_ = fabsf(A.in[I_KN][layer * 64 + F2.lane]);
#pragma unroll
                for (int o_ = 32; o_ >= 1; o_ >>= 1) { gq_ = fmaxf(gq_, __shfl_xor(gq_, o_)); gk_ = fmaxf(gk_, __shfl_xor(gk_, o_)); }
                gb = __builtin_amdgcn_readfirstlane(gq_ * gk_ * (8.0f * 1.4426950408889634f * 1.01f)); }
            for (int rep_ = 0; rep_ < NREP(3); ++rep_)
            if (gb < 64.0f) {
            for (int i = 0; gqa_next(i, F.vcu, F.G, qrow0, kvrow0, NT, h); ++i)
                attn_body::attn_unit<8, true, FP8_BR != 0, FP8_QK != 0>(qrow0, kvrow0, NT, FP8_QK ? (const attn_body::bf16*)(QKV8 + h * 64) : QKV + h * 64, FP8_QK ? (const attn_body::bf16*)(QKV8 + 512 + (h >> 2) * 64) : QKV + 512 + (h >> 2) * 64, FP8_QK ? (const attn_body::bf16*)(QKV8 + 640) + (h >> 2) * 64 : QKV + 640 + (h >> 2) * 64,
                                        FP8_BR ? (attn_body::bf16*)(WSP(unsigned char, WS_ATT) + (size_t)NTOK * 512 + h * 64) : (attn_body::bf16*)WSP(bf16, WS_ATT) + (size_t)NTOK * 512 + h * 64, (char*)lds + RING_OFF);
            } else {
            for (int i = 0; gqa_next(i, F.vcu, F.G, qrow0, kvrow0, NT, h); ++i)
                attn_body::attn_unit<8, false, FP8_BR != 0, FP8_QK != 0>(qrow0, kvrow0, NT, FP8_QK ? (const attn_body::bf16*)(QKV8 + h * 64) : QKV + h * 64, FP8_QK ? (const attn_body::bf16*)(QKV8 + 512 + (h >> 2) * 64) : QKV + 512 + (h >> 2) * 64, FP8_QK ? (const attn_body::bf16*)(QKV8 + 640) + (h >> 2) * 64 : QKV + 640 + (h >> 2) * 64,
                                        FP8_BR ? (attn_body::bf16*)(WSP(unsigned char, WS_ATT) + (size_t)NTOK * 512 + h * 64) : (attn_body::bf16*)WSP(bf16, WS_ATT) + (size_t)NTOK * 512 + h * 64, (char*)lds + RING_OFF);
            }
#if defined(DETPROBE) && (DETPROBE & (1 << 3))
            for (int i = 0; gqa_next(i, F.vcu, F.G, qrow0, kvrow0, NT, h); ++i)
                attn_body::attn_unit<8>(qrow0, kvrow0, NT, QKV + h * 64, QKV + 512 + (h >> 2) * 64, QKV + 640 + (h >> 2) * 64,
                                        (attn_body::bf16*)WSP(bf16, WS_Z) + h * 64, (char*)lds + RING_OFF);
            xcd_barrier(bar);
            { const Frame F2 = fresh_frame(F); const int gw = F2.vcu * NWAVES + F2.wave, NGW = F2.G * NWAVES; unsigned bad = 0u;
              for (int m = gw; m < NTOK; m += NGW) { const v4u a = ((const GAS v4u*)(WSP(bf16, WS_ATT) + (size_t)NTOK * 512 + (size_t)m * 512))[F2.lane], b = ((const GAS v4u*)(WSP(bf16, WS_Z) + (size_t)m * 512))[F2.lane];
                  bad |= (a.x ^ b.x) | (a.y ^ b.y) | (a.z ^ b.z) | (a.w ^ b.w); }
              if (bad) __hip_atomic_fetch_add((unsigned*)(A.ws + WS_CTL) + 8, 1u, __ATOMIC_RELAXED, __HIP_MEMORY_SCOPE_AGENT); }
#endif
            SEAM(P0 + 3);
        }
        if (PHON(4) && IN(P0 + 4)) {
            pg8::Gemm g{WSP(bf16, WS_ATT), WSP(bf16, WS_WBR), 2 * NTOK, 1024, FP8_BR ? 256 : 512}; pg8::TileOrder<3> S; S.init(NTOK / 256, 4, F.G, (int)blockIdx.x);
            pg8::EpiBranch E{WSP(unsigned char, WS_GATES), WSP(bf16, WS_Z), FP8_OUT ? WSP(unsigned char, WS_QKVB) : nullptr, FP8_BR ? 1.0f / (ATT_SCALE * WBR_SCALE) : 1.0f};
            for (int rep_ = 0; rep_ < NREP(4); ++rep_) pg8::gemm_phase<pg8::EpiBranch, pg8::TileOrder<3>, true, true, FP8_BR != 0>(F.lds + RING_OFF, g, S, E);
#if defined(DETPROBE) && (DETPROBE & (1 << 4))
            { pg8::EpiBranch E2{WSP(unsigned char, WS_GATES), WSP(bf16, WS_QKVB), nullptr, 1.0f}; pg8::gemm_phase<pg8::EpiBranch, pg8::TileOrder<3>, true, true>(F.lds + RING_OFF, g, S, E2); }
            DET_COMPARE(WS_Z, WS_QKVB, (size_t)NTOK * DM * 2);
#endif
            SEAM(P0 + 4);
        }
        if (PHON(5) && IN(P0 + 5)) {
            pg8::Gemm g{FP8_OUT ? WSP(bf16, WS_QKVB) : WSP(bf16, WS_Z), WSP(bf16, WS_WOUT), NTOK, DM, FP8_OUT ? DM / 2 : DM}; pg8::TileOrder<0> S; S.init(NTOK / 256, DM / 256, F.G, (int)blockIdx.x);
            pg8::EpiResid<FP8_MIX != 0> E{A.out, DN_ALPHA, FP8_OUT ? 1.0f / WOUT_SCALE : 1.0f, WSP(unsigned char, WS_MIX8)};
            for (int rep_ = 0; rep_ < NREP(5); ++rep_) pg8::gemm_phase<pg8::EpiResid<FP8_MIX != 0>, pg8::TileOrder<0>, true, true, FP8_OUT != 0>(F.lds + RING_OFF, g, S, E);
            SEAM(P0 + 5);
        }
        if (PHON(6) && IN(P0 + 6)) { if (NREP(13) > 1) { const Frame F2 = fresh_frame(F); const int gw = F2.vcu * NWAVES + F2.wave, NGW = F2.G * NWAVES, lane = F2.lane, d0 = 4 * (lane & 15);
                RopeLane L; L.gq = *(const GAS f32x4*)(A.in[I_QN] + layer * 64 + d0); L.gk = *(const GAS f32x4*)(A.in[I_KN] + layer * 64 + d0);
                for (int k = 0; k < 4; ++k) L.invf[k] = __builtin_amdgcn_exp2f(-(float)((d0 + k) & 15) * (13.287712379549449f / 16.0f));
#pragma unroll 1
                for (int m = gw; m < NTOK; m += NGW) { f32x4 v[3]; const GAS v2u* src = (const GAS v2u*)(WSP(bf16, WS_RAWQK) + (size_t)m * 768) + lane;
                    for (int j = 0; j < 3; ++j) { const v2u w_ = src[64 * j]; v[j].x = bf_lo(w_.x); v[j].y = bf_hi(w_.x); v[j].z = bf_lo(w_.y); v[j].w = bf_hi(w_.y); }
                    rope_compute<true>(A, L, v, m, lane); } }
            if (NREP(6) > 1) phase_ln1<true>(A, F, layer); phase_ln1<false>(A, F, layer);
#if defined(DETPROBE) && (DETPROBE & (1 << 6))
            DET_COMPARE(WS_AFFT, WS_R1 + 420 * MiB, (size_t)NTOK * NE * 4);
#endif
            SEAM(P0 + 6); }
        if (PHON(7) && IN(P0 + 7)) {
            for (int rep_ = 0; rep_ < NREP(7); ++rep_) {
            phase_select(A, F);
#if defined(DETPROBE) && (DETPROBE & (1 << 7))
            phase_select(A, F, SEL_ALT);
#endif
            if (F.G > 2 * NE) { if ((int)blockIdx.x >= 2 * NE) conv_experts(A, F, layer, ((int)blockIdx.x - 2 * NE) * NWAVES + F.wave, (F.G - 2 * NE) * NWAVES); }
            else conv_experts(A, F, layer, (int)blockIdx.x * NWAVES + F.wave, F.G * NWAVES);
            }
#if defined(DETPROBE) && (DETPROBE & (1 << 7))
            DET_COMPARE(WS_SLOT, WS_SLOT + SEL_ALT, (size_t)NTOK * NE * 4 + 2 * (size_t)NSLOTROWS * 4);
#endif
            SEAM(P0 + 7); }
        if (PHON(9) && IN(P0 + 9)) {
            pg8::Gemm g{FP8_E1 ? WSP(bf16, WS_XB8) : WSP(bf16, WS_XB), WSP(bf16, WS_W1), NSLOTROWS, 4096, FP8_E1 ? DM / 2 : DM}; pg8::TileOrderGather S; S.init(NSLOTROWS / 256, 16, F.G, (int)blockIdx.x); S.gidx = WSP(int, WS_IDX);
            pg8::EpiSwiGLU<FP8_E2 != 0> E{WSP(void, WS_H), FP8_E1 ? 1.0f / W1_SCALE : 1.0f};
            for (int rep_ = 0; rep_ < NREP(9); ++rep_) pg8::gemm_phase<pg8::EpiSwiGLU<FP8_E2 != 0>, pg8::TileOrderGather, true, true, FP8_E1 != 0>(F.lds + RING_OFF, g, S, E);
#if defined(DETPROBE) && (DETPROBE & (1 << 9))
            { pg8::EpiSwiGLU<FP8_E2 != 0> E2{WSP(void, WS_R1 + 448 * MiB), FP8_E1 ? 1.0f / W1_SCALE : 1.0f}; pg8::gemm_phase<pg8::EpiSwiGLU<FP8_E2 != 0>, pg8::TileOrderGather, true, true, FP8_E1 != 0>(F.lds + RING_OFF, g, S, E2); }
            DET_COMPARE(WS_H, WS_R1 + 448 * MiB, (size_t)NSLOTROWS * DF * (FP8_E2 ? 1 : 2));
#endif
            SEAM(P0 + 9);
        }
        if (PHON(10) && IN(P0 + 10)) {
            pg8::Gemm g{WSP(bf16, WS_H), WSP(bf16, WS_W2), NSLOTROWS, DM, FP8_E2 ? DF / 2 : DF}; pg8::TileOrder<2> S; S.init(NSLOTROWS / 256, 4, F.G, (int)blockIdx.x);
            pg8::EpiDown<FP8_YE != 0> E{WSP(void, WS_YE), FP8_E2 ? 1.0f / W2_SCALE : 1.0f};
            for (int rep_ = 0; rep_ < NREP(10); ++rep_) pg8::gemm_phase<pg8::EpiDown<FP8_YE != 0>, pg8::TileOrder<2>, true, true, FP8_E2 != 0>(F.lds + RING_OFF, g, S, E);
#if defined(DETPROBE) && (DETPROBE & (1 << 10))
            { pg8::EpiDown<FP8_YE != 0> E2{WSP(void, WS_R1 + 512 * MiB), FP8_E2 ? 1.0f / W2_SCALE : 1.0f}; pg8::gemm_phase<pg8::EpiDown<FP8_YE != 0>, pg8::TileOrder<2>, true, true, FP8_E2 != 0>(F.lds + RING_OFF, g, S, E2); }
            DET_COMPARE(WS_YE, WS_R1 + 512 * MiB, (size_t)NSLOTROWS * DM * 2);
#endif
            SEAM(P0 + 10);
        }
        if (PHON(11) && IN(P0 + 11)) { if (NREP(11) > 1) phase_ln2<true>(A, F, layer); phase_ln2<false>(A, F, layer);
            if (N_LAUNCHES == 1 && layer + 1 < DEPTH) phase_conv<0>(A, F, layer + 1, F.vcu * NWAVES + F.wave, F.G * NWAVES);
            SEAM(P0 + 11); }
    }
#if defined(DETPROBE)
    xcd_barrier(bar);
    if (blockIdx.x == 0 && threadIdx.x == 0 && __hip_atomic_load((unsigned*)(A.ws + WS_CTL) + 8, __ATOMIC_RELAXED, __HIP_MEMORY_SCOPE_AGENT) != 0u) A.out[0] = __builtin_nanf("");
#endif
#undef IN
#undef SEAM
}

extern "C" void kernel_launch(void* const* d_in, const int* in_sizes, int n_in, void* d_out, int out_size, void* d_ws, size_t ws_size, hipStream_t stream) {
    static int grid = 0;
    if (grid == 0) {
        if (n_in != 17 || out_size != NTOK * DM || ws_size < WS_END) { fprintf(stderr, "kernel_launch: built for 17 inputs, %d outputs, >= %zu bytes of workspace; got n_in %d, out %d, ws %zu; nothing launched\n", NTOK * DM, (size_t)WS_END, n_in, out_size, ws_size); grid = -1; return; }
        int dev = 0, cus = 0, per_cu = 0;
        if (hipGetDevice(&dev) != hipSuccess || hipDeviceGetAttribute(&cus, hipDeviceAttributeMultiprocessorCount, dev) != hipSuccess) { fprintf(stderr, "kernel_launch: hipGetDevice / hipDeviceGetAttribute failed\n"); grid = -1; return; }
        if (hipFuncSetAttribute((const void*)trunk_fwd, hipFuncAttributeMaxDynamicSharedMemorySize, LDS_BYTES) != hipSuccess) { fprintf(stderr, "kernel_launch: hipFuncSetAttribute failed\n"); grid = -1; return; }
        if (hipOccupancyMaxActiveBlocksPerMultiprocessor(&per_cu, (const void*)trunk_fwd, NWAVES * 64, LDS_BYTES) != hipSuccess || per_cu < 1)
            fprintf(stderr, "kernel_launch: note: occupancy query reports %d workgroups per CU\n", per_cu);
        (void)hipGetLastError();
        grid = cus;
    }
    if (grid < 0) return;
    if (hipMemsetAsync((char*)d_ws + WS_CTL, 0, CTL_ZERO_BYTES, stream) != hipSuccess) { fprintf(stderr, "kernel_launch: hipMemsetAsync failed\n"); return; }
#ifdef POISON_WS
    (void)hipMemsetAsync((char*)d_ws + 2 * MiB, 0xAA, WS_END - 2 * MiB, stream); (void)hipMemsetAsync(d_out, 0xAA, (size_t)NTOK * DM * 4, stream);
#endif
    Args a{};
    for (int i = 0; i < 17; ++i) a.in[i] = (const float*)d_in[i];
    a.out = (float*)d_out; a.ws = (unsigned char*)d_ws;
    for (int li = 0; li < N_LAUNCHES; ++li) {
        a.ph_lo = (N_LAUNCHES == 1) ? 0 : li; a.ph_hi = (N_LAUNCHES == 1) ? N_PHASES : li + 1;
        hipLaunchKernelGGL(trunk_fwd, dim3(grid), dim3(NWAVES * 64), LDS_BYTES, stream, a);
        const hipError_t le = hipPeekAtLastError();
        if (le != hipSuccess) { fprintf(stderr, "kernel_launch: launch %d failed: %s\n", li, hipGetErrorName(le)); break; }
    }
}
```

```cpp
#include <hip/hip_runtime.h>
#include <hip/hip_bf16.h>
#include <cstdio>
#include <cstdint>
#include <cmath>
#include <type_traits>

#ifndef MK_N_LAUNCHES
#define MK_N_LAUNCHES 1
#endif

namespace pg8 {
#define PG8_LAS __attribute__((address_space(3)))
typedef unsigned short bf16_t;
typedef short bf16x8 __attribute__((ext_vector_type(8)));
typedef float f32x4 __attribute__((ext_vector_type(4)));
typedef unsigned u32x4 __attribute__((ext_vector_type(4)));
constexpr int BM = 256, BK = 64, HALF = 128, HTB = HALF * BK * 2  , STAGE_BYTES = 8 * HTB, NXCD = 8, WGM = 8;

__host__ __device__ __forceinline__ int lds_byte(int r, int c) { const int st = (r >> 4) * 2 + (c >> 5), rr = r & 15, cc = c & 31, ob = rr * 64 + cc * 2; return st * 1024 + (ob ^ (((ob >> 9) & 1) << 5)); }
__host__ __device__ __forceinline__ void stage_rc(int b, int& R, int& C) { const int st = b / 1024, sb = b % 1024, swz = sb ^ (((sb >> 9) & 1) << 5); R = (st >> 1) * 16 + swz / 64; C = (st & 1) * 32 + (swz % 64) / 2; }
__host__ __device__ __forceinline__ int perm32(int rho) { const int n = rho >> 4, i = rho & 15; return 8 * (i >> 2) + 4 * n + (i & 3); }

struct Unit { int pm, pn; };
struct Gemm { const bf16_t* A; const bf16_t* Bt; int M, N, K; };

template <int MODE> struct TileOrder {
    int nM, nN, nwg, G, c;
    __host__ __device__ void init(int nM_, int nN_, int G_, int c_) { nM = nM_; nN = nN_; nwg = nM * nN; G = G_; c = c_; }
    __host__ __device__ bool next(int i, Unit& u) const {
        const long L = (MODE == 3) ? (long)(i >> 1) * G + c : (long)i * G + c; if (L >= nwg) return false;
        int wgid = (int)L; { const int q = nwg / NXCD, r = nwg % NXCD, xcd = wgid % NXCD, off = wgid / NXCD; wgid = (xcd < r ? xcd * (q + 1) : r * (q + 1) + (xcd - r) * q) + off; }
        const int nig = WGM * nN, gid = wgid / nig, fm = gid * WGM, gsz = (nM - fm) < WGM ? (nM - fm) : WGM;
        const int pm = fm + ((wgid % nig) % gsz), pn = (wgid % nig) / gsz;
        int grp = 0;
        if (MODE == 1) grp = pm / 384;
        if (MODE == 2) grp = pm < 256 ? (pm >> 4) : ((pm - 256) >> 5);
        if (MODE == 3) { grp = i & 1; u.pm = grp * nM + pm; u.pn = grp * nN + pn; return true; }
        u.pm = pm; u.pn = grp * nN + pn; return true;
    }
    static constexpr bool GATHER = false; const int* gidx;
    __device__ __forceinline__ void a_ready(const Unit&) const {}
    __device__ __forceinline__ void done(const Unit&) const {}
};
struct TileOrderGather : TileOrder<2> { static constexpr bool GATHER = true; };

typedef float f32x2_c __attribute__((ext_vector_type(2))); typedef __bf16 bf16x2_c __attribute__((ext_vector_type(2)));
__device__ __forceinline__ unsigned cvt_pk_bf16(float lo, float hi) { const f32x2_c v = {lo, hi}; const bf16x2_c b = __builtin_convertvector(v, bf16x2_c); return __builtin_bit_cast(unsigned, b); }
__device__ __forceinline__ u32x4 pack8(const f32x4 a, const f32x4 b) { u32x4 w; w.x = cvt_pk_bf16(a[0], a[1]); w.y = cvt_pk_bf16(a[2], a[3]); w.z = cvt_pk_bf16(b[0], b[1]); w.w = cvt_pk_bf16(b[2], b[3]); return w; }
__device__ __forceinline__ float bfbits2f(unsigned v16) { return __uint_as_float(v16 << 16); }
__device__ __forceinline__ float sigmoid_f(float v) { return __builtin_amdgcn_rcpf(1.0f + __builtin_amdgcn_exp2f(-1.4426950408889634f * v)); }
__device__ __forceinline__ f32x4 exp2_4(const f32x4 v) { return (f32x4){__builtin_amdgcn_exp2f(v[0]), __builtin_amdgcn_exp2f(v[1]), __builtin_amdgcn_exp2f(v[2]), __builtin_amdgcn_exp2f(v[3])}; }
__device__ __forceinline__ f32x4 rcp_4(const f32x4 v) { return (f32x4){__builtin_amdgcn_rcpf(v[0]), __builtin_amdgcn_rcpf(v[1]), __builtin_amdgcn_rcpf(v[2]), __builtin_amdgcn_rcpf(v[3])}; }
__device__ __forceinline__ f32x4 sigmoid_scaled4(const f32x4 a, const float cneg) { return rcp_4(exp2_4(a * cneg) + 1.0f); }

typedef unsigned u32x2 __attribute__((ext_vector_type(2)));
__device__ __forceinline__ unsigned pack4_fp8(float a, float b, float c, float d) { int w = 0; w = __builtin_amdgcn_cvt_pk_fp8_f32(a, b, w, false); w = __builtin_amdgcn_cvt_pk_fp8_f32(c, d, w, true); return (unsigned)w; }

struct EpiProj {
    static constexpr bool PERM = true, AFTER_DRAIN = false;
    bf16_t* NAQKV;
    bf16_t* RAW;
    unsigned char* GATES;
    float qscale, ascale;
    __device__ __forceinline__ void operator()(const f32x4 (&acc)[2][2][4][2], const Unit& u, int wr, int wc, int fr, int fq) const {
        const int pn = u.pn;
        const size_t row0 = (size_t)u.pm * BM + wr * 64 + fr; const int colw = wc * 32 + 8 * fq;
        if (pn < 6) {
            const float sc = (pn < 2 ? qscale : 1.0f) * ascale;
#pragma unroll
            for (int ai = 0; ai < 2; ++ai)
#pragma unroll
                for (int m = 0; m < 4; ++m)
#pragma unroll
                    for (int bj = 0; bj < 2; ++bj)
                        *(u32x4*)(NAQKV + (row0 + ai * HALF + m * 16) * 1536 + pn * BM + bj * HALF + colw) = pack8(acc[ai][bj][m][0] * sc, acc[ai][bj][m][1] * sc);
        } else if (pn < 9) {
#pragma unroll
            for (int ai = 0; ai < 2; ++ai)
#pragma unroll
                for (int m = 0; m < 4; ++m)
#pragma unroll
                    for (int bj = 0; bj < 2; ++bj) *(u32x4*)(RAW + (row0 + ai * HALF + m * 16) * 768 + (pn - 6) * BM + bj * HALF + colw) = pack8(acc[ai][bj][m][0] * ascale, acc[ai][bj][m][1] * ascale);
        } else {
#pragma unroll
            for (int ai = 0; ai < 2; ++ai)
#pragma unroll
                for (int m = 0; m < 4; ++m)
#pragma unroll
                    for (int bj = 0; bj < 2; ++bj) { f32x4 v0 = acc[ai][bj][m][0] * ascale, v1 = acc[ai][bj][m][1] * ascale;
#pragma unroll
                        for (int k = 0; k < 4; ++k) { v0[k] = sigmoid_f(v0[k]); v1[k] = sigmoid_f(v1[k]); }
                        u32x2 w8; w8.x = pack4_fp8(v0[0], v0[1], v0[2], v0[3]); w8.y = pack4_fp8(v1[0], v1[1], v1[2], v1[3]);
                        *(u32x2*)(GATES + (row0 + ai * HALF + m * 16) * 2048 + (pn - 9) * BM + bj * HALF + colw) = w8; }
        }
    }
};
struct EpiBranch {
    static constexpr bool PERM = true, AFTER_DRAIN = false;
    const unsigned char* GATES; bf16_t* Z; unsigned char* Z8; float ascale;
    template <bool G1> __device__ __forceinline__ void body8(const f32x4 (&acc)[2][2][4][2], const size_t row0, const int col0) const {
        typedef float f32x2g __attribute__((ext_vector_type(2)));
#pragma unroll
        for (int ai = 0; ai < 2; ++ai) {
            u32x2 g[4][2], z[4][2];
#pragma unroll
            for (int m = 0; m < 4; ++m)
#pragma unroll
                for (int bj = 0; bj < 2; ++bj) {
                    g[m][bj] = *(const u32x2*)(GATES + (row0 + ai * HALF + m * 16) * 2048 + (G1 ? 1024 : 0) + col0 + bj * HALF);
                    if (G1) z[m][bj] = *(const u32x2*)(Z8 + (row0 + ai * HALF + m * 16) * 1024 + col0 + bj * HALF); }
#pragma unroll
            for (int m = 0; m < 4; ++m)
#pragma unroll
                for (int bj = 0; bj < 2; ++bj) {
                    const u32x2 gw = g[m][bj];
                    const f32x2g a0 = __builtin_amdgcn_cvt_pk_f32_fp8((int)gw.x, false), a1 = __builtin_amdgcn_cvt_pk_f32_fp8((int)gw.x, true), a2 = __builtin_amdgcn_cvt_pk_f32_fp8((int)gw.y, false), a3 = __builtin_amdgcn_cvt_pk_f32_fp8((int)gw.y, true);
                    f32x4 v0 = acc[ai][bj][m][0] * ((f32x4){a0.x, a0.y, a1.x, a1.y} * ascale), v1 = acc[ai][bj][m][1] * ((f32x4){a2.x, a2.y, a3.x, a3.y} * ascale);
                    if (G1) { const u32x2 zw = z[m][bj];
                        const f32x2g b0 = __builtin_amdgcn_cvt_pk_f32_fp8((int)zw.x, false), b1 = __builtin_amdgcn_cvt_pk_f32_fp8((int)zw.x, true), b2 = __builtin_amdgcn_cvt_pk_f32_fp8((int)zw.y, false), b3 = __builtin_amdgcn_cvt_pk_f32_fp8((int)zw.y, true);
                        v0 = v0 + (f32x4){b0.x, b0.y, b1.x, b1.y}; v1 = v1 + (f32x4){b2.x, b2.y, b3.x, b3.y}; }
                    u32x2 w8; w8.x = pack4_fp8(v0[0], v0[1], v0[2], v0[3]); w8.y = pack4_fp8(v1[0], v1[1], v1[2], v1[3]);
                    *(u32x2*)(Z8 + (row0 + ai * HALF + m * 16) * 1024 + col0 + bj * HALF) = w8; }
            __builtin_amdgcn_sched_barrier(0);
        }
    }
    __device__ __forceinline__ void operator()(const f32x4 (&acc)[2][2][4][2], const Unit& u, int wr, int wc, int fr, int fq) const {
        const int grp = u.pm >= 384 ? 1 : 0, pm = u.pm - grp * 384, pn = u.pn & 3;
        if (Z8) { const size_t row0 = (size_t)pm * BM + wr * 64 + fr; const int col0 = pn * BM + wc * 32 + 8 * fq;
            if (grp) body8<true>(acc, row0, col0); else body8<false>(acc, row0, col0);
            return; }
#pragma unroll
        for (int ai = 0; ai < 2; ++ai)
#pragma unroll
            for (int m = 0; m < 4; ++m) {
                const size_t row = (size_t)pm * BM + ai * HALF + wr * 64 + m * 16 + fr;
#pragma unroll
                for (int bj = 0; bj < 2; ++bj) {
                    const int col = pn * BM + bj * HALF + wc * 32 + 8 * fq;
                    const u32x2 g = *(const u32x2*)(GATES + row * 2048 + grp * 1024 + col);
                    f32x4 v0 = acc[ai][bj][m][0], v1 = acc[ai][bj][m][1];
                    { typedef float f32x2g __attribute__((ext_vector_type(2)));
                      const f32x2g a0 = __builtin_amdgcn_cvt_pk_f32_fp8((int)g.x, false), a1 = __builtin_amdgcn_cvt_pk_f32_fp8((int)g.x, true), a2 = __builtin_amdgcn_cvt_pk_f32_fp8((int)g.y, false), a3 = __builtin_amdgcn_cvt_pk_f32_fp8((int)g.y, true);
                      v0[0] *= a0.x; v0[1] *= a0.y; v0[2] *= a1.x; v0[3] *= a1.y; v1[0] *= a2.x; v1[1] *= a2.y; v1[2] *= a3.x; v1[3] *= a3.y; }
                    bf16_t* zp = Z + row * 1024 + col;
                    if (grp) { const u32x4 z = *(const u32x4*)zp;
                        v0[0] += bfbits2f(z.x & 0xffffu); v0[1] += bfbits2f(z.x >> 16); v0[2] += bfbits2f(z.y & 0xffffu); v0[3] += bfbits2f(z.y >> 16);
                        v1[0] += bfbits2f(z.z & 0xffffu); v1[1] += bfbits2f(z.z >> 16); v1[2] += bfbits2f(z.w & 0xffffu); v1[3] += bfbits2f(z.w >> 16); }
                    *(u32x4*)zp = pack8(v0, v1);
                }
            }
    }
};
template <bool MIX8> struct EpiResid {
    static constexpr bool PERM = true, AFTER_DRAIN = false;
    float* X; float alpha, ascale; unsigned char* M8;
    __device__ __forceinline__ void operator()(const f32x4 (&acc)[2][2][4][2], const Unit& u, int wr, int wc, int fr, int fq) const {
#pragma unroll
        for (int ai = 0; ai < 2; ++ai)
#pragma unroll
            for (int m = 0; m < 4; ++m) {
                const size_t row = (size_t)u.pm * BM + ai * HALF + wr * 64 + m * 16 + fr;
#pragma unroll
                for (int bj = 0; bj < 2; ++bj) {
                    const size_t off = row * 1024 + u.pn * BM + bj * HALF + wc * 32 + 8 * fq;
                    if constexpr (MIX8) { const f32x4 m0 = acc[ai][bj][m][0] * ascale, m1 = acc[ai][bj][m][1] * ascale; u32x2 w8; w8.x = pack4_fp8(m0[0], m0[1], m0[2], m0[3]); w8.y = pack4_fp8(m1[0], m1[1], m1[2], m1[3]);
                        *(u32x2*)(M8 + off) = w8; }
                    else { float* p = X + off; const f32x4 x0 = *(const f32x4*)p, x1 = *(const f32x4*)(p + 4);
                        *(f32x4*)p = x0 * alpha + acc[ai][bj][m][0] * ascale; *(f32x4*)(p + 4) = x1 * alpha + acc[ai][bj][m][1] * ascale; }
                }
            }
    }
};
template <bool FP8OUT> struct EpiSwiGLU {
    static constexpr bool PERM = true, AFTER_DRAIN = false;
    void* H; float ascale;
    __device__ __forceinline__ void operator()(const f32x4 (&acc)[2][2][4][2], const Unit& u, int wr, int wc, int fr, int fq) const {
        const int pn = u.pn & 15;
#pragma unroll
        for (int ai = 0; ai < 2; ++ai)
#pragma unroll
            for (int m = 0; m < 4; ++m) {
                const size_t row = (size_t)u.pm * BM + ai * HALF + wr * 64 + m * 16 + fr;
                const float cneg = -1.4426950408889634f * ascale, s2 = ascale * ascale;
                const f32x4 h0 = (acc[ai][0][m][0] * acc[ai][1][m][0]) * (sigmoid_scaled4(acc[ai][0][m][0], cneg) * s2);
                const f32x4 h1 = (acc[ai][0][m][1] * acc[ai][1][m][1]) * (sigmoid_scaled4(acc[ai][0][m][1], cneg) * s2);
                const size_t off = row * 2048 + pn * HALF + wc * 32 + 8 * fq;
                if (FP8OUT) { u32x2 w; w.x = pack4_fp8(h0[0], h0[1], h0[2], h0[3]); w.y = pack4_fp8(h1[0], h1[1], h1[2], h1[3]); *(u32x2*)((unsigned char*)H + off) = w; }
                else *(u32x4*)((bf16_t*)H + off) = pack8(h0, h1);
            }
    }
};
template <bool FP8OUT> struct EpiDown {
    static constexpr bool PERM = true, AFTER_DRAIN = false;
    void* YE; float ascale;
    __device__ __forceinline__ void operator()(const f32x4 (&acc)[2][2][4][2], const Unit& u, int wr, int wc, int fr, int fq) const {
        const int pn = u.pn & 3;
#pragma unroll
        for (int ai = 0; ai < 2; ++ai)
#pragma unroll
            for (int m = 0; m < 4; ++m) {
                const size_t row = (size_t)u.pm * BM + ai * HALF + wr * 64 + m * 16 + fr;
#pragma unroll
                for (int bj = 0; bj < 2; ++bj)
                { const f32x4 v0 = acc[ai][bj][m][0] * ascale, v1 = acc[ai][bj][m][1] * ascale; const size_t off = row * 1024 + pn * BM + bj * HALF + wc * 32 + 8 * fq;
                  if (FP8OUT) { u32x2 w8; w8.x = pack4_fp8(v0[0], v0[1], v0[2], v0[3]); w8.y = pack4_fp8(v1[0], v1[1], v1[2], v1[3]); *(u32x2*)((unsigned char*)YE + off) = w8; }
                  else *(u32x4*)((bf16_t*)YE + off) = pack8(v0, v1); }
            }
    }
};

template <class Epi, class Sched, bool ALIGN_EPI = false, bool SP2 = false, bool FP8 = false>
__device__ __forceinline__ void gemm_phase(PG8_LAS unsigned char* lds, const Gemm g, const Sched& S, const Epi& E) {
    int tid_ = threadIdx.x; asm volatile("" : "+v"(tid_));
    const int tid = tid_, wid = __builtin_amdgcn_readfirstlane(tid >> 6), lane = tid & 63, wr = wid >> 2, wc = wid & 3, fr = lane & 15, fq = lane >> 4;
    const int K = g.K, nt = K / BK;
    unsigned voffA[2], voffB[2]; int gR[2]; unsigned gC[2];
#pragma unroll
    for (int i = 0; i < 2; ++i) { int R, C; stage_rc(tid * 16 + i * 8192, R, C); const int Rb = Epi::PERM ? ((R & ~31) + perm32(R & 31)) : R;
        voffA[i] = (unsigned)(R * K + C) * 2u; voffB[i] = (unsigned)(Rb * K + C) * 2u; gR[i] = R; gC[i] = (unsigned)C * 2u; }
    constexpr bool GATH = Sched::GATHER; static_assert(!GATH || SP2, "the gather variant is written for the SP2 loop");
    unsigned oc[2][2] = {{0u, 0u}, {0u, 0u}}, on[2][2] = {{0u, 0u}, {0u, 0u}};
#define PG8_GOFF(o, unit) do { _Pragma("unroll") for (int _h = 0; _h < 2; ++_h) _Pragma("unroll") for (int _i = 0; _i < 2; ++_i) \
        (o)[_h][_i] = (unsigned)S.gidx[(unit).pm * BM + _h * HALF + gR[_i]] * (unsigned)(K * 2) + gC[_i]; } while (0)
    const size_t kstep = (size_t)(BK * 2);
    const size_t hstep = (size_t)HALF * K * 2;
    const size_t tstep = 2 * hstep;
    const unsigned ldsw = (unsigned)wid * 1024u;
    const int aoff = lds_byte(wr * 64 + fr, fq * 8), boff = lds_byte(wc * 32 + fr, fq * 8);
    typedef int i32x4_t __attribute__((ext_vector_type(4))); typedef int i32x8_t __attribute__((ext_vector_type(8)));
    int sc8 = 0x7F7F7F7F; asm volatile("" : "+v"(sc8));
#define PG8_SA(b, h) (((b) * 2 + (h)) * HTB)
#define PG8_SB(b, h) ((4 + (b) * 2 + (h)) * HTB)
#define PG8_STAGE(bufoff, gbase, voff) do { _Pragma("unroll") for (int _i = 0; _i < 2; ++_i) \
        __builtin_amdgcn_global_load_lds((const unsigned*)((const char*)(gbase) + (voff)[_i]), (PG8_LAS unsigned*)(lds + (bufoff) + ldsw + _i * 8192), 16, 0, 0); } while (0)
#define PG8_LD32(p) __builtin_shufflevector(*(const PG8_LAS i32x4_t*)(p), *(const PG8_LAS i32x4_t*)((p) + 1024), 0, 1, 2, 3, 4, 5, 6, 7)
#define PG8_LDA(dst, b, h) do { if constexpr (FP8) { _Pragma("unroll") for (int m = 0; m < 4; ++m) dst##8[m] = PG8_LD32(lds + PG8_SA(b, h) + aoff + m * 2048); } else { \
        _Pragma("unroll") for (int m = 0; m < 4; ++m) _Pragma("unroll") for (int k = 0; k < 2; ++k) dst[m][k] = *(const PG8_LAS bf16x8*)(lds + PG8_SA(b, h) + aoff + m * 2048 + k * 1024); } } while (0)
#define PG8_LDB(dst, b, h) do { if constexpr (FP8) { _Pragma("unroll") for (int n = 0; n < 2; ++n) dst##8[n] = PG8_LD32(lds + PG8_SB(b, h) + boff + n * 2048); } else { \
        _Pragma("unroll") for (int n = 0; n < 2; ++n) _Pragma("unroll") for (int k = 0; k < 2; ++k) dst[n][k] = *(const PG8_LAS bf16x8*)(lds + PG8_SB(b, h) + boff + n * 2048 + k * 1024); } } while (0)
#define PG8_MMA(ai, bj, At, Bt) do { __builtin_amdgcn_s_setprio(1); if constexpr (FP8) { _Pragma("unroll") for (int m = 0; m < 4; ++m) _Pragma("unroll") for (int n = 0; n < 2; ++n) \
        asm volatile("v_mfma_scale_f32_16x16x128_f8f6f4 %0, %1, %2, %0, %3, %3 op_sel_hi:[0,0,0]" : "+v"(acc[ai][bj][m][n]) : "v"(Bt##8[n]), "v"(At##8[m]), "v"(sc8)); } else { \
        _Pragma("unroll") for (int m = 0; m < 4; ++m) _Pragma("unroll") for (int n = 0; n < 2; ++n) _Pragma("unroll") for (int k = 0; k < 2; ++k) \
        acc[ai][bj][m][n] = __builtin_amdgcn_mfma_f32_16x16x32_bf16(Bt[n][k], At[m][k], acc[ai][bj][m][n], 0, 0, 0); } __builtin_amdgcn_s_setprio(0); } while (0)
#define PG8_WAIT_V(n) asm volatile("s_waitcnt vmcnt(" #n ")" ::: "memory")
#define PG8_WAIT_L(n) asm volatile("s_waitcnt lgkmcnt(" #n ")" ::: "memory")
#define PG8_BAR __builtin_amdgcn_s_barrier()
#define PG8_SCHED __builtin_amdgcn_sched_barrier(0)
    Unit cur, nxt; int ui = 0;
    if (!S.next(0, cur)) return;
    f32x4 acc[2][2][4][2];
#pragma unroll
    for (int a = 0; a < 2; ++a)
#pragma unroll
        for (int b = 0; b < 2; ++b)
#pragma unroll
            for (int m = 0; m < 4; ++m)
#pragma unroll
                for (int n = 0; n < 2; ++n) acc[a][b][m][n] = (f32x4){0.f, 0.f, 0.f, 0.f};
    bf16x8 At[4][2], B0[2][2], B1[2][2]; i32x8_t At8[4], B08[2], B18[2];
    const char* const gA = (const char*)g.A;
    const char* cA = (const char*)g.A + (size_t)cur.pm * tstep; const char* cB = (const char*)g.Bt + (size_t)cur.pn * tstep;
    S.a_ready(cur);
    if constexpr (SP2) {
        if constexpr (GATH) { PG8_GOFF(oc, cur); }
        PG8_STAGE(PG8_SB(0, 0), cB, voffB); PG8_STAGE(PG8_SB(0, 1), cB + hstep, voffB);
        if constexpr (GATH) { PG8_STAGE(PG8_SA(0, 0), gA, oc[0]); PG8_STAGE(PG8_SA(0, 1), gA, oc[1]); } else { PG8_STAGE(PG8_SA(0, 0), cA, voffA); PG8_STAGE(PG8_SA(0, 1), cA + hstep, voffA); }
        if (wr == 1) PG8_BAR;
        PG8_WAIT_V(2); PG8_BAR;
        PG8_STAGE(PG8_SB(1, 0), cB + kstep, voffB); if constexpr (GATH) { PG8_STAGE(PG8_SA(1, 0), gA + kstep, oc[0]); } else { PG8_STAGE(PG8_SA(1, 0), cA + kstep, voffA); } PG8_STAGE(PG8_SB(1, 1), cB + hstep + kstep, voffB);
        PG8_WAIT_V(6); PG8_BAR;
    } else {
        PG8_STAGE(PG8_SB(0, 0), cB, voffB); PG8_STAGE(PG8_SA(0, 0), cA, voffA); PG8_STAGE(PG8_SB(0, 1), cB + hstep, voffB); PG8_STAGE(PG8_SA(0, 1), cA + hstep, voffA);
        if (wr == 1) PG8_BAR;
        PG8_WAIT_V(4); PG8_BAR;
        PG8_STAGE(PG8_SB(1, 0), cB + kstep, voffB); PG8_STAGE(PG8_SA(1, 0), cA + kstep, voffA); PG8_STAGE(PG8_SB(1, 1), cB + hstep + kstep, voffB);
        PG8_WAIT_V(6); PG8_BAR;
    }
    for (;;) {
        const bool has_next = S.next(ui + 1, nxt);
        if constexpr (GATH) { if (has_next) { PG8_GOFF(on, nxt); } else { _Pragma("unroll") for (int _h = 0; _h < 2; ++_h) _Pragma("unroll") for (int _i = 0; _i < 2; ++_i) on[_h][_i] = oc[_h][_i]; } }
        const char* nA = has_next ? (const char*)g.A + (size_t)nxt.pm * tstep : cA; const char* nB = has_next ? (const char*)g.Bt + (size_t)nxt.pn * tstep : cB;
        for (int t = 0; t < nt; t += 2) {
            const bool last = (t == nt - 2);
            const char* a1 = cA + (size_t)(t + 1) * kstep;
            const char* a2 = last ? nA : cA + (size_t)(t + 2) * kstep; const char* b2 = last ? nB : cB + (size_t)(t + 2) * kstep;
            const char* a3 = a2 + kstep; const char* b3 = b2 + kstep;
            if (last && has_next) S.a_ready(nxt);
            const char* ga1 = gA + (size_t)(t + 1) * kstep; const char* ga2 = last ? gA : gA + (size_t)(t + 2) * kstep;
            unsigned os0[2], os1[2];
            if constexpr (GATH) { os0[0] = last ? on[0][0] : oc[0][0]; os0[1] = last ? on[0][1] : oc[0][1]; os1[0] = last ? on[1][0] : oc[1][0]; os1[1] = last ? on[1][1] : oc[1][1]; }
            if constexpr (SP2) {
            PG8_LDB(B0, 0, 0); PG8_LDB(B1, 0, 1); PG8_SCHED; PG8_LDA(At, 0, 0); if constexpr (GATH) { PG8_STAGE(PG8_SA(1, 1), ga1, oc[1]); } else { PG8_STAGE(PG8_SA(1, 1), a1 + hstep, voffA); }
            PG8_WAIT_V(8); PG8_WAIT_L(0); PG8_BAR; PG8_MMA(0, 0, At, B0); PG8_MMA(0, 1, At, B1); PG8_BAR; PG8_SCHED;
            PG8_LDA(At, 0, 1); PG8_STAGE(PG8_SB(0, 0), b2, voffB); PG8_STAGE(PG8_SB(0, 1), b2 + hstep, voffB); if constexpr (GATH) { PG8_STAGE(PG8_SA(0, 0), ga2, os0); } else { PG8_STAGE(PG8_SA(0, 0), a2, voffA); }
            PG8_WAIT_V(8); PG8_WAIT_L(0); PG8_BAR; PG8_MMA(1, 0, At, B0); PG8_MMA(1, 1, At, B1); PG8_BAR; PG8_SCHED;
            PG8_LDB(B0, 1, 0); PG8_LDB(B1, 1, 1); PG8_SCHED; PG8_LDA(At, 1, 0); if constexpr (GATH) { PG8_STAGE(PG8_SA(0, 1), ga2, os1); } else { PG8_STAGE(PG8_SA(0, 1), a2 + hstep, voffA); }
            PG8_WAIT_V(8); PG8_WAIT_L(0); PG8_BAR; PG8_MMA(0, 0, At, B0); PG8_MMA(0, 1, At, B1); PG8_BAR; PG8_SCHED;
            PG8_LDA(At, 1, 1); PG8_STAGE(PG8_SB(1, 0), b3, voffB); PG8_STAGE(PG8_SB(1, 1), b3 + hstep, voffB); if constexpr (GATH) { PG8_STAGE(PG8_SA(1, 0), ga2 + kstep, os0); } else { PG8_STAGE(PG8_SA(1, 0), a3, voffA); }
            PG8_WAIT_V(8); PG8_WAIT_L(0); PG8_BAR; PG8_MMA(1, 0, At, B0); PG8_MMA(1, 1, At, B1); PG8_BAR; PG8_SCHED;
            } else {
            PG8_LDB(B0, 0, 0); PG8_SCHED; PG8_LDA(At, 0, 0); PG8_STAGE(PG8_SA(1, 1), a1 + hstep, voffA);
            PG8_WAIT_L(8); PG8_BAR; PG8_WAIT_L(0); PG8_MMA(0, 0, At, B0); PG8_BAR; PG8_SCHED;
            PG8_LDB(B1, 0, 1); PG8_STAGE(PG8_SB(0, 0), b2, voffB);
            PG8_BAR; PG8_WAIT_L(0); PG8_MMA(0, 1, At, B1); PG8_BAR;
            PG8_LDA(At, 0, 1); PG8_STAGE(PG8_SA(0, 0), a2, voffA);
            PG8_BAR; PG8_WAIT_L(0); PG8_MMA(1, 0, At, B0); PG8_BAR; PG8_SCHED;
            PG8_STAGE(PG8_SB(0, 1), b2 + hstep, voffB);
            PG8_WAIT_V(6); PG8_BAR; PG8_MMA(1, 1, At, B1); PG8_BAR;
            PG8_LDB(B0, 1, 0); PG8_SCHED; PG8_LDA(At, 1, 0); PG8_STAGE(PG8_SA(0, 1), a2 + hstep, voffA);
            PG8_WAIT_L(8); PG8_BAR; PG8_WAIT_L(0); PG8_MMA(0, 0, At, B0); PG8_BAR; PG8_SCHED;
            PG8_LDB(B1, 1, 1); PG8_STAGE(PG8_SB(1, 0), b3, voffB);
            PG8_BAR; PG8_WAIT_L(0); PG8_MMA(0, 1, At, B1); PG8_BAR;
            PG8_LDA(At, 1, 1); PG8_STAGE(PG8_SA(1, 0), a3, voffA);
            PG8_BAR; PG8_WAIT_L(0); PG8_MMA(1, 0, At, B0); PG8_BAR; PG8_SCHED;
            PG8_STAGE(PG8_SB(1, 1), b3 + hstep, voffB);
            PG8_WAIT_V(6); PG8_BAR; PG8_MMA(1, 1, At, B1); PG8_BAR;
            }
        }
        if constexpr (ALIGN_EPI) { if (wr == 0) PG8_BAR; }
        if constexpr (FP8) asm volatile("s_nop 15\n\ts_nop 15" ::: "memory");
        if constexpr (!Epi::AFTER_DRAIN) { E(acc, cur, wr, wc, fr, fq); S.done(cur); }
        if (!has_next) break;
#pragma unroll
        for (int a = 0; a < 2; ++a)
#pragma unroll
            for (int b = 0; b < 2; ++b)
#pragma unroll
                for (int m = 0; m < 4; ++m)
#pragma unroll
                    for (int n = 0; n < 2; ++n) acc[a][b][m][n] = (f32x4){0.f, 0.f, 0.f, 0.f};
        cur = nxt; cA = nA; cB = nB; ++ui;
        if constexpr (GATH) { _Pragma("unroll") for (int _h = 0; _h < 2; ++_h) _Pragma("unroll") for (int _i = 0; _i < 2; ++_i) oc[_h][_i] = on[_h][_i]; }
        if constexpr (ALIGN_EPI) { if (wr == 1) PG8_BAR; }
    }
    PG8_WAIT_V(0);
    if constexpr (!ALIGN_EPI) { if (wr == 0) PG8_BAR; }
    PG8_BAR;
    if constexpr (Epi::AFTER_DRAIN) { E.fused(acc, cur, wr, wc, fr, fq, lds, wid, lane); S.done(cur); }
#undef PG8_SA
#undef PG8_SB
#undef PG8_STAGE
#undef PG8_LDA
#undef PG8_LDB
#undef PG8_MMA
#undef PG8_WAIT_V
#undef PG8_WAIT_L
#undef PG8_BAR
#undef PG8_SCHED
#undef PG8_LD32
#undef PG8_GOFF
}

}

namespace attn_body {

using bf16=__hip_bfloat16;
using bf16x8=__attribute__((ext_vector_type(8)))short;
using s16x4=__attribute__((ext_vector_type(4)))short;
using f32x16=__attribute__((ext_vector_type(16)))float;
using u32x4=__attribute__((ext_vector_type(4)))unsigned;
constexpr int D=64,QP=768,KP=768,VP=768,OP=512;
constexpr int NW=8,QBLK=32,QB=QBLK*NW,KVBLK=64;
constexpr int ATTN_UNIT_ROWS=QB;
__device__ __forceinline__ int crow(int r,int hi){return (r&3)+8*(r>>2)+4*hi;}
#define SBAR() __builtin_amdgcn_sched_barrier(0)
constexpr int NSLOT=3, SLOTB=8192;
constexpr int LDS_K=0, LDS_V=NSLOT*SLOTB, LDS_WS=2*NSLOT*SLOTB, LDS_OST=LDS_WS+NW*64*4, LDS_BYTES=LDS_OST+NW*4096;
constexpr float C2=0.125f*1.4426950408889634f;
__device__ __forceinline__ void glds16(const void*gsrc,unsigned lds_dst){unsigned keep;
  asm volatile("s_mov_b32 %0, m0\n\ts_mov_b32 m0, %2\n\ts_nop 0\n\tglobal_load_lds_dwordx4 %1, off\n\ts_mov_b32 m0, %0":"=&s"(keep):"v"(gsrc),"s"(lds_dst):"memory");}
__device__ __forceinline__ float max3f(float a,float b,float c){float r;asm("v_max3_f32 %0, %1, %2, %3":"=v"(r):"v"(a),"v"(b),"v"(c));return r;}
__device__ __forceinline__ float max2f(float a,float b){float r;asm("v_max_f32_e32 %0, %1, %2":"=v"(r):"v"(a),"v"(b));return r;}
__device__ __forceinline__ float fadd_s(float a,float b){float r;asm("v_add_f32_e32 %0, %1, %2":"=v"(r):"v"(a),"v"(b));return r;}
__device__ __forceinline__ float fsub_s(float a,float b){float r;asm("v_sub_f32_e32 %0, %1, %2":"=v"(r):"v"(a),"v"(b));return r;}
typedef float f32x2_t __attribute__((ext_vector_type(2))); typedef __bf16 bf16x2_t __attribute__((ext_vector_type(2)));
__device__ __forceinline__ unsigned cvtpk_s(float lo,float hi){f32x2_t v={lo,hi};bf16x2_t b=__builtin_convertvector(v,bf16x2_t);return __builtin_bit_cast(unsigned,b);}
#define WAIT_BAR(N) asm volatile("s_waitcnt vmcnt(" #N ") lgkmcnt(0)\n\ts_barrier":::"memory")

__device__ __forceinline__ void qkt(f32x16&p0,f32x16&p1,const char*Kslot,const bf16x8*qr,const f32x16&negm,int r32,int hi){
  const char*kb=Kslot+hi*1024+r32*16;
  #pragma unroll
  for(int d0=0;d0<4;++d0){
    const bf16x8 b0=*reinterpret_cast<const bf16x8*>(kb+d0*2048);
    const bf16x8 b1=*reinterpret_cast<const bf16x8*>(kb+d0*2048+512);
    if(d0==0){p0=__builtin_amdgcn_mfma_f32_32x32x16_bf16(b0,qr[0],negm,0,0,0);p1=__builtin_amdgcn_mfma_f32_32x32x16_bf16(b1,qr[0],negm,0,0,0);}
    else{p0=__builtin_amdgcn_mfma_f32_32x32x16_bf16(b0,qr[d0],p0,0,0,0);p1=__builtin_amdgcn_mfma_f32_32x32x16_bf16(b1,qr[d0],p1,0,0,0);}}
}
typedef __attribute__((address_space(3))) const char* lds_cptr;
typedef short v4i16_t __attribute__((ext_vector_type(4)));
__device__ __forceinline__ void kload8(bf16x8*kf,lds_cptr kp){
  kf[0]=*(const __attribute__((address_space(3))) bf16x8*)(kp);      kf[1]=*(const __attribute__((address_space(3))) bf16x8*)(kp+512);
  kf[2]=*(const __attribute__((address_space(3))) bf16x8*)(kp+2048); kf[3]=*(const __attribute__((address_space(3))) bf16x8*)(kp+2560);
  kf[4]=*(const __attribute__((address_space(3))) bf16x8*)(kp+4096); kf[5]=*(const __attribute__((address_space(3))) bf16x8*)(kp+4608);
  kf[6]=*(const __attribute__((address_space(3))) bf16x8*)(kp+6144); kf[7]=*(const __attribute__((address_space(3))) bf16x8*)(kp+6656);
}
__device__ __forceinline__ void kload2(bf16x8*kf,lds_cptr kp,int j){ kf[2*j]=*(const __attribute__((address_space(3))) bf16x8*)(kp+j*2048); kf[2*j+1]=*(const __attribute__((address_space(3))) bf16x8*)(kp+j*2048+512); }
__device__ __forceinline__ s16x4 vtr(lds_cptr p){ return __builtin_bit_cast(s16x4,__builtin_amdgcn_ds_read_tr16_b64_v4i16((__attribute__((address_space(3))) v4i16_t*)p)); }
__device__ __forceinline__ float rowmax(const f32x16&p0,const f32x16&p1){
  float a=max3f(p0[0],p0[1],p1[0]),b=max3f(p0[2],p0[3],p1[1]);a=max3f(a,p1[2],p1[3]);
  #pragma unroll
  for(int r=4;r<16;r+=4){a=max3f(a,p0[r],p0[r+1]);b=max3f(b,p0[r+2],p0[r+3]);a=max3f(a,p1[r],p1[r+1]);b=max3f(b,p1[r+2],p1[r+3]);}
  const float m=max2f(a,b);
  auto rr=__builtin_amdgcn_permlane32_swap(__float_as_uint(m),__float_as_uint(m),false,false);
  return max2f(__uint_as_float(rr[0]),__uint_as_float(rr[1]));
}
__device__ __forceinline__ void pv(f32x16*o,int vb,bf16x8 pa0,bf16x8 pa1,bf16x8 pa2,bf16x8 pa3){
  #pragma unroll
  for(int d0=0;d0<2;++d0){s16x4 lo[4],hi[4];
    #pragma unroll
    for(int ks=0;ks<4;++ks){
      asm volatile("ds_read_b64_tr_b16 %0,%1 offset:%c2":"=&v"(lo[ks]):"v"(vb),"i"(d0*4096+ks*1024):"memory");
      asm volatile("ds_read_b64_tr_b16 %0,%1 offset:%c2":"=&v"(hi[ks]):"v"(vb),"i"(d0*4096+ks*1024+512):"memory");}
    asm volatile("s_waitcnt lgkmcnt(0)":::"memory");SBAR();
    #define PK(k) (bf16x8){lo[k][0],lo[k][1],lo[k][2],lo[k][3],hi[k][0],hi[k][1],hi[k][2],hi[k][3]}
    o[d0]=__builtin_amdgcn_mfma_f32_32x32x16_bf16(pa0,PK(0),o[d0],0,0,0);
    o[d0]=__builtin_amdgcn_mfma_f32_32x32x16_bf16(pa1,PK(1),o[d0],0,0,0);
    o[d0]=__builtin_amdgcn_mfma_f32_32x32x16_bf16(pa2,PK(2),o[d0],0,0,0);
    o[d0]=__builtin_amdgcn_mfma_f32_32x32x16_bf16(pa3,PK(3),o[d0],0,0,0);
    #undef PK
  }
}

#ifndef ATTN_STORE16
#define ATTN_STORE16(p,v) (*(u32x4*)(p)=(v))
#endif
constexpr float O8SCALE=32.f;
typedef int i32x8q __attribute__((ext_vector_type(8))); typedef int i32x4q __attribute__((ext_vector_type(4)));
#define MFMA8(a,b,c) __builtin_amdgcn_mfma_scale_f32_32x32x64_f8f6f4((a),(b),(c),0,0,0,0x7F7F7F7F,0,0x7F7F7F7F)
template<int THRL,bool NOMAX=false,bool O8=false,bool QK8=false> __device__ __forceinline__ void attn_unit(long qrow0,long kvrow0,int NT,const bf16*Qh,const bf16*__restrict__ Kh,const bf16*__restrict__ Vh,bf16*Oh,char*shm){
  int tid_=threadIdx.x; asm volatile("":"+v"(tid_)); const int tid=tid_,lane=tid&63,r32=lane&31,hi=lane>>5; const int wid=__builtin_amdgcn_readfirstlane(tid>>6);
  const bf16*Qw=Qh+(qrow0+wid*QBLK)*QP; constexpr int RB8=896, VPe=QK8?448:VP;
  const unsigned lds0=(unsigned)(uintptr_t)shm;
  float*wsf=(float*)(shm+LDS_WS)+wid*64;
  const char*ksrc=QK8?(const char*)Kh+(kvrow0+lane)*RB8+(wid&3)*16:(const char*)(Kh+(kvrow0+lane)*KP+wid*8);
  const long kstep=QK8?(long)KVBLK*RB8:(long)KVBLK*KP*2;
  const bf16*vsrc=Vh+(kvrow0+16*(wid&3)+(lane>>2))*VPe+(wid>>2)*32+(lane&3)*8;
  const unsigned kdst=lds0+LDS_K+(QK8?(wid&3):wid)*1024, vdst=lds0+LDS_V+wid*1024;
  #define DMA_K(t,slot) glds16(ksrc+(long)(t)*kstep,(unsigned)__builtin_amdgcn_readfirstlane(kdst+(slot)))
  #define DMA_V(t,slot) glds16(vsrc+(long)(t)*KVBLK*VPe,(unsigned)__builtin_amdgcn_readfirstlane(vdst+(slot)))
  const int vb0=(int)(lds0+LDS_V)+((lane>>4)&1)*32+(lane&3)*8+(4*hi+((lane&15)>>2))*64;
  const char*Kbase=shm+LDS_K; bf16x8 kf[8]; i32x8q kf8[2]; i32x8q qr8;
  const lds_cptr shm3=(lds_cptr)shm; const lds_cptr kp0=shm3+LDS_K+hi*(QK8?2048:1024)+r32*16;     const lds_cptr vp0=shm3+LDS_V+((lane>>4)&1)*32+(lane&3)*8+(4*hi+((lane&15)>>2))*64;
  DMA_K(0,0);DMA_V(0,0);DMA_K(1,SLOTB);
  bf16x8 qr[4];
  #pragma unroll
  for(int d0=0;d0<4;++d0)if constexpr(!QK8)qr[d0]=*reinterpret_cast<const bf16x8*>(&Qw[(long)r32*QP+d0*16+hi*8]);
  if constexpr(QK8){ const char*q8=(const char*)Qh+(qrow0+wid*QBLK+r32)*RB8+32*hi; const i32x4q a_=*reinterpret_cast<const i32x4q*>(q8), b_=*reinterpret_cast<const i32x4q*>(q8+16); qr8=__builtin_shufflevector(a_,b_,0,1,2,3,4,5,6,7); }
  float mhat=0.f,l_reg=0.f;f32x16 o[2];o[0]=f32x16{};o[1]=f32x16{};
  typedef float f32x4_t __attribute__((ext_vector_type(4)));
  f32x4_t lsum={0.f,0.f,0.f,0.f}; bf16x8 bones; { const short one_=((((lane>>4)&1)!=0)==((lane&15)>=8))?(short)0x3F80:(short)0; bones=(bf16x8){one_,one_,one_,one_,one_,one_,one_,one_}; }
  #define LSUM(k) do{ lsum=__builtin_amdgcn_mfma_f32_16x16x32_bf16(PAF(k),bones,lsum,0,0,0); }while(0)
f32x16 negm=f32x16{};if constexpr(!NOMAX)asm volatile("":"+v"(negm));
  #define CMASK(P0,P1,t) do{}while(0)
  bool resc=false;
  #define KLD8(blk,kp_) do{ const i32x4q a_=*(const __attribute__((address_space(3))) i32x4q*)((kp_)+(blk)*512), b_=*(const __attribute__((address_space(3))) i32x4q*)((kp_)+(blk)*512+1024); kf8[blk]=__builtin_shufflevector(a_,b_,0,1,2,3,4,5,6,7); }while(0)
  #define START(P0,P1) do{ if constexpr(!NOMAX){ const float rm=rowmax(P0,P1); resc=false; \
    { const float dl=rm; mhat=fadd_s(mhat,dl); \
      _Pragma("unroll") for(int r=0;r<16;++r){P0[r]=fsub_s(P0[r],dl);P1[r]=fsub_s(P1[r],dl);} \
      _Pragma("unroll") for(int r=0;r<16;++r)negm[r]=-mhat; asm volatile("":"+v"(negm)); } } \
    _Pragma("unroll") for(int r=0;r<16;++r)P0[r]=__builtin_amdgcn_exp2f(P0[r]); }while(0)
  #define RESC() do{ if constexpr(!NOMAX) if(resc){ asm volatile("s_waitcnt lgkmcnt(0)":::"memory"); \
      _Pragma("unroll") for(int d_=0;d_<2;++d_) _Pragma("unroll") for(int r=0;r<16;++r)o[d_][r]*=wsf[crow(r,hi)]; } }while(0)
  f32x16 pA0,pA1,pB0,pB1;
  int sl_prev=0,sl_cur=0,sl_next=SLOTB;
  #define ROT() do{sl_prev=sl_cur;sl_cur=sl_next;sl_next=(sl_next==(NSLOT-1)*SLOTB)?0:sl_next+SLOTB;}while(0)
  DMA_K(2,2*SLOTB);
  WAIT_BAR(3);
  if constexpr(QK8){ KLD8(0,kp0); KLD8(1,kp0); pA0=MFMA8(kf8[0],qr8,negm); pA1=MFMA8(kf8[1],qr8,negm); } else qkt(pA0,pA1,Kbase,qr,negm,r32,hi);
  asm volatile("s_nop 15\n\ts_nop 7":"+v"(pA0),"+v"(pA1));CMASK(pA0,pA1,0);
  START(pA0,pA1);
  if constexpr(!NOMAX){ _Pragma("unroll") for(int r=0;r<16;++r)pA1[r]=__builtin_amdgcn_exp2f(pA1[r]); }
  WAIT_BAR(0);
  DMA_K(3,0);DMA_V(1,SLOTB);
  ROT();
  if constexpr(QK8){ KLD8(0,kp0+sl_cur); KLD8(1,kp0+sl_cur); } else kload8(kf,kp0+sl_cur);
  WAIT_BAR(2);
  s16x4 vlo[8],vhi[8]; u32x4 pw0,pw1,pw2,pw3;
  #define PKW(P,B) cvtpk_s(P[B],P[B+1])
  #define PAF(k) __builtin_bit_cast(bf16x8,pw##k)
  #define VFR(i) (bf16x8){vlo[i][0],vlo[i][1],vlo[i][2],vlo[i][3],vhi[i][0],vhi[i][1],vhi[i][2],vhi[i][3]}
  #define PIN(x) asm volatile("":"+v"(x))
  #define MX3(a,b,c) __builtin_fmaxf(__builtin_fmaxf((a),(b)),(c))
  #define GAPA(MF,A0,A1,A2,A3,W0,W1,PW) do{ MF; sacc+=A0; sacc+=A1; sacc+=A2; sacc+=A3; PIN(sacc); W0; W1; PIN(PW); SBAR(); }while(0)
  #define EX(v) __builtin_amdgcn_exp2f(v)
  #define QKM(E8,E16) do{ if constexpr(QK8){ E8; } else { E16; } }while(0)
  #define GAPB(MF,X,B) do{ MF; X[B]=EX(X[B]); X[B+1]=EX(X[B+1]); X[B+2]=EX(X[B+2]); X[B+3]=EX(X[B+3]); PIN(X); SBAR(); }while(0)
  #define VRD(i) do{ vlo[i]=vtr(vp_+(((i)>>2)*4096+((i)&3)*1024)); vhi[i]=vtr(vp_+(((i)>>2)*4096+((i)&3)*1024+512)); }while(0)
  #define KRD(G,j) do{ if(G){ if constexpr(QK8){ if((j)<2){ KLD8((j),kp0+sl_next); SBAR(); } } else { kload2(kf,kp0+sl_next,j); SBAR(); } } }while(0)
  #define STEP(C0,C1,P0,P1,t,GK,GV,GL) do{ SBAR(); \
    const lds_cptr vp_=vp0+sl_prev; \
    VRD(0); SBAR(); float sacc=(P0[0]+P0[1]); \
    GAPA(QKM(C0=MFMA8(kf8[0],qr8,negm), C0=__builtin_amdgcn_mfma_f32_32x32x16_bf16(kf[0],qr[0],negm,0,0,0)), P0[2],P0[3],P0[4],P0[5],     pw0[0]=PKW(P0,0), pw0[1]=PKW(P0,2), pw0); \
    VRD(4); SBAR(); GAPA(QKM((void)0, C1=__builtin_amdgcn_mfma_f32_32x32x16_bf16(kf[1],qr[0],negm,0,0,0)), P0[6],P0[7],P0[8],P0[9],     pw0[2]=PKW(P0,4), pw0[3]=PKW(P0,6), pw0); \
    VRD(1); SBAR(); GAPA(QKM((void)0, C0=__builtin_amdgcn_mfma_f32_32x32x16_bf16(kf[2],qr[1],C0,0,0,0)),   P0[10],P0[11],P0[12],P0[13], pw1[0]=PKW(P0,8), pw1[1]=PKW(P0,10), pw1); \
    VRD(5); SBAR(); GAPA(QKM((void)0, C1=__builtin_amdgcn_mfma_f32_32x32x16_bf16(kf[3],qr[1],C1,0,0,0)),   P0[14],P0[15],P1[0],P1[1],   pw1[2]=PKW(P0,12),pw1[3]=PKW(P0,14), pw1); \
    VRD(2); SBAR(); GAPA(QKM(C1=MFMA8(kf8[1],qr8,negm), C0=__builtin_amdgcn_mfma_f32_32x32x16_bf16(kf[4],qr[2],C0,0,0,0)),   P1[2],P1[3],P1[4],P1[5],     pw2[0]=PKW(P1,0), pw2[1]=PKW(P1,2), pw2); \
    VRD(6); SBAR(); GAPA(QKM((void)0, C1=__builtin_amdgcn_mfma_f32_32x32x16_bf16(kf[5],qr[2],C1,0,0,0)),   P1[6],P1[7],P1[8],P1[9],     pw2[2]=PKW(P1,4), pw2[3]=PKW(P1,6), pw2); \
    VRD(3); SBAR(); GAPA(QKM((void)0, C0=__builtin_amdgcn_mfma_f32_32x32x16_bf16(kf[6],qr[3],C0,0,0,0)),   P1[10],P1[11],P1[12],P1[13], pw3[0]=PKW(P1,8), pw3[1]=PKW(P1,10), pw3); \
    VRD(7); SBAR(); GAPA(QKM((void)0, C1=__builtin_amdgcn_mfma_f32_32x32x16_bf16(kf[7],qr[3],C1,0,0,0)),   P1[14],P1[15],0.f,0.f,       pw3[2]=PKW(P1,12),pw3[3]=PKW(P1,14), pw3); \
    l_reg+=sacc; \
    if(GK){DMA_K((t)+3,sl_cur);} if(GV){DMA_V((t)+1,sl_next);} \
    CMASK(C0,C1,t); \
    if constexpr(!NOMAX){ float a=MX3(C0[0],C0[1],C1[0]),b=MX3(C0[2],C0[3],C1[1]); a=MX3(a,C1[2],C1[3]); \
      _Pragma("unroll") for(int r=4;r<16;r+=4){a=MX3(a,C0[r],C0[r+1]);b=MX3(b,C0[r+2],C0[r+3]);a=MX3(a,C1[r],C1[r+1]);b=MX3(b,C1[r+2],C1[r+3]);} \
      float rm=__builtin_fmaxf(a,b); { auto rr=__builtin_amdgcn_permlane32_swap(__float_as_uint(rm),__float_as_uint(rm),false,false); rm=__builtin_fmaxf(__uint_as_float(rr[0]),__uint_as_float(rr[1])); } \
      resc=false; \
      if(__builtin_expect(__any(rm>(float)THRL),0)){ const float dl=__builtin_fmaxf(rm,0.f); mhat+=dl; \
        _Pragma("unroll") for(int r=0;r<16;++r){C0[r]-=dl;C1[r]-=dl;} \
        _Pragma("unroll") for(int r=0;r<16;++r)negm[r]=-mhat; asm volatile("":"+v"(negm)); \
        const float f=__builtin_amdgcn_exp2f(-dl); l_reg*=f; if(hi==0)wsf[r32]=f; resc=true; } } \
    SBAR(); \
    GAPB(o[0]=__builtin_amdgcn_mfma_f32_32x32x16_bf16(PAF(0),VFR(0),o[0],0,0,0), C0,0); \
    GAPB(o[1]=__builtin_amdgcn_mfma_f32_32x32x16_bf16(PAF(0),VFR(4),o[1],0,0,0), C0,4); \
    KRD(GL,0); GAPB(o[0]=__builtin_amdgcn_mfma_f32_32x32x16_bf16(PAF(1),VFR(1),o[0],0,0,0), C0,8); \
    KRD(GL,1); GAPB(o[1]=__builtin_amdgcn_mfma_f32_32x32x16_bf16(PAF(1),VFR(5),o[1],0,0,0), C0,12); \
    KRD(GL,2); GAPB(o[0]=__builtin_amdgcn_mfma_f32_32x32x16_bf16(PAF(2),VFR(2),o[0],0,0,0), C1,0); \
    KRD(GL,3); GAPB(o[1]=__builtin_amdgcn_mfma_f32_32x32x16_bf16(PAF(2),VFR(6),o[1],0,0,0), C1,4); \
    GAPB(o[0]=__builtin_amdgcn_mfma_f32_32x32x16_bf16(PAF(3),VFR(3),o[0],0,0,0), C1,8); \
    GAPB(o[1]=__builtin_amdgcn_mfma_f32_32x32x16_bf16(PAF(3),VFR(7),o[1],0,0,0), C1,12); \
    }while(0)
  #define EX2(P,B) P[B]=EX(P[B]); P[(B)+1]=EX(P[(B)+1]);
  #define GAPX(MF,EXS,W0,W1,PW,PP) do{ MF; EXS PIN(PP); W0; W1; PIN(PW); SBAR(); }while(0)
  #define GAPY(MF,X,B) do{ MF; X[B]=EX(X[B]); X[(B)+1]=EX(X[(B)+1]); PIN(X); SBAR(); }while(0)
  #define STEPX(C0,C1,P0,P1,t,GK,GV,GL) do{ SBAR(); \
    const lds_cptr vp_=vp0+sl_prev; \
    VRD(0); SBAR(); \
    GAPX(QKM(C0=MFMA8(kf8[0],qr8,negm), C0=__builtin_amdgcn_mfma_f32_32x32x16_bf16(kf[0],qr[0],negm,0,0,0)), EX2(P1,0),             pw0[0]=PKW(P0,0), pw0[1]=PKW(P0,2), pw0, P1); \
    VRD(4); SBAR(); GAPX(QKM((void)0, C1=__builtin_amdgcn_mfma_f32_32x32x16_bf16(kf[1],qr[0],negm,0,0,0)), EX2(P1,2),  pw0[2]=PKW(P0,4), pw0[3]=PKW(P0,6), pw0, P1); \
    VRD(1); SBAR(); GAPX(QKM((void)0, C0=__builtin_amdgcn_mfma_f32_32x32x16_bf16(kf[2],qr[1],C0,0,0,0)),   EX2(P1,4),  pw1[0]=PKW(P0,8), pw1[1]=PKW(P0,10), pw1, P1); \
    VRD(5); SBAR(); GAPX(QKM((void)0, C1=__builtin_amdgcn_mfma_f32_32x32x16_bf16(kf[3],qr[1],C1,0,0,0)),   EX2(P1,6),  pw1[2]=PKW(P0,12),pw1[3]=PKW(P0,14), pw1, P1); \
    VRD(2); SBAR(); GAPX(QKM(C1=MFMA8(kf8[1],qr8,negm), C0=__builtin_amdgcn_mfma_f32_32x32x16_bf16(kf[4],qr[2],C0,0,0,0)),   EX2(P1,8) EX2(P1,10),  pw2[0]=PKW(P1,0), pw2[1]=PKW(P1,2), pw2, P1); \
    VRD(6); SBAR(); GAPX(QKM((void)0, C1=__builtin_amdgcn_mfma_f32_32x32x16_bf16(kf[5],qr[2],C1,0,0,0)),   EX2(P1,12) EX2(P1,14), pw2[2]=PKW(P1,4), pw2[3]=PKW(P1,6), pw2, P1); \
    VRD(3); SBAR(); GAPX(QKM((void)0, C0=__builtin_amdgcn_mfma_f32_32x32x16_bf16(kf[6],qr[3],C0,0,0,0)),   ,           pw3[0]=PKW(P1,8), pw3[1]=PKW(P1,10), pw3, P1); \
    VRD(7); SBAR(); GAPX(QKM((void)0, C1=__builtin_amdgcn_mfma_f32_32x32x16_bf16(kf[7],qr[3],C1,0,0,0)),   ,           pw3[2]=PKW(P1,12),pw3[3]=PKW(P1,14), pw3, P1); \
    if(GK){DMA_K((t)+3,sl_cur);} if(GV){DMA_V((t)+1,sl_next);} \
    SBAR(); \
    LSUM(0); GAPY(o[0]=__builtin_amdgcn_mfma_f32_32x32x16_bf16(PAF(0),VFR(0),o[0],0,0,0), C0,0); \
    GAPY(o[1]=__builtin_amdgcn_mfma_f32_32x32x16_bf16(PAF(0),VFR(4),o[1],0,0,0), C0,2); \
    KRD(GL,0); LSUM(1); GAPY(o[0]=__builtin_amdgcn_mfma_f32_32x32x16_bf16(PAF(1),VFR(1),o[0],0,0,0), C0,4); \
    KRD(GL,1); GAPY(o[1]=__builtin_amdgcn_mfma_f32_32x32x16_bf16(PAF(1),VFR(5),o[1],0,0,0), C0,6); \
    KRD(GL,2); LSUM(2); GAPY(o[0]=__builtin_amdgcn_mfma_f32_32x32x16_bf16(PAF(2),VFR(2),o[0],0,0,0), C0,8); \
    KRD(GL,3); GAPY(o[1]=__builtin_amdgcn_mfma_f32_32x32x16_bf16(PAF(2),VFR(6),o[1],0,0,0), C0,10); \
    LSUM(3); GAPY(o[0]=__builtin_amdgcn_mfma_f32_32x32x16_bf16(PAF(3),VFR(3),o[0],0,0,0), C0,12); \
    GAPY(o[1]=__builtin_amdgcn_mfma_f32_32x32x16_bf16(PAF(3),VFR(7),o[1],0,0,0), C0,14); \
    }while(0)
  #define STEPS(C0,C1,P0,P1,t,GK,GV,GL) do{ if constexpr(NOMAX) STEPX(C0,C1,P0,P1,t,GK,GV,GL); else STEP(C0,C1,P0,P1,t,GK,GV,GL); }while(0)
  int t=1;
  #undef CMASK
  #define CMASK(P0,P1,t) do{}while(0)
  for(;t+5<NT;t+=2){
    STEPS(pB0,pB1,pA0,pA1,t,true,true,true);     WAIT_BAR(2); RESC(); ROT();
    STEPS(pA0,pA1,pB0,pB1,t+1,true,true,true);   WAIT_BAR(2); RESC(); ROT();
  }
  #undef CMASK
  #define CMASK(P0,P1,t) do{}while(0)
  #define ENDW(tt) do{ if((tt)+3<NT){WAIT_BAR(2);} else if((tt)+2<NT){WAIT_BAR(1);} else {WAIT_BAR(0);} }while(0)
  for(;t+1<NT;t+=2){
    STEPS(pB0,pB1,pA0,pA1,t,(t+3<NT),(t+1<NT),(t+1<NT));       ENDW(t);   RESC(); ROT();
    STEPS(pA0,pA1,pB0,pB1,t+1,(t+4<NT),(t+2<NT),(t+2<NT));     ENDW(t+1); RESC(); ROT();
  }
  STEPS(pB0,pB1,pA0,pA1,NT-1,false,false,false); RESC();
  { if constexpr(NOMAX){ _Pragma("unroll") for(int r=0;r<16;++r)pB1[r]=__builtin_amdgcn_exp2f(pB1[r]); }
    else { float sacc=pB0[0]+pB0[1]; _Pragma("unroll") for(int r=2;r<16;++r)sacc+=pB0[r]; _Pragma("unroll") for(int r=0;r<16;++r)sacc+=pB1[r]; l_reg+=sacc; }
    pw0=(u32x4){PKW(pB0,0),PKW(pB0,2),PKW(pB0,4),PKW(pB0,6)};pw1=(u32x4){PKW(pB0,8),PKW(pB0,10),PKW(pB0,12),PKW(pB0,14)};pw2=(u32x4){PKW(pB1,0),PKW(pB1,2),PKW(pB1,4),PKW(pB1,6)};pw3=(u32x4){PKW(pB1,8),PKW(pB1,10),PKW(pB1,12),PKW(pB1,14)};
    SBAR(); if constexpr(NOMAX){ LSUM(0); LSUM(1); LSUM(2); LSUM(3); } pv(o,vb0+sl_cur,PAF(0),PAF(1),PAF(2),PAF(3)); }
  #undef LSUM
  #undef QKM
  #undef KLD8
  #undef EX2
  #undef GAPX
  #undef GAPY
  #undef STEPX
  #undef STEPS
  #undef PKW
  #undef PAF
  #undef VFR
  #undef PIN
  #undef MX3
  #undef GAPA
  #undef GAPB
  #undef EX
  #undef VRD
  #undef KRD
  #undef STEP
  #undef ENDW
  if constexpr(NOMAX){ asm volatile("s_nop 7":"+v"(lsum));
    if((lane&7)==0){ const int qb_=4*(lane>>4)+16*((lane>>3)&1); wsf[32+qb_]=lsum[0]; wsf[33+qb_]=lsum[1]; wsf[34+qb_]=lsum[2]; wsf[35+qb_]=lsum[3]; }
  } else {
  {auto rr=__builtin_amdgcn_permlane32_swap(__float_as_uint(l_reg),__float_as_uint(l_reg),false,false);l_reg=__uint_as_float(rr[0])+__uint_as_float(rr[1]);}
  if(hi==0)wsf[32+r32]=l_reg; }
  asm volatile("s_waitcnt lgkmcnt(0)":::"memory");
  float rli[16];
  #pragma unroll
  for(int r=0;r<16;++r)rli[r]=__builtin_amdgcn_rcpf(wsf[32+crow(r,hi)]);
  if constexpr(O8){ unsigned char*Ow8=(unsigned char*)Oh+(qrow0+wid*QBLK)*OP; unsigned char*stg8=(unsigned char*)(shm+LDS_OST)+wid*2048;
    #pragma unroll
    for(int r=0;r<16;++r){const int orow=crow(r,hi); const float sc=rli[r]*O8SCALE;
      #pragma unroll
      for(int d0=0;d0<2;++d0)stg8[orow*64+d0*32+r32]=(unsigned char)(__builtin_amdgcn_cvt_pk_fp8_f32(o[d0][r]*sc,o[d0][r]*sc,0,false)&0xff);}
    asm volatile("s_waitcnt lgkmcnt(0)":::"memory");
    #pragma unroll
    for(int i=0;i<2;++i){const int row=i*16+(lane>>2),ch=lane&3; const u32x4 v=*(const u32x4*)(stg8+row*64+ch*16); ATTN_STORE16(Ow8+(long)row*OP+ch*16,v);}
  } else {
  bf16*Ow=Oh+(qrow0+wid*QBLK)*OP;
  { bf16*stg=(bf16*)(shm+LDS_OST)+wid*2048;
    #pragma unroll
    for(int r=0;r<16;++r){const int orow=crow(r,hi);
      #pragma unroll
      for(int d0=0;d0<2;++d0)stg[orow*64+d0*32+r32]=__float2bfloat16(o[d0][r]*rli[r]);}
    asm volatile("s_waitcnt lgkmcnt(0)":::"memory");
    #pragma unroll
    for(int i=0;i<4;++i){const int row=i*8+(lane>>3),ch=lane&7; const u32x4 v=*(const u32x4*)(stg+row*64+ch*8); ATTN_STORE16(Ow+(long)row*OP+ch*8,v);} }
  }
  asm volatile("s_waitcnt lgkmcnt(0)\n\ts_barrier":::"memory");
  #undef DMA_K
  #undef DMA_V
  #undef CMASK
  #undef START
  #undef RESC
  #undef ROT
}
constexpr int ATTN_LDS_BYTES=LDS_BYTES;
#undef SBAR
#undef WAIT_BAR
}

#ifndef DUP_MASK
#define DUP_MASK 0
#endif
#ifndef ROPE_DRY_FIRST
#define ROPE_DRY_FIRST 0
#endif
#define NREP(p) (1 + (((DUP_MASK) >> (p)) & 1))
#ifndef FP8_E1
#define FP8_E1 1
#endif
#ifndef FP8_E2
#define FP8_E2 1
#endif
#ifndef FP8_G1
#define FP8_G1 1
#endif
#ifndef FP8_OUT
#define FP8_OUT 1
#endif
#ifndef FP8_MIX
#define FP8_MIX 1
#endif
#ifndef FP8_YE
#define FP8_YE 1
#endif
#ifndef FP8_NAQK
#define FP8_NAQK 1
#endif
#ifndef FP8_QK
#define FP8_QK 1
#endif
#ifndef FP8_BR
#define FP8_BR 1
#endif
constexpr float WIN_SCALE = 64.f, WOUT_SCALE = 64.f, ATT_SCALE = 32.f, WBR_SCALE = 16.f;
static_assert(!FP8_G1 || FP8_E1, "the e4m3 activation buffer sits in the upper half of the bf16 XB region: with FP8_G1 the bf16 x1 must not be written (needs FP8_E1)");
constexpr float W1_SCALE = 64.f, W2_SCALE = 128.f;
constexpr int NWAVES = 8;
constexpr int N_LAUNCHES = MK_N_LAUNCHES;
constexpr int DM = 1024, DEPTH = 4, NP = 32768, NS = 65536, NTOK = NP + NS;
constexpr int SEQ_P = 4096, SEQ_S = 8192;
constexpr int D_IN = 4352, NE = 16, DF = 2048;
constexpr int NSLOTROWS = 2 * NTOK;
constexpr int PH_PER_LAYER = 12, N_PHASES = DEPTH * PH_PER_LAYER;
constexpr float LN_EPS = 1e-5f, RMS_EPS = 1e-6f, LOG2E = 1.4426950408889634f;
constexpr float DN_ALPHA = 1.681792830507429f;
constexpr float QSCALE = 0.125f * LOG2E;
static_assert(N_LAUNCHES == 1 || N_LAUNCHES == N_PHASES, "MK_N_LAUNCHES is 1 or 48");

constexpr size_t MiB = 1u << 20;
constexpr size_t WS_CTL = 0, CTL_ZERO_BYTES = 1 * MiB;
constexpr size_t WS_WIN = 2 * MiB;
constexpr size_t WS_WBR = WS_WIN + (size_t)D_IN * DM * 2;
constexpr size_t WS_WOUT = WS_WBR + (size_t)2 * 1024 * 512 * 2;
constexpr size_t WS_W1 = WS_WOUT + (size_t)1024 * 2048 * 2;
constexpr size_t WS_W2 = WS_W1 + (size_t)NE * 4096 * 1024 * 2;
constexpr size_t WS_XB = WS_W2 + (size_t)NE * 1024 * 2048 * 2;
constexpr size_t WS_R1 = WS_XB + (size_t)NTOK * DM * 2;
constexpr size_t WS_NAQKV = WS_R1;
constexpr size_t WS_RAWQK = WS_NAQKV + (size_t)NTOK * 1536 * 2;
constexpr size_t WS_GATES = WS_RAWQK + (size_t)NTOK * 768 * 4;
constexpr size_t WS_R1_END = WS_GATES + (size_t)NTOK * 2048 * 2;
constexpr size_t WS_H = WS_R1;
constexpr size_t WS_XB8_OLD = WS_XB + (size_t)NTOK * DM;
static_assert(WS_H + (size_t)NSLOTROWS * DF * 2 <= WS_R1_END && (!(FP8_G1 || FP8_E1) || true), "H overlay fits R1");
constexpr size_t WS_R2 = WS_R1_END;
constexpr size_t WS_ATT = WS_R2;
constexpr size_t WS_Z = WS_ATT + (size_t)2 * NTOK * 512 * 2;
constexpr size_t WS_QKVB = WS_Z + (size_t)NTOK * 1024 * 2;
constexpr size_t WS_MIX8 = WS_QKVB + (size_t)NTOK * DM;
constexpr size_t WS_R2_END = WS_Z + (size_t)NTOK * 2048 * 2;
constexpr size_t WS_XG = WS_R2;
constexpr size_t WS_YE = WS_R2;
static_assert(WS_XG + (size_t)NSLOTROWS * DM * 2 <= WS_R2_END, "XG/YE overlay fits R2");
constexpr size_t WS_AFFT = WS_R2_END;
constexpr size_t WS_SLOT = WS_AFFT + (size_t)NTOK * NE * 4;
constexpr size_t WS_IDX = WS_SLOT + (size_t)NTOK * NE * 4;
constexpr size_t WS_GVAL = WS_IDX + (size_t)NSLOTROWS * 4;
constexpr size_t WS_XB8 = WS_GVAL + (size_t)NSLOTROWS * 4;
constexpr size_t WS_END = WS_XB8 + (size_t)NTOK * DM;
static_assert(WS_END <= (size_t)2047 * MiB, "d_ws map fits under 2 GiB");
constexpr size_t WS_STATS = 1 * MiB;
constexpr int CW_BAR = 4096;

constexpr int RING_OFF = 0, RING_BYTES = 131072;
constexpr int LDSCTL_OFF = RING_BYTES, MISC_OFF = LDSCTL_OFF + 320;
constexpr int LDS_BYTES = 147456;
static_assert(MISC_OFF + 128 <= LDS_BYTES, "LDS map");

#define GAS __attribute__((address_space(1)))
#define LAS __attribute__((address_space(3)))
typedef unsigned short bf16;
typedef unsigned v4u __attribute__((ext_vector_type(4)));
typedef unsigned v2u __attribute__((ext_vector_type(2)));
typedef float f32x4 __attribute__((ext_vector_type(4)));
typedef float f32x16 __attribute__((ext_vector_type(16)));
typedef short bf16x8 __attribute__((ext_vector_type(8)));
typedef GAS unsigned gu32;
#define RLX_AGENT __ATOMIC_RELAXED, __HIP_MEMORY_SCOPE_AGENT
#define LDS_WAIT() asm volatile("s_waitcnt lgkmcnt(0)" ::: "memory")
#define VM_WAIT() asm volatile("s_waitcnt vmcnt(0)" ::: "memory")
__device__ __forceinline__ unsigned f2bf(float f) { unsigned u = __builtin_bit_cast(unsigned, f); return (u + 0x7fffu + ((u >> 16) & 1u)) >> 16; }
__device__ __forceinline__ unsigned pk2(float lo, float hi) { typedef float f32x2p __attribute__((ext_vector_type(2))); typedef __bf16 bf16x2p __attribute__((ext_vector_type(2)));
    const f32x2p v = {lo, hi}; return __builtin_bit_cast(unsigned, __builtin_convertvector(v, bf16x2p)); }
__device__ __forceinline__ float bf_lo(unsigned w) { return __uint_as_float(w << 16); }
__device__ __forceinline__ float bf_hi(unsigned w) { return __uint_as_float(w & 0xffff0000u); }


#ifndef ROPE_FUSED
#define ROPE_FUSED 1
#endif
namespace pg8 {
struct EpiProjRope {
    static constexpr bool PERM = true, AFTER_DRAIN = false;
    bf16_t* NAQKV; bf16_t* QKVB; unsigned char* GATES; const float* qn; const float* kn; PG8_LAS float* xch; float qscale, ascale;
    __device__ __forceinline__ void operator()(const f32x4 (&acc)[2][2][4][2], const Unit& u, int wr, int wc, int fr, int fq) const {
        const int pn = u.pn;
        const size_t row0 = (size_t)u.pm * BM + wr * 64 + fr; const int colw = wc * 32 + 8 * fq;
        if (pn < 6) {
            const float sc = (pn < 2 ? qscale : 1.0f) * ascale;
#pragma unroll
            for (int ai = 0; ai < 2; ++ai)
#pragma unroll
                for (int m = 0; m < 4; ++m)
#pragma unroll
                    for (int bj = 0; bj < 2; ++bj) {
                        if (FP8_NAQK) { unsigned char* const rp = (unsigned char*)NAQKV + (row0 + ai * HALF + m * 16) * 2048; const f32x4 v0 = acc[ai][bj][m][0] * sc, v1 = acc[ai][bj][m][1] * sc;
                            if (pn < 4) { u32x2 w; w.x = pack4_fp8(v0[0], v0[1], v0[2], v0[3]); w.y = pack4_fp8(v1[0], v1[1], v1[2], v1[3]); *(u32x2*)(rp + pn * BM + bj * HALF + colw) = w; }
                            else *(u32x4*)(rp + 1024 + 2 * ((pn - 4) * BM + bj * HALF + colw)) = pack8(v0, v1); }
                        else *(u32x4*)(NAQKV + (row0 + ai * HALF + m * 16) * 1536 + pn * BM + bj * HALF + colw) = pack8(acc[ai][bj][m][0] * sc, acc[ai][bj][m][1] * sc); }
        } else if (pn < 9) {
            unsigned xo_mine = (unsigned)(size_t)xch + (unsigned)(((wr * 64 + fr) * 8 + wc) * 4), xo_part = (unsigned)(size_t)xch + (unsigned)(((wr * 64 + fr) * 8 + (wc ^ 1)) * 4);
            asm volatile("" : "+v"(xo_mine), "+v"(xo_part));
            PG8_LAS float* const xm = (PG8_LAS float*)(size_t)xo_mine; PG8_LAS float* const xp = (PG8_LAS float*)(size_t)xo_part;
#pragma unroll
            for (int ai = 0; ai < 2; ++ai)
#pragma unroll
                for (int m = 0; m < 4; ++m)
#pragma unroll
                    for (int bj = 0; bj < 2; ++bj) { const f32x4 a = acc[ai][bj][m][0], b = acc[ai][bj][m][1];
                        float s = ((a[0] * a[0] + a[1] * a[1]) + (a[2] * a[2] + a[3] * a[3])) + ((b[0] * b[0] + b[1] * b[1]) + (b[2] * b[2] + b[3] * b[3]));
                        s *= ascale * ascale; s += __shfl_xor(s, 16); s += __shfl_xor(s, 32);
                        if (fq == 0) xm[(ai * HALF + m * 16) * 8 + bj * 4] = s; }
            asm volatile("s_waitcnt lgkmcnt(0)\n\ts_barrier" ::: "memory");
            const int dq = 32 * (wc & 1) + 8 * fq;
            const int off0 = (pn - 6) * BM + colw, offv = 640 + 2 * colw;
            const float* gsrc = (pn == 8 ? kn : qn) + dq; const f32x4 g0 = *(const f32x4*)gsrc, g1 = *(const f32x4*)(gsrc + 4);
            const float invf0 = (fq & 1) ? 0.01f : 1.0f;
            constexpr float RJ[8] = {1.0f, 0.5623413251903491f, 0.31622776601683794f, 0.1778279410038923f, 0.1f, 0.05623413251903491f, 0.031622776601683794f, 0.01778279410038923f};
            const float sgn = (fq & 2) ? 1.f : -1.f;
            auto rows = [&](auto kv_) __attribute__((always_inline)) { constexpr bool KV = decltype(kv_)::value;
#pragma unroll
            for (int ai = 0; ai < 2; ++ai)
#pragma unroll
                for (int m = 0; m < 4; ++m) {
                    const int rl = ai * HALF + wr * 64 + m * 16 + fr; const int R = u.pm * BM + rl;
                    const int t = R < 32768 ? (R & 4095) : ((R - 32768) & 8191);
                    const float pos = (float)((wc & 1) ? (t & 63) : (t >> 6));
                    const float pf = pos * invf0;
                    const float tot0 = xm[(ai * HALF + m * 16) * 8] + xp[(ai * HALF + m * 16) * 8], tot1 = xm[(ai * HALF + m * 16) * 8 + 4] + xp[(ai * HALF + m * 16) * 8 + 4];
                    const float rn0 = 1.0f / sqrtf(tot0 * (1.0f / 64.0f) + 1e-6f), rn1 = 1.0f / sqrtf(tot1 * (1.0f / 64.0f) + 1e-6f), osc = pn < 8 ? qscale : 1.0f;
#pragma unroll
                    for (int hk = 0; hk < 2; ++hk) {
                        float cs[4], sn[4];
#pragma unroll
                        for (int k = 0; k < 4; ++k) { const float ang = pf * RJ[4 * hk + k]; cs[k] = __cosf(ang); sn[k] = __sinf(ang); }
#pragma unroll
                        for (int bj = 0; bj < 2; ++bj) {
                            constexpr bool plain_ct = KV; const bool plain = plain_ct && bj == 1;
                            const f32x4 a = acc[ai][bj][m][hk] * ascale, y = a * (bj ? rn1 : rn0) * (hk ? g1 : g0);
                            f32x4 r;
#pragma unroll
                            for (int k = 0; k < 4; ++k) { const float p = __shfl_xor(y[k], 32); r[k] = (y[k] * cs[k] + sgn * p * sn[k]) * osc; }
                            const f32x4 o = plain ? a : r;
                            if (FP8_QK) { unsigned char* const rowp = (unsigned char*)QKVB + (size_t)R * 896 + (bj ? (KV ? offv : off0 + HALF) : off0);
                                if (plain) { u32x2 w; w.x = cvt_pk_bf16(o[0], o[1]); w.y = cvt_pk_bf16(o[2], o[3]); *(u32x2*)(rowp + 8 * hk) = w; }
                                else *(unsigned*)(rowp + 4 * hk) = pack4_fp8(o[0], o[1], o[2], o[3]); }
                            else { u32x2 w; w.x = cvt_pk_bf16(o[0], o[1]); w.y = cvt_pk_bf16(o[2], o[3]);
                            *(u32x2*)(QKVB + (size_t)R * 768 + (pn - 6) * BM + bj * HALF + colw + 4 * hk) = w; }
                        }
                    }
                    __builtin_amdgcn_sched_barrier(0);
                }
            };
            if (pn == 8) rows(std::true_type{}); else rows(std::false_type{});
        } else {
#pragma unroll
            for (int ai = 0; ai < 2; ++ai)
#pragma unroll
                for (int m = 0; m < 4; ++m)
#pragma unroll
                    for (int bj = 0; bj < 2; ++bj) { const float cneg = -1.4426950408889634f * ascale; const f32x4 v0 = sigmoid_scaled4(acc[ai][bj][m][0], cneg), v1 = sigmoid_scaled4(acc[ai][bj][m][1], cneg);
                        u32x2 w8; w8.x = pack4_fp8(v0[0], v0[1], v0[2], v0[3]); w8.y = pack4_fp8(v1[0], v1[1], v1[2], v1[3]);
                        *(u32x2*)(GATES + (row0 + ai * HALF + m * 16) * 2048 + (pn - 9) * BM + bj * HALF + colw) = w8; }
        }
    }
};
}

#define XB_TMO      128
#define XB_XCNT(j)  (256  + 64 * (j))
#define XB_XSUB(j)  (1280 + 64 * (j))
#define XB_XGEN(j)  (2304 + 64 * (j))
#define XB_TOP      3328
#define XB_TOPGEN   3392
#define XCD_BAR_WORDS 3456
#define XB_SPIN_CAP (1u << 18)

__device__ __forceinline__ unsigned xb_ld(unsigned* p)              { return __hip_atomic_load(p, __ATOMIC_RELAXED, __HIP_MEMORY_SCOPE_AGENT); }
__device__ __forceinline__ unsigned xb_add(unsigned* p, unsigned v) { return __hip_atomic_fetch_add(p, v, __ATOMIC_RELAXED, __HIP_MEMORY_SCOPE_AGENT); }
__device__ __forceinline__ unsigned xb_xcc_id() { return (unsigned)__builtin_amdgcn_s_getreg((3 << 11) | 20) & 0xFu; }
#define XB_SPIN(cond, bar) do { unsigned _sp = 0; while (cond) { __builtin_amdgcn_s_sleep(0); \
    if ((++_sp & 255u) == 0u) { if (xb_ld(&(bar)[XB_TMO])) break; if (_sp > XB_SPIN_CAP) { atomicAdd(&(bar)[XB_TMO], 1u); break; } } } } while (0)

struct XcdBarrier {
    unsigned* bar; unsigned x;
    volatile LAS unsigned* st;
};

__device__ __forceinline__ XcdBarrier xcd_barrier_post(unsigned* bar, volatile LAS unsigned* st) {
    XcdBarrier b; b.bar = bar; b.x = xb_xcc_id(); b.st = st;
    if (threadIdx.x == 0) (void)xb_add(&bar[XB_XCNT(b.x)], 1u);
    return b;
}
__device__ __forceinline__ void xcd_barrier_complete(unsigned* bar, unsigned x, unsigned& nloc, unsigned& nx) {
    const unsigned G = gridDim.x * gridDim.y * gridDim.z;
    unsigned sum, cnt, mine, sp = 0u;
    for (;;) {
        sum = 0u; cnt = 0u; mine = 0u;
#pragma unroll
        for (unsigned j = 0; j < 16; ++j) { const unsigned c = xb_ld(&bar[XB_XCNT(j)]); sum += c; cnt += (c > 0u) ? 1u : 0u; mine = (j == x) ? c : mine; }
        if (sum == G) break;
        __builtin_amdgcn_s_sleep(1);
        if ((++sp & 255u) == 0u) { if (xb_ld(&bar[XB_TMO])) break; if (sp > XB_SPIN_CAP) { atomicAdd(&bar[XB_TMO], 1u); break; } }
    }
    nloc = mine > 0u ? mine : 1u; nx = cnt > 0u ? cnt : 1u;
}

__device__ __forceinline__ void xcd_barrier(const XcdBarrier& b) {
    asm volatile("s_waitcnt vmcnt(0)" ::: "memory");
    __syncthreads();
    if (threadIdx.x == 0) {
        unsigned* bar = b.bar;
        __builtin_amdgcn_s_waitcnt(0);
        unsigned nloc = b.st[0], nx = b.st[1];
        if (nloc == 0u) { xcd_barrier_complete(bar, b.x, nloc, nx); b.st[0] = nloc; b.st[1] = nx; }
        const unsigned old = xb_add(&bar[XB_XSUB(b.x)], 1u);
        const unsigned gen = old / nloc;
        if (old + 1u == (gen + 1u) * nloc) {
            __builtin_amdgcn_fence(__ATOMIC_RELEASE, "agent");
            asm volatile("s_waitcnt vmcnt(0)" ::: "memory");
            const unsigned og = xb_add(&bar[XB_TOP], 1u);
            const unsigned tg = og / nx;
            if (og + 1u == (tg + 1u) * nx) xb_add(&bar[XB_TOPGEN], 1u);
            else XB_SPIN(xb_ld(&bar[XB_TOPGEN]) == tg, bar);
            __builtin_amdgcn_fence(__ATOMIC_ACQUIRE, "agent");
            xb_add(&bar[XB_XGEN(b.x)], 1u);
            asm volatile("s_waitcnt vmcnt(0)" ::: "memory");
        } else {
            XB_SPIN(xb_ld(&bar[XB_XGEN(b.x)]) == gen, bar);
            __builtin_amdgcn_fence(__ATOMIC_ACQUIRE, "agent");
            asm volatile("s_waitcnt vmcnt(0)" ::: "memory");
        }
    }
    __syncthreads();
}


struct Args { const float* in[17]; float* out; unsigned char* ws; int ph_lo, ph_hi; };
enum { I_XP = 0, I_XS, I_WIN, I_RPB, I_QN, I_KN, I_WNA, I_WGQ, I_WOUT, I_L1G, I_L1B, I_WR, I_WG, I_WU, I_WD, I_L2G, I_L2B };
struct Frame {
    LAS unsigned char* lds;
    int tid, lane, wave;
    int vcu, G;
};
__device__ __forceinline__ GAS unsigned char* ws_here(unsigned char* p0) { GAS unsigned char* p = (GAS unsigned char*)p0; asm volatile("" : "+s"(p)); return p; }
#define WSP(T, off) ((T*)(ws_here(A.ws) + (off)))
__device__ __forceinline__ Frame fresh_frame(const Frame& F0) {
    Frame F = F0; int t = threadIdx.x; asm volatile("" : "+v"(t)); F.tid = t; F.lane = t & 63; F.wave = __builtin_amdgcn_readfirstlane(t >> 6); return F; }

__device__ __forceinline__ float wave_sum(float v) {
#pragma unroll
    for (int o = 1; o < 64; o <<= 1) v += __shfl_xor(v, o);
    return v;
}
__device__ __forceinline__ float wave_max(float v) {
#pragma unroll
    for (int o = 1; o < 64; o <<= 1) v = fmaxf(v, __shfl_xor(v, o));
    return v;
}

__device__ __forceinline__ void conv_item(const float* W, int N, int k0, int n0, bf16* dst, int dpitch, LAS float* scr, int lane) {
#pragma unroll 8
    for (int i = 0; i < 32; ++i) { const int kk = 2 * i + (lane >> 5); scr[kk * 33 + (lane & 31)] = W[(size_t)(k0 + kk) * N + n0 + (lane & 31)]; }
    LDS_WAIT(); asm volatile("" ::: "memory");
    const int c = lane & 7;
#pragma unroll
    for (int j = 0; j < 4; ++j) { const int n = (lane >> 3) + 8 * j; const LAS float* s = scr + (8 * c) * 33 + n;
        v4u o; o.x = pk2(s[0 * 33], s[1 * 33]); o.y = pk2(s[2 * 33], s[3 * 33]); o.z = pk2(s[4 * 33], s[5 * 33]); o.w = pk2(s[6 * 33], s[7 * 33]);
        *(GAS v4u*)(dst + (size_t)n * dpitch + 8 * c) = o; }
    LDS_WAIT(); asm volatile("" ::: "memory");
}
__device__ __forceinline__ void conv8_item(const float* W, int N, int k0, int n0, unsigned char* dst, int dpitch, float scale, LAS float* scr, int lane) {
#pragma unroll 8
    for (int i = 0; i < 32; ++i) { const int kk = 2 * i + (lane >> 5); scr[kk * 33 + (lane & 31)] = W[(size_t)(k0 + kk) * N + n0 + (lane & 31)] * scale; }
    LDS_WAIT(); asm volatile("" ::: "memory");
    const int n = lane >> 1, c2 = lane & 1; const LAS float* s = scr + (32 * c2) * 33 + n;
    v4u o0, o1;
    o0.x = pg8::pack4_fp8(s[0 * 33], s[1 * 33], s[2 * 33], s[3 * 33]);     o0.y = pg8::pack4_fp8(s[4 * 33], s[5 * 33], s[6 * 33], s[7 * 33]);
    o0.z = pg8::pack4_fp8(s[8 * 33], s[9 * 33], s[10 * 33], s[11 * 33]);   o0.w = pg8::pack4_fp8(s[12 * 33], s[13 * 33], s[14 * 33], s[15 * 33]);
    o1.x = pg8::pack4_fp8(s[16 * 33], s[17 * 33], s[18 * 33], s[19 * 33]); o1.y = pg8::pack4_fp8(s[20 * 33], s[21 * 33], s[22 * 33], s[23 * 33]);
    o1.z = pg8::pack4_fp8(s[24 * 33], s[25 * 33], s[26 * 33], s[27 * 33]); o1.w = pg8::pack4_fp8(s[28 * 33], s[29 * 33], s[30 * 33], s[31 * 33]);
    GAS v4u* d = (GAS v4u*)(dst + (size_t)n * dpitch + 32 * c2);
    d[0] = o0; d[1] = o1;
    LDS_WAIT(); asm volatile("" ::: "memory");
}
struct CItem { const float* src; unsigned char* dst; int N, dpitch; float scale; int f8; };
__device__ __forceinline__ CItem conv_expert_item(const Args& A, int layer, int r) {
    constexpr int I_E = 16 * 64, I_D = 32 * 32, per_e = 2 * I_E + I_D;
    CItem c; const int e = r / per_e; r -= e * per_e;
    if (r < 2 * I_E) { const int up = r / I_E, q = r % I_E, kb = q / 64, nb = q % 64, n0 = 32 * nb;
        c.src = (up ? A.in[I_WU] : A.in[I_WG]) + ((size_t)layer * NE + e) * DM * DF + (size_t)(64 * kb) * DF + n0; c.N = DF;
        const int drow = e * 4096 + (n0 >> 7) * 256 + up * 128 + (n0 & 127);
        c.f8 = FP8_E1; c.scale = FP8_E1 ? W1_SCALE : 1.f; c.dpitch = FP8_E1 ? DM : 2 * DM;
        c.dst = WSP(unsigned char, WS_W1) + (size_t)drow * c.dpitch + (size_t)(64 * kb) * (FP8_E1 ? 1 : 2);
    } else { r -= 2 * I_E; const int kb = r / 32, nb = r % 32;
        c.src = A.in[I_WD] + ((size_t)layer * NE + e) * DF * DM + (size_t)(64 * kb) * DM + 32 * nb; c.N = DM;
        c.f8 = FP8_E2; c.scale = FP8_E2 ? W2_SCALE : 1.f; c.dpitch = FP8_E2 ? DF : 2 * DF;
        c.dst = WSP(unsigned char, WS_W2) + (size_t)(e * 1024 + 32 * nb) * c.dpitch + (size_t)(64 * kb) * (FP8_E2 ? 1 : 2);
    }
    return c;
}
__device__ __forceinline__ void conv_experts(const Args& A, const Frame& F0, int layer, int gw, int NGW) {
    const Frame F = fresh_frame(F0);
    LAS float* scr = (LAS float*)(F.lds + RING_OFF + F.wave * 16384);
    const int lane = F.lane;
    constexpr int NIT = NE * (2 * 16 * 64 + 32 * 32);
    float ra[32], rb[32]; CItem cur, nxt;
    int it = gw;
    if (it < NIT) { cur = conv_expert_item(A, layer, it);
#pragma unroll
        for (int i = 0; i < 32; ++i) ra[i] = cur.src[(size_t)(2 * i + (lane >> 5)) * cur.N + (lane & 31)]; }
#pragma unroll 1
    while (it < NIT) {
        const int it2 = it + NGW;
        if (it2 < NIT) { nxt = conv_expert_item(A, layer, it2);
#pragma unroll
            for (int i = 0; i < 32; ++i) rb[i] = nxt.src[(size_t)(2 * i + (lane >> 5)) * nxt.N + (lane & 31)]; }
#pragma unroll
        for (int i = 0; i < 32; ++i) scr[(2 * i + (lane >> 5)) * 33 + (lane & 31)] = ra[i] * cur.scale;
        LDS_WAIT(); asm volatile("" ::: "memory");
        if (cur.f8) {
            const int n = lane >> 1, c2 = lane & 1; const LAS float* s = scr + (32 * c2) * 33 + n;
            v4u o0, o1;
            o0.x = pg8::pack4_fp8(s[0 * 33], s[1 * 33], s[2 * 33], s[3 * 33]);     o0.y = pg8::pack4_fp8(s[4 * 33], s[5 * 33], s[6 * 33], s[7 * 33]);
            o0.z = pg8::pack4_fp8(s[8 * 33], s[9 * 33], s[10 * 33], s[11 * 33]);   o0.w = pg8::pack4_fp8(s[12 * 33], s[13 * 33], s[14 * 33], s[15 * 33]);
            o1.x = pg8::pack4_fp8(s[16 * 33], s[17 * 33], s[18 * 33], s[19 * 33]); o1.y = pg8::pack4_fp8(s[20 * 33], s[21 * 33], s[22 * 33], s[23 * 33]);
            o1.z = pg8::pack4_fp8(s[24 * 33], s[25 * 33], s[26 * 33], s[27 * 33]); o1.w = pg8::pack4_fp8(s[28 * 33], s[29 * 33], s[30 * 33], s[31 * 33]);
            GAS v4u* d = (GAS v4u*)(cur.dst + (size_t)n * cur.dpitch + 32 * c2);
            d[0] = o0; d[1] = o1;
        } else {
            const int c = lane & 7;
#pragma unroll
            for (int j = 0; j < 4; ++j) { const int n = (lane >> 3) + 8 * j; const LAS float* s = scr + (8 * c) * 33 + n;
                v4u o; o.x = pk2(s[0 * 33], s[1 * 33]); o.y = pk2(s[2 * 33], s[3 * 33]); o.z = pk2(s[4 * 33], s[5 * 33]); o.w = pk2(s[6 * 33], s[7 * 33]);
                *(GAS v4u*)(cur.dst + (size_t)n * cur.dpitch + 16 * c) = o; }
        }
        LDS_WAIT(); asm volatile("" ::: "memory");
#pragma unroll
        for (int i = 0; i < 32; ++i) ra[i] = rb[i];
        cur = nxt; it = it2;
    }
}
template <int PART> __device__ __forceinline__ void phase_conv(const Args& A, const Frame& F0, int layer, int gw, int NGW) {
    const Frame F = fresh_frame(F0);
    LAS float* scr = (LAS float*)(F.lds + RING_OFF + F.wave * 16384);
    constexpr int I_IN = 16 * 136, I_BR = 8 * 32, I_OUT = 16 * 32, I_E = 16 * 64  , I_D = 32 * 32  ;
    constexpr int NSMALL = I_IN + 2 * I_BR + I_OUT, NITEMS = NSMALL + NE * (2 * I_E + I_D);
    for (int it = (PART == 0 ? 0 : NSMALL) + gw; it < (PART == 0 ? NSMALL : NITEMS); it += NGW) {
        int r = it;
        if (r < I_IN) { const int kb = r / 136, nb = r % 136;
            if (FP8_G1) conv8_item(A.in[I_WIN] + (size_t)layer * DM * D_IN, D_IN, 64 * kb, 32 * nb, WSP(unsigned char, WS_WIN) + (size_t)(32 * nb) * DM + 64 * kb, DM, WIN_SCALE, scr, F.lane);
            else conv_item(A.in[I_WIN] + (size_t)layer * DM * D_IN, D_IN, 64 * kb, 32 * nb, WSP(bf16, WS_WIN) + (size_t)(32 * nb) * DM + 64 * kb, DM, scr, F.lane);
            continue; } r -= I_IN;
        if (r < I_BR) { const int kb = r / 32, nb = r % 32;
            if (FP8_BR) conv8_item(A.in[I_WNA] + (size_t)layer * 512 * DM, DM, 64 * kb, 32 * nb, WSP(unsigned char, WS_WBR) + (size_t)(32 * nb) * 512 + 64 * kb, 512, WBR_SCALE, scr, F.lane);
            else conv_item(A.in[I_WNA] + (size_t)layer * 512 * DM, DM, 64 * kb, 32 * nb, WSP(bf16, WS_WBR) + (size_t)(32 * nb) * 512 + 64 * kb, 512, scr, F.lane); continue; } r -= I_BR;
        if (r < I_BR) { const int kb = r / 32, nb = r % 32;
            if (FP8_BR) conv8_item(A.in[I_WGQ] + (size_t)layer * 512 * DM, DM, 64 * kb, 32 * nb, WSP(unsigned char, WS_WBR) + (size_t)(1024 + 32 * nb) * 512 + 64 * kb, 512, WBR_SCALE, scr, F.lane);
            else conv_item(A.in[I_WGQ] + (size_t)layer * 512 * DM, DM, 64 * kb, 32 * nb, WSP(bf16, WS_WBR) + (size_t)(1024 + 32 * nb) * 512 + 64 * kb, 512, scr, F.lane); continue; } r -= I_BR;
        if (r < I_OUT) { const int kb = r / 32, nb = r % 32;
            if (FP8_OUT) conv8_item(A.in[I_WOUT] + (size_t)layer * DM * DM, DM, 64 * kb, 32 * nb, WSP(unsigned char, WS_WOUT) + (size_t)(32 * nb) * DM + 64 * kb, DM, WOUT_SCALE, scr, F.lane);
            else conv_item(A.in[I_WOUT] + (size_t)layer * DM * DM, DM, 64 * kb, 32 * nb, WSP(bf16, WS_WOUT) + (size_t)(32 * nb) * DM + 64 * kb, DM, scr, F.lane);
            continue; } r -= I_OUT;
        const int per_e = 2 * I_E + I_D, e = r / per_e; r -= e * per_e;
        if (r < 2 * I_E) { const int up = r / I_E, q = r % I_E, kb = q / 64, nb = q % 64, n0 = 32 * nb;
            const float* src = (up ? A.in[I_WU] : A.in[I_WG]) + ((size_t)layer * NE + e) * DM * DF;
            const int drow = e * 4096 + (n0 >> 7) * 256 + up * 128 + (n0 & 127);
            if (FP8_E1) conv8_item(src, DF, 64 * kb, n0, WSP(unsigned char, WS_W1) + (size_t)drow * DM + 64 * kb, DM, W1_SCALE, scr, F.lane);
            else conv_item(src, DF, 64 * kb, n0, WSP(bf16, WS_W1) + (size_t)drow * DM + 64 * kb, DM, scr, F.lane);
            continue; }
        r -= 2 * I_E;
        { const int kb = r / 32, nb = r % 32; const float* src = A.in[I_WD] + ((size_t)layer * NE + e) * DF * DM;
          if (FP8_E2) conv8_item(src, DM, 64 * kb, 32 * nb, WSP(unsigned char, WS_W2) + (size_t)(e * 1024 + 32 * nb) * DF + 64 * kb, DF, W2_SCALE, scr, F.lane);
          else conv_item(src, DM, 64 * kb, 32 * nb, WSP(bf16, WS_W2) + (size_t)(e * 1024 + 32 * nb) * DF + 64 * kb, DF, scr, F.lane); }
    }
    if (PART == 0 && layer == 0) {
        for (int m = gw; m < NTOK; m += NGW) {
            const float* src = m < NP ? A.in[I_XP] + (size_t)m * DM : A.in[I_XS] + (size_t)(m - NP) * DM;
            const GAS f32x4* xr = (const GAS f32x4*)src + F.lane;
            GAS f32x4* xo = (GAS f32x4*)(A.out + (size_t)m * DM) + F.lane;
            GAS v2u* bo = (GAS v2u*)(WSP(bf16, WS_XB) + (size_t)m * DM) + F.lane;
#pragma unroll
            for (int j = 0; j < 4; ++j) { const f32x4 v = xr[64 * j]; if (!FP8_MIX) xo[64 * j] = v;
                if (FP8_G1) ((GAS unsigned*)(WSP(unsigned char, WS_XB8) + (size_t)m * DM))[F.lane + 64 * j] = pg8::pack4_fp8(v.x, v.y, v.z, v.w);
                else { v2u w; w.x = pk2(v.x, v.y); w.y = pk2(v.z, v.w); bo[64 * j] = w; } }
        }
    }
}

__device__ __forceinline__ int crow16(int rr, int hi) { return (rr & 3) + 8 * (rr >> 2) + 4 * hi; }
#define NA_COMPUTE1(CUR_, KR_) { \
            const LAS unsigned char* trow = (const LAS unsigned char*)(tab + ((KR_) - rA + 7) * 32) + blane; \
            f32x16 c0; \
            if (FP8_NAQK) { const attn_body::i32x4q a_ = *(const LAS attn_body::i32x4q*)((CUR_) + kroff), b_ = *(const LAS attn_body::i32x4q*)((CUR_) + kroff + 1040); c0 = MFMA8(__builtin_shufflevector(a_, b_, 0, 1, 2, 3, 4, 5, 6, 7), qf8, am0v); } else \
    _Pragma("unroll") \
            for (int ds = 0; ds < 4; ++ds) { \
                const bf16x8 k0 = *(const LAS bf16x8*)((CUR_) + kroff + ds * 2080); \
                c0 = __builtin_amdgcn_mfma_f32_32x32x16_bf16(k0, qf[ds], ds == 0 ? am0v : c0, 0, 0, 0);     \
            } \
            float mx = -INFINITY; \
    _Pragma("unroll") \
            for (int rr = 0; rr < 16; rr += 2) { \
                const float b0 = *(const LAS float*)(trow + 4 * ((rr & 3) + 8 * (rr >> 2))), b1 = *(const LAS float*)(trow + 4 * (((rr + 1) & 3) + 8 * ((rr + 1) >> 2))); \
                c0[rr] += b0; c0[rr + 1] += b1; \
                mx = fmaxf(mx, fmaxf(c0[rr], c0[rr + 1])); \
            } \
            { const auto rr_ = __builtin_amdgcn_permlane32_swap(__float_as_uint(mx), __float_as_uint(mx), false, false); mx = fmaxf(__uint_as_float(rr_[0]), __uint_as_float(rr_[1])); }     \
            const bool rowlive = ((KR_) >= rsq) && ((KR_) < rsq + 8);      \
            { const bool need = rowlive && (mx > mrun + 8.0f);     \
              if (__any(need)) { const float mnew = need ? mx : mrun, alpha = need ? __builtin_amdgcn_exp2f(mrun - mnew) : 1.0f; mrun = mnew; lrun *= alpha; \
    _Pragma("unroll") \
                for (int db = 0; db < 2; ++db) \
    _Pragma("unroll") \
                    for (int k = 0; k < 16; ++k) o[db][k] *= alpha; } } \
            const float msub = rowlive ? mrun : INFINITY;                   \
            float ps = 0.f; \
    _Pragma("unroll") \
            for (int rr = 0; rr < 16; ++rr) { c0[rr] = __builtin_amdgcn_exp2f(c0[rr] - msub); ps += c0[rr]; } \
            lrun += ps; \
            bf16x8 pb[2]; \
    _Pragma("unroll") \
            for (int s = 0; s < 2; ++s) { \
                v4u w0; \
                w0.x = pk2(c0[8 * s + 0], c0[8 * s + 1]); w0.y = pk2(c0[8 * s + 2], c0[8 * s + 3]); w0.z = pk2(c0[8 * s + 4], c0[8 * s + 5]); w0.w = pk2(c0[8 * s + 6], c0[8 * s + 7]); \
                pb[s] = __builtin_bit_cast(bf16x8, w0); \
            } \
    _Pragma("unroll") \
            for (int s = 0; s < 2; ++s) \
    _Pragma("unroll") \
                for (int db = 0; db < 2; ++db) { \
                    const LAS unsigned char* vp = (CUR_) + vroff + db * 4160 + s * 1024; \
                    const attn_body::s16x4 lo = attn_body::vtr((attn_body::lds_cptr)vp), hi2 = attn_body::vtr((attn_body::lds_cptr)(vp + 512)); \
                    const bf16x8 vfr = (bf16x8){lo[0], lo[1], lo[2], lo[3], hi2[0], hi2[1], hi2[2], hi2[3]}; \
                    o[db] = __builtin_amdgcn_mfma_f32_32x32x16_bf16(vfr, pb[s], o[db], 0, 0, 0); } }
#define NA_COMPUTE2(CUR0_, CUR1_, KR_) { \
            const LAS unsigned char* trow = (const LAS unsigned char*)(tab + ((KR_) - rA + 7) * 32) + blane; \
            f32x16 c0, c1; \
            if (FP8_NAQK) { const attn_body::i32x4q a0_ = *(const LAS attn_body::i32x4q*)((CUR0_) + kroff), b0_ = *(const LAS attn_body::i32x4q*)((CUR0_) + kroff + 1040), a1_ = *(const LAS attn_body::i32x4q*)((CUR1_) + kroff), b1_ = *(const LAS attn_body::i32x4q*)((CUR1_) + kroff + 1040); \
                c0 = MFMA8(__builtin_shufflevector(a0_, b0_, 0, 1, 2, 3, 4, 5, 6, 7), qf8, am0v); c1 = MFMA8(__builtin_shufflevector(a1_, b1_, 0, 1, 2, 3, 4, 5, 6, 7), qf8, am0v); } else \
    _Pragma("unroll") \
            for (int ds = 0; ds < 4; ++ds) { \
                const bf16x8 k0 = *(const LAS bf16x8*)((CUR0_) + kroff + ds * 2080), k1 = *(const LAS bf16x8*)((CUR1_) + kroff + ds * 2080); \
                c0 = __builtin_amdgcn_mfma_f32_32x32x16_bf16(k0, qf[ds], ds == 0 ? am0v : c0, 0, 0, 0); \
                c1 = __builtin_amdgcn_mfma_f32_32x32x16_bf16(k1, qf[ds], ds == 0 ? am0v : c1, 0, 0, 0); \
            } \
            float mx0 = -INFINITY, mx1 = -INFINITY; \
    _Pragma("unroll") \
            for (int rr = 0; rr < 16; rr += 2) { \
                const float b0 = *(const LAS float*)(trow + 4 * ((rr & 3) + 8 * (rr >> 2))), b1 = *(const LAS float*)(trow + 4 * (((rr + 1) & 3) + 8 * ((rr + 1) >> 2))); \
                const float d0 = *(const LAS float*)(trow + 128 + 4 * ((rr & 3) + 8 * (rr >> 2))), d1 = *(const LAS float*)(trow + 128 + 4 * (((rr + 1) & 3) + 8 * ((rr + 1) >> 2))); \
                c0[rr] += b0; c0[rr + 1] += b1; c1[rr] += d0; c1[rr + 1] += d1; \
                mx0 = fmaxf(mx0, fmaxf(c0[rr], c0[rr + 1])); mx1 = fmaxf(mx1, fmaxf(c1[rr], c1[rr + 1])); \
            } \
            const bool rowlive0 = ((KR_) >= rsq) && ((KR_) < rsq + 8), rowlive1 = ((KR_) + 1 >= rsq) && ((KR_) + 1 < rsq + 8); \
            float mx = fmaxf(rowlive0 ? mx0 : -INFINITY, rowlive1 ? mx1 : -INFINITY); \
            { const auto rr_ = __builtin_amdgcn_permlane32_swap(__float_as_uint(mx), __float_as_uint(mx), false, false); mx = fmaxf(__uint_as_float(rr_[0]), __uint_as_float(rr_[1])); } \
            { const bool need = mx > mrun + 8.0f;                           \
              if (__any(need)) { const float mnew = need ? mx : mrun, alpha = need ? __builtin_amdgcn_exp2f(mrun - mnew) : 1.0f; mrun = mnew; lrun *= alpha; \
    _Pragma("unroll") \
                for (int db = 0; db < 2; ++db) \
    _Pragma("unroll") \
                    for (int k = 0; k < 16; ++k) o[db][k] *= alpha; } } \
            const float msub0 = rowlive0 ? mrun : INFINITY, msub1 = rowlive1 ? mrun : INFINITY; \
            float ps = 0.f; \
    _Pragma("unroll") \
            for (int rr = 0; rr < 16; ++rr) { c0[rr] = __builtin_amdgcn_exp2f(c0[rr] - msub0); c1[rr] = __builtin_amdgcn_exp2f(c1[rr] - msub1); ps += c0[rr] + c1[rr]; } \
            lrun += ps; \
            bf16x8 pb[2][2]; \
    _Pragma("unroll") \
            for (int s = 0; s < 2; ++s) { \
                v4u w0, w1; \
                w0.x = pk2(c0[8 * s + 0], c0[8 * s + 1]); w0.y = pk2(c0[8 * s + 2], c0[8 * s + 3]); w0.z = pk2(c0[8 * s + 4], c0[8 * s + 5]); w0.w = pk2(c0[8 * s + 6], c0[8 * s + 7]); \
                w1.x = pk2(c1[8 * s + 0], c1[8 * s + 1]); w1.y = pk2(c1[8 * s + 2], c1[8 * s + 3]); w1.z = pk2(c1[8 * s + 4], c1[8 * s + 5]); w1.w = pk2(c1[8 * s + 6], c1[8 * s + 7]); \
                pb[0][s] = __builtin_bit_cast(bf16x8, w0); pb[1][s] = __builtin_bit_cast(bf16x8, w1); \
            } \
    _Pragma("unroll") \
            for (int kb2 = 0; kb2 < 2; ++kb2) \
    _Pragma("unroll") \
                for (int s = 0; s < 2; ++s) \
    _Pragma("unroll") \
                    for (int db = 0; db < 2; ++db) { \
                        const LAS unsigned char* vp = (kb2 ? (CUR1_) : (CUR0_)) + vroff + db * 4160 + s * 1024; \
                        const attn_body::s16x4 lo = attn_body::vtr((attn_body::lds_cptr)vp), hi2 = attn_body::vtr((attn_body::lds_cptr)(vp + 512)); \
                        const bf16x8 vfr = (bf16x8){lo[0], lo[1], lo[2], lo[3], hi2[0], hi2[1], hi2[2], hi2[3]}; \
                        o[db] = __builtin_amdgcn_mfma_f32_32x32x16_bf16(vfr, pb[kb2][s], o[db], 0, 0, 0); } }
constexpr int NA_KBUF = 8 * 1040, NA_VBUF = 2 * 4160, NA_BUF = NA_KBUF + NA_VBUF;
__device__ __forceinline__ void na_unitset(const bf16* __restrict__ QKV, bf16* __restrict__ OUT, const LAS float* tab, LAS unsigned char* stg  , size_t tok0, int rows, int h, int r0, int tid, int lane, int wave) {
    const int r32 = lane & 31, hi = lane >> 5;
    const int rA = r0 + 2 * (wave >> 2), ag = wave & 3, rq = rA + (r32 >> 4);
    int rsA = rA - 4; rsA = rsA < 0 ? 0 : rsA; rsA = rsA > rows - 8 ? rows - 8 : rsA;
    int rsB = rA - 3; rsB = rsB < 0 ? 0 : rsB; rsB = rsB > rows - 8 ? rows - 8 : rsB;
    const int rsq = (r32 >> 4) ? rsB : rsA;
    int kr_lo = r0 - 4; kr_lo = kr_lo < 0 ? 0 : kr_lo; kr_lo = kr_lo > rows - 8 ? rows - 8 : kr_lo;
    int kr_hi = r0 - 1; kr_hi = kr_hi < 0 ? 0 : kr_hi; kr_hi = kr_hi > rows - 8 ? rows - 8 : kr_hi; kr_hi += 7;
    const int nk = kr_hi - kr_lo + 1;
    const int c = 16 * ag + (r32 & 15);
    int cs = c - 8; cs = cs < 0 ? 0 : cs; cs = cs > 48 ? 48 : cs;
    int kb = 16 * ag - 8; kb = kb < 0 ? 0 : kb; kb = kb > 32 ? 32 : kb;
    bf16x8 qf[4];
#pragma unroll
    for (int ds = 0; ds < 4; ++ds) qf[ds] = FP8_NAQK ? (bf16x8){} : *(const bf16x8*)(QKV + (tok0 + (size_t)rq * 64 + c) * 1536 + h * 64 + 16 * ds + 8 * hi);
    const unsigned char* const N8 = (const unsigned char*)QKV; attn_body::i32x8q qf8 = {};
    if (FP8_NAQK) { const unsigned char* qp = N8 + (tok0 + (size_t)rq * 64 + c) * 2048 + h * 64 + 32 * hi; const attn_body::i32x4q a_ = *(const attn_body::i32x4q*)qp, b_ = *(const attn_body::i32x4q*)(qp + 16); qf8 = __builtin_shufflevector(a_, b_, 0, 1, 2, 3, 4, 5, 6, 7); }
    f32x16 o[2];
#pragma unroll
    for (int b = 0; b < 2; ++b)
#pragma unroll
        for (int k = 0; k < 16; ++k) o[b][k] = 0.f;
    float mrun = -INFINITY, lrun = 0.f;
    f32x16 am0v;
#pragma unroll
    for (int rr = 0; rr < 16; ++rr) { const int kc0 = kb + crow16(rr, hi); am0v[rr] = (kc0 >= cs && kc0 < cs + 16) ? 0.f : -INFINITY; }
    const int blane = 4 * (15 - c + kb + 4 * hi) - 128 * (r32 >> 4);
    const int skey = tid >> 3, sch = tid & 7;
    const bf16* gk = QKV + (tok0 + (size_t)kr_lo * 64 + skey) * 1536 + 512 + h * 64 + 8 * sch;
    const unsigned char* const gkk = N8 + (tok0 + (size_t)kr_lo * 64 + skey) * 2048 + 512 + h * 64 + (sch & 3) * 16;
    const unsigned char* const gkv = N8 + (tok0 + (size_t)kr_lo * 64 + skey) * 2048 + 1024 + h * 128 + sch * 16;
#define NA_LDK(j_) (FP8_NAQK ? *(const GAS v4u*)(gkk + (size_t)(j_) * 131072) : *(const GAS v4u*)(gk + (size_t)(j_) * 64 * 1536))
#define NA_LDV(j_) (FP8_NAQK ? *(const GAS v4u*)(gkv + (size_t)(j_) * 131072) : *(const GAS v4u*)(gk + (size_t)(j_) * 64 * 1536 + 512))
    const int kwoff = (FP8_NAQK ? (sch & 3) : sch) * 1040 + skey * 16, vwoff = NA_KBUF + (sch >> 2) * 4160 + skey * 64 + (sch & 3) * 16;
    const int kroff = FP8_NAQK ? hi * 2080 + (kb + r32) * 16 : hi * 1040 + (kb + r32) * 16;
    const int vroff = NA_KBUF + kb * 64 + ((lane >> 4) & 1) * 32 + (lane & 3) * 8 + (4 * hi + ((lane & 15) >> 2)) * 64;
    v4u kq0 = NA_LDK(0), vq0 = NA_LDV(0), kq1 = kq0, vq1 = vq0, kq2 = kq0, vq2 = vq0, kq3 = kq0, vq3 = vq0;
    if (1 < nk) { kq1 = NA_LDK(1); vq1 = NA_LDV(1); }
    if (2 < nk) { kq2 = NA_LDK(2); vq2 = NA_LDV(2); }
    if (3 < nk) { kq3 = NA_LDK(3); vq3 = NA_LDV(3); }
    *(LAS v4u*)(stg + kwoff) = kq0; *(LAS v4u*)(stg + vwoff) = vq0;
    if (1 < nk) { *(LAS v4u*)(stg + NA_BUF + kwoff) = kq1; *(LAS v4u*)(stg + NA_BUF + vwoff) = vq1; }
    __syncthreads();
    if (4 < nk) { kq0 = NA_LDK(4); vq0 = NA_LDV(4); }
    if (5 < nk) { kq1 = NA_LDK(5); vq1 = NA_LDV(5); }
#define NA_STEP(t, KA, VA, KB, VB) do { \
        LAS unsigned char* cur0 = stg + ((t) & 3) * NA_BUF; LAS unsigned char* cur1 = stg + (((t) + 1) & 3) * NA_BUF; \
        const int kr = kr_lo + (t); \
        const bool live0 = kr >= rsA && kr < rsB + 8, live1 = ((t) + 1 < nk) && kr + 1 >= rsA && kr + 1 < rsB + 8; \
        if (live0 && live1) NA_COMPUTE2(cur0, cur1, kr) else if (live0) NA_COMPUTE1(cur0, kr) else if (live1) NA_COMPUTE1(cur1, kr + 1) \
        if ((t) + 2 < nk) { LAS unsigned char* nxt = stg + (((t) + 2) & 3) * NA_BUF; *(LAS v4u*)(nxt + kwoff) = KA; *(LAS v4u*)(nxt + vwoff) = VA; } \
        if ((t) + 3 < nk) { LAS unsigned char* nxt = stg + (((t) + 3) & 3) * NA_BUF; *(LAS v4u*)(nxt + kwoff) = KB; *(LAS v4u*)(nxt + vwoff) = VB; } \
        if ((t) + 6 < nk) { KA = NA_LDK((t) + 6); VA = NA_LDV((t) + 6); } \
        if ((t) + 7 < nk) { KB = NA_LDK((t) + 7); VB = NA_LDV((t) + 7); } \
        __syncthreads(); } while (0)
#pragma unroll 1
    for (int t0 = 0; t0 < nk; t0 += 4) {
        NA_STEP(t0, kq2, vq2, kq3, vq3);
        if (t0 + 2 < nk) NA_STEP(t0 + 2, kq0, vq0, kq1, vq1);
    }
#undef NA_STEP
    float l; { const auto rr_ = __builtin_amdgcn_permlane32_swap(__float_as_uint(lrun), __float_as_uint(lrun), false, false); l = __uint_as_float(rr_[0]) + __uint_as_float(rr_[1]); } const float inv = 1.0f / l;
    if (FP8_BR) { unsigned char* orow8 = (unsigned char*)OUT + (tok0 + (size_t)rq * 64 + c) * 512 + h * 64; const float sc = inv * ATT_SCALE;
#pragma unroll
        for (int db = 0; db < 2; ++db)
#pragma unroll
            for (int g = 0; g < 4; ++g) *(GAS unsigned*)(orow8 + 32 * db + 8 * g + 4 * hi) = pg8::pack4_fp8(o[db][4 * g + 0] * sc, o[db][4 * g + 1] * sc, o[db][4 * g + 2] * sc, o[db][4 * g + 3] * sc);
        return; }
    bf16* orow = OUT + (tok0 + (size_t)rq * 64 + c) * 512 + h * 64;
#pragma unroll
    for (int db = 0; db < 2; ++db)
#pragma unroll
        for (int g = 0; g < 4; ++g) { v2u w; w.x = pk2(o[db][4 * g + 0] * inv, o[db][4 * g + 1] * inv); w.y = pk2(o[db][4 * g + 2] * inv, o[db][4 * g + 3] * inv);
            *(GAS v2u*)(orow + 32 * db + 8 * g + 4 * hi) = w; }
}
struct RopeLane { f32x4 gq, gk; float invf[4]; };
template <bool DRY> __device__ __forceinline__ void rope_compute(const Args& A, const RopeLane& L, const f32x4 (&v)[3], int m, int lane) {
    bf16* outrow = (DRY ? WSP(bf16, WS_Z) : WSP(bf16, WS_QKVB)) + (size_t)m * 768;
    const int t = m < NP ? (m & (SEQ_P - 1)) : ((m - NP) & (SEQ_S - 1));
    const int pos = (lane & 8) ? (t & 63) : (t >> 6);
    float cs[4], sn[4];
#pragma unroll
    for (int k = 0; k < 4; ++k) { const float ang = (float)pos * L.invf[k]; cs[k] = __cosf(ang); sn[k] = __sinf(ang); }
    const float sgn = (lane & 4) ? 1.f : -1.f;
    v2u ob[3];
#pragma unroll
    for (int j = 0; j < 3; ++j) {
        f32x4 x = v[j];
        const bool is_v = (j == 2) && (lane >= 32);
        float ss = (x.x * x.x + x.y * x.y) + (x.z * x.z + x.w * x.w);
        ss += __shfl_xor(ss, 1); ss += __shfl_xor(ss, 2); ss += __shfl_xor(ss, 4); ss += __shfl_xor(ss, 8);
        const float rn = 1.0f / sqrtf(ss * (1.0f / 64.0f) + RMS_EPS);
        const f32x4 gn = (j < 2) ? L.gq : L.gk;
        f32x4 y = x * rn * gn;
        f32x4 pr; pr.x = __shfl_xor(y.x, 4); pr.y = __shfl_xor(y.y, 4); pr.z = __shfl_xor(y.z, 4); pr.w = __shfl_xor(y.w, 4);
        f32x4 o;
        o.x = y.x * cs[0] + sgn * pr.x * sn[0]; o.y = y.y * cs[1] + sgn * pr.y * sn[1]; o.z = y.z * cs[2] + sgn * pr.z * sn[2]; o.w = y.w * cs[3] + sgn * pr.w * sn[3];
        if (j < 2) o = o * QSCALE;
        if (is_v) o = x;
        ob[j].x = pk2(o.x, o.y); ob[j].y = pk2(o.z, o.w);
    }
    GAS v2u* dst = (GAS v2u*)outrow + lane;
#ifdef ROPE_DRY_NOSTORE
    if (DRY) { asm volatile("" :: "v"(ob[0].x), "v"(ob[0].y), "v"(ob[1].x), "v"(ob[1].y), "v"(ob[2].x), "v"(ob[2].y)); return; }
#endif
#pragma unroll
    for (int j = 0; j < 3; ++j) dst[64 * j] = ob[j];
}
__device__ __forceinline__ void phase_na(const Args& A, const Frame& F0, int layer) {
    const Frame F = fresh_frame(F0);
    LAS float* tab = (LAS float*)(F.lds + RING_OFF) + 64;
    const float* rpb = A.in[I_RPB] + (size_t)layer * 8 * 15 * 31;
    for (int idx = F.tid; idx < 128; idx += NWAVES * 64) { (idx < 64 ? tab - 64 : tab + 8 * 15 * 32 - 64)[idx] = 0.f; }
    for (int idx = F.tid; idx < 8 * 15 * 32; idx += NWAVES * 64) { const int h = idx / 480, rem = idx % 480, dr = rem >> 5, dc = rem & 31;
        tab[idx] = dc < 31 ? rpb[(h * 15 + dr) * 31 + dc] * LOG2E : 0.f; }
    __syncthreads();
    const int gw = F.vcu * NWAVES + F.wave, NGW = F.G * NWAVES;
    constexpr int NUS_P = 8 * 8 * 16, NUS = NUS_P + 8 * 8 * 32;
#pragma unroll 1
    for (int rep_ = 0; rep_ < NREP(2); ++rep_)
#pragma unroll 1
    for (int us = F.vcu; us < NUS; us += F.G) {
        size_t tok0; int rows, h, r0;
        if (us < NUS_P) { const int b = us >> 7; h = (us >> 4) & 7; r0 = (us & 15) * 4; tok0 = (size_t)b * SEQ_P; rows = 64; }
        else { const int q = us - NUS_P, b = q >> 8; h = (q >> 5) & 7; r0 = (q & 31) * 4; tok0 = (size_t)NP + (size_t)b * SEQ_S; rows = 128; }
        na_unitset(WSP(bf16, WS_NAQKV), rep_ ? WSP(bf16, WS_Z) : WSP(bf16, WS_ATT), tab + h * 480, F.lds + RING_OFF + 16384, tok0, rows, h, r0, F.tid, F.lane, F.wave);
    }
#pragma unroll 1
    for (int rq_ = 0; rq_ < (ROPE_FUSED ? 0 : NREP(12)); ++rq_) { const int rp_ = ROPE_DRY_FIRST ? (NREP(12) - 1 - rq_) : rq_;
        RopeLane L; const int lane = F.lane, d0 = 4 * (lane & 15);
        L.gq = *(const GAS f32x4*)(A.in[I_QN] + layer * 64 + d0); L.gk = *(const GAS f32x4*)(A.in[I_KN] + layer * 64 + d0);
#pragma unroll
        for (int k = 0; k < 4; ++k) L.invf[k] = __builtin_amdgcn_exp2f(-(float)((d0 + k) & 15) * (13.287712379549449f / 16.0f));
        v2u nxb[3];
        if (gw < NTOK) { const GAS v2u* src = (const GAS v2u*)(WSP(bf16, WS_RAWQK) + (size_t)gw * 768) + lane;
#pragma unroll
            for (int j = 0; j < 3; ++j) nxb[j] = src[64 * j]; }
#pragma unroll 1
        for (int m = gw; m < NTOK; m += NGW) {
            f32x4 v[3];
#pragma unroll
            for (int j = 0; j < 3; ++j) { v[j].x = bf_lo(nxb[j].x); v[j].y = bf_hi(nxb[j].x); v[j].z = bf_lo(nxb[j].y); v[j].w = bf_hi(nxb[j].y); }
            const int m2 = m + NGW;
            if (m2 < NTOK) { const GAS v2u* src = (const GAS v2u*)(WSP(bf16, WS_RAWQK) + (size_t)m2 * 768) + lane;
#pragma unroll
                for (int j = 0; j < 3; ++j) nxb[j] = src[64 * j]; }
            if (rp_) rope_compute<true>(A, L, v, m, lane); else rope_compute<false>(A, L, v, m, lane);
        }
    }
    __syncthreads();
}

#define XIN_BASES() const float* const XLO = (FP8_MIX && layer == 0) ? A.in[I_XP] : A.out; const float* const XHI = (FP8_MIX && layer == 0) ? A.in[I_XS] - (size_t)NP * DM : A.out
#define XIN_ROW(m_) (((m_) < NP ? XLO : XHI) + (size_t)(m_) * DM)
template <int CTRL> __device__ __forceinline__ float dpp_mov(float v) { return __int_as_float(__builtin_amdgcn_update_dpp(0, __float_as_int(v), CTRL, 0xF, 0xF, true)); }
__device__ __forceinline__ float row16_sum(float v) { v += dpp_mov<0x128>(v); v += dpp_mov<0x124>(v); v += dpp_mov<0x122>(v); v += dpp_mov<0x121>(v); return v; }
__device__ __forceinline__ float swap16_sum(float a, float b) { const auto rr = __builtin_amdgcn_permlane16_swap(__float_as_uint(a), __float_as_uint(b), false, false); return __uint_as_float(rr[0]) + __uint_as_float(rr[1]); }
__device__ __forceinline__ float swap32_sum(float a, float b) { const auto rr = __builtin_amdgcn_permlane32_swap(__float_as_uint(a), __float_as_uint(b), false, false); return __uint_as_float(rr[0]) + __uint_as_float(rr[1]); }
__device__ __forceinline__ float swap16_max(float a) { const auto rr = __builtin_amdgcn_permlane16_swap(__float_as_uint(a), __float_as_uint(a), false, false); return fmaxf(__uint_as_float(rr[0]), __uint_as_float(rr[1])); }
__device__ __forceinline__ float swap32_max(float a) { const auto rr = __builtin_amdgcn_permlane32_swap(__float_as_uint(a), __float_as_uint(a), false, false); return fmaxf(__uint_as_float(rr[0]), __uint_as_float(rr[1])); }
__device__ __forceinline__ float wave_sum_x(float v) { v = row16_sum(v); v = swap16_sum(v, v); return swap32_sum(v, v); }
template <bool DRY> __device__ __forceinline__ void phase_ln1(const Args& A, const Frame& F0, int layer) {
    const Frame F = fresh_frame(F0);
    constexpr int NR = 2;
    typedef float f32x2v __attribute__((ext_vector_type(2)));
    const int gw = F.vcu * NWAVES + F.wave, NGW = F.G * NWAVES, lane = F.lane;
    const GAS f32x4* gp = (const GAS f32x4*)(A.in[I_L1G] + (size_t)layer * DM) + lane;
    const GAS f32x4* bp = (const GAS f32x4*)(A.in[I_L1B] + (size_t)layer * DM) + lane;
    XIN_BASES();
    float* AFFT = DRY ? WSP(float, WS_R1 + 420 * MiB) : WSP(float, WS_AFFT);
    float* XO = DRY ? WSP(float, WS_R1) : A.out; bf16* XBO = DRY ? WSP(bf16, WS_Z + 201326592) : WSP(bf16, WS_XB);
    { const GAS f32x4* wsrc = (const GAS f32x4*)(A.in[I_WR] + (size_t)layer * DM * NE);
      for (int idx = F.tid; idx < DM * 4; idx += NWAVES * 64) { const int d = idx >> 2, q = idx & 3; *(LAS f32x4*)(F.lds + RING_OFF + d * 64 + (d >> 2) * 16 + q * 16) = wsrc[idx]; }
      __syncthreads(); }
    f32x4 nx[NR][4]; unsigned nmx[NR][4];
#define LN1_LOADSET(mb_) do { const GAS f32x4* src = (const GAS f32x4*)XIN_ROW(mb_) + lane; const GAS unsigned* ms = (const GAS unsigned*)(WSP(unsigned char, WS_MIX8) + (size_t)(mb_) * DM) + lane; \
        _Pragma("unroll") for (int r = 0; r < NR; ++r) { \
            _Pragma("unroll") for (int j = 0; j < 4; ++j) nx[r][j] = __builtin_nontemporal_load(&src[r * (DM / 4) + 64 * j]); \
            _Pragma("unroll") for (int j = 0; j < 4; ++j) nmx[r][j] = FP8_MIX ? ms[r * (DM / 4) + 64 * j] : 0u; } } while (0)
    if (NR * gw < NTOK) LN1_LOADSET(NR * gw);
#pragma unroll 1
    for (int m0 = NR * gw; m0 < NTOK; m0 += NR * NGW) {
        int wlo = lane * 272; asm volatile("" : "+v"(wlo));
        const LAS unsigned char* wl = F.lds + RING_OFF + wlo;
        f32x4 v[NR][4]; float mean[NR], rstd[NR];
#pragma unroll
        for (int r = 0; r < NR; ++r) {
            float s = 0.f;
#pragma unroll
            for (int j = 0; j < 4; ++j) { v[r][j] = nx[r][j];
                if (FP8_MIX) { const f32x2v lo = __builtin_amdgcn_cvt_pk_f32_fp8((int)nmx[r][j], false), hi = __builtin_amdgcn_cvt_pk_f32_fp8((int)nmx[r][j], true);
                    v[r][j].x = __builtin_fmaf(v[r][j].x, DN_ALPHA, lo.x); v[r][j].y = __builtin_fmaf(v[r][j].y, DN_ALPHA, lo.y); v[r][j].z = __builtin_fmaf(v[r][j].z, DN_ALPHA, hi.x); v[r][j].w = __builtin_fmaf(v[r][j].w, DN_ALPHA, hi.y); }
                s += (v[r][j].x + v[r][j].y) + (v[r][j].z + v[r][j].w); }
            mean[r] = wave_sum_x(s) * (1.f / DM);
        }
        __builtin_amdgcn_sched_barrier(0);
        { const int m2 = m0 + NR * NGW; if (m2 < NTOK) LN1_LOADSET(m2); }
        __builtin_amdgcn_sched_barrier(0);
#pragma unroll
        for (int r = 0; r < NR; ++r) { float s2 = 0.f;
#pragma unroll
            for (int j = 0; j < 4; ++j) { v[r][j] = v[r][j] - mean[r]; s2 += (v[r][j].x * v[r][j].x + v[r][j].y * v[r][j].y) + (v[r][j].z * v[r][j].z + v[r][j].w * v[r][j].w); }
            rstd[r] = 1.f / sqrtf(wave_sum_x(s2) * (1.f / DM) + LN_EPS);
            if (!DRY && lane == 0) { *(GAS f32x2v*)(WSP(float, WS_STATS) + (size_t)(m0 + r) * 2) = (f32x2v){mean[r], rstd[r]}; } }
        { int go = lane; asm volatile("" : "+v"(go));
#pragma unroll
          for (int j = 0; j < 4; ++j) { const f32x4 g4 = gp[go - lane + 64 * j], b4 = bp[go - lane + 64 * j];
#pragma unroll
            for (int r = 0; r < NR; ++r) { v[r][j] = v[r][j] * rstd[r] * g4 + b4;
                if (DRY) ((GAS f32x4*)(XO + (size_t)(m0 + r) * DM) + lane)[64 * j] = v[r][j];
                if (FP8_E1 && !DRY) ((GAS unsigned*)(WSP(unsigned char, WS_XB8) + (size_t)(m0 + r) * DM))[lane + 64 * j] = pg8::pack4_fp8(v[r][j].x, v[r][j].y, v[r][j].z, v[r][j].w);
                if (!FP8_E1) { v2u w; w.x = pk2(v[r][j].x, v[r][j].y); w.y = pk2(v[r][j].z, v[r][j].w); ((GAS v2u*)(XBO + (size_t)(m0 + r) * DM) + lane)[64 * j] = w; } } } }
        f32x2v lg[NR][8];
#pragma unroll
        for (int r = 0; r < NR; ++r)
#pragma unroll
            for (int e = 0; e < 8; ++e) lg[r][e] = (f32x2v){0.f, 0.f};
        {
            f32x4 wc[4], wn[4];
#pragma unroll
            for (int q = 0; q < 4; ++q) wc[q] = *(const LAS f32x4*)(wl + 16 * q);
#pragma unroll
            for (int g = 0; g < 16; ++g) {
                if (g + 1 < 16) {
#pragma unroll
                    for (int q = 0; q < 4; ++q) wn[q] = *(const LAS f32x4*)(wl + 17408 * ((g + 1) >> 2) + 64 * ((g + 1) & 3) + 16 * q); }
                __builtin_amdgcn_sched_barrier(0);
#pragma unroll
                for (int q = 0; q < 4; ++q) { const f32x2v wa = {wc[q].x, wc[q].y}, wb = {wc[q].z, wc[q].w};
#pragma unroll
                    for (int r = 0; r < NR; ++r) { const float xv = v[r][g >> 2][g & 3]; const f32x2v x2 = {xv, xv};
                        lg[r][2 * q] = __builtin_elementwise_fma(x2, wa, lg[r][2 * q]); lg[r][2 * q + 1] = __builtin_elementwise_fma(x2, wb, lg[r][2 * q + 1]); } }
                static_assert(NR == 2, "the pin below names both rows' accumulators");
                asm volatile("" : "+v"(lg[0][0]), "+v"(lg[0][1]), "+v"(lg[0][2]), "+v"(lg[0][3]), "+v"(lg[0][4]), "+v"(lg[0][5]), "+v"(lg[0][6]), "+v"(lg[0][7]),
                                  "+v"(lg[1][0]), "+v"(lg[1][1]), "+v"(lg[1][2]), "+v"(lg[1][3]), "+v"(lg[1][4]), "+v"(lg[1][5]), "+v"(lg[1][6]), "+v"(lg[1][7]));
                __builtin_amdgcn_sched_barrier(0);
#pragma unroll
                for (int q = 0; q < 4; ++q) wc[q] = wn[q];
            }
        }
#pragma unroll
        for (int r = 0; r < NR; ++r) {
            float t[8], u[4];
#pragma unroll
            for (int i = 0; i < 8; ++i) t[i] = swap32_sum(lg[r][i >> 1][i & 1], lg[r][4 + (i >> 1)][i & 1]);
#pragma unroll
            for (int i = 0; i < 4; ++i) u[i] = row16_sum(swap16_sum(t[i], t[i + 4]));
            float mx = fmaxf(fmaxf(u[0], u[1]), fmaxf(u[2], u[3])); mx = swap32_max(swap16_max(mx));
            float den = 0.f;
#pragma unroll
            for (int i = 0; i < 4; ++i) { u[i] = __expf(u[i] - mx); den += u[i]; }
            den = swap16_sum(den, den); den = swap32_sum(den, den);
            const float inv = 1.0f / den;
            const int i4 = lane & 3, e = 4 * (lane >> 4) + i4;
            const float mine = (i4 == 0 ? u[0] : i4 == 1 ? u[1] : i4 == 2 ? u[2] : u[3]) * inv;
            const int m = m0 + r;
            if ((lane & 15) < 4) { float* dst = m < NP ? AFFT + (size_t)e * NP + m : AFFT + (size_t)NE * NP + (size_t)e * NS + (m - NP); *dst = mine; }
        }
    }
}

constexpr size_t SEL_ALT = WS_R1 + 900 * MiB - WS_SLOT;
__device__ __forceinline__ void select_slow(const Args& A, const Frame& F, int task, size_t alt = 0) {
    const int grp = task >> 4, e = task & 15, n = grp ? NS : NP, cap = n >> 3;
    const unsigned* keys = (const unsigned*)(grp ? WSP(float, WS_AFFT) + (size_t)NE * NP + (size_t)e * NS : WSP(float, WS_AFFT) + (size_t)e * NP);
    const int tokbase = grp ? NP : 0, slotbase = grp ? NE * (NP >> 3) + e * cap : e * cap;
    int* SLOT = WSP(int, WS_SLOT + alt); int* IDX = WSP(int, WS_IDX + alt); float* GVAL = WSP(float, WS_GVAL + alt);
    LAS unsigned* hist = (LAS unsigned*)(F.lds + RING_OFF);
    LAS unsigned* wsum = hist + 2048;
    LAS unsigned* bc = hist + 2048 + 64;
    const int tid = F.tid, lane = F.lane, wid = F.wave;
    unsigned prefix = 0u, pmask = 0u, k = (unsigned)cap;
#pragma unroll 1
    for (int pass = 0; pass < 3; ++pass) {
        const int shift = pass == 0 ? 21 : (pass == 1 ? 10 : 0);
        const unsigned dmask = pass == 2 ? 1023u : 2047u;
        for (int i = tid; i < 2048; i += NWAVES * 64) hist[i] = 0u;
        __syncthreads();
        for (int i = tid; i < n; i += NWAVES * 64) { const unsigned key = keys[i]; if ((key & pmask) == prefix) __hip_atomic_fetch_add(&hist[(key >> shift) & dmask], 1u, __ATOMIC_RELAXED, __HIP_MEMORY_SCOPE_WORKGROUP); }
        __syncthreads();
        const unsigned c0 = hist[4 * tid], c1 = hist[4 * tid + 1], c2 = hist[4 * tid + 2], c3 = hist[4 * tid + 3];
        const unsigned tsum = c0 + c1 + c2 + c3;
        unsigned inc = tsum;
#pragma unroll
        for (int o = 1; o < 64; o <<= 1) { const unsigned t2 = __shfl_down(inc, o); if (lane + o < 64) inc += t2; }
        if (lane == 0) wsum[wid] = inc;
        __syncthreads();
        unsigned above = inc - tsum;
        for (int w = wid + 1; w < NWAVES; ++w) above += wsum[w];
        unsigned a = above;
        if (a < k && a + c3 >= k) { bc[0] = 4 * tid + 3; bc[1] = k - a; } a += c3;
        if (a < k && a + c2 >= k) { bc[0] = 4 * tid + 2; bc[1] = k - a; } a += c2;
        if (a < k && a + c1 >= k) { bc[0] = 4 * tid + 1; bc[1] = k - a; } a += c1;
        if (a < k && a + c0 >= k) { bc[0] = 4 * tid + 0; bc[1] = k - a; }
        __syncthreads();
        const unsigned bin = bc[0]; k = bc[1];
        prefix |= bin << shift; pmask |= dmask << shift;
        __syncthreads();
    }
    const unsigned thr = prefix, need = k;
    const unsigned cnt_gt = (unsigned)cap - need;
    unsigned base_gt = 0u, base_eq = 0u;
    const unsigned long long lt_mask = (1ull << lane) - 1ull;
#pragma unroll 1
    for (int base = 0, it = 0; base < n; base += NWAVES * 64, ++it) {
        const unsigned key = keys[base + tid];
        const bool gt = key > thr, eq = key == thr;
        const unsigned long long bg = __ballot(gt), be = __ballot(eq);
        LAS unsigned* ws = wsum + 16 + (it & 1) * 16;
        if (lane == 0) { ws[wid] = (unsigned)__popcll(bg); ws[8 + wid] = (unsigned)__popcll(be); }
        __syncthreads();
        unsigned og = 0u, oe = 0u, tg = 0u, te = 0u;
#pragma unroll
        for (int w = 0; w < NWAVES; ++w) { const unsigned a = ws[w], b = ws[8 + w]; if (w < wid) { og += a; oe += b; } tg += a; te += b; }
        const unsigned rg = base_gt + og + (unsigned)__popcll(bg & lt_mask), re = base_eq + oe + (unsigned)__popcll(be & lt_mask);
        int srow = -1;
        if (gt) srow = slotbase + (int)rg;
        else if (eq && re < need) srow = slotbase + (int)(cnt_gt + re);
        const int tok = tokbase + base + tid;
        SLOT[(size_t)tok * NE + e] = srow;
        if (srow >= 0) { IDX[srow] = tok; GVAL[srow] = __uint_as_float(key); }
        base_gt += tg; base_eq += te;
    }
    __syncthreads();
}

constexpr int SEL_LISTCAP = 2048;
#define SEL_BIN(kk) ({ int b_ = (int)(__uint_as_float(kk) * 2048.0f); b_ = b_ > 2047 ? 2047 : b_; b_; })
#define SEL_LOAD64(hb) _Pragma("unroll") for (int i = 0; i < 64; ++i) key[i] = (unsigned)__builtin_amdgcn_raw_buffer_load_b32(krs, tid * 4, ((hb) * 64 + i) * 2048, 0)
template <int NH  > __device__ __forceinline__ bool select_fast(const Args& A, const Frame& F, int task, size_t alt = 0) {
    const int grp = task >> 4, e = task & 15, cap = NH * 64 * 64;
    const unsigned* keys = (const unsigned*)(grp ? WSP(float, WS_AFFT) + (size_t)NE * NP + (size_t)e * NS : WSP(float, WS_AFFT) + (size_t)e * NP);
    const int tokbase = grp ? NP : 0, slotbase = grp ? NE * (NP >> 3) + e * cap : e * cap;
    GAS int* SLOT = (GAS int*)WSP(int, WS_SLOT + alt); GAS int* IDX = (GAS int*)WSP(int, WS_IDX + alt); GAS float* GVAL = (GAS float*)WSP(float, WS_GVAL + alt);
    LAS unsigned* hist = (LAS unsigned*)(F.lds + RING_OFF);
    LAS unsigned* wsum = hist + 2048;
    LAS unsigned* bc = hist + 2048 + 64;
    LAS unsigned* lkey = hist + 4096;
    LAS unsigned* lidx = lkey + SEL_LISTCAP;
    LAS unsigned* tabc = lidx + SEL_LISTCAP;
    const int tid = F.tid, lane = F.lane, wid = F.wave;
    const __amdgpu_buffer_rsrc_t krs = __builtin_amdgcn_make_buffer_rsrc((void*)keys, 0, NH * 64 * 512 * 4, 0x00020000);
    unsigned key[64];
    for (int i = tid; i < 2048; i += NWAVES * 64) hist[i] = 0u;
    if (tid == 0) bc[2] = 0u;
    __syncthreads();
#pragma unroll 1
    for (int hb = 0; hb < NH; ++hb) {
        SEL_LOAD64(hb);
#pragma unroll
        for (int i = 0; i < 64; ++i) __hip_atomic_fetch_add(&hist[SEL_BIN(key[i])], 1u, __ATOMIC_RELAXED, __HIP_MEMORY_SCOPE_WORKGROUP);
    }
    __syncthreads();
    {
        const unsigned c0 = hist[4 * tid], c1 = hist[4 * tid + 1], c2 = hist[4 * tid + 2], c3 = hist[4 * tid + 3];
        const unsigned tsum = c0 + c1 + c2 + c3, k = (unsigned)cap;
        unsigned inc = tsum;
#pragma unroll
        for (int o = 1; o < 64; o <<= 1) { const unsigned t2 = __shfl_down(inc, o); if (lane + o < 64) inc += t2; }
        if (lane == 0) wsum[wid] = inc;
        __syncthreads();
        unsigned a = inc - tsum;
        for (int w = wid + 1; w < NWAVES; ++w) a += wsum[w];
        if (a < k && a + c3 >= k) { bc[0] = 4 * tid + 3; bc[1] = k - a; bc[3] = c3; } a += c3;
        if (a < k && a + c2 >= k) { bc[0] = 4 * tid + 2; bc[1] = k - a; bc[3] = c2; } a += c2;
        if (a < k && a + c1 >= k) { bc[0] = 4 * tid + 1; bc[1] = k - a; bc[3] = c1; } a += c1;
        if (a < k && a + c0 >= k) { bc[0] = 4 * tid + 0; bc[1] = k - a; bc[3] = c0; }
        __syncthreads();
    }
    const int tbin = (int)bc[0]; const unsigned kin = bc[1], m = bc[3];
    if (m > (unsigned)SEL_LISTCAP) return false;
#pragma unroll 1
    for (int hb = 0; hb < NH; ++hb) {
        SEL_LOAD64(hb);
#pragma unroll
        for (int i = 0; i < 64; ++i) if (SEL_BIN(key[i]) == tbin) { const unsigned p = __hip_atomic_fetch_add(&bc[2], 1u, __ATOMIC_RELAXED, __HIP_MEMORY_SCOPE_WORKGROUP); lkey[p] = key[i]; lidx[p] = (unsigned)((hb * 64 + i) * 512 + tid); }
    }
    __syncthreads();
    for (unsigned p = tid; p < m; p += NWAVES * 64) {
        const unsigned kp = lkey[p], ip = lidx[p]; unsigned rank = 0u;
        for (unsigned q = 0; q < m; ++q) { const unsigned kq = lkey[q], iq = lidx[q]; rank += (kq > kp || (kq == kp && iq < ip)) ? 1u : 0u; }
        if (rank == kin - 1u) { bc[4] = kp; bc[5] = ip; }
    }
    __syncthreads();
    const unsigned tkey = bc[4], tidx = bc[5];
    const unsigned long long lt_mask = (1ull << lane) - 1ull;
#pragma unroll 1
    for (int hb = 0; hb < NH; ++hb) {
        SEL_LOAD64(hb);
#pragma unroll
        for (int i = 0; i < 64; ++i) {
            const int b = SEL_BIN(key[i]); const unsigned ti = (unsigned)((hb * 64 + i) * 512 + tid);
            const bool sel = b > tbin || (b == tbin && (key[i] > tkey || (key[i] == tkey && ti <= tidx)));
            const unsigned long long bal = __ballot(sel);
            if (lane == 0) tabc[(hb * 64 + i) * 8 + wid] = (unsigned)__popcll(bal);
            if ((i & 7) == 7) __builtin_amdgcn_sched_barrier(0);
        }
    }
    __syncthreads();
    {
        unsigned v[NH], s = 0u;
#pragma unroll
        for (int q = 0; q < NH; ++q) { v[q] = tabc[NH * tid + q]; s += v[q]; }
        unsigned inc = s;
#pragma unroll
        for (int o = 1; o < 64; o <<= 1) { const unsigned t2 = __shfl_up(inc, o); if (lane >= o) inc += t2; }
        if (lane == 63) wsum[wid] = inc;
        __syncthreads();
        unsigned base = inc - s;
        for (int w = 0; w < wid; ++w) base += wsum[w];
#pragma unroll
        for (int q = 0; q < NH; ++q) { tabc[NH * tid + q] = base; base += v[q]; }
        __syncthreads();
    }
#pragma unroll 1
    for (int hb = 0; hb < NH; ++hb) {
        SEL_LOAD64(hb);
#pragma unroll
        for (int i = 0; i < 64; ++i) {
            const int b = SEL_BIN(key[i]); const unsigned ti = (unsigned)((hb * 64 + i) * 512 + tid);
            const bool sel = b > tbin || (b == tbin && (key[i] > tkey || (key[i] == tkey && ti <= tidx)));
            const unsigned long long bal = __ballot(sel);
            const int tok = tokbase + (hb * 64 + i) * 512 + tid;
            int srow = -1;
            if (sel) srow = slotbase + (int)(tabc[(hb * 64 + i) * 8 + wid] + (unsigned)__popcll(bal & lt_mask));
            SLOT[(size_t)tok * NE + e] = srow;
            if (sel) { IDX[srow] = tok; GVAL[srow] = __uint_as_float(key[i]); }
            if ((i & 7) == 7) __builtin_amdgcn_sched_barrier(0);
        }
    }
    __syncthreads();
    return true;
}
#undef SEL_BIN
#undef SEL_LOAD64
__device__ __forceinline__ void phase_select(const Args& A, const Frame& F0, size_t alt = 0) {
    const Frame F = fresh_frame(F0);
    const int task = blockIdx.x;
    if (task >= 2 * NE) return;
    const bool ok = (task >> 4) ? select_fast<NS / 32768>(A, F, task, alt) : select_fast<NP / 32768>(A, F, task, alt);
    if (!ok) { __syncthreads(); select_slow(A, F, task, alt); }
}

__device__ __forceinline__ void phase_gather(const Args& A, const Frame& F0) {
    const Frame F = fresh_frame(F0);
    const int gw = F.vcu * NWAVES + F.wave, NGW = F.G * NWAVES, lane = F.lane;
    const int* IDX = WSP(int, WS_IDX);
#pragma unroll 1
    for (int s = gw; s < NSLOTROWS; s += NGW) {
        const int tok = IDX[s];
        const GAS v4u* src = (const GAS v4u*)(WSP(bf16, WS_XB) + (size_t)tok * DM);
        GAS v4u* dst = (GAS v4u*)(WSP(bf16, WS_XG) + (size_t)s * DM);
        const v4u a = src[lane], b = src[lane + 64];
        dst[lane] = a; dst[lane + 64] = b;
    }
}

template <bool DRY> __device__ __forceinline__ void phase_ln2(const Args& A, const Frame& F0, int layer) {
    static_assert(FP8_YE, "the pipelined combine reads e4m3 expert rows");
    const Frame F = fresh_frame(F0);
    const int gw = F.vcu * NWAVES + F.wave, NGW = F.G * NWAVES, lane = F.lane;
    const GAS f32x4* gp = (const GAS f32x4*)(A.in[I_L2G] + (size_t)layer * DM) + lane;
    const GAS f32x4* bp = (const GAS f32x4*)(A.in[I_L2B] + (size_t)layer * DM) + lane;
    XIN_BASES();
    const int* SLOT = WSP(int, WS_SLOT); const float* GVAL = WSP(float, WS_GVAL);
    const unsigned char* YE = WSP(unsigned char, WS_YE);
    float* XO = DRY ? WSP(float, WS_R1) : A.out; bf16* XBO = DRY ? WSP(bf16, WS_Z + 201326592) : WSP(bf16, WS_XB);
    const GAS f32x4* g1p = (const GAS f32x4*)(A.in[I_L1G] + (size_t)layer * DM) + lane;
    const GAS f32x4* b1p = (const GAS f32x4*)(A.in[I_L1B] + (size_t)layer * DM) + lane;
    f32x4 g1[4], b1[4];
#pragma unroll
    for (int j = 0; j < 4; ++j) { g1[j] = g1p[64 * j]; b1[j] = b1p[64 * j]; }
    typedef float f32x2s __attribute__((ext_vector_type(2)));
    const GAS f32x2s* STATS = (const GAS f32x2s*)WSP(float, WS_STATS);
#define LN2_DECODE(sv_, gvl_, srow_, gv_, rest_) do { unsigned long long mk_ = __ballot((sv_) >= 0); \
        _Pragma("unroll") for (int b = 0; b < 4; ++b) { if (mk_) { const int e_ = __builtin_ctzll(mk_); mk_ &= mk_ - 1ull; srow_[b] = __builtin_amdgcn_readlane((sv_), e_); \
            gv_[b] = __builtin_bit_cast(float, __builtin_amdgcn_readlane(__builtin_bit_cast(int, (gvl_)), e_)); } else { srow_[b] = -1; gv_[b] = 0.f; } } rest_ = mk_; } while (0)
#define LN2_LOADROW(m_, y_, wb_, srow_) do { const GAS f32x4* xr_ = (const GAS f32x4*)XIN_ROW(m_) + lane; \
        _Pragma("unroll") for (int j = 0; j < 4; ++j) y_[j] = __builtin_nontemporal_load(&xr_[64 * j]);     \
        if (FP8_MIX) { const GAS unsigned* ms_ = (const GAS unsigned*)(WSP(unsigned char, WS_MIX8) + (size_t)(m_) * DM) + lane; _Pragma("unroll") for (int j = 0; j < 4; ++j) y_##mx[j] = ms_[64 * j]; } \
        _Pragma("unroll") for (int b = 0; b < 4; ++b) { if (srow_[b] >= 0) { const GAS unsigned* yr_ = (const GAS unsigned*)(YE + (size_t)srow_[b] * DM) + lane; \
            _Pragma("unroll") for (int j = 0; j < 4; ++j) wb_[b][j] = yr_[64 * j]; } else { _Pragma("unroll") for (int j = 0; j < 4; ++j) wb_[b][j] = 0u; } } } while (0)
    int svC = -1; float gvlC = 0.f; f32x2s stC = (f32x2s){0.f, 1.f};
    if (gw < NTOK) { svC = lane < NE ? SLOT[(size_t)gw * NE + lane] : -1; gvlC = svC >= 0 ? GVAL[svC] : 0.f; stC = STATS[gw]; }
    int svB = -1; float gvlB = 0.f; f32x2s stB = (f32x2s){0.f, 1.f};
    if (gw + NGW < NTOK) { svB = lane < NE ? SLOT[(size_t)(gw + NGW) * NE + lane] : -1; gvlB = svB >= 0 ? GVAL[svB] : 0.f; stB = STATS[gw + NGW]; }
    int srowC[4]; float gvC[4]; unsigned long long restC; f32x4 yC[4]; unsigned wbC[4][4]; unsigned yCmx[4] = {0u, 0u, 0u, 0u};
    LN2_DECODE(svC, gvlC, srowC, gvC, restC);
    if (gw < NTOK) LN2_LOADROW(gw, yC, wbC, srowC);
#pragma unroll 1
    for (int m = gw; m < NTOK; m += NGW) {
        const int m2 = m + NGW, m3 = m + 2 * NGW;
        int srowN[4]; float gvN[4]; unsigned long long restN; f32x4 yN[4]; unsigned wbN[4][4]; unsigned yNmx[4] = {0u, 0u, 0u, 0u};
        LN2_DECODE(svB, gvlB, srowN, gvN, restN);
        if (m2 < NTOK) LN2_LOADROW(m2, yN, wbN, srowN);
        int svNN = -1; f32x2s stNN = (f32x2s){0.f, 1.f};
        if (m3 < NTOK) { svNN = lane < NE ? SLOT[(size_t)m3 * NE + lane] : -1; stNN = STATS[m3]; }
        f32x4 v[4];
#pragma unroll
        for (int j = 0; j < 4; ++j) { f32x4 y = yC[j];
            if (FP8_MIX) { const f32x2s lo = __builtin_amdgcn_cvt_pk_f32_fp8((int)yCmx[j], false), hi = __builtin_amdgcn_cvt_pk_f32_fp8((int)yCmx[j], true);
                y.x = __builtin_fmaf(y.x, DN_ALPHA, lo.x); y.y = __builtin_fmaf(y.y, DN_ALPHA, lo.y); y.z = __builtin_fmaf(y.z, DN_ALPHA, hi.x); y.w = __builtin_fmaf(y.w, DN_ALPHA, hi.y); }
            v[j] = (((y - stC.x) * stC.y) * g1[j] + b1[j]) * DN_ALPHA; }
#pragma unroll
        for (int b = 0; b < 4; ++b)
#pragma unroll
            for (int j = 0; j < 4; ++j) { const f32x2s lo = __builtin_amdgcn_cvt_pk_f32_fp8((int)wbC[b][j], false), hi = __builtin_amdgcn_cvt_pk_f32_fp8((int)wbC[b][j], true);
                v[j].x += gvC[b] * lo.x; v[j].y += gvC[b] * lo.y; v[j].z += gvC[b] * hi.x; v[j].w += gvC[b] * hi.y; }
        while (restC) {
            const int e = __builtin_ctzll(restC); restC &= restC - 1ull;
            const int sr = __builtin_amdgcn_readlane(svC, e); const float ge = __builtin_bit_cast(float, __builtin_amdgcn_readlane(__builtin_bit_cast(int, gvlC), e));
            const GAS unsigned* yr = (const GAS unsigned*)(YE + (size_t)sr * DM) + lane;
            unsigned w1[4];
#pragma unroll
            for (int j = 0; j < 4; ++j) w1[j] = yr[64 * j];
#pragma unroll
            for (int j = 0; j < 4; ++j) { const f32x2s lo = __builtin_amdgcn_cvt_pk_f32_fp8((int)w1[j], false), hi = __builtin_amdgcn_cvt_pk_f32_fp8((int)w1[j], true);
                v[j].x += ge * lo.x; v[j].y += ge * lo.y; v[j].z += ge * hi.x; v[j].w += ge * hi.y; }
        }
        float s = 0.f;
#pragma unroll
        for (int j = 0; j < 4; ++j) s += (v[j].x + v[j].y) + (v[j].z + v[j].w);
        const float mean = wave_sum_x(s) * (1.f / DM); float s2 = 0.f;
#pragma unroll
        for (int j = 0; j < 4; ++j) { v[j] = v[j] - mean; s2 += (v[j].x * v[j].x + v[j].y * v[j].y) + (v[j].z * v[j].z + v[j].w * v[j].w); }
        const float rstd = 1.f / sqrtf(wave_sum_x(s2) * (1.f / DM) + LN_EPS);
        GAS v2u* bo = (GAS v2u*)(XBO + (size_t)m * DM) + lane; GAS f32x4* xw = (GAS f32x4*)(XO + (size_t)m * DM) + lane;
#pragma unroll
        for (int j = 0; j < 4; ++j) { v[j] = v[j] * rstd * gp[64 * j] + bp[64 * j]; __builtin_nontemporal_store(v[j], &xw[64 * j]);
            if (FP8_G1) { if (!DRY && layer + 1 < DEPTH) ((GAS unsigned*)(WSP(unsigned char, WS_XB8) + (size_t)m * DM))[lane + 64 * j] = pg8::pack4_fp8(v[j].x, v[j].y, v[j].z, v[j].w); }
            else { v2u w2; w2.x = pk2(v[j].x, v[j].y); w2.y = pk2(v[j].z, v[j].w); bo[64 * j] = w2; } }
        float gvlNN = svNN >= 0 ? GVAL[svNN] : 0.f;
        __builtin_amdgcn_sched_barrier(0);
        svC = svB; gvlC = gvlB; stC = stB; restC = restN;
#pragma unroll
        for (int b = 0; b < 4; ++b) { srowC[b] = srowN[b]; gvC[b] = gvN[b];
#pragma unroll
            for (int j = 0; j < 4; ++j) wbC[b][j] = wbN[b][j]; }
#pragma unroll
        for (int j = 0; j < 4; ++j) { yC[j] = yN[j]; yCmx[j] = yNmx[j]; }
        svB = svNN; gvlB = gvlNN; stB = stNN;
    }
#undef LN2_DECODE
#undef LN2_LOADROW
}

__device__ __forceinline__ bool gqa_next(int i, int vcu, int G, long& qrow0, long& kvrow0, int& NT, int& h) {
    const long U = (long)i * G + vcu;
    if (U >= 3072) return false;
    if (U < 2048) { const int ii = (int)(U >> 8), v = (int)(U & 255), xcd = v >> 5, cu = v & 31;
        const int pair = 2 * xcd + (ii >> 2), b = pair >> 1, kvh = pair & 1; h = kvh * 4 + (ii & 3);
        kvrow0 = (long)NP + (long)b * SEQ_S; qrow0 = kvrow0 + 256 * cu; NT = SEQ_S / 64; }
    else { const int U2 = (int)(U - 2048), jj = U2 >> 8, v = U2 & 255, xcd = v >> 5, cu = v & 31;
        const int pair = 2 * xcd + (jj >> 1), b = pair >> 1, kvh = pair & 1; h = kvh * 4 + (jj & 1) * 2 + (cu >> 4);
        kvrow0 = (long)b * SEQ_P; qrow0 = kvrow0 + 256 * (cu & 15); NT = SEQ_P / 64; }
    return true;
}

__global__ void __launch_bounds__(NWAVES * 64, 2) trunk_fwd(Args A) {
    extern __shared__ __attribute__((aligned(16))) unsigned char lds[];
    Frame F;
    F.lds = (LAS unsigned char*)lds;
    F.tid = threadIdx.x; F.lane = F.tid & 63; F.wave = __builtin_amdgcn_readfirstlane(F.tid >> 6);
    F.G = gridDim.x; { const int bx = blockIdx.x; F.vcu = (F.G % 8 == 0) ? (bx % 8) * (F.G / 8) + bx / 8 : bx; }
#ifdef ZERO_ALL_LDS
    for (int u = F.tid; u < LDS_BYTES / 4; u += NWAVES * 64) ((LAS unsigned*)(F.lds))[u] = 0u;
#else
    for (int u = F.tid; u < (LDS_BYTES - LDSCTL_OFF) / 4; u += NWAVES * 64) ((LAS unsigned*)(F.lds + LDSCTL_OFF))[u] = 0u;
#endif
    __syncthreads();
    unsigned* barw = (unsigned*)(A.ws + WS_CTL) + CW_BAR;
    XcdBarrier bar; bar.bar = barw; bar.x = 0; bar.st = nullptr;
    if (N_LAUNCHES == 1) bar = xcd_barrier_post(barw, (volatile LAS unsigned*)(F.lds + MISC_OFF) + 8);

    const int lo = A.ph_lo, hi = A.ph_hi;
#ifdef TOUCH_PAGES
    { unsigned acc_ = 0u; const size_t gt_ = (size_t)blockIdx.x * 512 + threadIdx.x, NT_ = (size_t)gridDim.x * 512;
      for (size_t pg = gt_; pg < WS_END / 4096; pg += NT_) acc_ += *(const GAS unsigned*)(A.ws + pg * 4096);
      for (size_t pg = gt_; pg < (size_t)NTOK * DM * 4 / 4096; pg += NT_) acc_ += *(const GAS unsigned*)((const char*)A.out + pg * 4096);
      for (int k_ = 0; k_ < 17; ++k_) { const size_t nb_ = k_ < 2 ? (size_t)(k_ ? NS : NP) * DM * 4 : (k_ == I_WG || k_ == I_WU || k_ == I_WD) ? (size_t)DEPTH * NE * DM * DF * 4 : (k_ == I_WIN ? (size_t)DEPTH * DM * D_IN * 4 : (size_t)4096);
          for (size_t pg = gt_; pg < nb_ / 4096; pg += NT_) acc_ += *(const GAS unsigned*)((const char*)A.in[k_] + pg * 4096); }
      asm volatile("" :: "v"(acc_)); }
#endif
#define IN(k) (lo <= (k) && (k) < hi)
#ifndef PHASE_MASK
#define PHASE_MASK 0xFFF
#endif
#define PHON(p) (((PHASE_MASK) >> (p)) & 1)
#ifdef XB_DOUBLE
#define SEAM(k) do { if (N_LAUNCHES == 1) { if (IN((k) + 1)) { xcd_barrier(bar); xcd_barrier(bar); } } } while (0)
#else
#define SEAM(k) do { if (N_LAUNCHES == 1) { if (IN((k) + 1)) xcd_barrier(bar); } } while (0)
#endif
#define DET_COMPARE(offA, offB, nbytes) do { xcd_barrier(bar); const Frame F2 = fresh_frame(F); const size_t gt = (size_t)(F2.vcu * NWAVES + F2.wave) * 64 + F2.lane, NT_ = (size_t)F2.G * NWAVES * 64; unsigned bad = 0u; \
        for (size_t q = gt; q < (size_t)(nbytes) / 16; q += NT_) { const v4u a = ((const GAS v4u*)(A.ws + (offA)))[q], b = ((const GAS v4u*)(A.ws + (offB)))[q]; bad |= (a.x ^ b.x) | (a.y ^ b.y) | (a.z ^ b.z) | (a.w ^ b.w); } \
        if (bad) __hip_atomic_fetch_add((unsigned*)(A.ws + WS_CTL) + 8, 1u, __ATOMIC_RELAXED, __HIP_MEMORY_SCOPE_AGENT); } while (0)

#pragma unroll 1
    for (int layer = 0; layer < DEPTH; ++layer) {
        const int P0 = layer * PH_PER_LAYER;
        if (PHON(0) && IN(P0 + 0) && (layer == 0 || N_LAUNCHES != 1)) { phase_conv<0>(A, F, layer, F.vcu * NWAVES + F.wave, F.G * NWAVES); SEAM(P0 + 0); }
        if (PHON(1) && IN(P0 + 1)) {
            pg8::Gemm g{FP8_G1 ? WSP(bf16, WS_XB8) : WSP(bf16, WS_XB), WSP(bf16, WS_WIN), NTOK, D_IN, FP8_G1 ? DM / 2 : DM}; pg8::TileOrder<0> S; S.init(NTOK / 256, D_IN / 256, F.G, (int)blockIdx.x);
#if ROPE_FUSED
            pg8::EpiProjRope E{WSP(bf16, WS_NAQKV), WSP(bf16, WS_QKVB), WSP(unsigned char, WS_GATES), A.in[I_QN] + layer * 64, A.in[I_KN] + layer * 64, (PG8_LAS float*)(F.lds + LDSCTL_OFF + 512), QSCALE, FP8_G1 ? 1.0f / WIN_SCALE : 1.0f};
            for (int rep_ = 0; rep_ < NREP(1); ++rep_) pg8::gemm_phase<pg8::EpiProjRope, pg8::TileOrder<0>, true, true, FP8_G1 != 0>(F.lds + RING_OFF, g, S, E);
#else
            pg8::EpiProj E{WSP(bf16, WS_NAQKV), WSP(bf16, WS_RAWQK), WSP(unsigned char, WS_GATES), QSCALE, FP8_G1 ? 1.0f / WIN_SCALE : 1.0f};
            for (int rep_ = 0; rep_ < NREP(1); ++rep_) pg8::gemm_phase<pg8::EpiProj, pg8::TileOrder<0>, true, true, FP8_G1 != 0>(F.lds + RING_OFF, g, S, E);
#endif
#if defined(DETPROBE) && (DETPROBE & (1 << 1))
            { pg8::EpiProj E2{WSP(bf16, WS_R2), WSP(bf16, WS_R2 + (size_t)NTOK * 1536 * 2), WSP(unsigned char, WS_GATES), QSCALE, FP8_G1 ? 1.0f / WIN_SCALE : 1.0f};
              pg8::gemm_phase<pg8::EpiProj, pg8::TileOrder<0>, true, true, FP8_G1 != 0>(F.lds + RING_OFF, g, S, E2); }
            DET_COMPARE(WS_NAQKV, WS_R2, (size_t)NTOK * 1536 * 2 + (size_t)NTOK * 768 * 4);
#endif
            SEAM(P0 + 1);
        }
        if (PHON(2) && IN(P0 + 2)) { phase_na(A, F, layer);
#if defined(DETPROBE) && (DETPROBE & (1 << 2))
            xcd_barrier(bar);
            { const Frame F2 = fresh_frame(F); const int gw = F2.vcu * NWAVES + F2.wave, NGW = F2.G * NWAVES; unsigned bad = 0u;
              for (int m = gw; m < NTOK; m += NGW) { const v4u a = ((const GAS v4u*)(WSP(bf16, WS_ATT) + (size_t)m * 512))[F2.lane], b = ((const GAS v4u*)(WSP(bf16, WS_Z) + (size_t)m * 512))[F2.lane];
                  bad |= (a.x ^ b.x) | (a.y ^ b.y) | (a.z ^ b.z) | (a.w ^ b.w); }
              if (bad) __hip_atomic_fetch_add((unsigned*)(A.ws + WS_CTL) + 8, 1u, __ATOMIC_RELAXED, __HIP_MEMORY_SCOPE_AGENT); }
#endif
            if (!ROPE_FUSED) SEAM(P0 + 2); }
        if (PHON(3) && IN(P0 + 3)) {
            const attn_body::bf16* QKV = (const attn_body::bf16*)WSP(bf16, WS_QKVB); const unsigned char* QKV8 = WSP(unsigned char, WS_QKVB);
            long qrow0, kvrow0; int NT, h;
            float gb; { const Frame F2 = fresh_frame(F); float gq_ = fabsf(A.in[I_QN][layer * 64 + F2.lane]), gk_ = fabsf(A.in[I_KN][layer * 64 + F2.lane]);
#pragma unroll
                for (int o_ = 32; o_ >= 1; o_ >>= 1) { gq_ = fmaxf(gq_, __shfl_xor(gq_, o_)); gk_ = fmaxf(gk_, __shfl_xor(gk_, o_)); }
                gb = __builtin_amdgcn_readfirstlane(gq_ * gk_ * (8.0f * 1.4426950408889634f * 1.01f)); }
            for (int rep_ = 0; rep_ < NREP(3); ++rep_)
            if (gb < 64.0f) {
            for (int i = 0; gqa_next(i, F.vcu, F.G, qrow0, kvrow0, NT, h); ++i)
                attn_body::attn_unit<8, true, FP8_BR != 0, FP8_QK != 0>(qrow0, kvrow0, NT, FP8_QK ? (const attn_body::bf16*)(QKV8 + h * 64) : QKV + h * 64, FP8_QK ? (const attn_body::bf16*)(QKV8 + 512 + (h >> 2) * 64) : QKV + 512 + (h >> 2) * 64, FP8_QK ? (const attn_body::bf16*)(QKV8 + 640) + (h >> 2) * 64 : QKV + 640 + (h >> 2) * 64,
                                        FP8_BR ? (attn_body::bf16*)(WSP(unsigned char, WS_ATT) + (size_t)NTOK * 512 + h * 64) : (attn_body::bf16*)WSP(bf16, WS_ATT) + (size_t)NTOK * 512 + h * 64, (char*)lds + RING_OFF);
            } else {
            for (int i = 0; gqa_next(i, F.vcu, F.G, qrow0, kvrow0, NT, h); ++i)
                attn_body::attn_unit<8, false, FP8_BR != 0, FP8_QK != 0>(qrow0, kvrow0, NT, FP8_QK ? (const attn_body::bf16*)(QKV8 + h * 64) : QKV + h * 64, FP8_QK ? (const attn_body::bf16*)(QKV8 + 512 + (h >> 2) * 64) : QKV + 512 + (h >> 2) * 64, FP8_QK ? (const attn_body::bf16*)(QKV8 + 640) + (h >> 2) * 64 : QKV + 640 + (h >> 2) * 64,
                                        FP8_BR ? (attn_body::bf16*)(WSP(unsigned char, WS_ATT) + (size_t)NTOK * 512 + h * 64) : (attn_body::bf16*)WSP(bf16, WS_ATT) + (size_t)NTOK * 512 + h * 64, (char*)lds + RING_OFF);
            }
#if defined(DETPROBE) && (DETPROBE & (1 << 3))
            for (int i = 0; gqa_next(i, F.vcu, F.G, qrow0, kvrow0, NT, h); ++i)
                attn_body::attn_unit<8>(qrow0, kvrow0, NT, QKV + h * 64, QKV + 512 + (h >> 2) * 64, QKV + 640 + (h >> 2) * 64,
                                        (attn_body::bf16*)WSP(bf16, WS_Z) + h * 64, (char*)lds + RING_OFF);
            xcd_barrier(bar);
            { const Frame F2 = fresh_frame(F); const int gw = F2.vcu * NWAVES + F2.wave, NGW = F2.G * NWAVES; unsigned bad = 0u;
              for (int m = gw; m < NTOK; m += NGW) { const v4u a = ((const GAS v4u*)(WSP(bf16, WS_ATT) + (size_t)NTOK * 512 + (size_t)m * 512))[F2.lane], b = ((const GAS v4u*)(WSP(bf16, WS_Z) + (size_t)m * 512))[F2.lane];
                  bad |= (a.x ^ b.x) | (a.y ^ b.y) | (a.z ^ b.z) | (a.w ^ b.w); }
              if (bad) __hip_atomic_fetch_add((unsigned*)(A.ws + WS_CTL) + 8, 1u, __ATOMIC_RELAXED, __HIP_MEMORY_SCOPE_AGENT); }
#endif
            SEAM(P0 + 3);
        }
        if (PHON(4) && IN(P0 + 4)) {
            pg8::Gemm g{WSP(bf16, WS_ATT), WSP(bf16, WS_WBR), 2 * NTOK, 1024, FP8_BR ? 256 : 512}; pg8::TileOrder<3> S; S.init(NTOK / 256, 4, F.G, (int)blockIdx.x);
            pg8::EpiBranch E{WSP(unsigned char, WS_GATES), WSP(bf16, WS_Z), FP8_OUT ? WSP(unsigned char, WS_QKVB) : nullptr, FP8_BR ? 1.0f / (ATT_SCALE * WBR_SCALE) : 1.0f};
            for (int rep_ = 0; rep_ < NREP(4); ++rep_) pg8::gemm_phase<pg8::EpiBranch, pg8::TileOrder<3>, true, true, FP8_BR != 0>(F.lds + RING_OFF, g, S, E);
#if defined(DETPROBE) && (DETPROBE & (1 << 4))
            { pg8::EpiBranch E2{WSP(unsigned char, WS_GATES), WSP(bf16, WS_QKVB), nullptr, 1.0f}; pg8::gemm_phase<pg8::EpiBranch, pg8::TileOrder<3>, true, true>(F.lds + RING_OFF, g, S, E2); }
            DET_COMPARE(WS_Z, WS_QKVB, (size_t)NTOK * DM * 2);
#endif
            SEAM(P0 + 4);
        }
        if (PHON(5) && IN(P0 + 5)) {
            pg8::Gemm g{FP8_OUT ? WSP(bf16, WS_QKVB) : WSP(bf16, WS_Z), WSP(bf16, WS_WOUT), NTOK, DM, FP8_OUT ? DM / 2 : DM}; pg8::TileOrder<0> S; S.init(NTOK / 256, DM / 256, F.G, (int)blockIdx.x);
            pg8::EpiResid<FP8_MIX != 0> E{A.out, DN_ALPHA, FP8_OUT ? 1.0f / WOUT_SCALE : 1.0f, WSP(unsigned char, WS_MIX8)};
            for (int rep_ = 0; rep_ < NREP(5); ++rep_) pg8::gemm_phase<pg8::EpiResid<FP8_MIX != 0>, pg8::TileOrder<0>, true, true, FP8_OUT != 0>(F.lds + RING_OFF, g, S, E);
            SEAM(P0 + 5);
        }
        if (PHON(6) && IN(P0 + 6)) { if (NREP(13) > 1) { const Frame F2 = fresh_frame(F); const int gw = F2.vcu * NWAVES + F2.wave, NGW = F2.G * NWAVES, lane = F2.lane, d0 = 4 * (lane & 15);
                RopeLane L; L.gq = *(const GAS f32x4*)(A.in[I_QN] + layer * 64 + d0); L.gk = *(const GAS f32x4*)(A.in[I_KN] + layer * 64 + d0);
                for (int k = 0; k < 4; ++k) L.invf[k] = __builtin_amdgcn_exp2f(-(float)((d0 + k) & 15) * (13.287712379549449f / 16.0f));
#pragma unroll 1
                for (int m = gw; m < NTOK; m += NGW) { f32x4 v[3]; const GAS v2u* src = (const GAS v2u*)(WSP(bf16, WS_RAWQK) + (size_t)m * 768) + lane;
                    for (int j = 0; j < 3; ++j) { const v2u w_ = src[64 * j]; v[j].x = bf_lo(w_.x); v[j].y = bf_hi(w_.x); v[j].z = bf_lo(w_.y); v[j].w = bf_hi(w_.y); }
                    rope_compute<true>(A, L, v, m, lane); } }
            if (NREP(6) > 1) phase_ln1<true>(A, F, layer); phase_ln1<false>(A, F, layer);
#if defined(DETPROBE) && (DETPROBE & (1 << 6))
            DET_COMPARE(WS_AFFT, WS_R1 + 420 * MiB, (size_t)NTOK * NE * 4);
#endif
            SEAM(P0 + 6); }
        if (PHON(7) && IN(P0 + 7)) {
            for (int rep_ = 0; rep_ < NREP(7); ++rep_) {
            phase_select(A, F);
#if defined(DETPROBE) && (DETPROBE & (1 << 7))
            phase_select(A, F, SEL_ALT);
#endif
            if (F.G > 2 * NE) { if ((int)blockIdx.x >= 2 * NE) conv_experts(A, F, layer, ((int)blockIdx.x - 2 * NE) * NWAVES + F.wave, (F.G - 2 * NE) * NWAVES); }
            else conv_experts(A, F, layer, (int)blockIdx.x * NWAVES + F.wave, F.G * NWAVES);
            }
#if defined(DETPROBE) && (DETPROBE & (1 << 7))
            DET_COMPARE(WS_SLOT, WS_SLOT + SEL_ALT, (size_t)NTOK * NE * 4 + 2 * (size_t)NSLOTROWS * 4);
#endif
            SEAM(P0 + 7); }
        if (PHON(9) && IN(P0 + 9)) {
            pg8::Gemm g{FP8_E1 ? WSP(bf16, WS_XB8) : WSP(bf16, WS_XB), WSP(bf16, WS_W1), NSLOTROWS, 4096, FP8_E1 ? DM / 2 : DM}; pg8::TileOrderGather S; S.init(NSLOTROWS / 256, 16, F.G, (int)blockIdx.x); S.gidx = WSP(int, WS_IDX);
            pg8::EpiSwiGLU<FP8_E2 != 0> E{WSP(void, WS_H), FP8_E1 ? 1.0f / W1_SCALE : 1.0f};
            for (int rep_ = 0; rep_ < NREP(9); ++rep_) pg8::gemm_phase<pg8::EpiSwiGLU<FP8_E2 != 0>, pg8::TileOrderGather, true, true, FP8_E1 != 0>(F.lds + RING_OFF, g, S, E);
#if defined(DETPROBE) && (DETPROBE & (1 << 9))
            { pg8::EpiSwiGLU<FP8_E2 != 0> E2{WSP(void, WS_R1 + 448 * MiB), FP8_E1 ? 1.0f / W1_SCALE : 1.0f}; pg8::gemm_phase<pg8::EpiSwiGLU<FP8_E2 != 0>, pg8::TileOrderGather, true, true, FP8_E1 != 0>(F.lds + RING_OFF, g, S, E2); }
            DET_COMPARE(WS_H, WS_R1 + 448 * MiB, (size_t)NSLOTROWS * DF * (FP8_E2 ? 1 : 2));
#endif
            SEAM(P0 + 9);
        }
        if (PHON(10) && IN(P0 + 10)) {
            pg8::Gemm g{WSP(bf16, WS_H), WSP(bf16, WS_W2), NSLOTROWS, DM, FP8_E2 ? DF / 2 : DF}; pg8::TileOrder<2> S; S.init(NSLOTROWS / 256, 4, F.G, (int)blockIdx.x);
            pg8::EpiDown<FP8_YE != 0> E{WSP(void, WS_YE), FP8_E2 ? 1.0f / W2_SCALE : 1.0f};
            for (int rep_ = 0; rep_ < NREP(10); ++rep_) pg8::gemm_phase<pg8::EpiDown<FP8_YE != 0>, pg8::TileOrder<2>, true, true, FP8_E2 != 0>(F.lds + RING_OFF, g, S, E);
#if defined(DETPROBE) && (DETPROBE & (1 << 10))
            { pg8::EpiDown<FP8_YE != 0> E2{WSP(void, WS_R1 + 512 * MiB), FP8_E2 ? 1.0f / W2_SCALE : 1.0f}; pg8::gemm_phase<pg8::EpiDown<FP8_YE != 0>, pg8::TileOrder<2>, true, true, FP8_E2 != 0>(F.lds + RING_OFF, g, S, E2); }
            DET_COMPARE(WS_YE, WS_R1 + 512 * MiB, (size_t)NSLOTROWS * DM * 2);
#endif
            SEAM(P0 + 10);
        }
        if (PHON(11) && IN(P0 + 11)) { if (NREP(11) > 1) phase_ln2<true>(A, F, layer); phase_ln2<false>(A, F, layer);
            if (N_LAUNCHES == 1 && layer + 1 < DEPTH) phase_conv<0>(A, F, layer + 1, F.vcu * NWAVES + F.wave, F.G * NWAVES);
            SEAM(P0 + 11); }
    }
#if defined(DETPROBE)
    xcd_barrier(bar);
    if (blockIdx.x == 0 && threadIdx.x == 0 && __hip_atomic_load((unsigned*)(A.ws + WS_CTL) + 8, __ATOMIC_RELAXED, __HIP_MEMORY_SCOPE_AGENT) != 0u) A.out[0] = __builtin_nanf("");
#endif
#undef IN
#undef SEAM
}

extern "C" void kernel_launch(void* const* d_in, const int* in_sizes, int n_in, void* d_out, int out_size, void* d_ws, size_t ws_size, hipStream_t stream) {
    static int grid = 0;
    if (grid == 0) {
        if (n_in != 17 || out_size != NTOK * DM || ws_size < WS_END) { fprintf(stderr, "kernel_launch: built for 17 inputs, %d outputs, >= %zu bytes of workspace; got n_in %d, out %d, ws %zu; nothing launched\n", NTOK * DM, (size_t)WS_END, n_in, out_size, ws_size); grid = -1; return; }
        int dev = 0, cus = 0, per_cu = 0;
        if (hipGetDevice(&dev) != hipSuccess || hipDeviceGetAttribute(&cus, hipDeviceAttributeMultiprocessorCount, dev) != hipSuccess) { fprintf(stderr, "kernel_launch: hipGetDevice / hipDeviceGetAttribute failed\n"); grid = -1; return; }
        if (hipFuncSetAttribute((const void*)trunk_fwd, hipFuncAttributeMaxDynamicSharedMemorySize, LDS_BYTES) != hipSuccess) { fprintf(stderr, "kernel_launch: hipFuncSetAttribute failed\n"); grid = -1; return; }
        if (hipOccupancyMaxActiveBlocksPerMultiprocessor(&per_cu, (const void*)trunk_fwd, NWAVES * 64, LDS_BYTES) != hipSuccess || per_cu < 1)
            fprintf(stderr, "kernel_launch: note: occupancy query reports %d workgroups per CU\n", per_cu);
        (void)hipGetLastError();
        grid = cus;
    }
    if (grid < 0) return;
    if (hipMemsetAsync((char*)d_ws + WS_CTL, 0, CTL_ZERO_BYTES, stream) != hipSuccess) { fprintf(stderr, "kernel_launch: hipMemsetAsync failed\n"); return; }
#ifdef POISON_WS
    (void)hipMemsetAsync((char*)d_ws + 2 * MiB, 0xAA, WS_END - 2 * MiB, stream); (void)hipMemsetAsync(d_out, 0xAA, (size_t)NTOK * DM * 4, stream);
#endif
    Args a{};
    for (int i = 0; i < 17; ++i) a.in[i] = (const float*)d_in[i];
    a.out = (float*)d_out; a.ws = (unsigned char*)d_ws;
    for (int li = 0; li < N_LAUNCHES; ++li) {
        a.ph_lo = (N_LAUNCHES == 1) ? 0 : li; a.ph_hi = (N_LAUNCHES == 1) ? N_PHASES : li + 1;
        hipLaunchKernelGGL(trunk_fwd, dim3(grid), dim3(NWAVES * 64), LDS_BYTES, stream, a);
        const hipError_t le = hipPeekAtLastError();
        if (le != hipSuccess) { fprintf(stderr, "kernel_launch: launch %d failed: %s\n", li, hipGetErrorName(le)); break; }
    }
}
```
